# Optimizing an MI355X kernel written in HIP

```python
import math
import jax, jax.numpy as jnp
from jax import lax
import numpy as np

D_MODEL = 1024
BATCH = 32
SEQ = 2048
DEPTH = 4

CHUNK = 64
H_A = 8
DH_A = 64
D_CQ = 256
D_C = 128
H_IDX = 4
D_IDX = 64
TOPK_MAX = 256
QB_A = 32
GMLP_CHUNK = 128
G_B = 8
GMLP_WIDTH = 512
CG_B = GMLP_WIDTH // G_B
H_C = 8
DH_C = 64
QB_C = 128
QK_W_C = H_C * 2 * DH_C
N_EXPERTS = 32
TOP_K = 4
D_FF = 1024
SWIGLU_ALPHA = 1.702
SWIGLU_LIMIT = 7.0
MOE_BLOCK = 256
DN_ALPHA = (2 * DEPTH) ** 0.25
DN_BETA = (8 * DEPTH) ** -0.25
N_EVEN = (DEPTH + 1) // 2
N_ODD = DEPTH // 2
E_IN_EVEN = D_CQ + D_C + D_IDX + H_IDX + 2 * GMLP_WIDTH
MIX_EVEN = H_A * DH_A + GMLP_WIDTH
LN_EPS = 1e-5
NEG = -1e30

kernel_name = 'hybrid_dsa_gmlp_diffattn_moe_deepnorm'


def _layer_norm(x, g, b):
    xf = x.astype(jnp.float32)
    mu = jnp.mean(xf, -1, keepdims=True)
    var = jnp.mean(jnp.square(xf - mu), -1, keepdims=True)
    return ((xf - mu) * lax.rsqrt(var + LN_EPS) * g + b).astype(x.dtype)


def _rms_norm(x, g):
    xf = x.astype(jnp.float32)
    return (xf * lax.rsqrt(jnp.mean(xf * xf, -1, keepdims=True) + LN_EPS) * g).astype(x.dtype)


def _alibi_slopes(n):
    return jnp.exp2(-8.0 * jnp.arange(1, n + 1, dtype=jnp.float32) / n)


def _to_blocks(t, qb):
    b, s = t.shape[:2]
    return jnp.moveaxis(t.reshape((b, s // qb, qb) + t.shape[2:]), 1, 0)


def _from_blocks(t):
    t = jnp.moveaxis(t, 0, 1)
    return t.reshape((t.shape[0], t.shape[1] * t.shape[2]) + t.shape[3:])


def _dsa_attention(c_q, c_kv, k_idx, w_idx, w_uq, w_uk, w_uv, w_iq):
    f32 = jnp.float32
    b, s, _ = c_kv.shape
    n_sel = min(TOPK_MAX, s // 4)
    q = jnp.einsum('bsc,chd->bshd', c_q, w_uq)
    q_lat = jnp.einsum('bshd,hdc->bshc', q, w_uk)
    q_idx = jnp.einsum('bsc,chd->bshd', c_q, w_iq)
    w_idx = w_idx.astype(f32) * (H_IDX ** -0.5)
    slopes = _alibi_slopes(H_A)
    k_chunk = jnp.arange(s) // CHUNK

    def block(args):
        i, qi, ql, wi = args
        t_pos = i * QB_A + jnp.arange(QB_A)
        t_chunk = t_pos // CHUNK
        rel = jax.nn.relu(jnp.einsum('bqhd,bsd->bqhs', qi, k_idx).astype(f32) * (D_IDX ** -0.5))
        score = jnp.einsum('bqhs,bqh->bqs', rel, wi)
        score = jnp.where((k_chunk[None, :] <= t_chunk[:, None])[None], score, NEG)
        _, sel = lax.top_k(score, n_sel)
        c_sel = jax.vmap(lambda c, ix: c[ix])(c_kv, sel)
        logits = jnp.einsum('bqhc,bqkc->bqhk', ql, c_sel).astype(f32) * (DH_A ** -0.5)
        dist = jnp.abs(t_pos[None, :, None] - sel).astype(f32)
        logits = logits - slopes[None, None, :, None] * dist[:, :, None, :]
        valid = (sel // CHUNK) <= t_chunk[None, :, None]
        logits = jnp.where(valid[:, :, None, :], logits, NEG)
        p = jax.nn.softmax(logits, axis=-1).astype(c_kv.dtype)
        return jnp.einsum('bqhk,bqkc->bqhc', p, c_sel)

    o_lat = lax.map(block, (jnp.arange(s // QB_A), _to_blocks(q_idx, QB_A),
                            _to_blocks(q_lat, QB_A), _to_blocks(w_idx, QB_A)))
    o = jnp.einsum('bshc,hcd->bshd', _from_blocks(o_lat), w_uv)
    return o.reshape(b, s, H_A * DH_A)


def _spatial_gating(u, v, v_g, v_b, w_s, b_s):
    b, s, _ = u.shape
    u = jax.nn.gelu(u)
    v = _layer_norm(jax.nn.gelu(v), v_g, v_b)
    mask = jnp.tril(jnp.ones((GMLP_CHUNK, GMLP_CHUNK), dtype=bool))
    w = jnp.where(mask[None], w_s, 0.0)
    vg = v.reshape(b, s // GMLP_CHUNK, GMLP_CHUNK, G_B, CG_B)
    mixed = jnp.einsum('gij,bnjgc->bnigc', w, vg) + jnp.transpose(b_s)[None, None, :, :, None]
    return u * mixed.reshape(b, s, GMLP_WIDTH)


def _even_mixer(x, w_in, q_norm_g, kv_norm_g, w_uq, w_uk, w_uv, w_iq, idx_k_g, idx_k_b,
                v_norm_g, v_norm_b, w_s, b_s, w_out):
    proj = jnp.dot(x, w_in)
    o1 = D_CQ
    o2 = o1 + D_C
    o3 = o2 + D_IDX
    o4 = o3 + H_IDX
    o5 = o4 + GMLP_WIDTH
    c_q = _rms_norm(proj[..., :o1], q_norm_g)
    c_kv = _rms_norm(proj[..., o1:o2], kv_norm_g)
    k_idx = _layer_norm(proj[..., o2:o3], idx_k_g, idx_k_b)
    w_idx = proj[..., o3:o4]
    o_a = _dsa_attention(c_q, c_kv, k_idx, w_idx, w_uq, w_uk, w_uv, w_iq)
    o_b = _spatial_gating(proj[..., o4:o5], proj[..., o5:], v_norm_g, v_norm_b, w_s, b_s)
    return jnp.dot(jnp.concatenate([o_a, o_b], axis=-1), w_out)


def _diff_attention(x, w_in, lq1, lk1, lq2, lk2, subln_g, w_out, lam_init):
    f32 = jnp.float32
    b, s, _ = x.shape
    proj = jnp.dot(x, w_in)
    q = proj[..., :QK_W_C].reshape(b, s, H_C, 2, DH_C)
    k = proj[..., QK_W_C:2 * QK_W_C].reshape(b, s, H_C, 2, DH_C)
    v = proj[..., 2 * QK_W_C:].reshape(b, s, H_C, 2 * DH_C)
    lam = (jnp.exp(jnp.sum(lq1.astype(f32) * lk1.astype(f32)))
           - jnp.exp(jnp.sum(lq2.astype(f32) * lk2.astype(f32))) + lam_init)
    slopes = _alibi_slopes(H_C)
    k_pos = jnp.arange(s)
    k_chunk = k_pos // CHUNK

    def block(args):
        i, qb = args
        t_pos = i * QB_C + jnp.arange(QB_C)
        logits = jnp.einsum('bqhmd,bshmd->bhmqs', qb, k).astype(f32) * (DH_C ** -0.5)
        dist = jnp.abs(t_pos[:, None] - k_pos[None, :]).astype(f32)
        logits = logits - slopes[:, None, None, None] * dist
        allowed = k_chunk[None, :] <= (t_pos // CHUNK)[:, None]
        p = jax.nn.softmax(jnp.where(allowed, logits, NEG), axis=-1)
        attn = (p[:, :, 0] - lam * p[:, :, 1]).astype(v.dtype)
        return jnp.einsum('bhqs,bshe->bqhe', attn, v)

    o = _from_blocks(lax.map(block, (jnp.arange(s // QB_C), _to_blocks(q, QB_C))))
    o = _rms_norm(o, subln_g) * (1.0 - lam_init)
    return jnp.dot(o.reshape(b, s, H_C * 2 * DH_C), w_out)


def _clamped_swiglu(gu):
    gate, up = gu[..., :D_FF], gu[..., D_FF:]
    gate = jnp.minimum(gate, SWIGLU_LIMIT)
    up = jnp.clip(up, -SWIGLU_LIMIT, SWIGLU_LIMIT)
    return (up + 1.0) * (gate * jax.nn.sigmoid(gate * SWIGLU_ALPHA))


def _moe_ffn(h, router_w, router_b, w_gu, b_gu, w_dn, b_dn):
    n_tok = h.shape[0]
    logits = jnp.dot(h, router_w).astype(jnp.float32) + router_b.astype(jnp.float32)
    top_logit, top_e = lax.top_k(logits, TOP_K)
    gate = jax.nn.softmax(top_logit, axis=-1).astype(h.dtype)
    n_asg = n_tok * TOP_K
    flat_e = top_e.reshape(n_asg)
    flat_tok = jnp.arange(n_asg, dtype=jnp.int32) // TOP_K
    flat_gate = gate.reshape(n_asg)
    order = jnp.argsort(flat_e)
    sorted_e = flat_e[order]
    counts = jnp.bincount(flat_e, length=N_EXPERTS)
    padded = (counts + MOE_BLOCK - 1) // MOE_BLOCK * MOE_BLOCK
    pad_end = jnp.cumsum(padded)
    pad_start = pad_end - padded
    start = jnp.cumsum(counts) - counts
    dest = pad_start[sorted_e] + jnp.arange(n_asg, dtype=jnp.int32) - start[sorted_e]
    n_blocks = -(-n_asg // MOE_BLOCK) + N_EXPERTS
    n_rows = n_blocks * MOE_BLOCK
    row_tok = jnp.zeros((n_rows,), jnp.int32).at[dest].set(flat_tok[order])
    row_gate = jnp.zeros((n_rows,), h.dtype).at[dest].set(flat_gate[order])
    block_e = jnp.minimum(jnp.searchsorted(pad_end, jnp.arange(n_blocks, dtype=jnp.int32) * MOE_BLOCK,
                                           side='right'), N_EXPERTS - 1)

    def step(out, blk):
        tok, g, e = blk
        xb = h[tok]
        y = jnp.dot(_clamped_swiglu(jnp.dot(xb, w_gu[e]) + b_gu[e]), w_dn[e]) + b_dn[e]
        return out.at[tok].add(g[:, None] * y), None

    out, _ = lax.scan(step, jnp.zeros_like(h),
                      (row_tok.reshape(n_blocks, MOE_BLOCK), row_gate.reshape(n_blocks, MOE_BLOCK), block_e))
    return out


def setup_inputs(seed: int = 0) -> dict:
    key = jax.random.key(seed)
    k = jax.random.split(key, 32)
    f32 = jnp.float32
    D = D_MODEL

    def nrm(kk, shape, scale):
        return jax.random.normal(kk, shape, f32) * scale

    def gain(kk, shape):
        return 1.0 + nrm(kk, shape, 0.05)

    NE, NO, L = N_EVEN, N_ODD, DEPTH
    od_w_in = nrm(k[15], (NO, D, 3 * QK_W_C), D ** -0.5)
    od_w_in = od_w_in.at[..., 2 * QK_W_C:].multiply(DN_BETA)
    return {
        'x': nrm(k[0], (BATCH, SEQ, D), 1.0),
        'ev_w_in': nrm(k[1], (NE, D, E_IN_EVEN), D ** -0.5),
        'ev_q_norm': gain(k[2], (NE, D_CQ)),
        'ev_kv_norm': gain(k[3], (NE, D_C)),
        'ev_w_uq': nrm(k[4], (NE, D_CQ, H_A, DH_A), D_CQ ** -0.5),
        'ev_w_uk': nrm(k[5], (NE, H_A, DH_A, D_C), DH_A ** -0.5),
        'ev_w_uv': nrm(k[6], (NE, H_A, D_C, DH_A), D_C ** -0.5 * DN_BETA),
        'ev_w_iq': nrm(k[7], (NE, D_CQ, H_IDX, D_IDX), D_CQ ** -0.5),
        'ev_idx_k_g': gain(k[8], (NE, D_IDX)),
        'ev_idx_k_b': nrm(k[9], (NE, D_IDX), 0.02),
        'ev_v_norm_g': gain(k[10], (NE, GMLP_WIDTH)),
        'ev_v_norm_b': nrm(k[11], (NE, GMLP_WIDTH), 0.02),
        'ev_w_s': nrm(k[12], (NE, G_B, GMLP_CHUNK, GMLP_CHUNK), GMLP_CHUNK ** -0.5),
        'ev_b_s': 1.0 + nrm(k[13], (NE, G_B, GMLP_CHUNK), 0.1),
        'ev_w_out': nrm(k[14], (NE, MIX_EVEN, D), MIX_EVEN ** -0.5 * DN_BETA),
        'od_w_in': od_w_in,
        'od_lambda_q1': nrm(k[16], (NO, DH_C), 0.1),
        'od_lambda_k1': nrm(k[17], (NO, DH_C), 0.1),
        'od_lambda_q2': nrm(k[18], (NO, DH_C), 0.1),
        'od_lambda_k2': nrm(k[19], (NO, DH_C), 0.1),
        'od_subln_g': gain(k[20], (NO, 2 * DH_C)),
        'od_w_out': nrm(k[21], (NO, QK_W_C, D), QK_W_C ** -0.5 * DN_BETA),
        'ln1_g': gain(k[22], (L, D)),
        'ln1_b': nrm(k[23], (L, D), 0.02),
        'ln2_g': gain(k[24], (L, D)),
        'ln2_b': nrm(k[25], (L, D), 0.02),
        'router_w': nrm(k[26], (L, D, N_EXPERTS), D ** -0.5),
        'router_b': nrm(k[27], (L, N_EXPERTS), 0.01),
        'exp_w_gu': nrm(k[28], (L, N_EXPERTS, D, 2 * D_FF), D ** -0.5 * DN_BETA),
        'exp_b_gu': nrm(k[29], (L, N_EXPERTS, 2 * D_FF), 0.01),
        'exp_w_dn': nrm(k[30], (L, N_EXPERTS, D_FF, D), D_FF ** -0.5 * DN_BETA),
        'exp_b_dn': nrm(k[31], (L, N_EXPERTS, D), 0.01),
    }


def reference(x, ev_w_in, ev_q_norm, ev_kv_norm, ev_w_uq, ev_w_uk, ev_w_uv, ev_w_iq, ev_idx_k_g,
              ev_idx_k_b, ev_v_norm_g, ev_v_norm_b, ev_w_s, ev_b_s, ev_w_out, od_w_in, od_lambda_q1,
              od_lambda_k1, od_lambda_q2, od_lambda_k2, od_subln_g, od_w_out, ln1_g, ln1_b, ln2_g,
              ln2_b, router_w, router_b, exp_w_gu, exp_b_gu, exp_w_dn, exp_b_dn):
    b, s, d = x.shape
    h = x
    for l in range(DEPTH):
        j = l // 2
        if l % 2 == 0:
            mix = _even_mixer(h, ev_w_in[j], ev_q_norm[j], ev_kv_norm[j], ev_w_uq[j], ev_w_uk[j],
                              ev_w_uv[j], ev_w_iq[j], ev_idx_k_g[j], ev_idx_k_b[j], ev_v_norm_g[j],
                              ev_v_norm_b[j], ev_w_s[j], ev_b_s[j], ev_w_out[j])
        else:
            lam_init = 0.8 - 0.6 * math.exp(-0.3 * l)
            mix = _diff_attention(h, od_w_in[j], od_lambda_q1[j], od_lambda_k1[j], od_lambda_q2[j],
                                  od_lambda_k2[j], od_subln_g[j], od_w_out[j], lam_init)
        h = _layer_norm(DN_ALPHA * h + mix, ln1_g[l], ln1_b[l])
        ff = _moe_ffn(h.reshape(b * s, d), router_w[l], router_b[l], exp_w_gu[l], exp_b_gu[l],
                      exp_w_dn[l], exp_b_dn[l]).reshape(b, s, d)
        h = _layer_norm(DN_ALPHA * h + ff, ln2_g[l], ln2_b[l])
    return h
```

```cpp
#include <hip/hip_runtime.h>
#include <hip/hip_bf16.h>
#include <cstdio>
#include <cstdint>

#ifndef MK_CHECK
#define MK_CHECK 0
#endif
#ifndef MOE_FP8
#define MOE_FP8 1
#endif
#ifndef MK_FUSED
#define MK_FUSED 1
#endif

constexpr int D_MODEL = 1024, BATCH = 32, SEQ = 2048, DEPTH = 4, T_TOK = BATCH * SEQ;
constexpr int CHUNK = 64;
constexpr int H_A = 8, D_CQ = 256, D_C = 128, H_IDX = 4, D_IDX = 64, N_SEL = 256;
constexpr int GW = 512, G_B = 8, CG_B = 64, GCH = 128;
constexpr int H_C = 8, DH_C = 64;
constexpr int NEXP = 32, TOPK = 4, D_FF = 1024;
constexpr int E_IN_EVEN = D_CQ + D_C + D_IDX + H_IDX + 2 * GW;
constexpr float LN_EPS = 1e-5f;
constexpr float DN_ALPHA = 1.681792830507429f;
constexpr float LOG2E = 1.4426950408889634f;
constexpr int NE_PR = 1536;
constexpr int NO_PR = 3072;
constexpr int NQQ = 1280;
constexpr int NMX = 1536;
constexpr int MOE_ROWS_MAX = (T_TOK * TOPK / 256 + NEXP) * 256;
constexpr int MOE_RB_MAX = MOE_ROWS_MAX / 256;

constexpr size_t MiB = 1u << 20;
constexpr size_t WS_CTL = 0, CTL_ZERO_BYTES = 1 * MiB;
constexpr size_t WS_WI = 1 * MiB;
constexpr size_t WS_GATE = 2 * MiB;
constexpr size_t WS_SLOT = 3 * MiB;
constexpr size_t WS_ROWTOK = 4 * MiB;
constexpr size_t WS_MASK = 12 * MiB;
constexpr size_t WS_WS = 28 * MiB;
constexpr size_t WS_WINE = 32 * MiB;
constexpr size_t WS_WQE = 38 * MiB;
constexpr size_t WS_WOUTE = 40 * MiB;
constexpr size_t WS_WINO = 46 * MiB;
constexpr size_t WS_WOUTO = 58 * MiB;
constexpr size_t WS_WRT = 62 * MiB;
constexpr size_t WS_WGU = 64 * MiB;
constexpr size_t WS_WDN = 576 * MiB;
constexpr size_t WS_HB = 832 * MiB;
constexpr size_t WS_Z = 960 * MiB;
constexpr size_t WS_PR = 1216 * MiB;
constexpr size_t WS_CQ = 1600 * MiB;
constexpr size_t WS_CKV = 1632 * MiB;
constexpr size_t WS_KI = 1648 * MiB;
constexpr size_t WS_QQ = 1656 * MiB;
constexpr size_t WS_MX = 1816 * MiB;
constexpr size_t WS_ACT = 2008 * MiB;
constexpr size_t WS_HB8 = 2272 * MiB;
constexpr size_t WS_Y = 2536 * MiB;
constexpr size_t WS_END = 3064 * MiB;
constexpr int CW_TMO = 0;
constexpr int CW_BAR = 4096;
constexpr int CW_CUR = 16384;

constexpr int RING_BYTES = 131072;
constexpr int MISC_OFF = RING_BYTES + 2048;
constexpr int LDS_BYTES = 147456;
constexpr int MI_BAR = 8;
constexpr int MI_RBSTART = 32;
constexpr int MI_CNT = 80;
constexpr int MI_LCNT = 112;
constexpr int MI_LBASE = 144;
constexpr int MI_NUNITS = 180;
constexpr int MI_RBE = 256;
constexpr int MI_REC = 1408;
constexpr int MI_END = MI_REC + 2048;
static_assert(MISC_OFF + MI_END * 4 <= LDS_BYTES, "LDS map");

#define GAS __attribute__((address_space(1)))
#define LAS __attribute__((address_space(3)))
typedef unsigned short bf16_t;
typedef short bf16x8 __attribute__((ext_vector_type(8)));
typedef short s16x4 __attribute__((ext_vector_type(4)));
typedef float f32x4 __attribute__((ext_vector_type(4)));
typedef float f32x2 __attribute__((ext_vector_type(2)));
typedef float f32x16 __attribute__((ext_vector_type(16)));
typedef unsigned u32x4 __attribute__((ext_vector_type(4)));
typedef unsigned u32x2 __attribute__((ext_vector_type(2)));
typedef GAS unsigned gu32;
typedef int v8i __attribute__((ext_vector_type(8)));
typedef int i32x4 __attribute__((ext_vector_type(4)));
__device__ __forceinline__ unsigned pk4_fp8(float a, float b, float c, float d) { int p = __builtin_amdgcn_cvt_pk_fp8_f32(a, b, 0, false); return (unsigned)__builtin_amdgcn_cvt_pk_fp8_f32(c, d, p, true); }
#define RLX_AGENT __ATOMIC_RELAXED, __HIP_MEMORY_SCOPE_AGENT
#define LDS_WAIT() asm volatile("s_waitcnt lgkmcnt(0)" ::: "memory")
#define VM_WAIT() asm volatile("s_waitcnt vmcnt(0)" ::: "memory")

__device__ __forceinline__ unsigned f2bf(float f) { unsigned u = __builtin_bit_cast(unsigned, f); return (u + 0x7fffu + ((u >> 16) & 1u)) >> 16; }
__device__ __forceinline__ unsigned pk2(float lo, float hi) { return f2bf(lo) | (f2bf(hi) << 16); }
__device__ __forceinline__ float bf2f(unsigned short v) { return __builtin_bit_cast(float, (unsigned)v << 16); }
__device__ __forceinline__ float bflo(unsigned w) { return __builtin_bit_cast(float, w << 16); }
__device__ __forceinline__ float bfhi(unsigned w) { return __builtin_bit_cast(float, w & 0xffff0000u); }
__device__ __forceinline__ unsigned cvt_pk_bf16(float lo, float hi) { unsigned r; asm volatile("v_cvt_pk_bf16_f32 %0, %1, %2" : "=v"(r) : "v"(lo), "v"(hi)); return r; }
template <int CTRL> __device__ __forceinline__ float dppx(float v) { return __builtin_bit_cast(float, __builtin_amdgcn_update_dpp(0, __builtin_bit_cast(int, v), CTRL, 0xf, 0xf, true)); }
template <int M> __device__ __forceinline__ float xshfl(float v, int) {
    static_assert(M == 1 || M == 2 || M == 4 || M == 8 || M == 16, "xshfl: inside a 32-lane half only");
    if constexpr (M == 1) return dppx<0xB1>(v);
    else if constexpr (M == 2) return dppx<0x4E>(v);
    else if constexpr (M == 4) return dppx<0x141>(v);
    else if constexpr (M == 8) return dppx<0x128>(v);
    else return __builtin_bit_cast(float, __builtin_amdgcn_ds_swizzle(__builtin_bit_cast(int, v), (16 << 10) | 0x1f));
}
__device__ __forceinline__ void plswap(unsigned a, unsigned b, unsigned& r0, unsigned& r1) {
    asm volatile("" : "+v"(a), "+v"(b));
    auto rr = __builtin_amdgcn_permlane32_swap(a, b, false, false); r0 = rr[0]; r1 = rr[1];
    asm volatile("" : "+v"(r0), "+v"(r1));
}
__device__ __forceinline__ void half_swap(float v, float& r0, float& r1) {
    unsigned u0, u1; plswap(__builtin_bit_cast(unsigned, v), __builtin_bit_cast(unsigned, v), u0, u1); r0 = __builtin_bit_cast(float, u0); r1 = __builtin_bit_cast(float, u1);
}
__device__ __forceinline__ float rdl(float v, int l) { return __builtin_bit_cast(float, __builtin_amdgcn_readlane(__builtin_bit_cast(int, v), l)); }
__device__ __forceinline__ float wave_sum(float v) {
    v += dppx<0xB1>(v); v += dppx<0x4E>(v); v += dppx<0x141>(v); v += dppx<0x140>(v);
    return (rdl(v, 0) + rdl(v, 16)) + (rdl(v, 32) + rdl(v, 48));
}
__device__ __forceinline__ float wave_max(float v) {
    v = fmaxf(v, dppx<0xB1>(v)); v = fmaxf(v, dppx<0x4E>(v)); v = fmaxf(v, dppx<0x141>(v)); v = fmaxf(v, dppx<0x140>(v));
    return fmaxf(fmaxf(rdl(v, 0), rdl(v, 16)), fmaxf(rdl(v, 32), rdl(v, 48)));
}
__device__ __forceinline__ int lane_id() { int l; asm volatile("v_mbcnt_lo_u32_b32 %0, -1, 0\n\tv_mbcnt_hi_u32_b32 %0, -1, %0" : "=v"(l)); return l; }
__device__ __forceinline__ int tid_of(int wv) { int t = (wv << 6) + lane_id(); asm volatile("" : "+v"(t)); return t; }
__device__ __forceinline__ float fast_exp2(float x) { return __builtin_amdgcn_exp2f(x); }
__device__ __forceinline__ float fast_rcp(float x) { return __builtin_amdgcn_rcpf(x); }
__device__ __forceinline__ float gelu_tanh(float x) {
    const float u = x * (0.7978845608028654f + 0.035677408136300125f * x * x);
    return x * fast_rcp(1.0f + fast_exp2(-2.0f * LOG2E * u));
}
namespace pg8 {
constexpr int BM = 256, BK = 64, HALF = 128, HTB = HALF * BK * 2  , STAGE_BYTES = 8 * HTB, NXCD = 8, WGM = 8;
__host__ __device__ __forceinline__ int lds_byte(int r, int c) { const int st = (r >> 4) * 2 + (c >> 5), rr = r & 15, cc = c & 31, ob = rr * 64 + cc * 2; return st * 1024 + (ob ^ (((ob >> 9) & 1) << 5)); }
__host__ __device__ __forceinline__ void stage_rc(int b, int& R, int& C) { const int st = b / 1024, sb = b % 1024, swz = sb ^ (((sb >> 9) & 1) << 5); R = (st >> 1) * 16 + swz / 64; C = (st & 1) * 32 + (swz % 64) / 2; }
__host__ __device__ __forceinline__ int perm32(int rho) { const int n = rho >> 4, i = rho & 15; return 8 * (i >> 2) + 4 * n + (i & 3); }

struct Unit { int pm, pn, bt, e, blk; };

struct DenseOrder {
    int nM, nN, nwg, G, c;
    __device__ void init(int M, int N, int G_, int c_) { nM = M / BM; nN = N / BM; nwg = nM * nN; G = G_; c = c_; }
    __device__ bool next(int i, Unit& u) const {
        const long L = (long)i * G + c; if (L >= nwg) return false;
        int wgid = (int)L; { const int q = nwg / NXCD, r = nwg % NXCD, xcd = wgid % NXCD, off = wgid / NXCD; wgid = (xcd < r ? xcd * (q + 1) : r * (q + 1) + (xcd - r) * q) + off; }
        const int nig = WGM * nN, gid = wgid / nig, fm = gid * WGM, gsz = (nM - fm) < WGM ? (nM - fm) : WGM;
        u.pm = fm + ((wgid % nig) % gsz); u.pn = (wgid % nig) / gsz; u.bt = u.pn; u.e = 0; u.blk = 0; return true;
    }
    __device__ __forceinline__ int count(int) const { return 0; }
};
struct MoeOrder {
    int nunits, npn, G, c; const LAS int* tab;
    __device__ bool next(int i, Unit& u) const {
        const long L = (long)i * G + c; if (L >= nunits) return false;
        const int rb = (int)L / npn, pn = (int)L % npn, e = __builtin_amdgcn_readfirstlane(tab[MI_RBE + rb]);
        u.pm = rb; u.pn = pn; u.e = e; u.bt = e * npn + pn; u.blk = rb - __builtin_amdgcn_readfirstlane(tab[MI_RBSTART + e]); return true;
    }
    __device__ __forceinline__ int count(int e) const { return __builtin_amdgcn_readfirstlane(tab[MI_CNT + e]); }
};

struct EpiStoreBf16 {
    static constexpr bool PERM = true;
    bf16_t* O; int ldc; int gelu_from;
    __device__ __forceinline__ void operator()(const f32x4 (&acc)[2][2][4][2], const Unit& u, int wr, int wc, int fr, int fq) const {
        const int row0 = u.pm * BM + wr * 64 + fr; const int col0 = u.pn * BM + wc * 32 + 8 * fq; const bool g = u.pn >= gelu_from;
#pragma unroll
        for (int ai = 0; ai < 2; ++ai)
#pragma unroll
            for (int m = 0; m < 4; ++m) { GAS bf16_t* rowp = (GAS bf16_t*)O + (size_t)(row0 + ai * HALF + m * 16) * ldc + col0;
#pragma unroll
                for (int bj = 0; bj < 2; ++bj) { f32x4 v0 = acc[ai][bj][m][0], v1 = acc[ai][bj][m][1];
                    if (g) {
#pragma unroll
                        for (int q = 0; q < 4; ++q) { v0[q] = gelu_tanh(v0[q]); v1[q] = gelu_tanh(v1[q]); } }
                    u32x4 w; w.x = cvt_pk_bf16(v0[0], v0[1]); w.y = cvt_pk_bf16(v0[2], v0[3]); w.z = cvt_pk_bf16(v1[0], v1[1]); w.w = cvt_pk_bf16(v1[2], v1[3]);
                    *(GAS u32x4*)(rowp + bj * HALF) = w; } }
    }
};
struct EpiResid {
    static constexpr bool PERM = true;
    const bf16_t* Hs; bf16_t* Z; float alpha;
    __device__ __forceinline__ void operator()(const f32x4 (&acc)[2][2][4][2], const Unit& u, int wr, int wc, int fr, int fq) const {
        const int row0 = u.pm * BM + wr * 64 + fr; const int col0 = u.pn * BM + wc * 32 + 8 * fq;
#pragma unroll
        for (int ai = 0; ai < 2; ++ai) {
            u32x4 hw[4][2];
#pragma unroll
            for (int m = 0; m < 4; ++m)
#pragma unroll
                for (int bj = 0; bj < 2; ++bj) hw[m][bj] = *(const GAS u32x4*)((const GAS bf16_t*)Hs + (size_t)(row0 + ai * HALF + m * 16) * D_MODEL + col0 + bj * HALF);
#pragma unroll
            for (int m = 0; m < 4; ++m) { const size_t off = (size_t)(row0 + ai * HALF + m * 16) * D_MODEL + col0;
#pragma unroll
                for (int bj = 0; bj < 2; ++bj) { const u32x4 h = hw[m][bj];
                    const f32x4 v0 = (f32x4){bflo(h.x), bfhi(h.x), bflo(h.y), bfhi(h.y)} * alpha + acc[ai][bj][m][0], v1 = (f32x4){bflo(h.z), bfhi(h.z), bflo(h.w), bfhi(h.w)} * alpha + acc[ai][bj][m][1];
                    u32x4 w; w.x = cvt_pk_bf16(v0[0], v0[1]); w.y = cvt_pk_bf16(v0[2], v0[3]); w.z = cvt_pk_bf16(v1[0], v1[1]); w.w = cvt_pk_bf16(v1[2], v1[3]);
                    *(GAS u32x4*)((GAS bf16_t*)Z + off + bj * HALF) = w; } } }
    }
};
struct EpiSwiglu {
    static constexpr bool PERM = true;
    bf16_t* ACT; const float* bgu;
    __device__ __forceinline__ void operator()(const f32x4 (&acc)[2][2][4][2], const Unit& u, int wr, int wc, int fr, int fq) const {
        const int row0 = u.pm * BM + wr * 64 + fr; const int oc0 = u.pn * HALF + wc * 32 + 8 * fq;
        const float* bb = bgu + (size_t)u.e * 2048 + oc0;
        f32x4 bg[2], bu[2];
#pragma unroll
        for (int n = 0; n < 2; ++n) { bg[n] = *(const GAS f32x4*)((const GAS float*)bb + 4 * n); bu[n] = *(const GAS f32x4*)((const GAS float*)bb + 1024 + 4 * n); }
#pragma unroll
        for (int ai = 0; ai < 2; ++ai)
#pragma unroll
            for (int m = 0; m < 4; ++m) { float o[8];
#pragma unroll
                for (int n = 0; n < 2; ++n) { const f32x4 gv = acc[ai][0][m][n] + bg[n], uv = acc[ai][1][m][n] + bu[n];
#pragma unroll
                    for (int q = 0; q < 4; ++q) { const float gt = fminf(gv[q], 7.0f), up = fminf(fmaxf(uv[q], -7.0f), 7.0f);
                        o[4 * n + q] = (up + 1.0f) * gt * fast_rcp(1.0f + fast_exp2(-1.702f * LOG2E * gt)); } }
#if MOE_FP8
                u32x2 w; w.x = pk4_fp8(o[0] * 8.0f, o[1] * 8.0f, o[2] * 8.0f, o[3] * 8.0f); w.y = pk4_fp8(o[4] * 8.0f, o[5] * 8.0f, o[6] * 8.0f, o[7] * 8.0f);
                *(GAS u32x2*)((GAS unsigned char*)ACT + (size_t)(row0 + ai * HALF + m * 16) * D_FF + oc0) = w; }
#else
                u32x4 w; w.x = cvt_pk_bf16(o[0], o[1]); w.y = cvt_pk_bf16(o[2], o[3]); w.z = cvt_pk_bf16(o[4], o[5]); w.w = cvt_pk_bf16(o[6], o[7]);
                *(GAS u32x4*)((GAS bf16_t*)ACT + (size_t)(row0 + ai * HALF + m * 16) * D_FF + oc0) = w; }
#endif
    }
};
struct EpiBiasBf16 {
    static constexpr bool PERM = true;
    bf16_t* Y; const float* bdn;
    __device__ __forceinline__ void operator()(const f32x4 (&acc)[2][2][4][2], const Unit& u, int wr, int wc, int fr, int fq) const {
        const int row0 = u.pm * BM + wr * 64 + fr; const int col0 = u.pn * BM + wc * 32 + 8 * fq;
        const float* bb = bdn + (size_t)u.e * 1024 + col0;
        f32x4 bv[2][2];
#pragma unroll
        for (int bj = 0; bj < 2; ++bj)
#pragma unroll
            for (int n = 0; n < 2; ++n) bv[bj][n] = *(const GAS f32x4*)((const GAS float*)bb + bj * HALF + 4 * n);
#pragma unroll
        for (int ai = 0; ai < 2; ++ai)
#pragma unroll
            for (int m = 0; m < 4; ++m) { const size_t roff = (size_t)(row0 + ai * HALF + m * 16) * D_MODEL + col0;
#pragma unroll
                for (int bj = 0; bj < 2; ++bj) { const f32x4 v0 = acc[ai][bj][m][0] + bv[bj][0], v1 = acc[ai][bj][m][1] + bv[bj][1];
#if MOE_FP8
                    f32x4 s0 = v0 * 64.f, s1 = v1 * 64.f;
#pragma unroll
                    for (int q = 0; q < 4; ++q) { s0[q] = fminf(fmaxf(s0[q], -448.f), 448.f); s1[q] = fminf(fmaxf(s1[q], -448.f), 448.f); }
                    u32x2 w; w.x = pk4_fp8(s0[0], s0[1], s0[2], s0[3]); w.y = pk4_fp8(s1[0], s1[1], s1[2], s1[3]);
                    *(GAS u32x2*)((GAS unsigned char*)Y + roff + bj * HALF) = w; } }
#else
                    u32x4 w; w.x = cvt_pk_bf16(v0[0], v0[1]); w.y = cvt_pk_bf16(v0[2], v0[3]); w.z = cvt_pk_bf16(v1[0], v1[1]); w.w = cvt_pk_bf16(v1[2], v1[3]);
                    *(GAS u32x4*)((GAS bf16_t*)Y + roff + bj * HALF) = w; } }
#endif
    }
};

template <class Epi, class Sched, bool GATHER, bool FP8 = false>
__device__ __forceinline__ void gemm_phase(LAS unsigned char* lds, const bf16_t* A, const bf16_t* Bt, const int K_, const int* __restrict__ rowidx, const Sched& S, const Epi& E, const int wv, int sclA = 0x7f7f7f7f, int sclB = 0x7f7f7f7f) {
    int Kh_ = K_; asm volatile("" : "+s"(Kh_)); const int K = Kh_;
    asm volatile("" : "+v"(sclA), "+v"(sclB));
    const int tid_ = tid_of(wv);
    const int tid = tid_, wid = __builtin_amdgcn_readfirstlane(tid >> 6), lane = tid & 63, wr = wid >> 2, wc = wid & 3, fr = lane & 15, fq = lane >> 4;
    const int nt = K / BK;
    unsigned voffB[2]; unsigned oc0[2], oc1[2];
    LAS unsigned* gnx = (LAS unsigned*)(lds + MISC_OFF + MI_REC * 4) + tid * 4;
    const size_t kstep = (size_t)(BK * 2);
    const size_t hstep = (size_t)HALF * K * 2;
    const size_t tstep = 2 * hstep;
#pragma unroll
    for (int i = 0; i < 2; ++i) { int R, C; stage_rc(tid * 16 + i * 8192, R, C); const int Rb = Epi::PERM ? ((R & ~31) + perm32(R & 31)) : R;
        oc0[i] = (unsigned)(R * K + C) * 2u; oc1[i] = oc0[i] + (unsigned)hstep;
        voffB[i] = (unsigned)(Rb * K + C) * 2u; }
    const unsigned ldsw = (unsigned)wid * 1024u;
    const int aoff = lds_byte(wr * 64 + fr, fq * 8), boff = lds_byte(wc * 32 + fr, fq * 8);
#define PG8_SA(b, h) (((b) * 2 + (h)) * HTB)
#define PG8_SB(b, h) ((4 + (b) * 2 + (h)) * HTB)
#define PG8_STAGE(bufoff, gbase, voff) do { _Pragma("unroll") for (int _i = 0; _i < 2; ++_i) { unsigned keep_; \
        asm volatile("s_mov_b32 %0, m0\n\ts_mov_b32 m0, %3\n\ts_nop 0\n\tglobal_load_lds_dwordx4 %1, %2\n\ts_mov_b32 m0, %0" \
            : "=&s"(keep_) : "v"((voff)[_i]), "s"((const char*)(gbase)), "s"((unsigned)(size_t)(lds + (bufoff) + ldsw + _i * 8192)) : "memory"); } } while (0)
#define PG8_RD8(p) __builtin_shufflevector(*(const LAS i32x4*)(p), *(const LAS i32x4*)((p) + 1024), 0, 1, 2, 3, 4, 5, 6, 7)
#define PG8_LDA(dst, b, h) do { if constexpr (FP8) { _Pragma("unroll") for (int m = 0; m < 4; ++m) dst##8[m] = PG8_RD8(lds + PG8_SA(b, h) + aoff + m * 2048); } \
        else { _Pragma("unroll") for (int m = 0; m < 4; ++m) _Pragma("unroll") for (int k = 0; k < 2; ++k) dst[m][k] = *(const LAS bf16x8*)(lds + PG8_SA(b, h) + aoff + m * 2048 + k * 1024); } } while (0)
#define PG8_LDB(dst, b, h) do { if constexpr (FP8) { _Pragma("unroll") for (int n = 0; n < 2; ++n) dst##8[n] = PG8_RD8(lds + PG8_SB(b, h) + boff + n * 2048); } \
        else { _Pragma("unroll") for (int n = 0; n < 2; ++n) _Pragma("unroll") for (int k = 0; k < 2; ++k) dst[n][k] = *(const LAS bf16x8*)(lds + PG8_SB(b, h) + boff + n * 2048 + k * 1024); } } while (0)
#define PG8_MMA(ai, bj, At, Bt_) do { __builtin_amdgcn_s_setprio(1); _Pragma("unroll") for (int m = 0; m < 4; ++m) _Pragma("unroll") for (int n = 0; n < 2; ++n) { \
        if constexpr (FP8) asm volatile("v_mfma_scale_f32_16x16x128_f8f6f4 %0, %1, %2, %0, %3, %4 op_sel_hi:[0,0,0]" : "+v"(acc[ai][bj][m][n]) : "v"(Bt_##8[n]), "v"(At##8[m]), "v"(sclB), "v"(sclA));   \
        else { _Pragma("unroll") for (int k = 0; k < 2; ++k) acc[ai][bj][m][n] = __builtin_amdgcn_mfma_f32_16x16x32_bf16(Bt_[n][k], At[m][k], acc[ai][bj][m][n], 0, 0, 0); } } \
        __builtin_amdgcn_s_setprio(0); } while (0)
#define PG8_WAIT_V(n) asm volatile("s_waitcnt vmcnt(" #n ")" ::: "memory")
#define PG8_WAIT_L(n) asm volatile("s_waitcnt lgkmcnt(" #n ")" ::: "memory")
#define PG8_BAR __builtin_amdgcn_s_barrier()
#define PG8_SCHED __builtin_amdgcn_sched_barrier(0)
#define PG8_GOFF(u, g0, g1) do { const int cn_ = S.count((u).e); const GAS int* rp_ = (const GAS int*)rowidx + (size_t)(u).e * 65536 + (u).blk * 256; \
        _Pragma("unroll") for (int i_ = 0; i_ < 2; ++i_) { int r0_, c0_; stage_rc(tid * 16 + i_ * 8192, r0_, c0_); const unsigned gc_ = (unsigned)c0_ * 2u; \
            const int t0_ = ((u).blk * 256 + r0_ < cn_) ? rp_[r0_] : 0; const int t1_ = ((u).blk * 256 + 128 + r0_ < cn_) ? rp_[128 + r0_] : 0; \
            g0[i_] = (unsigned)t0_ * (unsigned)(K * 2) + gc_; g1[i_] = (unsigned)t1_ * (unsigned)(K * 2) + gc_; asm volatile("" : "+v"(g0[i_]), "+v"(g1[i_])); } } while (0)
    Unit cur, nxt; int ui = 0;
    if (!S.next(0, cur)) return;
    f32x4 acc[2][2][4][2];
#pragma unroll
    for (int a = 0; a < 2; ++a)
#pragma unroll
        for (int b = 0; b < 2; ++b)
#pragma unroll
            for (int m = 0; m < 4; ++m)
#pragma unroll
                for (int n = 0; n < 2; ++n) acc[a][b][m][n] = (f32x4){0.f, 0.f, 0.f, 0.f};
    bf16x8 At[4][2], B0[2][2], B1[2][2]; v8i At8[4], B08[2], B18[2];
    if constexpr (GATHER) { PG8_GOFF(cur, oc0, oc1); gnx[0] = oc0[0]; gnx[1] = oc0[1]; gnx[2] = oc1[0]; gnx[3] = oc1[1]; }
    const char* cA = GATHER ? (const char*)A : (const char*)A + (size_t)cur.pm * tstep; const char* cB = (const char*)Bt + (size_t)cur.bt * tstep;
    PG8_STAGE(PG8_SB(0, 0), cB, voffB); PG8_STAGE(PG8_SB(0, 1), cB + hstep, voffB); PG8_STAGE(PG8_SA(0, 0), cA, oc0); PG8_STAGE(PG8_SA(0, 1), cA, oc1);
    if (wr == 1) PG8_BAR;
    PG8_WAIT_V(2); PG8_BAR;
    PG8_STAGE(PG8_SB(1, 0), cB + kstep, voffB); PG8_STAGE(PG8_SA(1, 0), cA + kstep, oc0); PG8_STAGE(PG8_SB(1, 1), cB + hstep + kstep, voffB);
    PG8_WAIT_V(6); PG8_BAR;
    for (;;) {
        const bool has_next = S.next(ui + 1, nxt);
        if constexpr (GATHER) { if (has_next) { unsigned on0[2], on1[2]; PG8_GOFF(nxt, on0, on1); gnx[0] = on0[0]; gnx[1] = on0[1]; gnx[2] = on1[0]; gnx[3] = on1[1]; } }
        const char* nA = GATHER ? (const char*)A : (has_next ? (const char*)A + (size_t)nxt.pm * tstep : cA); const char* nB = has_next ? (const char*)Bt + (size_t)nxt.bt * tstep : cB;
        for (int t = 0; t < nt; t += 2) {
            const bool last = (t == nt - 2);
            const char* a1 = cA + (size_t)(t + 1) * kstep;
            const char* a2 = last ? nA : cA + (size_t)(t + 2) * kstep; const char* b2 = last ? nB : cB + (size_t)(t + 2) * kstep;
            const char* a3 = a2 + kstep; const char* b3 = b2 + kstep;
            unsigned s0[2], s1[2];
#pragma unroll
            for (int i = 0; i < 2; ++i) { s0[i] = oc0[i]; s1[i] = oc1[i]; }
            if constexpr (GATHER) { if (last) { s0[0] = gnx[0]; s0[1] = gnx[1]; s1[0] = gnx[2]; s1[1] = gnx[3]; } }
            PG8_LDB(B0, 0, 0); PG8_LDB(B1, 0, 1); PG8_SCHED; PG8_LDA(At, 0, 0); PG8_STAGE(PG8_SA(1, 1), a1, oc1);
            PG8_WAIT_V(8); PG8_WAIT_L(0); PG8_BAR; PG8_MMA(0, 0, At, B0); PG8_MMA(0, 1, At, B1); PG8_BAR; PG8_SCHED;
            PG8_LDA(At, 0, 1); PG8_STAGE(PG8_SB(0, 0), b2, voffB); PG8_STAGE(PG8_SB(0, 1), b2 + hstep, voffB); PG8_STAGE(PG8_SA(0, 0), a2, s0);
            PG8_WAIT_V(8); PG8_WAIT_L(0); PG8_BAR; PG8_MMA(1, 0, At, B0); PG8_MMA(1, 1, At, B1); PG8_BAR; PG8_SCHED;
            PG8_LDB(B0, 1, 0); PG8_LDB(B1, 1, 1); PG8_SCHED; PG8_LDA(At, 1, 0); PG8_STAGE(PG8_SA(0, 1), a2, s1);
            PG8_WAIT_V(8); PG8_WAIT_L(0); PG8_BAR; PG8_MMA(0, 0, At, B0); PG8_MMA(0, 1, At, B1); PG8_BAR; PG8_SCHED;
            PG8_LDA(At, 1, 1); PG8_STAGE(PG8_SB(1, 0), b3, voffB); PG8_STAGE(PG8_SB(1, 1), b3 + hstep, voffB); PG8_STAGE(PG8_SA(1, 0), a3, s0);
            PG8_WAIT_V(8); PG8_WAIT_L(0); PG8_BAR; PG8_MMA(1, 0, At, B0); PG8_MMA(1, 1, At, B1); PG8_BAR; PG8_SCHED;
        }
        if (wr == 0) PG8_BAR;
        if constexpr (FP8) asm volatile("s_nop 15\n\ts_nop 15" ::: "memory");
        E(acc, cur, wr, wc, fr, fq);
        if (!has_next) break;
#pragma unroll
        for (int a = 0; a < 2; ++a)
#pragma unroll
            for (int b = 0; b < 2; ++b)
#pragma unroll
                for (int m = 0; m < 4; ++m)
#pragma unroll
                    for (int n = 0; n < 2; ++n) acc[a][b][m][n] = (f32x4){0.f, 0.f, 0.f, 0.f};
        cur = nxt; cA = nA; cB = nB; ++ui;
        if constexpr (GATHER) { oc0[0] = gnx[0]; oc0[1] = gnx[1]; oc1[0] = gnx[2]; oc1[1] = gnx[3]; }
        if (wr == 1) PG8_BAR;
    }
    PG8_WAIT_V(0);
    PG8_BAR;
#undef PG8_SA
#undef PG8_SB
#undef PG8_STAGE
#undef PG8_LDA
#undef PG8_LDB
#undef PG8_MMA
#undef PG8_RD8
#undef PG8_WAIT_V
#undef PG8_WAIT_L
#undef PG8_BAR
#undef PG8_SCHED
#undef PG8_GOFF
}
}
namespace att {
#define ATT_SBAR() __builtin_amdgcn_sched_barrier(0)
constexpr float THR = 8.f;
__device__ __forceinline__ int crow(int r, int hi) { return (r & 3) + 8 * (r >> 2) + 4 * hi; }
__device__ __forceinline__ unsigned cvtpk(float lo, float hi) { unsigned r; asm volatile("v_cvt_pk_bf16_f32 %0, %1, %2" : "=v"(r) : "v"(lo), "v"(hi)); return r; }

__device__ __forceinline__ void partialSM(f32x16& p0, f32x16& p1, float& m_reg, float& alpha) {
  float pmax = p0[0];
#pragma unroll
  for (int r = 1; r < 16; ++r) pmax = fmaxf(pmax, p0[r]);
#pragma unroll
  for (int r = 0; r < 16; ++r) pmax = fmaxf(pmax, p1[r]);
  { float r0, r1; half_swap(pmax, r0, r1); pmax = fmaxf(r0, r1); }
  float mn;
  if (__builtin_expect(__all(pmax - m_reg <= THR), 1)) { mn = m_reg; alpha = 1.f; }
  else { mn = fmaxf(m_reg, pmax); alpha = __builtin_amdgcn_exp2f(m_reg - mn); m_reg = mn; }
#pragma unroll
  for (int r = 0; r < 16; ++r) { p0[r] = __builtin_amdgcn_exp2f(p0[r] - mn); p1[r] = __builtin_amdgcn_exp2f(p1[r] - mn); }
}
__device__ __forceinline__ void finishSM(const f32x16& p0, const f32x16& p1, float alpha, float& l_reg, bf16x8& pa0, bf16x8& pa1, bf16x8& pa2, bf16x8& pa3) {
  float ps = 0;
#pragma unroll
  for (int r = 0; r < 16; ++r) ps += p0[r];
#pragma unroll
  for (int r = 0; r < 16; ++r) ps += p1[r];
  { float r0, r1; half_swap(ps, r0, r1); ps = r0 + r1; }
  l_reg = l_reg * alpha + ps;
#define ATT_PK4(P, BASE, OUT) do { unsigned a0 = cvtpk(P[BASE + 0], P[BASE + 1]), a1 = cvtpk(P[BASE + 2], P[BASE + 3]);   \
    unsigned b0 = cvtpk(P[BASE + 4], P[BASE + 5]), b1 = cvtpk(P[BASE + 6], P[BASE + 7]);                              \
    unsigned r00, r01, r10, r11; plswap(a0, b0, r00, r01); plswap(a1, b1, r10, r11); \
    u32x4 w = {r00, r10, r01, r11}; OUT = __builtin_bit_cast(bf16x8, w); } while (0)
  ATT_PK4(p0, 0, pa0); ATT_PK4(p0, 8, pa1); ATT_PK4(p1, 0, pa2); ATT_PK4(p1, 8, pa3);
#undef ATT_PK4
}
__device__ __forceinline__ int v_st(int k, int c) { const int kk = (k & ~0xC) | ((k & 4) << 1) | ((k & 8) >> 1); return ((kk >> 3) * 4 + (c >> 5)) * 512 + ((kk & 7) * 32 + (c & 31)) * 2; }
__device__ __forceinline__ int v_rd_base(int lane) { return ((lane & 3) << 3) | (((lane >> 2) & 3) << 6) | (((lane >> 4) & 1) << 5) | (((lane >> 5) & 1) << 8); }
constexpr int v_rd_off(int d0, int ks, int half) { return d0 * 512 + ks * 4096 + half * 2048; }
template <int OFF> __device__ __forceinline__ s16x4 tr_read(int vb) {
  s16x4 r; asm volatile("ds_read_b64_tr_b16 %0, %1 offset:%2" : "=&v"(r) : "v"(vb), "i"(OFF) : "memory"); return r;
}
template <int D0> __device__ __forceinline__ void pv_one(f32x16& od, int vb, bf16x8 pa0, bf16x8 pa1, bf16x8 pa2, bf16x8 pa3) {
  const s16x4 l0 = tr_read<v_rd_off(D0, 0, 0)>(vb), h0 = tr_read<v_rd_off(D0, 0, 1)>(vb), l1 = tr_read<v_rd_off(D0, 1, 0)>(vb), h1 = tr_read<v_rd_off(D0, 1, 1)>(vb);
  const s16x4 l2 = tr_read<v_rd_off(D0, 2, 0)>(vb), h2 = tr_read<v_rd_off(D0, 2, 1)>(vb), l3 = tr_read<v_rd_off(D0, 3, 0)>(vb), h3 = tr_read<v_rd_off(D0, 3, 1)>(vb);
  asm volatile("s_waitcnt lgkmcnt(0)" ::: "memory"); ATT_SBAR();
#define ATT_PK(L, H) (bf16x8){L[0], L[1], L[2], L[3], H[0], H[1], H[2], H[3]}
  od = __builtin_amdgcn_mfma_f32_32x32x16_bf16(pa0, ATT_PK(l0, h0), od, 0, 0, 0);
  od = __builtin_amdgcn_mfma_f32_32x32x16_bf16(pa1, ATT_PK(l1, h1), od, 0, 0, 0);
  od = __builtin_amdgcn_mfma_f32_32x32x16_bf16(pa2, ATT_PK(l2, h2), od, 0, 0, 0);
  od = __builtin_amdgcn_mfma_f32_32x32x16_bf16(pa3, ATT_PK(l3, h3), od, 0, 0, 0);
#undef ATT_PK
}
constexpr int ATT_LDS_V = 0, ATT_LDS_K = 32768, ATT_LDS_WS = 65536, ATT_LDS_CORE = 65536 + 2048;
template <int DQK, bool MASKED, bool KVSAME>
__device__ __forceinline__ void attn_core(const GAS bf16_t* __restrict__ Qrow0, int ldq, const GAS bf16_t* __restrict__ Kh, int ldk, const GAS bf16_t* __restrict__ Vh, int ldv,
                                          int NTB, int NTW, float slope2, int tq0, const LAS unsigned long long* mask, LAS char* lds, f32x16 (&o)[4], float& l_out, const int wv) {
  static_assert(DQK == 64 || DQK == 128, "DQK"); static_assert(!KVSAME || DQK == 128, "KVSAME needs DQK 128");
  constexpr int KROWB = DQK * 2, KBUF = 64 * KROWB, ND0 = DQK / 16;
  const int tid_ = tid_of(wv);
  const int tid = tid_, wid = tid >> 6, lane = tid & 63, r32 = lane & 31, hi = lane >> 5;
  LAS char* V_lds = lds + ATT_LDS_V; LAS char* K_lds = lds + ATT_LDS_K;
  LAS float* wsf = (LAS float*)(lds + ATT_LDS_WS) + wid * 64; LAS float* al_l = wsf + 32;
  float m_reg = -1e30f, l_reg = 0.f;
#pragma unroll
  for (int d = 0; d < 4; ++d) o[d] = f32x16{};
  bf16x8 qr[ND0];
  { const GAS bf16_t* Qp = Qrow0 + (size_t)r32 * ldq + hi * 8;
#pragma unroll
    for (int d0 = 0; d0 < ND0; ++d0) qr[d0] = *(const GAS bf16x8*)(Qp + d0 * 16); }
  const int sr = tid >> 4, sc = (tid & 15) * 8, vst0 = v_st(sr, sc), vst1 = v_st(32 + sr, sc);
  const int kr = tid >> 3, kc = (tid & 7) * 8;
  const int vb0 = (int)(unsigned)(size_t)V_lds + v_rd_base(lane);
  bf16x8 vs0, vs1, ks0, ks1, wv0, wv1, wk0, wk1;
#define ATT_KSWZ(row, colB) ((row) * KROWB + ((colB) ^ (((row) & 7) << 4)))
#define ATT_SLOADX(k0, vs0, vs1, ks0, ks1) do { vs0 = *(const GAS bf16x8*)(&Vh[(size_t)((k0) + sr) * ldv + sc]); vs1 = *(const GAS bf16x8*)(&Vh[(size_t)((k0) + 32 + sr) * ldv + sc]); \
    if constexpr (!KVSAME) { if constexpr (DQK == 128) { ks0 = *(const GAS bf16x8*)(&Kh[(size_t)((k0) + sr) * ldk + sc]); ks1 = *(const GAS bf16x8*)(&Kh[(size_t)((k0) + 32 + sr) * ldk + sc]); } \
                             else { ks0 = *(const GAS bf16x8*)(&Kh[(size_t)((k0) + kr) * ldk + kc]); } } } while (0)
#define ATT_SLOAD(k0) ATT_SLOADX(k0, vs0, vs1, ks0, ks1)
#define ATT_SLOADB(k0) ATT_SLOADX(k0, wv0, wv1, wk0, wk1)
#define ATT_SWRITEX(b, vs0, vs1, ks0, ks1) do { *(LAS bf16x8*)(V_lds + (b) * 16384 + vst0) = vs0; *(LAS bf16x8*)(V_lds + (b) * 16384 + vst1) = vs1; \
    if constexpr (KVSAME) { *(LAS bf16x8*)(K_lds + (b) * KBUF + ATT_KSWZ(sr, sc * 2)) = vs0; *(LAS bf16x8*)(K_lds + (b) * KBUF + ATT_KSWZ(32 + sr, sc * 2)) = vs1; } \
    else if constexpr (DQK == 128) { *(LAS bf16x8*)(K_lds + (b) * KBUF + ATT_KSWZ(sr, sc * 2)) = ks0; *(LAS bf16x8*)(K_lds + (b) * KBUF + ATT_KSWZ(32 + sr, sc * 2)) = ks1; } \
    else { *(LAS bf16x8*)(K_lds + (b) * KBUF + ATT_KSWZ(kr, kc * 2)) = ks0; } } while (0)
#define ATT_SWRITE(b) ATT_SWRITEX(b, vs0, vs1, ks0, ks1)
#define ATT_SWRITEB(b) ATT_SWRITEX(b, wv0, wv1, wk0, wk1)
  constexpr bool SD2 = false;
  ATT_SLOAD((NTB - 1) * 64); ATT_SWRITE(0);
  if constexpr (SD2) { if (NTB > 1) ATT_SLOADB((NTB - 2) * 64); if (NTB > 2) ATT_SLOAD((NTB - 3) * 64); }
  __syncthreads();
  float m_ref = 0.f;
  const int jdiag = tq0 >> 6;
  for (int jj = 0; jj < NTB; ++jj) {
    const int j = NTB - 1 - jj, buf = jj & 1;
    if constexpr (!SD2) { if (j > 0) ATT_SLOAD((j - 1) * 64); }
    if (j < NTW) {
      f32x16 p0, p1;
      unsigned mlo = 0xffffffffu, mhi = 0xffffffffu;
      if constexpr (MASKED) { const unsigned long long mw = mask[j * 32 + r32]; mlo = (unsigned)mw >> (4 * hi); mhi = (unsigned)(mw >> 32) >> (4 * hi); }
      if (j == jdiag) {
        const float x = (float)(tq0 + r32 - j * 64 - 4 * hi);
#pragma unroll
        for (int r = 0; r < 16; ++r) { const int cr = (r & 3) + 8 * (r >> 2); const float d = x - (float)cr; p0[r] = -slope2 * fabsf(d) - m_ref; p1[r] = -slope2 * fabsf(d - 32.f) - m_ref; }
      } else {
        const float b0 = slope2 * (float)(j * 64 + 4 * hi - tq0 - r32) - m_ref, s2 = slope2 + slope2, s3 = s2 + slope2, s8 = 8.f * slope2, s32 = 32.f * slope2;
        float bg = b0;
#pragma unroll
        for (int g = 0; g < 4; ++g) { p0[4 * g] = bg; p0[4 * g + 1] = bg + slope2; p0[4 * g + 2] = bg + s2; p0[4 * g + 3] = bg + s3; bg += s8; }
#pragma unroll
        for (int r = 0; r < 16; ++r) p1[r] = p0[r] + s32;
      }
      if constexpr (MASKED) {
#pragma unroll
        for (int r = 0; r < 16; ++r) { const int cr = (r & 3) + 8 * (r >> 2);
          if (!((mlo >> cr) & 1u)) p0[r] = -INFINITY; if (!((mhi >> cr) & 1u)) p1[r] = -INFINITY; }
      }
      { const LAS char* Kb = K_lds + buf * KBUF;
#pragma unroll
        for (int d0 = 0; d0 < ND0; ++d0) { const int cb = (d0 * 16 + hi * 8) * 2;
          const bf16x8 b0 = *(const LAS bf16x8*)(Kb + ATT_KSWZ(r32, cb));
          const bf16x8 b1 = *(const LAS bf16x8*)(Kb + ATT_KSWZ(32 + r32, cb));
          p0 = __builtin_amdgcn_mfma_f32_32x32x16_bf16(b0, qr[d0], p0, 0, 0, 0);
          p1 = __builtin_amdgcn_mfma_f32_32x32x16_bf16(b1, qr[d0], p1, 0, 0, 0); } }
      float pmax = fmaxf(p0[0], p1[0]);
#pragma unroll
      for (int r = 1; r < 16; ++r) pmax = fmaxf(pmax, fmaxf(p0[r], p1[r]));
      { float r0, r1; half_swap(pmax, r0, r1); pmax = fmaxf(r0, r1); }
      const bool first = (j == NTW - 1);
      if (first || __any(pmax > THR)) {
        const float dl = first ? ((pmax > -1e30f) ? pmax : 0.f) : fmaxf(pmax, 0.f);
        m_ref += dl; const float alpha = __builtin_amdgcn_exp2f(-dl); l_reg *= alpha;
#pragma unroll
        for (int r = 0; r < 16; ++r) { p0[r] -= dl; p1[r] -= dl; }
        if (!first) { if (hi == 0) al_l[r32] = alpha; asm volatile("s_waitcnt lgkmcnt(0)" ::: "memory");
#pragma unroll
          for (int d = 0; d < 4; ++d)
#pragma unroll
            for (int r = 0; r < 16; ++r) o[d][r] *= al_l[crow(r, hi)]; }
      }
#pragma unroll
      for (int r = 0; r < 16; ++r) { p0[r] = __builtin_amdgcn_exp2f(p0[r]); p1[r] = __builtin_amdgcn_exp2f(p1[r]); }
      bf16x8 pa0, pa1, pa2, pa3;
      finishSM(p0, p1, 1.f, l_reg, pa0, pa1, pa2, pa3); ATT_SBAR();
      const int vb = vb0 + buf * 16384;
      pv_one<0>(o[0], vb, pa0, pa1, pa2, pa3); pv_one<1>(o[1], vb, pa0, pa1, pa2, pa3); pv_one<2>(o[2], vb, pa0, pa1, pa2, pa3); pv_one<3>(o[3], vb, pa0, pa1, pa2, pa3);
    }
    if constexpr (!SD2) { if (j > 0) ATT_SWRITE(buf ^ 1); }
    else { if (j > 0) { if ((jj + 1) & 1) ATT_SWRITEB(buf ^ 1); else ATT_SWRITE(buf ^ 1); }
           if (j > 2) { if ((jj + 1) & 1) ATT_SLOADB((j - 3) * 64); else ATT_SLOAD((j - 3) * 64); } }
    __syncthreads();
  }
  l_out = l_reg;
#undef ATT_KSWZ
#undef ATT_SLOAD
#undef ATT_SWRITE
#undef ATT_SLOADB
#undef ATT_SWRITEB
#undef ATT_SLOADX
#undef ATT_SWRITEX
}
__device__ __forceinline__ void row_rcp(float l_reg, LAS char* lds, float (&rli)[16], const int wv) {
  const int tid_ = tid_of(wv);
  const int tid = tid_, wid = tid >> 6, lane = tid & 63, r32 = lane & 31, hi = lane >> 5;
  LAS float* li_l = (LAS float*)(lds + ATT_LDS_WS) + wid * 64;
  if (hi == 0) li_l[r32] = l_reg; asm volatile("s_waitcnt lgkmcnt(0)" ::: "memory");
#pragma unroll
  for (int r = 0; r < 16; ++r) rli[r] = __builtin_amdgcn_rcpf(li_l[crow(r, hi)]);
}
}
#define XB_TMO      128
#define XB_XCNT(j)  (256  + 64 * (j))
#define XB_XSUB(j)  (1280 + 64 * (j))
#define XB_XGEN(j)  (2304 + 64 * (j))
#define XB_TOP      3328
#define XB_TOPGEN   3392
#define XCD_BAR_WORDS 3456
#define XB_SPIN_CAP (1u << 18)

__device__ __forceinline__ unsigned xb_ld(unsigned* p)              { return __hip_atomic_load(p, __ATOMIC_RELAXED, __HIP_MEMORY_SCOPE_AGENT); }
__device__ __forceinline__ unsigned xb_add(unsigned* p, unsigned v) { return __hip_atomic_fetch_add(p, v, __ATOMIC_RELAXED, __HIP_MEMORY_SCOPE_AGENT); }
__device__ __forceinline__ unsigned xb_xcc_id() { return (unsigned)__builtin_amdgcn_s_getreg((3 << 11) | 20) & 0xFu; }
#define XB_SPIN(cond, bar) do { unsigned _sp = 0; while (cond) { __builtin_amdgcn_s_sleep(1); \
    if ((++_sp & 255u) == 0u) { if (xb_ld(&(bar)[XB_TMO])) break; if (_sp > XB_SPIN_CAP) { atomicAdd(&(bar)[XB_TMO], 1u); break; } } } } while (0)

struct XcdBarrier {
    unsigned* bar; unsigned x; unsigned w;
    volatile LAS unsigned* st;
};

__device__ __forceinline__ XcdBarrier xcd_barrier_post(unsigned* bar, volatile LAS unsigned* st) {
    XcdBarrier b; b.bar = bar; b.x = xb_xcc_id(); b.st = st; b.w = (unsigned)__builtin_amdgcn_readfirstlane((int)(threadIdx.x >> 6));
    if (threadIdx.x == 0) (void)xb_add(&bar[XB_XCNT(b.x)], 1u);
    return b;
}
__device__ __forceinline__ void xcd_barrier_complete(unsigned* bar, unsigned x, unsigned& nloc, unsigned& nx) {
    const unsigned G = gridDim.x * gridDim.y * gridDim.z;
    unsigned sum, cnt, mine, sp = 0u;
    for (;;) {
        sum = 0u; cnt = 0u; mine = 0u;
#pragma unroll
        for (unsigned j = 0; j < 16; ++j) { const unsigned c = xb_ld(&bar[XB_XCNT(j)]); sum += c; cnt += (c > 0u) ? 1u : 0u; mine = (j == x) ? c : mine; }
        if (sum == G) break;
        __builtin_amdgcn_s_sleep(1);
        if ((++sp & 255u) == 0u) { if (xb_ld(&bar[XB_TMO])) break; if (sp > XB_SPIN_CAP) { atomicAdd(&bar[XB_TMO], 1u); break; } }
    }
    nloc = mine > 0u ? mine : 1u; nx = cnt > 0u ? cnt : 1u;
}

__device__ __forceinline__ void xcd_barrier(const XcdBarrier& b) {
    asm volatile("s_waitcnt vmcnt(0)" ::: "memory");
    __syncthreads();
    if (b.w == 0u && lane_id() == 0) {
        unsigned* bar = b.bar;
        __builtin_amdgcn_s_waitcnt(0);
        unsigned nloc = b.st[0], nx = b.st[1];
        if (nloc == 0u) { xcd_barrier_complete(bar, b.x, nloc, nx); b.st[0] = nloc; b.st[1] = nx; }
        const unsigned old = xb_add(&bar[XB_XSUB(b.x)], 1u);
        const unsigned gen = old / nloc;
        if (old + 1u == (gen + 1u) * nloc) {
            __builtin_amdgcn_fence(__ATOMIC_RELEASE, "agent");
            asm volatile("s_waitcnt vmcnt(0)" ::: "memory");
            const unsigned og = xb_add(&bar[XB_TOP], 1u);
            const unsigned tg = og / nx;
            if (og + 1u == (tg + 1u) * nx) xb_add(&bar[XB_TOPGEN], 1u);
            else XB_SPIN(xb_ld(&bar[XB_TOPGEN]) == tg, bar);
            __builtin_amdgcn_fence(__ATOMIC_ACQUIRE, "agent");
            xb_add(&bar[XB_XGEN(b.x)], 1u);
            asm volatile("s_waitcnt vmcnt(0)" ::: "memory");
        } else {
            XB_SPIN(xb_ld(&bar[XB_XGEN(b.x)]) == gen, bar);
            __builtin_amdgcn_fence(__ATOMIC_ACQUIRE, "agent");
            asm volatile("s_waitcnt vmcnt(0)" ::: "memory");
        }
    }
    __syncthreads();
}
struct Args { const float* in[32]; float* out; unsigned char* ws; int l_lo, l_hi, p_lo, p_hi, do_pro, fused; };
enum { I_X = 0, I_EV_W_IN, I_EV_Q_NORM, I_EV_KV_NORM, I_EV_W_UQ, I_EV_W_UK, I_EV_W_UV, I_EV_W_IQ, I_EV_IDX_K_G, I_EV_IDX_K_B, I_EV_V_NORM_G, I_EV_V_NORM_B, I_EV_W_S, I_EV_B_S, I_EV_W_OUT,
       I_OD_W_IN, I_OD_LQ1, I_OD_LK1, I_OD_LQ2, I_OD_LK2, I_OD_SUBLN_G, I_OD_W_OUT, I_LN1_G, I_LN1_B, I_LN2_G, I_LN2_B, I_ROUTER_W, I_ROUTER_B, I_EXP_W_GU, I_EXP_B_GU, I_EXP_W_DN, I_EXP_B_DN };
struct Frame {
    LAS unsigned char* lds; char* ldsg; volatile LAS int* MISC; gu32* ctl;
    int tid, lane, wave, vcu, G;
    unsigned char* ws;
};
typedef const __attribute__((address_space(4))) Args* ArgsP;
#define WSP(T, off) ((T*)(ws_ + (off)))
#define PHASE_PROLOG() unsigned char* ws_ = F.ws; asm volatile("" : "+s"(ws_)); asm volatile("" : "+s"(a)); int vcu_ = F.vcu, G_ = F.G; asm volatile("" : "+s"(vcu_), "+s"(G_))
#define fresh_tid() tid_of(F.wave)

__device__ __forceinline__ void tr_block(const float* src, int ld, bf16_t* dst, int dld, float scale, LAS float* scr, int lane) {
#pragma unroll 8
    for (int i = 0; i < 32; ++i) { const int kk = 2 * i + (lane >> 5); scr[kk * 33 + (lane & 31)] = src[(size_t)kk * ld + (lane & 31)]; }
    LDS_WAIT(); asm volatile("" ::: "memory");
    const int c = lane & 7;
#pragma unroll
    for (int j = 0; j < 4; ++j) { const int n = (lane >> 3) + 8 * j; const LAS float* s = scr + (8 * c) * 33 + n;
        u32x4 o; o.x = pk2(s[0 * 33] * scale, s[1 * 33] * scale); o.y = pk2(s[2 * 33] * scale, s[3 * 33] * scale); o.z = pk2(s[4 * 33] * scale, s[5 * 33] * scale); o.w = pk2(s[6 * 33] * scale, s[7 * 33] * scale);
        *(GAS u32x4*)(dst + (size_t)n * dld + 8 * c) = o; }
    LDS_WAIT(); asm volatile("" ::: "memory");
}
__device__ __forceinline__ void tr_block8(const float* src, int ld, unsigned char* dst, int dld, float scale, LAS float* scr, int lane) {
#pragma unroll 8
    for (int i = 0; i < 32; ++i) { const int kk = 2 * i + (lane >> 5); scr[kk * 33 + (lane & 31)] = src[(size_t)kk * ld + (lane & 31)]; }
    LDS_WAIT(); asm volatile("" ::: "memory");
    const int n = lane >> 1, kh = (lane & 1) * 32; const LAS float* s = scr + kh * 33 + n;
#pragma unroll
    for (int j = 0; j < 2; ++j) { u32x4 o;
        o.x = pk4_fp8(s[(16 * j + 0) * 33] * scale, s[(16 * j + 1) * 33] * scale, s[(16 * j + 2) * 33] * scale, s[(16 * j + 3) * 33] * scale);
        o.y = pk4_fp8(s[(16 * j + 4) * 33] * scale, s[(16 * j + 5) * 33] * scale, s[(16 * j + 6) * 33] * scale, s[(16 * j + 7) * 33] * scale);
        o.z = pk4_fp8(s[(16 * j + 8) * 33] * scale, s[(16 * j + 9) * 33] * scale, s[(16 * j + 10) * 33] * scale, s[(16 * j + 11) * 33] * scale);
        o.w = pk4_fp8(s[(16 * j + 12) * 33] * scale, s[(16 * j + 13) * 33] * scale, s[(16 * j + 14) * 33] * scale, s[(16 * j + 15) * 33] * scale);
        *(GAS u32x4*)(dst + (size_t)n * dld + kh + 16 * j) = o; }
    LDS_WAIT(); asm volatile("" ::: "memory");
}
__device__ __forceinline__ void pro_phase(Frame& F, ArgsP a) {
    PHASE_PROLOG();
    const int ftid = fresh_tid(), flane = ftid & 63;
    LAS float* scr = (LAS float*)(F.lds + F.wave * 16384);
    const int gw = vcu_ * 8 + F.wave, NGW = G_ * 8;
    constexpr int IA = DEPTH * NEXP * 16 * 64, IB = DEPTH * NEXP * 16 * 32, IC = 2 * 16 * 46, ID = 2 * 16 * 96, IE = 2 * 16 * 32;
    for (int it = gw; it < IA + IB + IC + ID + IE; it += NGW) {
        int r = it;
        if (r < IA) { const int m = r >> 10, rem = r & 1023, kb = rem >> 6, nb = rem & 63, n0 = nb * 32;
            const int drow = 256 * ((n0 & 1023) >> 7) + 128 * (n0 >> 10) + (n0 & 127);
#if MOE_FP8
            tr_block8(a->in[I_EXP_W_GU] + (size_t)m * 1024 * 2048 + (size_t)(kb * 64) * 2048 + n0, 2048, WSP(unsigned char, WS_WGU) + ((size_t)m * 2048 + drow) * 1024 + kb * 64, 1024, 64.f, scr, flane); continue; }
#else
            tr_block(a->in[I_EXP_W_GU] + (size_t)m * 1024 * 2048 + (size_t)(kb * 64) * 2048 + n0, 2048, WSP(bf16_t, WS_WGU) + ((size_t)m * 2048 + drow) * 1024 + kb * 64, 1024, 1.f, scr, flane); continue; }
#endif
        r -= IA;
        if (r < IB) { const int m = r >> 9, rem = r & 511, kb = rem >> 5, nb = rem & 31;
#if MOE_FP8
            tr_block8(a->in[I_EXP_W_DN] + (size_t)m * 1024 * 1024 + (size_t)(kb * 64) * 1024 + nb * 32, 1024, WSP(unsigned char, WS_WDN) + ((size_t)m * 1024 + nb * 32) * 1024 + kb * 64, 1024, 64.f, scr, flane); continue; }
#else
            tr_block(a->in[I_EXP_W_DN] + (size_t)m * 1024 * 1024 + (size_t)(kb * 64) * 1024 + nb * 32, 1024, WSP(bf16_t, WS_WDN) + ((size_t)m * 1024 + nb * 32) * 1024 + kb * 64, 1024, 1.f, scr, flane); continue; }
#endif
        r -= IB;
        if (r < IC) { const int jj = r / 736, rem = r % 736, kb = rem / 46, nb = rem % 46;
            const int scol = nb < 14 ? nb * 32 : 452 + (nb - 14) * 32, drow = nb < 14 ? nb * 32 : 512 + (nb - 14) * 32;
            tr_block(a->in[I_EV_W_IN] + (size_t)jj * 1024 * E_IN_EVEN + (size_t)(kb * 64) * E_IN_EVEN + scol, E_IN_EVEN, WSP(bf16_t, WS_WINE) + ((size_t)jj * NE_PR + drow) * 1024 + kb * 64, 1024, 1.f, scr, flane); continue; }
        r -= IC;
        if (r < ID) { const int jj = r / 1536, rem = r % 1536, kb = rem / 96, nb = rem % 96;
            tr_block(a->in[I_OD_W_IN] + (size_t)jj * 1024 * NO_PR + (size_t)(kb * 64) * NO_PR + nb * 32, NO_PR, WSP(bf16_t, WS_WINO) + ((size_t)jj * NO_PR + nb * 32) * 1024 + kb * 64, 1024, nb < 32 ? 0.125f * LOG2E : 1.f, scr, flane); continue; }
        r -= ID;
        { const int jj = r / 512, rem = r % 512, kb = rem / 32, nb = rem % 32;
            tr_block(a->in[I_OD_W_OUT] + (size_t)jj * 1024 * 1024 + (size_t)(kb * 64) * 1024 + nb * 32, 1024, WSP(bf16_t, WS_WOUTO) + ((size_t)jj * 1024 + nb * 32) * 1024 + kb * 64, 1024, 1.f, scr, flane); }
    }
    const int gt = vcu_ * 512 + ftid, NGT = G_ * 512;
    for (int i = gt; i < 2 * 64 * 1024; i += NGT) { const int jj = i >> 16, rr = 448 + ((i >> 10) & 63), k = i & 1023;
        const float v = rr < 452 ? a->in[I_EV_W_IN][(size_t)jj * 1024 * E_IN_EVEN + (size_t)k * E_IN_EVEN + rr] : 0.f;
        WSP(bf16_t, WS_WINE)[((size_t)jj * NE_PR + rr) * 1024 + k] = (bf16_t)f2bf(v); }
    for (int i = gt; i < 2 * NQQ * 256; i += NGT) { const int jj = i / (NQQ * 256), rem = i % (NQQ * 256), n = rem >> 8, c = rem & 255; float v;
        if (n < 1024) { const int h = n >> 7, lat = n & 127; const float* uq = a->in[I_EV_W_UQ] + ((size_t)(jj * 256 + c) * 8 + h) * 64; const float* uk = a->in[I_EV_W_UK] + ((size_t)(jj * 8 + h) * 64) * 128 + lat;
            float s = 0.f;
            for (int d = 0; d < 64; ++d) s += uq[d] * uk[(size_t)d * 128];
            v = s * (0.125f * LOG2E); }
        else { const int hd = n - 1024; v = 0.125f * a->in[I_EV_W_IQ][(size_t)(jj * 256 + c) * 256 + hd]; }
        WSP(bf16_t, WS_WQE)[i] = (bf16_t)f2bf(v); }
    for (int i = gt; i < 2 * 1024 * NMX; i += NGT) { const int jj = i / (1024 * NMX), rem = i % (1024 * NMX), n = rem / NMX, k = rem % NMX; float v;
        const float* wo = a->in[I_EV_W_OUT] + (size_t)jj * 1024 * 1024 + n;
        if (k < 1024) { const int h = k >> 7, c = k & 127; const float* uv = a->in[I_EV_W_UV] + ((size_t)(jj * 8 + h) * 128 + c) * 64; float s = 0.f;
            for (int d = 0; d < 64; ++d) s += uv[d] * wo[(size_t)(h * 64 + d) * 1024];
            v = s; }
        else v = wo[(size_t)(512 + k - 1024) * 1024];
        WSP(bf16_t, WS_WOUTE)[i] = (bf16_t)f2bf(v); }
    for (int i = gt; i < DEPTH * 32768; i += NGT) { const int l = i >> 15, rem = i & 32767, k = rem >> 5, e = rem & 31; const float w = a->in[I_LN1_G][l * 1024 + k] * a->in[I_ROUTER_W][i];
        const unsigned h16 = f2bf(w), l16 = f2bf(w - bf2f((unsigned short)h16)); const int off = e * 2048 + (((k >> 3) ^ (e & 15)) << 4) + (k & 7) * 2;
        unsigned char* img = WSP(unsigned char, WS_WRT) + (size_t)l * 131072; *(bf16_t*)(img + off) = (bf16_t)h16; *(bf16_t*)(img + 65536 + off) = (bf16_t)l16; }
    for (int i = gw; i < DEPTH * 32; i += NGW) { const int l = i >> 5, e = i & 31; float s1 = 0.f, s2 = 0.f;
        for (int k = flane; k < 1024; k += 64) { const float wv = a->in[I_ROUTER_W][((size_t)l * 1024 + k) * 32 + e]; s1 += a->in[I_LN1_G][l * 1024 + k] * wv; s2 += a->in[I_LN1_B][l * 1024 + k] * wv; }
        s1 = wave_sum(s1); s2 = wave_sum(s2);
        if (flane == 0) { float* cc = WSP(float, WS_WRT + 512 * 1024) + l * 64; cc[e] = s1; cc[32 + e] = s2 + a->in[I_ROUTER_B][l * 32 + e]; } }
    for (int i = gt; i < 2 * 8 * 128 * 128; i += NGT) { const int ii = (i >> 7) & 127, jx = i & 127; WSP(bf16_t, WS_WS)[i] = (bf16_t)f2bf(jx <= ii ? a->in[I_EV_W_S][i] : 0.f); }
    for (int m = gw; m < T_TOK; m += NGW) { const GAS f32x4* xr = (const GAS f32x4*)(a->in[I_X] + (size_t)m * D_MODEL) + flane; GAS u32x2* o8 = (GAS u32x2*)(WSP(bf16_t, WS_HB) + (size_t)m * D_MODEL) + flane;
#pragma unroll
        for (int jx = 0; jx < 4; ++jx) { const f32x4 v = xr[64 * jx]; u32x2 w; w.x = pk2(v.x, v.y); w.y = pk2(v.z, v.w); o8[64 * jx] = w; } }
}

__device__ __forceinline__ void e1b_phase(Frame& F, ArgsP a, int l) {
    PHASE_PROLOG();
    const int j = l >> 1, lane = fresh_tid() & 63; const int gw = vcu_ * 8 + F.wave, NGW = G_ * 8;
    const float* qg = a->in[I_EV_Q_NORM] + j * 256; const float* kvg = a->in[I_EV_KV_NORM] + j * 128; const float* ig = a->in[I_EV_IDX_K_G] + j * 64; const float* ib = a->in[I_EV_IDX_K_B] + j * 64;
    const f32x4 g4 = *(const f32x4*)(qg + 4 * lane); const float kg0 = kvg[2 * lane], kg1 = kvg[2 * lane + 1], igl = ig[lane], ibl = ib[lane];
    const bf16_t* PR = WSP(bf16_t, WS_PR);
    for (int tok = gw; tok < T_TOK; tok += NGW) {
        const bf16_t* pr = PR + (size_t)tok * NE_PR;
        { const u32x2 w = *(const u32x2*)(pr + 4 * lane); const float a0 = bflo(w.x), a1 = bfhi(w.x), a2 = bflo(w.y), a3 = bfhi(w.y);
          const float ss = wave_sum(a0 * a0 + a1 * a1 + a2 * a2 + a3 * a3); const float rs = 1.0f / sqrtf(ss * (1.0f / 256.0f) + LN_EPS);
          u32x2 o; o.x = pk2(a0 * rs * g4.x, a1 * rs * g4.y); o.y = pk2(a2 * rs * g4.z, a3 * rs * g4.w); *(u32x2*)(WSP(bf16_t, WS_CQ) + (size_t)tok * 256 + 4 * lane) = o; }
        { const unsigned w = *(const unsigned*)(pr + 256 + 2 * lane); const float a0 = bflo(w), a1 = bfhi(w);
          const float ss = wave_sum(a0 * a0 + a1 * a1); const float rs = 1.0f / sqrtf(ss * (1.0f / 128.0f) + LN_EPS);
          *(unsigned*)(WSP(bf16_t, WS_CKV) + (size_t)tok * 128 + 2 * lane) = pk2(a0 * rs * kg0, a1 * rs * kg1); }
        { const float x = bf2f(pr[384 + lane]); const float mu = wave_sum(x) * (1.0f / 64.0f); const float d = x - mu; const float var = wave_sum(d * d) * (1.0f / 64.0f);
          WSP(bf16_t, WS_KI)[(size_t)tok * 64 + lane] = (bf16_t)f2bf(d * (1.0f / sqrtf(var + LN_EPS)) * igl + ibl); }
        if (lane < 4) WSP(float, WS_WI)[(size_t)tok * 4 + lane] = 0.5f * bf2f(pr[448 + lane]);
    }
}

__device__ __forceinline__ unsigned ord_key(float f) { const unsigned u = __builtin_bit_cast(unsigned, f); return (u & 0x80000000u) ? ~u : (u | 0x80000000u); }
__device__ __forceinline__ void e3a_phase(Frame& F, ArgsP a) {
    PHASE_PROLOG();
    const int tid = fresh_tid(), wid = F.wave, lane = tid & 63, fr = lane & 15, fq = lane >> 4;
    LAS float* sc = (LAS float*)F.lds;
    const bf16_t* QQ = WSP(bf16_t, WS_QQ); const bf16_t* KI = WSP(bf16_t, WS_KI); const float* WI = WSP(float, WS_WI);
    unsigned long long* MASK = WSP(unsigned long long, WS_MASK);
    for (int L = vcu_; L < BATCH * (SEQ / 16); L += G_) {
        const int b = L >> 7, qb = ((L & 127) + 8 * (L >> 8)) & 127, t0 = qb * 16, NT = t0 / 64 + 1;
        const size_t rb0 = (size_t)b * SEQ;
        bf16x8 qf[4][2]; f32x4 wq4;
        { const bf16_t* qp = QQ + (rb0 + t0 + fr) * NQQ + 1024 + fq * 8;
#pragma unroll
          for (int h = 0; h < 4; ++h)
#pragma unroll
              for (int ks = 0; ks < 2; ++ks) qf[h][ks] = *(const bf16x8*)(qp + h * 64 + ks * 32);
          wq4 = *(const f32x4*)(WI + (rb0 + t0 + fr) * 4); }
#ifndef E3A_REP_SC
#define E3A_REP_SC 1
#endif
#ifndef E3A_REP_SEL
#define E3A_REP_SEL 1
#endif
#pragma unroll 1
        for (int rsc = 0; rsc < E3A_REP_SC; ++rsc)
        for (int kt = wid; kt < NT; kt += 8) {
#pragma unroll
            for (int kb = 0; kb < 4; ++kb) { const bf16_t* kp = KI + (rb0 + kt * 64 + kb * 16 + fr) * 64 + fq * 8;
                const bf16x8 k0 = *(const bf16x8*)kp, k1 = *(const bf16x8*)(kp + 32);
                f32x4 s4 = (f32x4){0.f, 0.f, 0.f, 0.f};
#pragma unroll
                for (int h = 0; h < 4; ++h) { f32x4 acc = (f32x4){0.f, 0.f, 0.f, 0.f};
                    acc = __builtin_amdgcn_mfma_f32_16x16x32_bf16(k0, qf[h][0], acc, 0, 0, 0); acc = __builtin_amdgcn_mfma_f32_16x16x32_bf16(k1, qf[h][1], acc, 0, 0, 0);
#pragma unroll
                    for (int q = 0; q < 4; ++q) s4[q] += fmaxf(acc[q], 0.f) * wq4[h]; }
                s4 += 0.0f;
                *(LAS f32x4*)(sc + fr * 2048 + kt * 64 + kb * 16 + fq * 4) = s4; }
        }
        __syncthreads();
#pragma unroll 1
        for (int qq2 = 0; qq2 < 2 * E3A_REP_SEL; ++qq2) { const int qq = qq2 & 1; const int q = 2 * wid + qq; const int tq = t0 + q;
            unsigned long long myword = 0ull; int lane_q = lane; asm volatile("" : "+v"(lane_q));
            if (NT <= 4) { myword = (lane < NT) ? ~0ull : 0ull; }
            else {
                unsigned x[32];
                { float f[32];
#pragma unroll
                  for (int i = 0; i < 32; ++i) f[i] = sc[q * 2048 + i * 64 + lane_q];
#pragma unroll
                  for (int i = 0; i < 32; ++i) x[i] = (i * 64 + lane_q < NT * 64) ? ord_key(f[i]) : 0u; }
                unsigned prefix = 0u;
                bool exact = false;
                for (int bit = 31; bit >= 0; --bit) { const unsigned cand = prefix | (1u << bit); int cnt = 0;
#pragma unroll
                    for (int g = 0; g < 2; ++g) { if (16 * g < NT) { unsigned long long m[16];
#pragma unroll
                            for (int i = 0; i < 16; ++i) asm volatile("v_cmp_ge_u32_e64 %0, %1, %2" : "=s"(m[i]) : "v"(x[16 * g + i]), "s"(cand));
                            __builtin_amdgcn_sched_barrier(0);
#pragma unroll
                            for (int i = 0; i < 16; ++i) cnt += __builtin_popcountll(m[i]);
                            __builtin_amdgcn_sched_barrier(0); } }
                    if (cnt >= N_SEL) { prefix = cand; if (cnt == N_SEL) { exact = true; break; } } }
                int wlo = 0, whi = 0;
                if (exact) {
#pragma unroll
                    for (int i = 0; i < 32; ++i)
                        asm volatile("v_cmp_ge_u32_e64 vcc, %2, %3\n\ts_nop 4\n\tv_writelane_b32 %0, vcc_lo, %4\n\tv_writelane_b32 %1, vcc_hi, %4" : "+v"(wlo), "+v"(whi) : "v"(x[i]), "s"(prefix), "n"(i) : "vcc");
                } else {
                    const unsigned Tk = prefix; int cgt = 0;
#pragma unroll
                    for (int i = 0; i < 32; ++i) { cgt += __builtin_popcountll(__builtin_amdgcn_ballot_w64(x[i] > Tk)); if ((i & 7) == 7) __builtin_amdgcn_sched_barrier(0); }
                    int need = N_SEL - cgt;
#pragma unroll
                    for (int i = 0; i < 32; ++i) { const bool eq = x[i] == Tk; const unsigned long long meq = __builtin_amdgcn_ballot_w64(eq);
                        const int rank = (int)__builtin_amdgcn_mbcnt_hi((unsigned)(meq >> 32), __builtin_amdgcn_mbcnt_lo((unsigned)meq, 0u));
                        const unsigned long long sel = __builtin_amdgcn_ballot_w64((x[i] > Tk) || (eq && rank < need));
                        need = max(need - (int)__builtin_popcountll(meq), 0);
                        asm volatile("s_nop 4\n\tv_writelane_b32 %0, %2, %4\n\tv_writelane_b32 %1, %3, %4" : "+v"(wlo), "+v"(whi) : "s"((unsigned)sel), "s"((unsigned)(sel >> 32)), "n"(i));
                        __builtin_amdgcn_sched_barrier(0); }
                }
                myword = ((unsigned long long)(unsigned)whi << 32) | (unsigned long long)(unsigned)wlo;
            }
            if (lane < 32) MASK[(rb0 + tq) * 32 + lane] = myword;
        }
        __syncthreads();
    }
}

__device__ __forceinline__ void dsa_phase(Frame& F, ArgsP a) {
    PHASE_PROLOG();
    const int tid = fresh_tid(), wid = __builtin_amdgcn_readfirstlane(tid >> 6), lane = tid & 63, r32 = lane & 31, hi = lane >> 5;
    LAS char* lds = (LAS char*)F.lds; LAS unsigned long long* msk = (LAS unsigned long long*)(lds + att::ATT_LDS_CORE);
    const GAS bf16_t* QQ = (const GAS bf16_t*)WSP(bf16_t, WS_QQ); const GAS bf16_t* CKV = (const GAS bf16_t*)WSP(bf16_t, WS_CKV); const GAS unsigned long long* MASK = (const GAS unsigned long long*)WSP(unsigned long long, WS_MASK); GAS bf16_t* MX = (GAS bf16_t*)WSP(bf16_t, WS_MX);
    const float slope2 = exp2f(-(float)(wid + 1)) * LOG2E;
    for (int L = vcu_; L < BATCH * (SEQ / 32); L += G_) {
        const int i = L >> 8, v = L & 255, b = v >> 3, c8 = v & 7, jx = (i & 1) ? 7 - c8 : c8, qb = 63 - (8 * i + jx), t0 = qb * 32, NT = t0 / 64 + 1;
        const size_t rb0 = (size_t)b * SEQ;
        for (int k = tid; k < 1024; k += 512) { const int q = k >> 5, jj = k & 31; msk[jj * 32 + q] = MASK[(rb0 + t0 + q) * 32 + jj]; }
        f32x16 o[4]; float l_reg;
        att::attn_core<128, true, true>(QQ + (rb0 + t0) * NQQ + wid * 128, NQQ, CKV + rb0 * 128, 128, CKV + rb0 * 128, 128, NT, NT, slope2, t0, msk, lds, o, l_reg, wid);
        float rli[16]; att::row_rcp(l_reg, lds, rli, wid);
        GAS bf16_t* Ow = MX + (rb0 + t0) * NMX + wid * 128;
#pragma unroll
        for (int r = 0; r < 16; ++r) { int orow = att::crow(r, hi); asm volatile("" : "+v"(orow));
#pragma unroll
            for (int d0 = 0; d0 < 4; ++d0) Ow[(size_t)orow * NMX + d0 * 32 + r32] = (bf16_t)f2bf(o[d0][r] * rli[r]); }
    }
}

__device__ __forceinline__ void gml_phase(Frame& F, ArgsP a, int l) {
    PHASE_PROLOG();
    const int j = l >> 1, tid = fresh_tid(), g = F.wave, lane = tid & 63;
    LAS float* stat = (LAS float*)(F.lds + 131072 - 1024);
    stat = (LAS float*)(F.MISC + MI_REC);
    LAS unsigned char* vT = F.lds + g * 16384;
    const GAS bf16_t* PR = (const GAS bf16_t*)WSP(bf16_t, WS_PR); GAS bf16_t* MX = (GAS bf16_t*)WSP(bf16_t, WS_MX); const GAS bf16_t* Wt = (const GAS bf16_t*)WSP(bf16_t, WS_WS) + (size_t)(j * 8 + g) * 128 * 128;
    const float* vg = a->in[I_EV_V_NORM_G] + j * GW; const float* vb = a->in[I_EV_V_NORM_B] + j * GW; const float* bs = a->in[I_EV_B_S] + (size_t)(j * 8 + g) * 128;
    for (int L = vcu_; L < BATCH * (SEQ / GCH); L += G_) {
        const size_t tok0 = (size_t)(L >> 4) * SEQ + (size_t)(L & 15) * GCH;
        for (int tt = 0; tt < 16; ++tt) { const int tl = g * 16 + tt; const u32x4 w = *(const GAS u32x4*)(PR + (tok0 + tl) * NE_PR + 1024 + 8 * lane);
            const float x0 = bflo(w.x), x1 = bfhi(w.x), x2 = bflo(w.y), x3 = bfhi(w.y), x4 = bflo(w.z), x5 = bfhi(w.z), x6 = bflo(w.w), x7 = bfhi(w.w);
            const float mu = wave_sum(((x0 + x1) + (x2 + x3)) + ((x4 + x5) + (x6 + x7))) * (1.0f / 512.0f);
            const float d0 = x0 - mu, d1 = x1 - mu, d2 = x2 - mu, d3 = x3 - mu, d4 = x4 - mu, d5 = x5 - mu, d6 = x6 - mu, d7 = x7 - mu;
            const float var = wave_sum(((d0 * d0 + d1 * d1) + (d2 * d2 + d3 * d3)) + ((d4 * d4 + d5 * d5) + (d6 * d6 + d7 * d7))) * (1.0f / 512.0f);
            if (lane == 0) { stat[2 * tl] = mu; stat[2 * tl + 1] = 1.0f / sqrtf(var + LN_EPS); } }
        __syncthreads();
        for (int it = 0; it < 16; ++it) { const int idx = it * 64 + lane, tl = idx >> 3, ch8 = idx & 7;
            const u32x4 w = *(const GAS u32x4*)(PR + (tok0 + tl) * NE_PR + 1024 + g * 64 + ch8 * 8);
            const float mu = stat[2 * tl], rs = stat[2 * tl + 1];
            float xv[8] = {bflo(w.x), bfhi(w.x), bflo(w.y), bfhi(w.y), bflo(w.z), bfhi(w.z), bflo(w.w), bfhi(w.w)};
#pragma unroll
            for (int q = 0; q < 8; ++q) { const int c = ch8 * 8 + q; const float y = (xv[q] - mu) * rs * vg[g * 64 + c] + vb[g * 64 + c];
                *(LAS bf16_t*)(vT + c * 256 + ((((tl >> 3) ^ (c & 15)) << 4) | ((tl & 7) * 2))) = (bf16_t)f2bf(y); } }
        LDS_WAIT(); asm volatile("" ::: "memory");
#pragma unroll 1
        for (int mh = 0; mh < 2; ++mh) {
            f32x4 acc[4][4];
#pragma unroll
            for (int mi = 0; mi < 4; ++mi)
#pragma unroll
                for (int ni = 0; ni < 4; ++ni) acc[mi][ni] = (f32x4){0.f, 0.f, 0.f, 0.f};
#pragma unroll
            for (int ks = 0; ks < 4; ++ks) { bf16x8 bfr[4];
#pragma unroll
                for (int ni = 0; ni < 4; ++ni) { const int c = 16 * ni + (lane & 15), ch = (ks * 4 + (lane >> 4)) ^ (c & 15); bfr[ni] = *(const LAS bf16x8*)(vT + c * 256 + (ch << 4)); }
#pragma unroll
                for (int mi = 0; mi < 4; ++mi) { if (32 * ks <= 16 * (4 * mh + mi) + 15) { int wrow = 16 * (4 * mh + mi) + (lane & 15); asm volatile("" : "+v"(wrow)); const bf16x8 af = *(const GAS bf16x8*)(Wt + (size_t)wrow * 128 + 32 * ks + 8 * (lane >> 4));
#pragma unroll
                        for (int ni = 0; ni < 4; ++ni) acc[mi][ni] = __builtin_amdgcn_mfma_f32_16x16x32_bf16(af, bfr[ni], acc[mi][ni], 0, 0, 0); } } }
#pragma unroll
            for (int mi = 0; mi < 4; ++mi)
#pragma unroll
                for (int q = 0; q < 4; ++q) { int ii = 16 * (4 * mh + mi) + 4 * (lane >> 4) + q; asm volatile("" : "+v"(ii)); const float bsv = bs[ii];
#pragma unroll
                    for (int ni = 0; ni < 4; ++ni) { const int col = g * 64 + 16 * ni + (lane & 15); const float uv = bf2f(PR[(tok0 + ii) * NE_PR + 512 + col]);
                        MX[(tok0 + ii) * NMX + 1024 + col] = (bf16_t)f2bf(uv * (acc[mi][ni][q] + bsv)); }
                    __builtin_amdgcn_sched_barrier(0); }
        }
        __syncthreads();
    }
}

__device__ __forceinline__ void datt_phase(Frame& F, ArgsP a, int l) {
    PHASE_PROLOG();
    const int j = l >> 1, tid = fresh_tid(), wid = __builtin_amdgcn_readfirstlane(tid >> 6), lane = tid & 63, r32 = lane & 31, hi = lane >> 5;
    LAS char* lds = (LAS char*)F.lds; LAS unsigned* stash = (LAS unsigned*)(lds + att::ATT_LDS_CORE);
    const GAS bf16_t* PR = (const GAS bf16_t*)WSP(bf16_t, WS_PR); GAS bf16_t* OA = (GAS bf16_t*)WSP(bf16_t, WS_MX);
    const float lam_init = 0.8f - 0.6f * expf(-0.3f * (float)l);
    float lam;
    { const float s1 = wave_sum(a->in[I_OD_LQ1][j * 64 + lane] * a->in[I_OD_LK1][j * 64 + lane]), s2 = wave_sum(a->in[I_OD_LQ2][j * 64 + lane] * a->in[I_OD_LK2][j * 64 + lane]);
      lam = expf(s1) - expf(s2) + lam_init; }
    const float* sg = a->in[I_OD_SUBLN_G] + j * 128;
    for (int L = vcu_; L < BATCH * H_C * (SEQ / 256); L += G_) {
        const int qb = 7 - (L >> 8), v = L & 255, b = v >> 3, h = v & 7;
        const size_t rb0 = (size_t)b * SEQ; const int t0w = qb * 256 + 32 * wid, NTB = 4 * qb + 4, NTW = t0w / 64 + 1;
        const float slope2 = exp2f(-(float)(h + 1)) * LOG2E;
#pragma unroll 1
        for (int m = 0; m < 2; ++m) {
            f32x16 o[4]; float l_reg;
            att::attn_core<64, false, false>(PR + (rb0 + t0w) * NO_PR + h * 128 + m * 64, NO_PR, PR + rb0 * NO_PR + 1024 + h * 128 + m * 64, NO_PR, PR + rb0 * NO_PR + 2048 + h * 128, NO_PR,
                                             NTB, NTW, slope2, t0w, nullptr, lds, o, l_reg, wid);
            float rli[16]; att::row_rcp(l_reg, lds, rli, wid);
            if (m == 0) {
#pragma unroll
                for (int d0 = 0; d0 < 4; ++d0)
#pragma unroll
                    for (int r = 0; r < 16; r += 2) stash[(d0 * 8 + (r >> 1)) * 512 + tid] = att::cvtpk(o[d0][r] * rli[r], o[d0][r + 1] * rli[r + 1]);
            } else {
                float ssq[16];
#pragma unroll
                for (int r = 0; r < 16; ++r) ssq[r] = 0.f;
#pragma unroll
                for (int d0 = 0; d0 < 4; ++d0)
#pragma unroll
                    for (int r = 0; r < 16; r += 2) { const unsigned w = stash[(d0 * 8 + (r >> 1)) * 512 + tid];
                        const float y0 = bflo(w) - lam * (o[d0][r] * rli[r]), y1 = bfhi(w) - lam * (o[d0][r + 1] * rli[r + 1]);
                        o[d0][r] = y0; o[d0][r + 1] = y1; ssq[r] += y0 * y0; ssq[r + 1] += y1 * y1; if ((r & 6) == 6) __builtin_amdgcn_sched_barrier(0); }
#pragma unroll
                for (int r = 0; r < 16; ++r) { float s = ssq[r]; s += xshfl<1>(s, 0); s += xshfl<2>(s, 0); s += xshfl<4>(s, 0); s += xshfl<8>(s, 0); s += xshfl<16>(s, 0);
                    ssq[r] = (1.0f - lam_init) / sqrtf(s * (1.0f / 128.0f) + LN_EPS); }
                GAS bf16_t* Ow = OA + (rb0 + t0w) * D_MODEL + h * 128;
#pragma unroll
                for (int d0 = 0; d0 < 4; ++d0) { const float gv = sg[d0 * 32 + r32];
#pragma unroll
                    for (int r = 0; r < 16; ++r) { int orow = att::crow(r, hi); asm volatile("" : "+v"(orow)); Ow[(size_t)orow * D_MODEL + d0 * 32 + r32] = (bf16_t)f2bf(o[d0][r] * ssq[r] * gv); }
                    __builtin_amdgcn_sched_barrier(0); }
            }
        }
    }
}

template <int H, int BIT> __device__ __forceinline__ void rs_step(float (&p)[32], int lane) {
    if constexpr (BIT == 32) {
#pragma unroll
        for (int i = 0; i < H; ++i) { unsigned u0, u1; plswap(__builtin_bit_cast(unsigned, p[i]), __builtin_bit_cast(unsigned, p[H + i]), u0, u1);
            p[i] = __builtin_bit_cast(float, u0) + __builtin_bit_cast(float, u1); }
    } else {
        const bool up = (lane & BIT) != 0;
#pragma unroll
        for (int i = 0; i < H; ++i) { const float keep = up ? p[H + i] : p[i], send = up ? p[i] : p[H + i]; p[i] = keep + xshfl<BIT>(send, lane); }
    }
}
template <int N> __device__ __forceinline__ void ln16(float (&v)[16], const float (&gg)[16], const float (&bb)[16]) {
    float s = 0.f;
#pragma unroll
    for (int i = 0; i < 16; ++i) s += v[i];
    const float mean = wave_sum(s) * (1.0f / 1024.0f); float s2 = 0.f;
#pragma unroll
    for (int i = 0; i < 16; ++i) { v[i] -= mean; s2 += v[i] * v[i]; }
    const float rstd = 1.0f / sqrtf(wave_sum(s2) * (1.0f / 1024.0f) + LN_EPS);
#pragma unroll
    for (int i = 0; i < 16; ++i) v[i] = v[i] * rstd * gg[i] + bb[i];
}
__device__ __forceinline__ void lnr_load_ln(const bf16_t* zrow, float* hrow, bf16_t* hbrow, unsigned char* hb8row, const float* g1, const float* b1, int lane, float (&hv)[16]) {
    float gg[16], bb[16];
#pragma unroll
    for (int jj = 0; jj < 4; ++jj) { const u32x2 zw = *(const u32x2*)(zrow + 256 * jj + 4 * lane); const f32x4 z4 = (f32x4){bflo(zw.x), bfhi(zw.x), bflo(zw.y), bfhi(zw.y)}; const f32x4 g4 = *(const f32x4*)(g1 + 256 * jj + 4 * lane), b4 = *(const f32x4*)(b1 + 256 * jj + 4 * lane);
#pragma unroll
        for (int i = 0; i < 4; ++i) { hv[jj * 4 + i] = z4[i]; gg[jj * 4 + i] = g4[i]; bb[jj * 4 + i] = b4[i]; } }
    ln16<0>(hv, gg, bb);
#pragma unroll
    for (int jj = 0; jj < 4; ++jj) {
        u32x2 w; w.x = pk2(hv[jj * 4], hv[jj * 4 + 1]); w.y = pk2(hv[jj * 4 + 2], hv[jj * 4 + 3]); *(u32x2*)(hbrow + 256 * jj + 4 * lane) = w;
#if MOE_FP8
        *(unsigned*)(hb8row + 256 * jj + 4 * lane) = pk4_fp8(hv[jj * 4], hv[jj * 4 + 1], hv[jj * 4 + 2], hv[jj * 4 + 3]);
#endif
    }
}
__device__ __forceinline__ void lnr_tail(Frame& F, unsigned char* ws_, float* gate_out, float (&part)[32], float rbias, int tl, size_t tok, int lane) {
    rs_step<4, 8>(part, lane); rs_step<2, 4>(part, lane); rs_step<1, 2>(part, lane);
    float v = part[0] + xshfl<1>(part[0], lane) + rbias;
    float t0, t1, t2, t3; int e0, e1, e2, e3;
#define LNR_PICK(tk, ek) do { const float m_ = wave_max(v); const unsigned long long bm_ = __builtin_amdgcn_ballot_w64(v == m_); ek = __builtin_ctzll(bm_) >> 1; tk = m_; if ((lane >> 1) == ek) v = -INFINITY; } while (0)
    LNR_PICK(t0, e0); LNR_PICK(t1, e1); LNR_PICK(t2, e2); LNR_PICK(t3, e3);
#undef LNR_PICK
    const float x1 = fast_exp2((t1 - t0) * LOG2E), x2 = fast_exp2((t2 - t0) * LOG2E), x3 = fast_exp2((t3 - t0) * LOG2E);
    const float inv = 1.0f / (1.0f + x1 + x2 + x3);
    if (lane < 4) { const int ek = lane == 0 ? e0 : lane == 1 ? e1 : lane == 2 ? e2 : e3; const float gk = (lane == 0 ? 1.0f : lane == 1 ? x1 : lane == 2 ? x2 : x3) * inv;
        const int lr = __hip_atomic_fetch_add((LAS int*)&F.MISC[MI_LCNT + ek], 1, __ATOMIC_RELAXED, __HIP_MEMORY_SCOPE_WORKGROUP);
        F.MISC[MI_REC + tl * 4 + lane] = (ek << 16) | lr;
        gate_out[tok * 4 + lane] = gk; }
}
__device__ __forceinline__ void lnr_phase(Frame& F, ArgsP a, int l, bool dry = false) {
    PHASE_PROLOG();
    const int tid = fresh_tid(), wid = F.wave, lane = tid & 63;
    LAS float* rws = (LAS float*)F.lds;
    { const float* rw = a->in[I_ROUTER_W] + (size_t)l * 1024 * 32;
      for (int idx = tid; idx < 32768; idx += 512) { const int d = idx >> 5, e = idx & 31, jj = d >> 8, ln = (d & 255) >> 2, i = d & 3; rws[((jj * 4 + i) * 8 + (e >> 2)) * 256 + ln * 4 + (e & 3)] = rw[idx]; } }
    const float* g1 = a->in[I_LN1_G] + l * 1024; const float* b1 = a->in[I_LN1_B] + l * 1024;
    const float rbias = a->in[I_ROUTER_B][l * 32 + ((lane >> 1) & 31)];
    const bf16_t* Z = WSP(bf16_t, WS_Z); float* H32 = a->out; bf16_t* HB = dry ? WSP(bf16_t, WS_PR) : WSP(bf16_t, WS_HB); unsigned char* HB8 = dry ? WSP(unsigned char, WS_QQ) : WSP(unsigned char, WS_HB8);
    float* gate_out = dry ? WSP(float, WS_WI) : WSP(float, WS_GATE); int* rowtok = dry ? WSP(int, WS_MASK) : WSP(int, WS_ROWTOK); unsigned* slot_out = dry ? WSP(unsigned, WS_CKV) : WSP(unsigned, WS_SLOT);
    gu32* cur = F.ctl + CW_CUR + (size_t)(dry ? l + 4 : l) * 32 * 64;
    __syncthreads();
    for (int u = vcu_; u < T_TOK / 256; u += G_) {
        if (tid < 32) F.MISC[MI_LCNT + tid] = 0;
        __syncthreads();
#pragma unroll 1
        for (int tp = 0; tp < 16; ++tp) {
            const int tl0 = wid * 32 + 2 * tp; const size_t tok0 = (size_t)u * 256 + tl0;
            float hv0[16], hv1[16];
            lnr_load_ln(Z + tok0 * D_MODEL, H32 + tok0 * D_MODEL, HB + tok0 * D_MODEL, HB8 + tok0 * D_MODEL, g1, b1, lane, hv0);
            lnr_load_ln(Z + (tok0 + 1) * D_MODEL, H32 + (tok0 + 1) * D_MODEL, HB + (tok0 + 1) * D_MODEL, HB8 + (tok0 + 1) * D_MODEL, g1, b1, lane, hv1);
            __builtin_amdgcn_sched_barrier(0);
            f32x4 pv0[8], pv1[8]; LAS float* rw_ = rws + lane * 4; asm volatile("" : "+v"(rw_));
#pragma unroll
            for (int e = 0; e < 8; ++e) { pv0[e] = (f32x4){0.f, 0.f, 0.f, 0.f}; pv1[e] = (f32x4){0.f, 0.f, 0.f, 0.f}; }
#pragma unroll
            for (int ji = 0; ji < 16; ++ji) {
#pragma unroll
                for (int e4 = 0; e4 < 8; ++e4) { const f32x4 w4 = *(const LAS f32x4*)(rw_ + (ji * 8 + e4) * 256); pv0[e4] += w4 * hv0[ji]; pv1[e4] += w4 * hv1[ji]; }
                __builtin_amdgcn_sched_barrier(0); }
            float part0[32], part1[32];
#pragma unroll
            for (int e = 0; e < 32; ++e) part0[e] = pv0[e >> 2][e & 3];
            rs_step<16, 32>(part0, lane); rs_step<8, 16>(part0, lane);
            __builtin_amdgcn_sched_barrier(0);
#pragma unroll
            for (int e = 0; e < 32; ++e) part1[e] = pv1[e >> 2][e & 3];
            rs_step<16, 32>(part1, lane); rs_step<8, 16>(part1, lane);
            __builtin_amdgcn_sched_barrier(0);
            lnr_tail(F, ws_, gate_out, part0, rbias, tl0, tok0, lane);
            __builtin_amdgcn_sched_barrier(0);
            lnr_tail(F, ws_, gate_out, part1, rbias, tl0 + 1, tok0 + 1, lane);
            __builtin_amdgcn_sched_barrier(0);
        }
        __syncthreads();
        if (tid < 32) { const int c = F.MISC[MI_LCNT + tid]; F.MISC[MI_LBASE + tid] = c ? (int)__hip_atomic_fetch_add(cur + tid * 64, (unsigned)c, RLX_AGENT) : 0; }
        __syncthreads();
        for (int i = tid; i < 1024; i += 512) { const int rec = F.MISC[MI_REC + i], e = rec >> 16, rank = F.MISC[MI_LBASE + e] + (rec & 0xffff); const int tok = u * 256 + (i >> 2);
            rowtok[(size_t)(dry ? (e & 31) : e) * 65536 + (dry ? (rank & 32767) : rank)] = tok; slot_out[(size_t)tok * 4 + (i & 3)] = ((unsigned)e << 20) | (unsigned)rank; }
        __syncthreads();
    }
}

__device__ __forceinline__ void lnr2_phase(Frame& F, ArgsP a, int l, bool dry = false) {
    PHASE_PROLOG();
    const int tid = fresh_tid(), wid = __builtin_amdgcn_readfirstlane(tid >> 6), lane = tid & 63, r32 = lane & 31, hi = lane >> 5;
    LAS unsigned char* Wh = F.lds; LAS unsigned char* Wl = F.lds + 65536;
    LAS float* stats = (LAS float*)(F.lds + RING_BYTES);
    LAS float* cc = (LAS float*)(F.MISC + MI_RBE);
    const float* g1 = a->in[I_LN1_G] + l * 1024; const float* b1 = a->in[I_LN1_B] + l * 1024;
    { const GAS u32x4* img = (const GAS u32x4*)(WSP(unsigned char, WS_WRT) + (size_t)l * 131072);
      for (int i = tid; i < 8192; i += 512) *(LAS u32x4*)(F.lds + i * 16) = img[i];
      if (tid < 64) cc[tid] = WSP(float, WS_WRT + 512 * 1024)[l * 64 + tid]; }
    const GAS bf16_t* Z = (const GAS bf16_t*)WSP(bf16_t, WS_Z); GAS bf16_t* HB = (GAS bf16_t*)(dry ? WSP(bf16_t, WS_PR) : WSP(bf16_t, WS_HB)); GAS unsigned char* HB8 = (GAS unsigned char*)(dry ? WSP(unsigned char, WS_QQ) : WSP(unsigned char, WS_HB8));
    float* gate_out = dry ? WSP(float, WS_WI) : WSP(float, WS_GATE); int* rowtok = dry ? WSP(int, WS_MASK) : WSP(int, WS_ROWTOK); unsigned* slot_out = dry ? WSP(unsigned, WS_CKV) : WSP(unsigned, WS_SLOT);
    gu32* cur = F.ctl + CW_CUR + (size_t)(dry ? l + 4 : l) * 32 * 64;
    float gg[16], bb[16];
#pragma unroll
    for (int jj = 0; jj < 4; ++jj) { const f32x4 g4 = *(const f32x4*)(g1 + 256 * jj + 4 * lane), b4 = *(const f32x4*)(b1 + 256 * jj + 4 * lane);
#pragma unroll
        for (int i = 0; i < 4; ++i) { gg[jj * 4 + i] = g4[i]; bb[jj * 4 + i] = b4[i]; } }
    __syncthreads();
    for (int u = vcu_; u < T_TOK / 256; u += G_) {
        if (tid < 32) F.MISC[MI_LCNT + tid] = 0;
        __syncthreads();
        {
            const int tl = 32 * wid + r32; const size_t tok = (size_t)u * 256 + tl;
            const GAS bf16_t* zp = Z + tok * D_MODEL + 512 * hi;
            const LAS unsigned char* whp = Wh + r32 * 2048; const LAS unsigned char* wlp = Wl + r32 * 2048; const int sw = r32 & 15;
            f32x16 acc = f32x16{}; float sm = 0.f, sq = 0.f;
#pragma unroll 8
            for (int sx = 0; sx < 64; ++sx) { const u32x4 zw = *(const GAS u32x4*)(zp + 8 * sx); const bf16x8 zf = __builtin_bit_cast(bf16x8, zw);
                const int ch = ((64 * hi + sx) ^ sw) << 4;
                const bf16x8 ah = *(const LAS bf16x8*)(whp + ch), al = *(const LAS bf16x8*)(wlp + ch);
                acc = __builtin_amdgcn_mfma_f32_32x32x16_bf16(ah, zf, acc, 0, 0, 0); acc = __builtin_amdgcn_mfma_f32_32x32x16_bf16(al, zf, acc, 0, 0, 0);
#pragma unroll
                for (int q = 0; q < 4; ++q) { const float x0 = bflo(zw[q]), x1 = bfhi(zw[q]); sm += x0 + x1; sq += x0 * x0 + x1 * x1; } }
            { float r0, r1; half_swap(sm, r0, r1); sm = r0 + r1; half_swap(sq, r0, r1); sq = r0 + r1; }
            const float mu = sm * (1.0f / 1024.0f); const float rstd = 1.0f / sqrtf(fmaxf(sq * (1.0f / 1024.0f) - mu * mu, 0.f) + LN_EPS);
            if (hi == 0) { stats[2 * tl] = mu; stats[2 * tl + 1] = rstd; }
            float lg[16];
#pragma unroll
            for (int r = 0; r < 16; ++r) { const int e = att::crow(r, hi); lg[r] = rstd * (acc[r] - mu * cc[e]) + cc[32 + e]; }
            float cv[8]; int ci[8];
#pragma unroll
            for (int k = 0; k < 4; ++k) { float best = -INFINITY; int bid = 0;
#pragma unroll
                for (int r = 0; r < 16; ++r) { const int e = att::crow(r, hi); if (lg[r] > best) { best = lg[r]; bid = e; } }
                cv[k] = best; ci[k] = bid;
#pragma unroll
                for (int r = 0; r < 16; ++r) if (att::crow(r, hi) == bid) lg[r] = -INFINITY; }
#pragma unroll
            for (int k = 0; k < 4; ++k) { unsigned a0, a1, b0, b1; plswap(__builtin_bit_cast(unsigned, cv[k]), __builtin_bit_cast(unsigned, cv[k]), a0, a1); plswap((unsigned)ci[k], (unsigned)ci[k], b0, b1);
                cv[4 + k] = __builtin_bit_cast(float, hi ? a0 : a1); ci[4 + k] = (int)(hi ? b0 : b1); }
            float tv[4]; int te[4];
#pragma unroll
            for (int k = 0; k < 4; ++k) { float best = -INFINITY; int bid = 1 << 20;
#pragma unroll
                for (int i = 0; i < 8; ++i) if (cv[i] > best || (cv[i] == best && ci[i] < bid)) { best = cv[i]; bid = ci[i]; }
                tv[k] = best; te[k] = bid;
#pragma unroll
                for (int i = 0; i < 8; ++i) if (ci[i] == bid) cv[i] = -INFINITY; }
            const float x1 = fast_exp2((tv[1] - tv[0]) * LOG2E), x2 = fast_exp2((tv[2] - tv[0]) * LOG2E), x3 = fast_exp2((tv[3] - tv[0]) * LOG2E);
            const float inv = 1.0f / (1.0f + x1 + x2 + x3);
            if (hi == 0) {
#pragma unroll
                for (int k = 0; k < 4; ++k) { const int lr = __hip_atomic_fetch_add((LAS int*)&F.MISC[MI_LCNT + te[k]], 1, __ATOMIC_RELAXED, __HIP_MEMORY_SCOPE_WORKGROUP);
                    F.MISC[MI_REC + tl * 4 + k] = (te[k] << 16) | lr; }
                *(f32x4*)(gate_out + tok * 4) = (f32x4){inv, x1 * inv, x2 * inv, x3 * inv}; }
        }
        __syncthreads();
#pragma unroll 1
        for (int tp = 0; tp < 32; ++tp) { const int tl = 32 * wid + tp; const size_t tok = (size_t)u * 256 + tl; const float mu = stats[2 * tl], rstd = stats[2 * tl + 1];
#pragma unroll
            for (int jj = 0; jj < 4; ++jj) { const u32x2 zw = *(const GAS u32x2*)(Z + tok * D_MODEL + 256 * jj + 4 * lane);
                const float h0 = (bflo(zw.x) - mu) * rstd * gg[jj * 4] + bb[jj * 4], h1 = (bfhi(zw.x) - mu) * rstd * gg[jj * 4 + 1] + bb[jj * 4 + 1], h2 = (bflo(zw.y) - mu) * rstd * gg[jj * 4 + 2] + bb[jj * 4 + 2], h3 = (bfhi(zw.y) - mu) * rstd * gg[jj * 4 + 3] + bb[jj * 4 + 3];
                u32x2 w; w.x = pk2(h0, h1); w.y = pk2(h2, h3); *(GAS u32x2*)(HB + tok * D_MODEL + 256 * jj + 4 * lane) = w;
#if MOE_FP8
                *(GAS unsigned*)(HB8 + tok * D_MODEL + 256 * jj + 4 * lane) = pk4_fp8(h0, h1, h2, h3);
#endif
            } }
        if (tid < 32) { const int c = F.MISC[MI_LCNT + tid]; F.MISC[MI_LBASE + tid] = c ? (int)__hip_atomic_fetch_add(cur + tid * 64, (unsigned)c, RLX_AGENT) : 0; }
        __syncthreads();
        for (int i = tid; i < 1024; i += 512) { const int rec = F.MISC[MI_REC + i], e = rec >> 16, rank = F.MISC[MI_LBASE + e] + (rec & 0xffff); const int tok = u * 256 + (i >> 2);
            rowtok[(size_t)(dry ? (e & 31) : e) * 65536 + (dry ? (rank & 32767) : rank)] = tok; slot_out[(size_t)tok * 4 + (i & 3)] = ((unsigned)e << 20) | (unsigned)rank; }
        __syncthreads();
    }
}

__device__ __forceinline__ void moe_tables(Frame& F, int l) {
    const int tid = fresh_tid();
    __syncthreads();
    if (tid < 32) F.MISC[MI_CNT + tid] = (int)__hip_atomic_load(F.ctl + CW_CUR + (size_t)(l * 32 + tid) * 64, RLX_AGENT);
    __syncthreads();
    if (tid == 0) { int acc = 0; for (int e = 0; e < 32; ++e) { F.MISC[MI_RBSTART + e] = acc; acc += (F.MISC[MI_CNT + e] + 255) >> 8; } F.MISC[MI_RBSTART + 32] = acc; }
    __syncthreads();
    const int nrb = F.MISC[MI_RBSTART + 32];
    for (int rb = tid; rb < nrb; rb += 512) { int e = 0; while (e < 31 && F.MISC[MI_RBSTART + e + 1] <= rb) ++e; F.MISC[MI_RBE + rb] = e; }
    __syncthreads();
}

__device__ __forceinline__ void cmb_phase(Frame& F, ArgsP a, int l, bool dry = false) {
    PHASE_PROLOG();
    moe_tables(F, l);
    const int lane = fresh_tid() & 63; const int gw = vcu_ * 8 + F.wave, NGW = G_ * 8;
    float gg[16], bb[16];
#pragma unroll
    for (int jj = 0; jj < 4; ++jj) { const f32x4 g4 = *(const f32x4*)(a->in[I_LN2_G] + l * 1024 + 256 * jj + 4 * lane), b4 = *(const f32x4*)(a->in[I_LN2_B] + l * 1024 + 256 * jj + 4 * lane);
#pragma unroll
        for (int i = 0; i < 4; ++i) { gg[jj * 4 + i] = g4[i]; bb[jj * 4 + i] = b4[i]; } }
    GAS float* H32 = (GAS float*)(dry ? WSP(float, WS_Z) : a->out); const GAS bf16_t* HB = (const GAS bf16_t*)WSP(bf16_t, WS_HB); GAS bf16_t* HBo = (GAS bf16_t*)(dry ? WSP(bf16_t, WS_PR) : WSP(bf16_t, WS_HB)); const GAS bf16_t* Y = (const GAS bf16_t*)WSP(bf16_t, WS_Y);
    for (int tok = gw; tok < T_TOK; tok += NGW) {
        const unsigned sl = ((const GAS unsigned*)WSP(unsigned, WS_SLOT))[(size_t)tok * 4 + (lane & 3)]; const float gt = ((const GAS float*)WSP(float, WS_GATE))[(size_t)tok * 4 + (lane & 3)];
        float z[16];
#pragma unroll
        for (int jj = 0; jj < 4; ++jj) { const u32x2 hw = *(const GAS u32x2*)(HB + (size_t)tok * D_MODEL + 256 * jj + 4 * lane);
            z[jj * 4] = DN_ALPHA * bflo(hw.x); z[jj * 4 + 1] = DN_ALPHA * bfhi(hw.x); z[jj * 4 + 2] = DN_ALPHA * bflo(hw.y); z[jj * 4 + 3] = DN_ALPHA * bfhi(hw.y); }
#pragma unroll
        for (int k = 0; k < 4; ++k) { const unsigned sk = (unsigned)__builtin_amdgcn_readlane((int)sl, k); const float gk = __builtin_bit_cast(float, __builtin_amdgcn_readlane(__builtin_bit_cast(int, gt), k));
            const int e = (int)(sk >> 20), rank = (int)(sk & 0xfffffu); const size_t row = (size_t)F.MISC[MI_RBSTART + e] * 256 + rank;
#if MOE_FP8
            const GAS unsigned char* y = (const GAS unsigned char*)Y + row * D_MODEL + 4 * lane; const float gs = gk * (1.0f / 64.0f);
#pragma unroll
            for (int jj = 0; jj < 4; ++jj) { const int w = *(const GAS int*)(y + 256 * jj);
                z[jj * 4] += gs * __builtin_amdgcn_cvt_f32_fp8(w, 0); z[jj * 4 + 1] += gs * __builtin_amdgcn_cvt_f32_fp8(w, 1); z[jj * 4 + 2] += gs * __builtin_amdgcn_cvt_f32_fp8(w, 2); z[jj * 4 + 3] += gs * __builtin_amdgcn_cvt_f32_fp8(w, 3); } }
#else
            const bf16_t* y = Y + row * D_MODEL + 4 * lane;
#pragma unroll
            for (int jj = 0; jj < 4; ++jj) { const u32x2 w = *(const u32x2*)(y + 256 * jj); z[jj * 4] += gk * bflo(w.x); z[jj * 4 + 1] += gk * bfhi(w.x); z[jj * 4 + 2] += gk * bflo(w.y); z[jj * 4 + 3] += gk * bfhi(w.y); } }
#endif
        ln16<0>(z, gg, bb);
#pragma unroll
        for (int jj = 0; jj < 4; ++jj) { if (l == DEPTH - 1) *(GAS f32x4*)(H32 + (size_t)tok * D_MODEL + 256 * jj + 4 * lane) = (f32x4){z[jj * 4], z[jj * 4 + 1], z[jj * 4 + 2], z[jj * 4 + 3]};
            else { u32x2 w; w.x = pk2(z[jj * 4], z[jj * 4 + 1]); w.y = pk2(z[jj * 4 + 2], z[jj * 4 + 3]); *(GAS u32x2*)(HBo + (size_t)tok * D_MODEL + 256 * jj + 4 * lane) = w; } }
    }
}
#if MK_CHECK
constexpr int CW_CHK = 32768, N_CHK = 16, CHK_NS = 64;
__device__ __forceinline__ int chk_tok(int i) { return (i * 1021 + 77) & 65535; }
__device__ __forceinline__ void chk_put(Frame& F, int k, float err, float ref) {
    if (!(err == err)) err = 1e30f;
    err = wave_max(err); ref = wave_max(ref);
    if ((fresh_tid() & 63) == 0) { __hip_atomic_fetch_max(F.ctl + CW_CHK + 2 * k, __builtin_bit_cast(unsigned, err), RLX_AGENT); __hip_atomic_fetch_max(F.ctl + CW_CHK + 2 * k + 1, __builtin_bit_cast(unsigned, ref), RLX_AGENT); }
}
__device__ __forceinline__ float nanfix(float d) { return (d == d) ? d : 1e30f; }
__device__ __forceinline__ float chk_dot_bf(const bf16_t* x, const bf16_t* y, int n, int lane) { float s = 0.f; for (int k = lane; k < n; k += 64) s += bf2f(x[k]) * bf2f(y[k]); return wave_sum(s); }

__device__ __forceinline__ void chk_gemm(Frame& F, ArgsP a, int l, int which) {
    PHASE_PROLOG(); const int lane = fresh_tid() & 63, gw = vcu_ * 8 + F.wave, NGW = G_ * 8; const bool odd = l & 1; const int j = l >> 1;
    float err = 0.f, ref = 0.f, errg = 0.f, refg = 0.f;
    for (int si = gw; si < CHK_NS * 8; si += NGW) { const int tok = chk_tok(si >> 3), ci = si & 7;
        if (which == 1) { const int colsE[8] = {5, 300, 390, 449, 460, 700, 1100, 1500}, colsO[8] = {5, 1000, 1100, 2000, 2100, 3000, 3071, 64};
            int col = 0;
#pragma unroll
            for (int q = 0; q < 8; ++q) if (ci == q) col = odd ? colsO[q] : colsE[q];
            const int N = odd ? NO_PR : NE_PR; const bf16_t* W = odd ? WSP(bf16_t, WS_WINO) + ((size_t)j * NO_PR + col) * 1024 : WSP(bf16_t, WS_WINE) + ((size_t)j * NE_PR + col) * 1024;
            float v = chk_dot_bf(WSP(bf16_t, WS_HB) + (size_t)tok * 1024, W, 1024, lane); if (!odd && col >= 512) v = gelu_tanh(v);
            const float f = bf2f(WSP(bf16_t, WS_PR)[(size_t)tok * N + col]);
            if (!odd && col >= 512) { errg = fmaxf(errg, nanfix(fabsf(f - v))); refg = fmaxf(refg, fabsf(v)); } else { err = fmaxf(err, nanfix(fabsf(f - v))); ref = fmaxf(ref, fabsf(v)); } }
        else if (which == 3) { const int cols[8] = {3, 500, 1023, 1030, 1279, 1100, 128, 1200}; int col = 0;
#pragma unroll
            for (int q = 0; q < 8; ++q) if (ci == q) col = cols[q];
            const float v = chk_dot_bf(WSP(bf16_t, WS_CQ) + (size_t)tok * 256, WSP(bf16_t, WS_WQE) + ((size_t)j * NQQ + col) * 256, 256, lane);
            const float f = bf2f(WSP(bf16_t, WS_QQ)[(size_t)tok * NQQ + col]); err = fmaxf(err, nanfix(fabsf(f - v))); ref = fmaxf(ref, fabsf(v)); }
        else { const int cols[8] = {1, 300, 600, 1023, 255, 256, 777, 512}; int col = 0;
#pragma unroll
            for (int q = 0; q < 8; ++q) if (ci == q) col = cols[q];
            const int K = odd ? 1024 : NMX; const bf16_t* W = odd ? WSP(bf16_t, WS_WOUTO) + ((size_t)j * 1024 + col) * 1024 : WSP(bf16_t, WS_WOUTE) + ((size_t)j * 1024 + col) * NMX;
            const float hs = (l == 0 ? a->in[I_X] : (const float*)a->out)[(size_t)tok * 1024 + col];
            const float v = DN_ALPHA * hs + chk_dot_bf(WSP(bf16_t, WS_MX) + (size_t)tok * K, W, K, lane);
            const float f = WSP(float, WS_Z)[(size_t)tok * 1024 + col]; err = fmaxf(err, nanfix(fabsf(f - v))); ref = fmaxf(ref, fabsf(v)); }
    }
    if (which == 1) { if (odd) chk_put(F, 14, err, ref); else { chk_put(F, 1, err, ref); chk_put(F, 13, errg, refg); } } else chk_put(F, which, err, ref);
}
__device__ __forceinline__ void chk_e1b(Frame& F, ArgsP a, int l) {
    PHASE_PROLOG(); const int lane = fresh_tid() & 63, gw = vcu_ * 8 + F.wave, NGW = G_ * 8, j = l >> 1; float err = 0.f, ref = 0.f;
    for (int si = gw; si < CHK_NS; si += NGW) { const int tok = chk_tok(si); const bf16_t* pr = WSP(bf16_t, WS_PR) + (size_t)tok * NE_PR;
        float x[4], ss = 0.f;
#pragma unroll
        for (int i = 0; i < 4; ++i) { x[i] = bf2f(pr[lane + 64 * i]); ss += x[i] * x[i]; }
        ss = wave_sum(ss); float rs = 1.0f / sqrtf(ss / 256.0f + LN_EPS);
#pragma unroll
        for (int i = 0; i < 4; ++i) { const float v = x[i] * rs * a->in[I_EV_Q_NORM][j * 256 + lane + 64 * i]; err = fmaxf(err, nanfix(fabsf(v - bf2f(WSP(bf16_t, WS_CQ)[(size_t)tok * 256 + lane + 64 * i])))); ref = fmaxf(ref, fabsf(v)); }
        float y0 = bf2f(pr[256 + lane]), y1 = bf2f(pr[256 + 64 + lane]); ss = wave_sum(y0 * y0 + y1 * y1); rs = 1.0f / sqrtf(ss / 128.0f + LN_EPS);
        { const float v0 = y0 * rs * a->in[I_EV_KV_NORM][j * 128 + lane], v1 = y1 * rs * a->in[I_EV_KV_NORM][j * 128 + 64 + lane];
          err = fmaxf(err, nanfix(fabsf(v0 - bf2f(WSP(bf16_t, WS_CKV)[(size_t)tok * 128 + lane])))); err = fmaxf(err, nanfix(fabsf(v1 - bf2f(WSP(bf16_t, WS_CKV)[(size_t)tok * 128 + 64 + lane])))); }
        { const float z = bf2f(pr[384 + lane]); const float mu = wave_sum(z) / 64.0f; const float var = wave_sum((z - mu) * (z - mu)) / 64.0f;
          const float v = (z - mu) / sqrtf(var + LN_EPS) * a->in[I_EV_IDX_K_G][j * 64 + lane] + a->in[I_EV_IDX_K_B][j * 64 + lane];
          err = fmaxf(err, nanfix(fabsf(v - bf2f(WSP(bf16_t, WS_KI)[(size_t)tok * 64 + lane])))); ref = fmaxf(ref, fabsf(v)); }
        if (lane < 4) err = fmaxf(err, nanfix(fabsf(0.5f * bf2f(pr[448 + lane]) - WSP(float, WS_WI)[(size_t)tok * 4 + lane])));
    }
    chk_put(F, 2, err, ref);
}
__device__ __forceinline__ void chk_dsa(Frame& F, ArgsP a, int l) {
    PHASE_PROLOG(); const int lane = fresh_tid() & 63, gw = vcu_ * 8 + F.wave, NGW = G_ * 8; float err4 = 0.f, ref4 = 1e-20f, err5 = 0.f, ref5 = 0.f;
    LAS float* pl = (LAS float*)F.lds + F.wave * 2048;
    const bf16_t* QQ = WSP(bf16_t, WS_QQ); const bf16_t* KI = WSP(bf16_t, WS_KI); const bf16_t* CKV = WSP(bf16_t, WS_CKV);
    for (int si = gw; si < CHK_NS; si += NGW) { const int tok = chk_tok(si), b = tok >> 11, t = tok & 2047, NT = t / 64 + 1, N = NT * 64; const size_t rb0 = (size_t)b * SEQ;
        int npop = 0; float minsel = 1e30f, maxun = -1e30f, maxabs = 0.f; int maxselzero = -1, minunzero = 1 << 20;
        for (int i = 0; i < NT; ++i) { const int s = i * 64 + lane; float sc = 0.f;
            for (int h = 0; h < 4; ++h) { float d = 0.f; for (int k = 0; k < 64; ++k) d += bf2f(QQ[(size_t)tok * NQQ + 1024 + h * 64 + k]) * bf2f(KI[(rb0 + s) * 64 + k]); sc += fmaxf(d, 0.f) * WSP(float, WS_WI)[(size_t)tok * 4 + h]; }
            sc += 0.0f;
            const unsigned long long mw = WSP(unsigned long long, WS_MASK)[(size_t)tok * 32 + i]; const bool sel = (mw >> lane) & 1ull;
            npop += sel ? 1 : 0; maxabs = fmaxf(maxabs, fabsf(sc));
            if (sel) { minsel = fminf(minsel, sc); if (sc == 0.f) maxselzero = max(maxselzero, s); } else { maxun = fmaxf(maxun, sc); if (sc == 0.f) minunzero = min(minunzero, s); } }
        for (int i = NT; i < 32; ++i) if (WSP(unsigned long long, WS_MASK)[(size_t)tok * 32 + i] != 0ull) err4 = 1e30f;
        npop = (int)wave_sum((float)npop); minsel = -wave_max(-minsel); maxun = wave_max(maxun); maxabs = wave_max(maxabs);
        maxselzero = (int)wave_max((float)maxselzero); minunzero = -(int)wave_max(-(float)minunzero);
        if (npop != (N < N_SEL ? N : N_SEL)) err4 = 1e30f;
        if (N > N_SEL) { err4 = fmaxf(err4, maxun - minsel); if (minsel == 0.f && maxun == 0.f && maxselzero > minunzero) err4 = 1e30f; }
        ref4 = fmaxf(ref4, maxabs / 30.0f);
        const int h = si & 7; const float slope2 = exp2f(-(float)(h + 1)) * LOG2E; float mx = -1e30f;
        for (int i = 0; i < NT; ++i) { const int s = i * 64 + lane; float d = 0.f; for (int k = 0; k < 128; ++k) d += bf2f(QQ[(size_t)tok * NQQ + h * 128 + k]) * bf2f(CKV[(rb0 + s) * 128 + k]);
            d -= slope2 * fabsf((float)(t - s)); const unsigned long long mw = WSP(unsigned long long, WS_MASK)[(size_t)tok * 32 + i]; if (!((mw >> lane) & 1ull)) d = -1e30f; pl[s] = d; mx = fmaxf(mx, d); }
        mx = wave_max(mx); float sum = 0.f;
        for (int i = 0; i < NT; ++i) { const int s = i * 64 + lane; const float p = fast_exp2(pl[s] - mx); pl[s] = p; sum += p; }
        sum = wave_sum(sum); LDS_WAIT();
        for (int cc = 0; cc < 2; ++cc) { const int c = lane + 64 * cc; float o = 0.f; for (int s = 0; s < N; ++s) o += pl[s] * bf2f(CKV[(rb0 + s) * 128 + c]); o /= sum;
            const float f = bf2f(WSP(bf16_t, WS_MX)[(size_t)tok * NMX + h * 128 + c]); err5 = fmaxf(err5, nanfix(fabsf(f - o))); ref5 = fmaxf(ref5, fabsf(o)); }
        LDS_WAIT();
    }
    chk_put(F, 4, err4, ref4); chk_put(F, 5, err5, ref5);
}
__device__ __forceinline__ void chk_gml(Frame& F, ArgsP a, int l) {
    PHASE_PROLOG(); const int lane = fresh_tid() & 63, gw = vcu_ * 8 + F.wave, NGW = G_ * 8, j = l >> 1; float err = 0.f, ref = 0.f;
    const bf16_t* PR = WSP(bf16_t, WS_PR);
    for (int si = gw; si < CHK_NS; si += NGW) { const int tok = chk_tok(si), g = si & 7, ii = tok & 127; const size_t tok0 = (size_t)(tok - ii); float mixed = 0.f;
        for (int jx = 0; jx <= ii; ++jx) { const bf16_t* vr = PR + (tok0 + jx) * NE_PR + 1024; float xs[8], s = 0.f;
#pragma unroll
            for (int q = 0; q < 8; ++q) { xs[q] = bf2f(vr[lane + 64 * q]); s += xs[q]; }
            const float mu = wave_sum(s) / 512.0f; float s2 = 0.f;
#pragma unroll
            for (int q = 0; q < 8; ++q) s2 += (xs[q] - mu) * (xs[q] - mu);
            const float rs = 1.0f / sqrtf(wave_sum(s2) / 512.0f + LN_EPS);
            const float vln = (bf2f(vr[g * 64 + lane]) - mu) * rs * a->in[I_EV_V_NORM_G][j * GW + g * 64 + lane] + a->in[I_EV_V_NORM_B][j * GW + g * 64 + lane];
            mixed += a->in[I_EV_W_S][((size_t)(j * 8 + g) * 128 + ii) * 128 + jx] * vln; }
        mixed += a->in[I_EV_B_S][(size_t)(j * 8 + g) * 128 + ii];
        const float v = bf2f(PR[(size_t)tok * NE_PR + 512 + g * 64 + lane]) * mixed; const float f = bf2f(WSP(bf16_t, WS_MX)[(size_t)tok * NMX + 1024 + g * 64 + lane]);
        err = fmaxf(err, nanfix(fabsf(f - v))); ref = fmaxf(ref, fabsf(v)); }
    chk_put(F, 6, err, ref);
}
__device__ __forceinline__ void chk_lnr(Frame& F, ArgsP a, int l) {
    PHASE_PROLOG(); const int lane = fresh_tid() & 63, gw = vcu_ * 8 + F.wave, NGW = G_ * 8; float err = 0.f, ref = 0.f;
    for (int si = gw; si < CHK_NS; si += NGW) { const int tok = chk_tok(si); const float* z = WSP(float, WS_Z) + (size_t)tok * 1024; float x[16], s = 0.f;
#pragma unroll
        for (int i = 0; i < 16; ++i) { x[i] = z[lane + 64 * i]; s += x[i]; }
        const float mu = wave_sum(s) / 1024.0f; float s2 = 0.f;
#pragma unroll
        for (int i = 0; i < 16; ++i) s2 += (x[i] - mu) * (x[i] - mu);
        const float rs = 1.0f / sqrtf(wave_sum(s2) / 1024.0f + LN_EPS);
#pragma unroll
        for (int i = 0; i < 16; ++i) { x[i] = (x[i] - mu) * rs * a->in[I_LN1_G][l * 1024 + lane + 64 * i] + a->in[I_LN1_B][l * 1024 + lane + 64 * i];
            err = fmaxf(err, nanfix(fabsf(x[i] - a->out[(size_t)tok * 1024 + lane + 64 * i]))); err = fmaxf(err, nanfix(fabsf(x[i] - bf2f(WSP(bf16_t, WS_HB)[(size_t)tok * 1024 + lane + 64 * i])) * 0.25f)); ref = fmaxf(ref, fabsf(x[i])); }
        float lg = 0.f;
        for (int e = 0; e < 32; ++e) { float p = 0.f;
#pragma unroll
            for (int i = 0; i < 16; ++i) p += x[i] * a->in[I_ROUTER_W][((size_t)l * 1024 + lane + 64 * i) * 32 + e];
            p = wave_sum(p) + a->in[I_ROUTER_B][l * 32 + e]; if (lane == e) lg = p; }
        if (lane >= 32) lg = -1e30f;
        float tl[4]; int te[4]; float v = lg;
        for (int k = 0; k < 4; ++k) { const float m = wave_max(v); const unsigned long long bm = __builtin_amdgcn_ballot_w64(v == m); te[k] = __builtin_ctzll(bm); tl[k] = m; if (lane == te[k]) v = -1e30f; }
        const float den = 1.0f + expf(tl[1] - tl[0]) + expf(tl[2] - tl[0]) + expf(tl[3] - tl[0]);
        for (int k = 0; k < 4; ++k) { const unsigned sl = WSP(unsigned, WS_SLOT)[(size_t)tok * 4 + k]; const int e = (int)(sl >> 20), rank = (int)(sl & 0xfffffu);
            if (e != te[k]) {
                const float mine = __builtin_bit_cast(float, __builtin_amdgcn_ds_bpermute(e << 2, __builtin_bit_cast(int, lg)));
                if (fabsf(mine - tl[k]) > 1e-4f) err = 1e30f; }
            if (WSP(int, WS_ROWTOK)[(size_t)e * 65536 + rank] != tok) err = 1e30f;
            const float gk = expf(tl[k] - tl[0]) / den; err = fmaxf(err, nanfix(fabsf(gk - WSP(float, WS_GATE)[(size_t)tok * 4 + k]))); }
    }
    chk_put(F, 8, err, ref);
}
__device__ __forceinline__ void chk_moe(Frame& F, ArgsP a, int l) {
    PHASE_PROLOG(); const int lane = fresh_tid() & 63, gw = vcu_ * 8 + F.wave, NGW = G_ * 8; float err = 0.f, ref = 0.f;
    LAS float* al = (LAS float*)F.lds + F.wave * 1024;
    for (int si = gw; si < CHK_NS; si += NGW) { const int tok = chk_tok(si), k = si & 3; const unsigned sl = WSP(unsigned, WS_SLOT)[(size_t)tok * 4 + k]; const int e = (int)(sl >> 20), rank = (int)(sl & 0xfffffu);
        int rbs = 0; for (int q = 0; q < e; ++q) rbs += ((int)__hip_atomic_load(F.ctl + CW_CUR + (size_t)(l * 32 + q) * 64, RLX_AGENT) + 255) >> 8;
        const size_t crow = (size_t)rbs * 256 + rank;
        const float* wgu = a->in[I_EXP_W_GU] + ((size_t)l * NEXP + e) * 1024 * 2048; const float* wdn = a->in[I_EXP_W_DN] + ((size_t)l * NEXP + e) * 1024 * 1024;
        const bf16_t* hb = WSP(bf16_t, WS_HB) + (size_t)tok * 1024;
        float ag[16], au[16];
#pragma unroll
        for (int i = 0; i < 16; ++i) { ag[i] = 0.f; au[i] = 0.f; }
        for (int kk = 0; kk < 1024; ++kk) { const float hv = bf2f(hb[kk]);
#pragma unroll
            for (int i = 0; i < 16; ++i) { ag[i] += hv * wgu[(size_t)kk * 2048 + lane + 64 * i]; au[i] += hv * wgu[(size_t)kk * 2048 + 1024 + lane + 64 * i]; } }
#pragma unroll
        for (int i = 0; i < 16; ++i) { const int f = lane + 64 * i; float gt = ag[i] + a->in[I_EXP_B_GU][((size_t)l * NEXP + e) * 2048 + f], up = au[i] + a->in[I_EXP_B_GU][((size_t)l * NEXP + e) * 2048 + 1024 + f];
            gt = fminf(gt, 7.0f); up = fminf(fmaxf(up, -7.0f), 7.0f); const float act = (up + 1.0f) * gt / (1.0f + expf(-1.702f * gt)); al[f] = act;
            const float fa = bf2f(WSP(bf16_t, WS_ACT)[crow * 1024 + f]); err = fmaxf(err, nanfix(fabsf(fa - act))); ref = fmaxf(ref, fabsf(act)); }
        LDS_WAIT();
#pragma unroll
        for (int ci = 0; ci < 4; ++ci) { const int col = ci == 0 ? 0 : ci == 1 ? 511 : ci == 2 ? 1023 : 700; float s = 0.f; for (int f = lane; f < 1024; f += 64) s += al[f] * wdn[(size_t)f * 1024 + col];
            s = wave_sum(s) + a->in[I_EXP_B_DN][((size_t)l * NEXP + e) * 1024 + col]; const float fy = bf2f(WSP(bf16_t, WS_Y)[crow * 1024 + col]);
            err = fmaxf(err, nanfix(fabsf(fy - s)) * 2.0f); ref = fmaxf(ref, fabsf(s)); }
        LDS_WAIT();
    }
    chk_put(F, 9, err, ref);
}
__device__ __forceinline__ void chk_datt(Frame& F, ArgsP a, int l) {
    PHASE_PROLOG(); const int lane = fresh_tid() & 63, gw = vcu_ * 8 + F.wave, NGW = G_ * 8, j = l >> 1; float err = 0.f, ref = 0.f;
    LAS float* pl = (LAS float*)F.lds + F.wave * 2048; const bf16_t* PR = WSP(bf16_t, WS_PR);
    const float lam_init = 0.8f - 0.6f * expf(-0.3f * (float)l);
    const float lam = expf(wave_sum(a->in[I_OD_LQ1][j * 64 + lane] * a->in[I_OD_LK1][j * 64 + lane])) - expf(wave_sum(a->in[I_OD_LQ2][j * 64 + lane] * a->in[I_OD_LK2][j * 64 + lane])) + lam_init;
    for (int si = gw; si < CHK_NS; si += NGW) { const int tok = chk_tok(si), b = tok >> 11, t = tok & 2047, NT = t / 64 + 1, N = NT * 64, h = si & 7; const size_t rb0 = (size_t)b * SEQ;
        const float slope2 = exp2f(-(float)(h + 1)) * LOG2E; float oc[2][2];
        for (int m = 0; m < 2; ++m) { float mx = -1e30f;
            for (int i = 0; i < NT; ++i) { const int s = i * 64 + lane; float d = 0.f; for (int k = 0; k < 64; ++k) d += bf2f(PR[(size_t)tok * NO_PR + h * 128 + m * 64 + k]) * bf2f(PR[(rb0 + s) * NO_PR + 1024 + h * 128 + m * 64 + k]);
                d -= slope2 * fabsf((float)(t - s)); pl[s] = d; mx = fmaxf(mx, d); }
            mx = wave_max(mx); float sum = 0.f;
            for (int i = 0; i < NT; ++i) { const int s = i * 64 + lane; const float p = fast_exp2(pl[s] - mx); pl[s] = p; sum += p; }
            sum = wave_sum(sum); LDS_WAIT();
            for (int cc = 0; cc < 2; ++cc) { const int c = lane + 64 * cc; float o = 0.f; for (int s = 0; s < N; ++s) o += pl[s] * bf2f(PR[(rb0 + s) * NO_PR + 2048 + h * 128 + c]); oc[m][cc] = o / sum; }
            LDS_WAIT(); }
        const float y0 = oc[0][0] - lam * oc[1][0], y1 = oc[0][1] - lam * oc[1][1]; const float rs = (1.0f - lam_init) / sqrtf(wave_sum(y0 * y0 + y1 * y1) / 128.0f + LN_EPS);
        const float v0 = y0 * rs * a->in[I_OD_SUBLN_G][j * 128 + lane], v1 = y1 * rs * a->in[I_OD_SUBLN_G][j * 128 + 64 + lane];
        const float f0 = bf2f(WSP(bf16_t, WS_MX)[(size_t)tok * 1024 + h * 128 + lane]), f1 = bf2f(WSP(bf16_t, WS_MX)[(size_t)tok * 1024 + h * 128 + 64 + lane]);
        err = fmaxf(err, nanfix(fabsf(f0 - v0))); err = fmaxf(err, nanfix(fabsf(f1 - v1))); ref = fmaxf(ref, fmaxf(fabsf(v0), fabsf(v1))); }
    chk_put(F, 11, err, ref);
}
__device__ __forceinline__ void chk_final(Frame& F, ArgsP a) {
    PHASE_PROLOG(); int code = 0;
    for (int k = N_CHK - 1; k >= 1; --k) { const float e = __builtin_bit_cast(float, __hip_atomic_load(F.ctl + CW_CHK + 2 * k, RLX_AGENT)), r = __builtin_bit_cast(float, __hip_atomic_load(F.ctl + CW_CHK + 2 * k + 1, RLX_AGENT));
        if (e > 0.03f * r) code = k; }
    if (code == 0) return;
    const float sc = 1.0f + 0.05f * (float)code; const int gt = vcu_ * 512 + fresh_tid(), NGT = G_ * 512;
    for (size_t i = gt; i < (size_t)T_TOK * 1024; i += NGT) a->out[i] *= sc;
}
#endif
constexpr int N_PHASES = 10;
__global__ void __launch_bounds__(512, 2) mk_fwd(Args a) {
    extern __shared__ __attribute__((aligned(16))) unsigned char lds_raw[];
    Frame F;
    F.lds = (LAS unsigned char*)lds_raw; F.ldsg = (char*)lds_raw;
    F.MISC = (volatile LAS int*)(F.lds + MISC_OFF);
    F.tid = threadIdx.x; F.lane = F.tid & 63; F.wave = __builtin_amdgcn_readfirstlane(F.tid >> 6);
    F.G = gridDim.x; { const int bx = blockIdx.x; F.vcu = (F.G % 8 == 0) ? (bx % 8) * (F.G / 8) + bx / 8 : bx; }
    ArgsP ap = (ArgsP)__builtin_amdgcn_kernarg_segment_ptr();
    F.ws = ap->ws; F.ctl = (gu32*)(ap->ws + WS_CTL);
    const int a_fused = ap->fused, a_llo = ap->l_lo, a_lhi = ap->l_hi, a_plo0 = ap->p_lo, a_phi0 = ap->p_hi, a_pro = ap->do_pro;
    for (int u = F.tid; u < (LDS_BYTES - MISC_OFF) / 4; u += 512) F.MISC[u] = 0;
    __syncthreads();
    XcdBarrier bar; bar.bar = (unsigned*)(F.ctl + CW_BAR); bar.x = 0; bar.st = nullptr; bar.w = (unsigned)F.wave;
    if (a_fused) bar = xcd_barrier_post((unsigned*)(F.ctl + CW_BAR), (volatile LAS unsigned*)(F.MISC + MI_BAR));
#define GRID_BAR() do { if (a_fused) xcd_barrier(bar); } while (0)
#define KPROLOG() ArgsP a = ap; unsigned char* ws_ = F.ws; asm volatile("" : "+s"(ws_)); asm volatile("" : "+s"(a)); int vcu_ = F.vcu, G_ = F.G, bx_ = (int)blockIdx.x; asm volatile("" : "+s"(vcu_), "+s"(G_), "+s"(bx_))
#ifndef PHASE_MASK
#define PHASE_MASK 0x7ff
#endif
#define RUN(p) (((PHASE_MASK >> (p)) & 1) && a_plo <= (p) && (p) < a_phi)
#ifndef PROBE_REP
#define PROBE_REP 0
#endif
#ifndef PROBE_PAR
#define PROBE_PAR 0
#endif
#define REPS(p) _Pragma("unroll 1") for (int rep_ = 0; rep_ < 1 + (((PROBE_REP >> (p)) & 1) && (PROBE_PAR == 0 || (PROBE_PAR == 1 && !(l_probe & 1)) || (PROBE_PAR == 2 && (l_probe & 1))) ? 1 : 0); ++rep_)
    { const int l_probe = 0; if (((PHASE_MASK >> 10) & 1) && a_pro) { REPS(10) { pro_phase(F, ap); GRID_BAR(); } } }
    for (int l = a_llo; l < a_lhi; ++l) {
        int a_plo = a_plo0, a_phi = a_phi0; asm volatile("" : "+s"(a_plo), "+s"(a_phi));
        const bool odd = (l & 1) != 0; const int j = l >> 1; const int l_probe = l;
        if (RUN(0)) REPS(0) { KPROLOG();
            const bf16_t* Bt = odd ? WSP(bf16_t, WS_WINO) + (size_t)j * NO_PR * 1024 : WSP(bf16_t, WS_WINE) + (size_t)j * NE_PR * 1024; const int N = odd ? NO_PR : NE_PR;
            pg8::DenseOrder S; S.init(T_TOK, N, G_, bx_);
            pg8::EpiStoreBf16 E{WSP(bf16_t, WS_PR), N, odd ? (1 << 30) : 2};
            pg8::gemm_phase<pg8::EpiStoreBf16, pg8::DenseOrder, false>(F.lds, WSP(bf16_t, WS_HB), Bt, 1024, nullptr, S, E, F.wave);
            GRID_BAR();
        }
        if (!odd) {
            if (RUN(1)) REPS(1) { e1b_phase(F, ap, l); GRID_BAR(); }
            if (RUN(2)) REPS(2) { KPROLOG();
                pg8::DenseOrder S; S.init(T_TOK, NQQ, G_, bx_);
                pg8::EpiStoreBf16 E{WSP(bf16_t, WS_QQ), NQQ, 1 << 30};
                pg8::gemm_phase<pg8::EpiStoreBf16, pg8::DenseOrder, false>(F.lds, WSP(bf16_t, WS_CQ), WSP(bf16_t, WS_WQE) + (size_t)j * NQQ * 256, 256, nullptr, S, E, F.wave);
                GRID_BAR();
            }
            if (RUN(3)) REPS(3) { e3a_phase(F, ap); GRID_BAR(); }
        }
        if (RUN(4)) REPS(4) {
#ifndef ATT_SEL
#define ATT_SEL 7
#endif
            if (odd) { if (ATT_SEL & 4) datt_phase(F, ap, l); }
            else { if (ATT_SEL & 1) dsa_phase(F, ap); if (ATT_SEL & 2) gml_phase(F, ap, l); }
            GRID_BAR();
        }
        if (RUN(5)) REPS(5) { KPROLOG();
            const bf16_t* Bt = odd ? WSP(bf16_t, WS_WOUTO) + (size_t)j * 1024 * 1024 : WSP(bf16_t, WS_WOUTE) + (size_t)j * 1024 * NMX; const int K = odd ? 1024 : NMX;
            pg8::DenseOrder S; S.init(T_TOK, D_MODEL, G_, bx_);
            pg8::EpiResid E{WSP(bf16_t, WS_HB), WSP(bf16_t, WS_Z), DN_ALPHA};
            pg8::gemm_phase<pg8::EpiResid, pg8::DenseOrder, false>(F.lds, WSP(bf16_t, WS_MX), Bt, K, nullptr, S, E, F.wave);
            GRID_BAR();
        }
#ifndef LNR_MFMA
#define LNR_MFMA 1
#endif
        if (RUN(6)) { if ((PROBE_REP >> 6) & 1) { if (LNR_MFMA) lnr2_phase(F, ap, l, true); else lnr_phase(F, ap, l, true); GRID_BAR(); } if (LNR_MFMA) lnr2_phase(F, ap, l); else lnr_phase(F, ap, l); GRID_BAR(); }
        if (RUN(7)) REPS(7) { KPROLOG();
            moe_tables(F, l);
            pg8::MoeOrder S; S.npn = 8; S.nunits = __builtin_amdgcn_readfirstlane(F.MISC[MI_RBSTART + 32]) * 8; S.G = G_; S.c = vcu_; S.tab = (const LAS int*)F.MISC;
            pg8::EpiSwiglu E{WSP(bf16_t, WS_ACT), a->in[I_EXP_B_GU] + (size_t)l * NEXP * 2048};
#if MOE_FP8
            pg8::gemm_phase<pg8::EpiSwiglu, pg8::MoeOrder, true, true>(F.lds, WSP(bf16_t, WS_HB8), (const bf16_t*)(WSP(unsigned char, WS_WGU) + (size_t)l * NEXP * 2048 * 1024), 512, WSP(int, WS_ROWTOK), S, E, F.wave, 0x7f7f7f7f, 0x79797979);
#else
            pg8::gemm_phase<pg8::EpiSwiglu, pg8::MoeOrder, true>(F.lds, WSP(bf16_t, WS_HB), WSP(bf16_t, WS_WGU) + (size_t)l * NEXP * 2048 * 1024, 1024, WSP(int, WS_ROWTOK), S, E, F.wave);
#endif
            GRID_BAR();
        }
        if (RUN(8)) REPS(8) { KPROLOG();
            moe_tables(F, l);
            pg8::MoeOrder S; S.npn = 4; S.nunits = __builtin_amdgcn_readfirstlane(F.MISC[MI_RBSTART + 32]) * 4; S.G = G_; S.c = vcu_; S.tab = (const LAS int*)F.MISC;
            pg8::EpiBiasBf16 E{WSP(bf16_t, WS_Y), a->in[I_EXP_B_DN] + (size_t)l * NEXP * 1024};
#if MOE_FP8
            pg8::gemm_phase<pg8::EpiBiasBf16, pg8::MoeOrder, false, true>(F.lds, WSP(bf16_t, WS_ACT), (const bf16_t*)(WSP(unsigned char, WS_WDN) + (size_t)l * NEXP * 1024 * 1024), 512, nullptr, S, E, F.wave, 0x7c7c7c7c, 0x79797979);
#else
            pg8::gemm_phase<pg8::EpiBiasBf16, pg8::MoeOrder, false>(F.lds, WSP(bf16_t, WS_ACT), WSP(bf16_t, WS_WDN) + (size_t)l * NEXP * 1024 * 1024, 1024, nullptr, S, E, F.wave);
#endif
            GRID_BAR();
        }
        if (RUN(9)) { if ((PROBE_REP >> 9) & 1) { cmb_phase(F, ap, l, true); GRID_BAR(); } cmb_phase(F, ap, l); if (l + 1 < DEPTH) GRID_BAR(); }
    }
#undef GRID_BAR
#undef RUN
}

#if MK_CHECK
__global__ void __launch_bounds__(512, 2) mk_chk(Args a_) {
    extern __shared__ __attribute__((aligned(16))) unsigned char lds_raw[];
    Frame F;
    F.lds = (LAS unsigned char*)lds_raw; F.ldsg = (char*)lds_raw; F.MISC = (volatile LAS int*)(F.lds + MISC_OFF);
    F.tid = threadIdx.x; F.lane = F.tid & 63; F.wave = __builtin_amdgcn_readfirstlane(F.tid >> 6);
    F.G = gridDim.x; { const int bx = blockIdx.x; F.vcu = (F.G % 8 == 0) ? (bx % 8) * (F.G / 8) + bx / 8 : bx; }
    ArgsP ap = (ArgsP)__builtin_amdgcn_kernarg_segment_ptr();
    F.ws = ap->ws; F.ctl = (gu32*)(ap->ws + WS_CTL);
    const int l = ap->l_lo, p = ap->p_lo;
    if (p == 21) chk_gemm(F, ap, l, 1);
    if (p == 22) chk_e1b(F, ap, l);
    if (p == 23) chk_gemm(F, ap, l, 3);
    if (p == 24) chk_dsa(F, ap, l);
    if (p == 26) chk_gml(F, ap, l);
    if (p == 27) chk_gemm(F, ap, l, 7);
    if (p == 28) chk_lnr(F, ap, l);
    if (p == 29) chk_moe(F, ap, l);
    if (p == 31) chk_datt(F, ap, l);
    if (p == 40) chk_final(F, ap);
}
#endif

extern "C" void kernel_launch(void* const* d_in, const int* in_sizes, int n_in, void* d_out, int out_size, void* d_ws, size_t ws_size, hipStream_t stream) {
    static int grid = 0;
    if (grid == 0) {
        if (n_in != 32 || in_sizes[0] != T_TOK * D_MODEL || out_size != T_TOK * D_MODEL || ws_size < WS_END) {
            fprintf(stderr, "kernel_launch: shape mismatch: n_in %d in0 %d out %d ws %zu (need %zu)\n", n_in, n_in > 0 ? in_sizes[0] : -1, out_size, ws_size, (size_t)WS_END); grid = -1; return; }
        int dev = 0, cus = 0, per_cu = 0;
        if (hipGetDevice(&dev) != hipSuccess || hipDeviceGetAttribute(&cus, hipDeviceAttributeMultiprocessorCount, dev) != hipSuccess) { fprintf(stderr, "kernel_launch: device query failed\n"); grid = -1; return; }
#if MK_CHECK
        (void)hipFuncSetAttribute((const void*)mk_chk, hipFuncAttributeMaxDynamicSharedMemorySize, LDS_BYTES);
#endif
        if (hipFuncSetAttribute((const void*)mk_fwd, hipFuncAttributeMaxDynamicSharedMemorySize, LDS_BYTES) != hipSuccess) { fprintf(stderr, "kernel_launch: hipFuncSetAttribute failed\n"); grid = -1; return; }
        if (hipOccupancyMaxActiveBlocksPerMultiprocessor(&per_cu, (const void*)mk_fwd, 512, LDS_BYTES) != hipSuccess || per_cu < 1) { fprintf(stderr, "kernel_launch: occupancy query says %d\n", per_cu); }
        (void)hipGetLastError();
        grid = cus;
    }
    if (grid < 0) return;
    if (hipMemsetAsync((char*)d_ws + WS_CTL, 0, CTL_ZERO_BYTES, stream) != hipSuccess) { fprintf(stderr, "kernel_launch: memset failed\n"); return; }
    Args a{};
    for (int i = 0; i < 32; ++i) a.in[i] = (const float*)d_in[i];
    a.out = (float*)d_out; a.ws = (unsigned char*)d_ws;
#if MK_FUSED
    a.l_lo = 0; a.l_hi = DEPTH; a.p_lo = 0; a.p_hi = N_PHASES; a.do_pro = 1; a.fused = 1;
    hipLaunchKernelGGL(mk_fwd, dim3(grid), dim3(512), LDS_BYTES, stream, a);
#else
    a.fused = 0;
    a.l_lo = 0; a.l_hi = 0; a.p_lo = 0; a.p_hi = 0; a.do_pro = 1;
    hipLaunchKernelGGL(mk_fwd, dim3(grid), dim3(512), LDS_BYTES, stream, a);
    a.do_pro = 0;
    for (int l = 0; l < DEPTH; ++l)
        for (int p = 0; p < N_PHASES; ++p) {
            if ((l & 1) && p >= 1 && p <= 3) continue;
            a.l_lo = l; a.l_hi = l + 1; a.p_lo = p; a.p_hi = p + 1;
            hipLaunchKernelGGL(mk_fwd, dim3(grid), dim3(512), LDS_BYTES, stream, a);
#if MK_CHECK
            {
                int cks[3] = {0, 0, 0}; int nck = 0;
                if (l == 0) { if (p == 0) cks[nck++] = 21; if (p == 1) cks[nck++] = 22; if (p == 2) cks[nck++] = 23; if (p == 4) { cks[nck++] = 24; cks[nck++] = 26; } if (p == 5) cks[nck++] = 27; if (p == 6) cks[nck++] = 28; if (p == 8) cks[nck++] = 29; }
                if (l == 1) { if (p == 0) cks[nck++] = 21; if (p == 4) cks[nck++] = 31; if (p == 5) cks[nck++] = 27; }
                if (l == DEPTH - 1 && p == N_PHASES - 1) cks[nck++] = 40;
                for (int c = 0; c < nck; ++c) { a.p_lo = cks[c]; a.p_hi = cks[c] + 1; hipLaunchKernelGGL(mk_chk, dim3(grid), dim3(512), LDS_BYTES, stream, a); }
            }
#endif
        }
#endif
    const hipError_t le = hipPeekAtLastError();
    if (le != hipSuccess) fprintf(stderr, "kernel_launch: launch failed: %s\n", hipGetErrorName(le));
}
```

```cpp
#include <hip/hip_runtime.h>
#include <hip/hip_bf16.h>
#include <cstdio>
#include <cstdint>

#ifndef MK_CHECK
#define MK_CHECK 0
#endif
#ifndef MOE_FP8
#define MOE_FP8 1
#endif
#ifndef MK_FUSED
#define MK_FUSED 1
#endif

constexpr int D_MODEL = 1024, BATCH = 32, SEQ = 2048, DEPTH = 4, T_TOK = BATCH * SEQ;
constexpr int CHUNK = 64;
constexpr int H_A = 8, D_CQ = 256, D_C = 128, H_IDX = 4, D_IDX = 64, N_SEL = 256;
constexpr int GW = 512, G_B = 8, CG_B = 64, GCH = 128;
constexpr int H_C = 8, DH_C = 64;
constexpr int NEXP = 32, TOPK = 4, D_FF = 1024;
constexpr int E_IN_EVEN = D_CQ + D_C + D_IDX + H_IDX + 2 * GW;
constexpr float LN_EPS = 1e-5f;
constexpr float DN_ALPHA = 1.681792830507429f;
constexpr float LOG2E = 1.4426950408889634f;
constexpr int NE_PR = 1536;
constexpr int NO_PR = 3072;
constexpr int NQQ = 1280;
constexpr int NMX = 1536;
constexpr int MOE_ROWS_MAX = (T_TOK * TOPK / 256 + NEXP) * 256;
constexpr int MOE_RB_MAX = MOE_ROWS_MAX / 256;

constexpr size_t MiB = 1u << 20;
constexpr size_t WS_CTL = 0, CTL_ZERO_BYTES = 1 * MiB;
constexpr size_t WS_WI = 1 * MiB;
constexpr size_t WS_GATE = 2 * MiB;
constexpr size_t WS_SLOT = 3 * MiB;
constexpr size_t WS_ROWTOK = 4 * MiB;
constexpr size_t WS_MASK = 12 * MiB;
constexpr size_t WS_WS = 28 * MiB;
constexpr size_t WS_WINE = 32 * MiB;
constexpr size_t WS_WQE = 38 * MiB;
constexpr size_t WS_WOUTE = 40 * MiB;
constexpr size_t WS_WINO = 46 * MiB;
constexpr size_t WS_WOUTO = 58 * MiB;
constexpr size_t WS_WRT = 62 * MiB;
constexpr size_t WS_WGU = 64 * MiB;
constexpr size_t WS_WDN = 576 * MiB;
constexpr size_t WS_HB = 832 * MiB;
constexpr size_t WS_Z = 960 * MiB;
constexpr size_t WS_PR = 1216 * MiB;
constexpr size_t WS_CQ = 1600 * MiB;
constexpr size_t WS_CKV = 1632 * MiB;
constexpr size_t WS_KI = 1648 * MiB;
constexpr size_t WS_QQ = 1656 * MiB;
constexpr size_t WS_MX = 1816 * MiB;
constexpr size_t WS_ACT = 2008 * MiB;
constexpr size_t WS_HB8 = 2272 * MiB;
constexpr size_t WS_Y = 2536 * MiB;
constexpr size_t WS_END = 3064 * MiB;
constexpr int CW_TMO = 0;
constexpr int CW_BAR = 4096;
constexpr int CW_CUR = 16384;

constexpr int RING_BYTES = 131072;
constexpr int MISC_OFF = RING_BYTES + 2048;
constexpr int LDS_BYTES = 147456;
constexpr int MI_BAR = 8;
constexpr int MI_RBSTART = 32;
constexpr int MI_CNT = 80;
constexpr int MI_LCNT = 112;
constexpr int MI_LBASE = 144;
constexpr int MI_NUNITS = 180;
constexpr int MI_RBE = 256;
constexpr int MI_REC = 1408;
constexpr int MI_END = MI_REC + 2048;
static_assert(MISC_OFF + MI_END * 4 <= LDS_BYTES, "LDS map");

#define GAS __attribute__((address_space(1)))
#define LAS __attribute__((address_space(3)))
typedef unsigned short bf16_t;
typedef short bf16x8 __attribute__((ext_vector_type(8)));
typedef short s16x4 __attribute__((ext_vector_type(4)));
typedef float f32x4 __attribute__((ext_vector_type(4)));
typedef float f32x2 __attribute__((ext_vector_type(2)));
typedef float f32x16 __attribute__((ext_vector_type(16)));
typedef unsigned u32x4 __attribute__((ext_vector_type(4)));
typedef unsigned u32x2 __attribute__((ext_vector_type(2)));
typedef GAS unsigned gu32;
typedef int v8i __attribute__((ext_vector_type(8)));
typedef int i32x4 __attribute__((ext_vector_type(4)));
__device__ __forceinline__ unsigned pk4_fp8(float a, float b, float c, float d) { int p = __builtin_amdgcn_cvt_pk_fp8_f32(a, b, 0, false); return (unsigned)__builtin_amdgcn_cvt_pk_fp8_f32(c, d, p, true); }
#define RLX_AGENT __ATOMIC_RELAXED, __HIP_MEMORY_SCOPE_AGENT
#define LDS_WAIT() asm volatile("s_waitcnt lgkmcnt(0)" ::: "memory")
#define VM_WAIT() asm volatile("s_waitcnt vmcnt(0)" ::: "memory")

__device__ __forceinline__ unsigned f2bf(float f) { unsigned u = __builtin_bit_cast(unsigned, f); return (u + 0x7fffu + ((u >> 16) & 1u)) >> 16; }
__device__ __forceinline__ unsigned pk2(float lo, float hi) { return f2bf(lo) | (f2bf(hi) << 16); }
__device__ __forceinline__ float bf2f(unsigned short v) { return __builtin_bit_cast(float, (unsigned)v << 16); }
__device__ __forceinline__ float bflo(unsigned w) { return __builtin_bit_cast(float, w << 16); }
__device__ __forceinline__ float bfhi(unsigned w) { return __builtin_bit_cast(float, w & 0xffff0000u); }
__device__ __forceinline__ unsigned cvt_pk_bf16(float lo, float hi) { unsigned r; asm volatile("v_cvt_pk_bf16_f32 %0, %1, %2" : "=v"(r) : "v"(lo), "v"(hi)); return r; }
template <int CTRL> __device__ __forceinline__ float dppx(float v) { return __builtin_bit_cast(float, __builtin_amdgcn_update_dpp(0, __builtin_bit_cast(int, v), CTRL, 0xf, 0xf, true)); }
template <int M> __device__ __forceinline__ float xshfl(float v, int) {
    static_assert(M == 1 || M == 2 || M == 4 || M == 8 || M == 16, "xshfl: inside a 32-lane half only");
    if constexpr (M == 1) return dppx<0xB1>(v);
    else if constexpr (M == 2) return dppx<0x4E>(v);
    else if constexpr (M == 4) return dppx<0x141>(v);
    else if constexpr (M == 8) return dppx<0x128>(v);
    else return __builtin_bit_cast(float, __builtin_amdgcn_ds_swizzle(__builtin_bit_cast(int, v), (16 << 10) | 0x1f));
}
__device__ __forceinline__ void plswap(unsigned a, unsigned b, unsigned& r0, unsigned& r1) {
    asm volatile("" : "+v"(a), "+v"(b));
    auto rr = __builtin_amdgcn_permlane32_swap(a, b, false, false); r0 = rr[0]; r1 = rr[1];
    asm volatile("" : "+v"(r0), "+v"(r1));
}
__device__ __forceinline__ void half_swap(float v, float& r0, float& r1) {
    unsigned u0, u1; plswap(__builtin_bit_cast(unsigned, v), __builtin_bit_cast(unsigned, v), u0, u1); r0 = __builtin_bit_cast(float, u0); r1 = __builtin_bit_cast(float, u1);
}
__device__ __forceinline__ float rdl(float v, int l) { return __builtin_bit_cast(float, __builtin_amdgcn_readlane(__builtin_bit_cast(int, v), l)); }
__device__ __forceinline__ float wave_sum(float v) {
    v += dppx<0xB1>(v); v += dppx<0x4E>(v); v += dppx<0x141>(v); v += dppx<0x140>(v);
    return (rdl(v, 0) + rdl(v, 16)) + (rdl(v, 32) + rdl(v, 48));
}
__device__ __forceinline__ float wave_max(float v) {
    v = fmaxf(v, dppx<0xB1>(v)); v = fmaxf(v, dppx<0x4E>(v)); v = fmaxf(v, dppx<0x141>(v)); v = fmaxf(v, dppx<0x140>(v));
    return fmaxf(fmaxf(rdl(v, 0), rdl(v, 16)), fmaxf(rdl(v, 32), rdl(v, 48)));
}
__device__ __forceinline__ int lane_id() { int l; asm volatile("v_mbcnt_lo_u32_b32 %0, -1, 0\n\tv_mbcnt_hi_u32_b32 %0, -1, %0" : "=v"(l)); return l; }
__device__ __forceinline__ int tid_of(int wv) { int t = (wv << 6) + lane_id(); asm volatile("" : "+v"(t)); return t; }
__device__ __forceinline__ float fast_exp2(float x) { return __builtin_amdgcn_exp2f(x); }
__device__ __forceinline__ float fast_rcp(float x) { return __builtin_amdgcn_rcpf(x); }
__device__ __forceinline__ float gelu_tanh(float x) {
    const float u = x * (0.7978845608028654f + 0.035677408136300125f * x * x);
    return x * fast_rcp(1.0f + fast_exp2(-2.0f * LOG2E * u));
}
namespace pg8 {
constexpr int BM = 256, BK = 64, HALF = 128, HTB = HALF * BK * 2  , STAGE_BYTES = 8 * HTB, NXCD = 8, WGM = 8;
__host__ __device__ __forceinline__ int lds_byte(int r, int c) { const int st = (r >> 4) * 2 + (c >> 5), rr = r & 15, cc = c & 31, ob = rr * 64 + cc * 2; return st * 1024 + (ob ^ (((ob >> 9) & 1) << 5)); }
__host__ __device__ __forceinline__ void stage_rc(int b, int& R, int& C) { const int st = b / 1024, sb = b % 1024, swz = sb ^ (((sb >> 9) & 1) << 5); R = (st >> 1) * 16 + swz / 64; C = (st & 1) * 32 + (swz % 64) / 2; }
__host__ __device__ __forceinline__ int perm32(int rho) { const int n = rho >> 4, i = rho & 15; return 8 * (i >> 2) + 4 * n + (i & 3); }

struct Unit { int pm, pn, bt, e, blk; };

struct DenseOrder {
    int nM, nN, nwg, G, c;
    __device__ void init(int M, int N, int G_, int c_) { nM = M / BM; nN = N / BM; nwg = nM * nN; G = G_; c = c_; }
    __device__ bool next(int i, Unit& u) const {
        const long L = (long)i * G + c; if (L >= nwg) return false;
        int wgid = (int)L; { const int q = nwg / NXCD, r = nwg % NXCD, xcd = wgid % NXCD, off = wgid / NXCD; wgid = (xcd < r ? xcd * (q + 1) : r * (q + 1) + (xcd - r) * q) + off; }
        const int nig = WGM * nN, gid = wgid / nig, fm = gid * WGM, gsz = (nM - fm) < WGM ? (nM - fm) : WGM;
        u.pm = fm + ((wgid % nig) % gsz); u.pn = (wgid % nig) / gsz; u.bt = u.pn; u.e = 0; u.blk = 0; return true;
    }
    __device__ __forceinline__ int count(int) const { return 0; }
};
struct MoeOrder {
    int nunits, npn, G, c; const LAS int* tab;
    __device__ bool next(int i, Unit& u) const {
        const long L = (long)i * G + c; if (L >= nunits) return false;
        const int rb = (int)L / npn, pn = (int)L % npn, e = __builtin_amdgcn_readfirstlane(tab[MI_RBE + rb]);
        u.pm = rb; u.pn = pn; u.e = e; u.bt = e * npn + pn; u.blk = rb - __builtin_amdgcn_readfirstlane(tab[MI_RBSTART + e]); return true;
    }
    __device__ __forceinline__ int count(int e) const { return __builtin_amdgcn_readfirstlane(tab[MI_CNT + e]); }
};

struct EpiStoreBf16 {
    static constexpr bool PERM = true;
    bf16_t* O; int ldc; int gelu_from;
    __device__ __forceinline__ void operator()(const f32x4 (&acc)[2][2][4][2], const Unit& u, int wr, int wc, int fr, int fq) const {
        const int row0 = u.pm * BM + wr * 64 + fr; const int col0 = u.pn * BM + wc * 32 + 8 * fq; const bool g = u.pn >= gelu_from;
#pragma unroll
        for (int ai = 0; ai < 2; ++ai)
#pragma unroll
            for (int m = 0; m < 4; ++m) { GAS bf16_t* rowp = (GAS bf16_t*)O + (size_t)(row0 + ai * HALF + m * 16) * ldc + col0;
#pragma unroll
                for (int bj = 0; bj < 2; ++bj) { f32x4 v0 = acc[ai][bj][m][0], v1 = acc[ai][bj][m][1];
                    if (g) {
#pragma unroll
                        for (int q = 0; q < 4; ++q) { v0[q] = gelu_tanh(v0[q]); v1[q] = gelu_tanh(v1[q]); } }
                    u32x4 w; w.x = cvt_pk_bf16(v0[0], v0[1]); w.y = cvt_pk_bf16(v0[2], v0[3]); w.z = cvt_pk_bf16(v1[0], v1[1]); w.w = cvt_pk_bf16(v1[2], v1[3]);
                    *(GAS u32x4*)(rowp + bj * HALF) = w; } }
    }
};
struct EpiResid {
    static constexpr bool PERM = true;
    const bf16_t* Hs; bf16_t* Z; float alpha;
    __device__ __forceinline__ void operator()(const f32x4 (&acc)[2][2][4][2], const Unit& u, int wr, int wc, int fr, int fq) const {
        const int row0 = u.pm * BM + wr * 64 + fr; const int col0 = u.pn * BM + wc * 32 + 8 * fq;
#pragma unroll
        for (int ai = 0; ai < 2; ++ai) {
            u32x4 hw[4][2];
#pragma unroll
            for (int m = 0; m < 4; ++m)
#pragma unroll
                for (int bj = 0; bj < 2; ++bj) hw[m][bj] = *(const GAS u32x4*)((const GAS bf16_t*)Hs + (size_t)(row0 + ai * HALF + m * 16) * D_MODEL + col0 + bj * HALF);
#pragma unroll
            for (int m = 0; m < 4; ++m) { const size_t off = (size_t)(row0 + ai * HALF + m * 16) * D_MODEL + col0;
#pragma unroll
                for (int bj = 0; bj < 2; ++bj) { const u32x4 h = hw[m][bj];
                    const f32x4 v0 = (f32x4){bflo(h.x), bfhi(h.x), bflo(h.y), bfhi(h.y)} * alpha + acc[ai][bj][m][0], v1 = (f32x4){bflo(h.z), bfhi(h.z), bflo(h.w), bfhi(h.w)} * alpha + acc[ai][bj][m][1];
                    u32x4 w; w.x = cvt_pk_bf16(v0[0], v0[1]); w.y = cvt_pk_bf16(v0[2], v0[3]); w.z = cvt_pk_bf16(v1[0], v1[1]); w.w = cvt_pk_bf16(v1[2], v1[3]);
                    *(GAS u32x4*)((GAS bf16_t*)Z + off + bj * HALF) = w; } } }
    }
};
__device__ __forceinline__ f32x2 pk_add(f32x2 a, f32x2 b) { f32x2 d; asm("v_pk_add_f32 %0, %1, %2" : "=v"(d) : "v"(a), "v"(b)); return d; }
__device__ __forceinline__ f32x2 pk_mul(f32x2 a, f32x2 b) { f32x2 d; asm("v_pk_mul_f32 %0, %1, %2" : "=v"(d) : "v"(a), "v"(b)); return d; }
__device__ __forceinline__ f32x2 pk_fma(f32x2 a, f32x2 b, f32x2 c) { f32x2 d; asm("v_pk_fma_f32 %0, %1, %2, %3" : "=v"(d) : "v"(a), "v"(b), "v"(c)); return d; }
__device__ __forceinline__ float a_min(float a, float b) { float d; asm("v_min_f32 %0, %1, %2" : "=v"(d) : "v"(a), "v"(b)); return d; }
__device__ __forceinline__ float a_med3(float a, float lo, float hi) { float d; asm("v_med3_f32 %0, %1, %2, %3" : "=v"(d) : "v"(a), "v"(lo), "v"(hi)); return d; }
__device__ __forceinline__ f32x2 pk_add_t(f32x2 a, f32x2 b) { f32x2 d; asm("s_nop 0\n\tv_pk_add_f32 %0, %1, %2" : "=v"(d) : "v"(a), "v"(b)); return d; }
__device__ __forceinline__ f32x2 pk_mul_t(f32x2 a, f32x2 b) { f32x2 d; asm("s_nop 0\n\tv_pk_mul_f32 %0, %1, %2" : "=v"(d) : "v"(a), "v"(b)); return d; }
struct EpiSwiglu {
    static constexpr bool PERM = true;
    bf16_t* ACT; const float* bgu;
    __device__ __forceinline__ void operator()(const f32x4 (&acc)[2][2][4][2], const Unit& u, int wr, int wc, int fr, int fq) const {
        const int row0 = u.pm * BM + wr * 64 + fr; const int oc0 = u.pn * HALF + wc * 32 + 8 * fq;
        const float* bb = bgu + (size_t)u.e * 2048 + oc0;
        f32x4 bg[2], bu[2];
#pragma unroll
        for (int n = 0; n < 2; ++n) { bg[n] = *(const GAS f32x4*)((const GAS float*)bb + 4 * n); bu[n] = *(const GAS f32x4*)((const GAS float*)bb + 1024 + 4 * n); }
#if MOE_FP8
        constexpr float OSC = 8.0f;
#else
        constexpr float OSC = 1.0f;
#endif
#pragma unroll
        for (int n = 0; n < 2; ++n) { bu[n] = (bu[n] + 1.0f) * OSC; asm volatile("" : "+v"(bu[n])); }
        f32x2 c_osc = {OSC, OSC}, c_z = {-1.702f * LOG2E, -1.702f * LOG2E}, c_one = {1.0f, 1.0f};
        f32x2 c_lim = {7.0f, -6.0f * OSC}; float c_hi = 8.0f * OSC;
        asm volatile("" : "+v"(c_osc), "+v"(c_z), "+v"(c_one), "+v"(c_lim), "+v"(c_hi));
#pragma unroll
        for (int ai = 0; ai < 2; ++ai)
#pragma unroll
            for (int m = 0; m < 4; ++m) { float o[8];
#pragma unroll
                for (int n = 0; n < 2; ++n)
#pragma unroll
                    for (int h = 0; h < 2; ++h) {
                        const f32x2 ag = {acc[ai][0][m][n][2 * h], acc[ai][0][m][n][2 * h + 1]}, au = {acc[ai][1][m][n][2 * h], acc[ai][1][m][n][2 * h + 1]};
                        const f32x2 vbg = {bg[n][2 * h], bg[n][2 * h + 1]}, vbu = {bu[n][2 * h], bu[n][2 * h + 1]};
                        f32x2 gt = pk_add(ag, vbg), up = pk_fma(au, c_osc, vbu);
                        gt.x = a_min(gt.x, c_lim.x); gt.y = a_min(gt.y, c_lim.x);
                        up.x = a_med3(up.x, c_lim.y, c_hi); up.y = a_med3(up.y, c_lim.y, c_hi);
                        f32x2 e = pk_mul(gt, c_z);
                        e.x = fast_exp2(e.x); e.y = fast_exp2(e.y);
                        f32x2 r = pk_add_t(e, c_one);
                        r.x = fast_rcp(r.x); r.y = fast_rcp(r.y);
                        const f32x2 ov = pk_mul_t(pk_mul(up, gt), r);
                        o[4 * n + 2 * h] = ov.x; o[4 * n + 2 * h + 1] = ov.y; }
#if MOE_FP8
                u32x2 w; w.x = pk4_fp8(o[0], o[1], o[2], o[3]); w.y = pk4_fp8(o[4], o[5], o[6], o[7]);
                *(GAS u32x2*)((GAS unsigned char*)ACT + (size_t)(row0 + ai * HALF + m * 16) * D_FF + oc0) = w; }
#else
                u32x4 w; w.x = cvt_pk_bf16(o[0], o[1]); w.y = cvt_pk_bf16(o[2], o[3]); w.z = cvt_pk_bf16(o[4], o[5]); w.w = cvt_pk_bf16(o[6], o[7]);
                *(GAS u32x4*)((GAS bf16_t*)ACT + (size_t)(row0 + ai * HALF + m * 16) * D_FF + oc0) = w; }
#endif
    }
};
struct EpiBiasBf16 {
    static constexpr bool PERM = true;
    bf16_t* Y; const float* bdn;
    __device__ __forceinline__ void operator()(const f32x4 (&acc)[2][2][4][2], const Unit& u, int wr, int wc, int fr, int fq) const {
        const int row0 = u.pm * BM + wr * 64 + fr; const int col0 = u.pn * BM + wc * 32 + 8 * fq;
        const float* bb = bdn + (size_t)u.e * 1024 + col0;
        f32x4 bv[2][2];
#pragma unroll
        for (int bj = 0; bj < 2; ++bj)
#pragma unroll
            for (int n = 0; n < 2; ++n) bv[bj][n] = *(const GAS f32x4*)((const GAS float*)bb + bj * HALF + 4 * n);
#pragma unroll
        for (int ai = 0; ai < 2; ++ai)
#pragma unroll
            for (int m = 0; m < 4; ++m) { const size_t roff = (size_t)(row0 + ai * HALF + m * 16) * D_MODEL + col0;
#pragma unroll
                for (int bj = 0; bj < 2; ++bj) { const f32x4 v0 = acc[ai][bj][m][0] + bv[bj][0], v1 = acc[ai][bj][m][1] + bv[bj][1];
#if MOE_FP8
                    f32x4 s0 = v0 * 64.f, s1 = v1 * 64.f;
#pragma unroll
                    for (int q = 0; q < 4; ++q) { s0[q] = fminf(fmaxf(s0[q], -448.f), 448.f); s1[q] = fminf(fmaxf(s1[q], -448.f), 448.f); }
                    u32x2 w; w.x = pk4_fp8(s0[0], s0[1], s0[2], s0[3]); w.y = pk4_fp8(s1[0], s1[1], s1[2], s1[3]);
                    *(GAS u32x2*)((GAS unsigned char*)Y + roff + bj * HALF) = w; } }
#else
                    u32x4 w; w.x = cvt_pk_bf16(v0[0], v0[1]); w.y = cvt_pk_bf16(v0[2], v0[3]); w.z = cvt_pk_bf16(v1[0], v1[1]); w.w = cvt_pk_bf16(v1[2], v1[3]);
                    *(GAS u32x4*)((GAS bf16_t*)Y + roff + bj * HALF) = w; } }
#endif
    }
};

template <class Epi, class Sched, bool GATHER, bool FP8 = false>
__device__ __forceinline__ void gemm_phase(LAS unsigned char* lds, const bf16_t* A, const bf16_t* Bt, const int K_, const int* __restrict__ rowidx, const Sched& S, const Epi& E, const int wv, int sclA = 0x7f7f7f7f, int sclB = 0x7f7f7f7f) {
    int Kh_ = K_; asm volatile("" : "+s"(Kh_)); const int K = Kh_;
    asm volatile("" : "+v"(sclA), "+v"(sclB));
    const int tid_ = tid_of(wv);
    const int tid = tid_, wid = __builtin_amdgcn_readfirstlane(tid >> 6), lane = tid & 63, wr = wid >> 2, wc = wid & 3, fr = lane & 15, fq = lane >> 4;
    const int nt = K / BK;
    unsigned voffB[2]; unsigned oc0[2], oc1[2];
    LAS unsigned* gnx = (LAS unsigned*)(lds + MISC_OFF + MI_REC * 4) + tid * 4;
    const size_t kstep = (size_t)(BK * 2);
    const size_t hstep = (size_t)HALF * K * 2;
    const size_t tstep = 2 * hstep;
#pragma unroll
    for (int i = 0; i < 2; ++i) { int R, C; stage_rc(tid * 16 + i * 8192, R, C); const int Rb = Epi::PERM ? ((R & ~31) + perm32(R & 31)) : R;
        oc0[i] = (unsigned)(R * K + C) * 2u; oc1[i] = oc0[i] + (unsigned)hstep;
        voffB[i] = (unsigned)(Rb * K + C) * 2u; }
    const unsigned ldsw = (unsigned)wid * 1024u;
    const int aoff = lds_byte(wr * 64 + fr, fq * 8), boff = lds_byte(wc * 32 + fr, fq * 8);
#define PG8_SA(b, h) (((b) * 2 + (h)) * HTB)
#define PG8_SB(b, h) ((4 + (b) * 2 + (h)) * HTB)
#define PG8_STAGE(bufoff, gbase, voff) do { _Pragma("unroll") for (int _i = 0; _i < 2; ++_i) { unsigned keep_; \
        asm volatile("s_mov_b32 %0, m0\n\ts_mov_b32 m0, %3\n\ts_nop 0\n\tglobal_load_lds_dwordx4 %1, %2\n\ts_mov_b32 m0, %0" \
            : "=&s"(keep_) : "v"((voff)[_i]), "s"((const char*)(gbase)), "s"((unsigned)(size_t)(lds + (bufoff) + ldsw + _i * 8192)) : "memory"); } } while (0)
#define PG8_RD8(p) __builtin_shufflevector(*(const LAS i32x4*)(p), *(const LAS i32x4*)((p) + 1024), 0, 1, 2, 3, 4, 5, 6, 7)
#define PG8_LDA(dst, b, h) do { if constexpr (FP8) { _Pragma("unroll") for (int m = 0; m < 4; ++m) dst##8[m] = PG8_RD8(lds + PG8_SA(b, h) + aoff + m * 2048); } \
        else { _Pragma("unroll") for (int m = 0; m < 4; ++m) _Pragma("unroll") for (int k = 0; k < 2; ++k) dst[m][k] = *(const LAS bf16x8*)(lds + PG8_SA(b, h) + aoff + m * 2048 + k * 1024); } } while (0)
#define PG8_LDB(dst, b, h) do { if constexpr (FP8) { _Pragma("unroll") for (int n = 0; n < 2; ++n) dst##8[n] = PG8_RD8(lds + PG8_SB(b, h) + boff + n * 2048); } \
        else { _Pragma("unroll") for (int n = 0; n < 2; ++n) _Pragma("unroll") for (int k = 0; k < 2; ++k) dst[n][k] = *(const LAS bf16x8*)(lds + PG8_SB(b, h) + boff + n * 2048 + k * 1024); } } while (0)
#define PG8_MMA(ai, bj, At, Bt_) do { __builtin_amdgcn_s_setprio(1); _Pragma("unroll") for (int m = 0; m < 4; ++m) _Pragma("unroll") for (int n = 0; n < 2; ++n) { \
        if constexpr (FP8) asm volatile("v_mfma_scale_f32_16x16x128_f8f6f4 %0, %1, %2, %0, %3, %4 op_sel_hi:[0,0,0]" : "+v"(acc[ai][bj][m][n]) : "v"(Bt_##8[n]), "v"(At##8[m]), "v"(sclB), "v"(sclA));   \
        else { _Pragma("unroll") for (int k = 0; k < 2; ++k) acc[ai][bj][m][n] = __builtin_amdgcn_mfma_f32_16x16x32_bf16(Bt_[n][k], At[m][k], acc[ai][bj][m][n], 0, 0, 0); } } \
        __builtin_amdgcn_s_setprio(0); } while (0)
#define PG8_WAIT_V(n) asm volatile("s_waitcnt vmcnt(" #n ")" ::: "memory")
#define PG8_WAIT_L(n) asm volatile("s_waitcnt lgkmcnt(" #n ")" ::: "memory")
#define PG8_BAR __builtin_amdgcn_s_barrier()
#define PG8_SCHED __builtin_amdgcn_sched_barrier(0)
#define PG8_GOFF(u, g0, g1) do { const int cn_ = S.count((u).e); const GAS int* rp_ = (const GAS int*)rowidx + (size_t)(u).e * 65536 + (u).blk * 256; \
        _Pragma("unroll") for (int i_ = 0; i_ < 2; ++i_) { int r0_, c0_; stage_rc(tid * 16 + i_ * 8192, r0_, c0_); const unsigned gc_ = (unsigned)c0_ * 2u; \
            const int t0_ = ((u).blk * 256 + r0_ < cn_) ? rp_[r0_] : 0; const int t1_ = ((u).blk * 256 + 128 + r0_ < cn_) ? rp_[128 + r0_] : 0; \
            g0[i_] = (unsigned)t0_ * (unsigned)(K * 2) + gc_; g1[i_] = (unsigned)t1_ * (unsigned)(K * 2) + gc_; asm volatile("" : "+v"(g0[i_]), "+v"(g1[i_])); } } while (0)
    Unit cur, nxt; int ui = 0;
    if (!S.next(0, cur)) return;
    f32x4 acc[2][2][4][2];
#pragma unroll
    for (int a = 0; a < 2; ++a)
#pragma unroll
        for (int b = 0; b < 2; ++b)
#pragma unroll
            for (int m = 0; m < 4; ++m)
#pragma unroll
                for (int n = 0; n < 2; ++n) acc[a][b][m][n] = (f32x4){0.f, 0.f, 0.f, 0.f};
    bf16x8 At[4][2], B0[2][2], B1[2][2]; v8i At8[4], B08[2], B18[2];
    if constexpr (GATHER) { PG8_GOFF(cur, oc0, oc1); gnx[0] = oc0[0]; gnx[1] = oc0[1]; gnx[2] = oc1[0]; gnx[3] = oc1[1]; }
    const char* cA = GATHER ? (const char*)A : (const char*)A + (size_t)cur.pm * tstep; const char* cB = (const char*)Bt + (size_t)cur.bt * tstep;
    PG8_STAGE(PG8_SB(0, 0), cB, voffB); PG8_STAGE(PG8_SB(0, 1), cB + hstep, voffB); PG8_STAGE(PG8_SA(0, 0), cA, oc0); PG8_STAGE(PG8_SA(0, 1), cA, oc1);
    if (wr == 1) PG8_BAR;
    PG8_WAIT_V(2); PG8_BAR;
    PG8_STAGE(PG8_SB(1, 0), cB + kstep, voffB); PG8_STAGE(PG8_SA(1, 0), cA + kstep, oc0); PG8_STAGE(PG8_SB(1, 1), cB + hstep + kstep, voffB);
    PG8_WAIT_V(6); PG8_BAR;
    for (;;) {
        const bool has_next = S.next(ui + 1, nxt);
        if constexpr (GATHER) { if (has_next) { unsigned on0[2], on1[2]; PG8_GOFF(nxt, on0, on1); gnx[0] = on0[0]; gnx[1] = on0[1]; gnx[2] = on1[0]; gnx[3] = on1[1]; } }
        const char* nA = GATHER ? (const char*)A : (has_next ? (const char*)A + (size_t)nxt.pm * tstep : cA); const char* nB = has_next ? (const char*)Bt + (size_t)nxt.bt * tstep : cB;
        for (int t = 0; t < nt; t += 2) {
            const bool last = (t == nt - 2);
            const char* a1 = cA + (size_t)(t + 1) * kstep;
            const char* a2 = last ? nA : cA + (size_t)(t + 2) * kstep; const char* b2 = last ? nB : cB + (size_t)(t + 2) * kstep;
            const char* a3 = a2 + kstep; const char* b3 = b2 + kstep;
            unsigned s0[2], s1[2];
#pragma unroll
            for (int i = 0; i < 2; ++i) { s0[i] = oc0[i]; s1[i] = oc1[i]; }
            if constexpr (GATHER) { if (last) { s0[0] = gnx[0]; s0[1] = gnx[1]; s1[0] = gnx[2]; s1[1] = gnx[3]; } }
            PG8_LDB(B0, 0, 0); PG8_LDB(B1, 0, 1); PG8_SCHED; PG8_LDA(At, 0, 0); PG8_STAGE(PG8_SA(1, 1), a1, oc1);
            PG8_WAIT_V(8); PG8_WAIT_L(0); PG8_BAR; PG8_MMA(0, 0, At, B0); PG8_MMA(0, 1, At, B1); PG8_BAR; PG8_SCHED;
            PG8_LDA(At, 0, 1); PG8_STAGE(PG8_SB(0, 0), b2, voffB); PG8_STAGE(PG8_SB(0, 1), b2 + hstep, voffB); PG8_STAGE(PG8_SA(0, 0), a2, s0);
            PG8_WAIT_V(8); PG8_WAIT_L(0); PG8_BAR; PG8_MMA(1, 0, At, B0); PG8_MMA(1, 1, At, B1); PG8_BAR; PG8_SCHED;
            PG8_LDB(B0, 1, 0); PG8_LDB(B1, 1, 1); PG8_SCHED; PG8_LDA(At, 1, 0); PG8_STAGE(PG8_SA(0, 1), a2, s1);
            PG8_WAIT_V(8); PG8_WAIT_L(0); PG8_BAR; PG8_MMA(0, 0, At, B0); PG8_MMA(0, 1, At, B1); PG8_BAR; PG8_SCHED;
            PG8_LDA(At, 1, 1); PG8_STAGE(PG8_SB(1, 0), b3, voffB); PG8_STAGE(PG8_SB(1, 1), b3 + hstep, voffB); PG8_STAGE(PG8_SA(1, 0), a3, s0);
            PG8_WAIT_V(8); PG8_WAIT_L(0); PG8_BAR; PG8_MMA(1, 0, At, B0); PG8_MMA(1, 1, At, B1); PG8_BAR; PG8_SCHED;
        }
        if (wr == 0) PG8_BAR;
        if constexpr (FP8) asm volatile("s_nop 15\n\ts_nop 15" ::: "memory");
        E(acc, cur, wr, wc, fr, fq);
        if (!has_next) break;
#pragma unroll
        for (int a = 0; a < 2; ++a)
#pragma unroll
            for (int b = 0; b < 2; ++b)
#pragma unroll
                for (int m = 0; m < 4; ++m)
#pragma unroll
                    for (int n = 0; n < 2; ++n) acc[a][b][m][n] = (f32x4){0.f, 0.f, 0.f, 0.f};
        cur = nxt; cA = nA; cB = nB; ++ui;
        if constexpr (GATHER) { oc0[0] = gnx[0]; oc0[1] = gnx[1]; oc1[0] = gnx[2]; oc1[1] = gnx[3]; }
        if (wr == 1) PG8_BAR;
    }
    PG8_WAIT_V(0);
    PG8_BAR;
#undef PG8_SA
#undef PG8_SB
#undef PG8_STAGE
#undef PG8_LDA
#undef PG8_LDB
#undef PG8_MMA
#undef PG8_RD8
#undef PG8_WAIT_V
#undef PG8_WAIT_L
#undef PG8_BAR
#undef PG8_SCHED
#undef PG8_GOFF
}
}
namespace att {
#define ATT_SBAR() __builtin_amdgcn_sched_barrier(0)
constexpr float THR = 8.f;
__device__ __forceinline__ int crow(int r, int hi) { return (r & 3) + 8 * (r >> 2) + 4 * hi; }
__device__ __forceinline__ unsigned cvtpk(float lo, float hi) { unsigned r; asm volatile("v_cvt_pk_bf16_f32 %0, %1, %2" : "=v"(r) : "v"(lo), "v"(hi)); return r; }

__device__ __forceinline__ void partialSM(f32x16& p0, f32x16& p1, float& m_reg, float& alpha) {
  float pmax = p0[0];
#pragma unroll
  for (int r = 1; r < 16; ++r) pmax = fmaxf(pmax, p0[r]);
#pragma unroll
  for (int r = 0; r < 16; ++r) pmax = fmaxf(pmax, p1[r]);
  { float r0, r1; half_swap(pmax, r0, r1); pmax = fmaxf(r0, r1); }
  float mn;
  if (__builtin_expect(__all(pmax - m_reg <= THR), 1)) { mn = m_reg; alpha = 1.f; }
  else { mn = fmaxf(m_reg, pmax); alpha = __builtin_amdgcn_exp2f(m_reg - mn); m_reg = mn; }
#pragma unroll
  for (int r = 0; r < 16; ++r) { p0[r] = __builtin_amdgcn_exp2f(p0[r] - mn); p1[r] = __builtin_amdgcn_exp2f(p1[r] - mn); }
}
__device__ __forceinline__ void finishSM(const f32x16& p0, const f32x16& p1, float alpha, float& l_reg, bf16x8& pa0, bf16x8& pa1, bf16x8& pa2, bf16x8& pa3) {
  float ps = 0;
#pragma unroll
  for (int r = 0; r < 16; ++r) ps += p0[r];
#pragma unroll
  for (int r = 0; r < 16; ++r) ps += p1[r];
  { float r0, r1; half_swap(ps, r0, r1); ps = r0 + r1; }
  l_reg = l_reg * alpha + ps;
#define ATT_PK4(P, BASE, OUT) do { unsigned a0 = cvtpk(P[BASE + 0], P[BASE + 1]), a1 = cvtpk(P[BASE + 2], P[BASE + 3]);   \
    unsigned b0 = cvtpk(P[BASE + 4], P[BASE + 5]), b1 = cvtpk(P[BASE + 6], P[BASE + 7]);                              \
    unsigned r00, r01, r10, r11; plswap(a0, b0, r00, r01); plswap(a1, b1, r10, r11); \
    u32x4 w = {r00, r10, r01, r11}; OUT = __builtin_bit_cast(bf16x8, w); } while (0)
  ATT_PK4(p0, 0, pa0); ATT_PK4(p0, 8, pa1); ATT_PK4(p1, 0, pa2); ATT_PK4(p1, 8, pa3);
#undef ATT_PK4
}
__device__ __forceinline__ int v_st(int k, int c) { const int kk = (k & ~0xC) | ((k & 4) << 1) | ((k & 8) >> 1); return ((kk >> 3) * 4 + (c >> 5)) * 512 + ((kk & 7) * 32 + (c & 31)) * 2; }
__device__ __forceinline__ int v_rd_base(int lane) { return ((lane & 3) << 3) | (((lane >> 2) & 3) << 6) | (((lane >> 4) & 1) << 5) | (((lane >> 5) & 1) << 8); }
constexpr int v_rd_off(int d0, int ks, int half) { return d0 * 512 + ks * 4096 + half * 2048; }
template <int OFF> __device__ __forceinline__ s16x4 tr_read(int vb) {
  s16x4 r; asm volatile("ds_read_b64_tr_b16 %0, %1 offset:%2" : "=&v"(r) : "v"(vb), "i"(OFF) : "memory"); return r;
}
template <int D0> __device__ __forceinline__ void pv_one(f32x16& od, int vb, bf16x8 pa0, bf16x8 pa1, bf16x8 pa2, bf16x8 pa3) {
  const s16x4 l0 = tr_read<v_rd_off(D0, 0, 0)>(vb), h0 = tr_read<v_rd_off(D0, 0, 1)>(vb), l1 = tr_read<v_rd_off(D0, 1, 0)>(vb), h1 = tr_read<v_rd_off(D0, 1, 1)>(vb);
  const s16x4 l2 = tr_read<v_rd_off(D0, 2, 0)>(vb), h2 = tr_read<v_rd_off(D0, 2, 1)>(vb), l3 = tr_read<v_rd_off(D0, 3, 0)>(vb), h3 = tr_read<v_rd_off(D0, 3, 1)>(vb);
  asm volatile("s_waitcnt lgkmcnt(0)" ::: "memory"); ATT_SBAR();
#define ATT_PK(L, H) (bf16x8){L[0], L[1], L[2], L[3], H[0], H[1], H[2], H[3]}
  od = __builtin_amdgcn_mfma_f32_32x32x16_bf16(pa0, ATT_PK(l0, h0), od, 0, 0, 0);
  od = __builtin_amdgcn_mfma_f32_32x32x16_bf16(pa1, ATT_PK(l1, h1), od, 0, 0, 0);
  od = __builtin_amdgcn_mfma_f32_32x32x16_bf16(pa2, ATT_PK(l2, h2), od, 0, 0, 0);
  od = __builtin_amdgcn_mfma_f32_32x32x16_bf16(pa3, ATT_PK(l3, h3), od, 0, 0, 0);
#undef ATT_PK
}
constexpr int ATT_LDS_V = 0, ATT_LDS_K = 32768, ATT_LDS_WS = 65536, ATT_LDS_CORE = 65536 + 2048;
template <int DQK, bool MASKED, bool KVSAME>
__device__ __forceinline__ void attn_core(const GAS bf16_t* __restrict__ Qrow0, int ldq, const GAS bf16_t* __restrict__ Kh, int ldk, const GAS bf16_t* __restrict__ Vh, int ldv,
                                          int NTB, int NTW, float slope2, int tq0, const LAS unsigned long long* mask, LAS char* lds, f32x16 (&o)[4], float& l_out, const int wv) {
  static_assert(DQK == 64 || DQK == 128, "DQK"); static_assert(!KVSAME || DQK == 128, "KVSAME needs DQK 128");
  constexpr int KROWB = DQK * 2, KBUF = 64 * KROWB, ND0 = DQK / 16;
  const int tid_ = tid_of(wv);
  const int tid = tid_, wid = tid >> 6, lane = tid & 63, r32 = lane & 31, hi = lane >> 5;
  LAS char* V_lds = lds + ATT_LDS_V; LAS char* K_lds = lds + ATT_LDS_K;
  LAS float* wsf = (LAS float*)(lds + ATT_LDS_WS) + wid * 64; LAS float* al_l = wsf + 32;
  float m_reg = -1e30f, l_reg = 0.f;
#pragma unroll
  for (int d = 0; d < 4; ++d) o[d] = f32x16{};
  bf16x8 qr[ND0];
  { const GAS bf16_t* Qp = Qrow0 + (size_t)r32 * ldq + hi * 8;
#pragma unroll
    for (int d0 = 0; d0 < ND0; ++d0) qr[d0] = *(const GAS bf16x8*)(Qp + d0 * 16); }
  const int sr = tid >> 4, sc = (tid & 15) * 8, vst0 = v_st(sr, sc), vst1 = v_st(32 + sr, sc);
  const int kr = tid >> 3, kc = (tid & 7) * 8;
  const int vb0 = (int)(unsigned)(size_t)V_lds + v_rd_base(lane);
  bf16x8 vs0, vs1, ks0, ks1, wv0, wv1, wk0, wk1;
#define ATT_KSWZ(row, colB) ((row) * KROWB + ((colB) ^ (((row) & 7) << 4)))
#define ATT_SLOADX(k0, vs0, vs1, ks0, ks1) do { vs0 = *(const GAS bf16x8*)(&Vh[(size_t)((k0) + sr) * ldv + sc]); vs1 = *(const GAS bf16x8*)(&Vh[(size_t)((k0) + 32 + sr) * ldv + sc]); \
    if constexpr (!KVSAME) { if constexpr (DQK == 128) { ks0 = *(const GAS bf16x8*)(&Kh[(size_t)((k0) + sr) * ldk + sc]); ks1 = *(const GAS bf16x8*)(&Kh[(size_t)((k0) + 32 + sr) * ldk + sc]); } \
                             else { ks0 = *(const GAS bf16x8*)(&Kh[(size_t)((k0) + kr) * ldk + kc]); } } } while (0)
#define ATT_SLOAD(k0) ATT_SLOADX(k0, vs0, vs1, ks0, ks1)
#define ATT_SLOADB(k0) ATT_SLOADX(k0, wv0, wv1, wk0, wk1)
#define ATT_SWRITEX(b, vs0, vs1, ks0, ks1) do { *(LAS bf16x8*)(V_lds + (b) * 16384 + vst0) = vs0; *(LAS bf16x8*)(V_lds + (b) * 16384 + vst1) = vs1; \
    if constexpr (KVSAME) { *(LAS bf16x8*)(K_lds + (b) * KBUF + ATT_KSWZ(sr, sc * 2)) = vs0; *(LAS bf16x8*)(K_lds + (b) * KBUF + ATT_KSWZ(32 + sr, sc * 2)) = vs1; } \
    else if constexpr (DQK == 128) { *(LAS bf16x8*)(K_lds + (b) * KBUF + ATT_KSWZ(sr, sc * 2)) = ks0; *(LAS bf16x8*)(K_lds + (b) * KBUF + ATT_KSWZ(32 + sr, sc * 2)) = ks1; } \
    else { *(LAS bf16x8*)(K_lds + (b) * KBUF + ATT_KSWZ(kr, kc * 2)) = ks0; } } while (0)
#define ATT_SWRITE(b) ATT_SWRITEX(b, vs0, vs1, ks0, ks1)
#define ATT_SWRITEB(b) ATT_SWRITEX(b, wv0, wv1, wk0, wk1)
  constexpr bool SD2 = false;
  ATT_SLOAD((NTB - 1) * 64); ATT_SWRITE(0);
  if constexpr (SD2) { if (NTB > 1) ATT_SLOADB((NTB - 2) * 64); if (NTB > 2) ATT_SLOAD((NTB - 3) * 64); }
  __syncthreads();
  float m_ref = 0.f;
  const int jdiag = tq0 >> 6;
  for (int jj = 0; jj < NTB; ++jj) {
    const int j = NTB - 1 - jj, buf = jj & 1;
    if constexpr (!SD2) { if (j > 0) ATT_SLOAD((j - 1) * 64); }
    if (j < NTW) {
      f32x16 p0, p1;
      unsigned mlo = 0xffffffffu, mhi = 0xffffffffu;
      if constexpr (MASKED) { const unsigned long long mw = mask[j * 32 + r32]; mlo = (unsigned)mw >> (4 * hi); mhi = (unsigned)(mw >> 32) >> (4 * hi); }
      if (j == jdiag) {
        const float x = (float)(tq0 + r32 - j * 64 - 4 * hi);
#pragma unroll
        for (int r = 0; r < 16; ++r) { const int cr = (r & 3) + 8 * (r >> 2); const float d = x - (float)cr; p0[r] = -slope2 * fabsf(d) - m_ref; p1[r] = -slope2 * fabsf(d - 32.f) - m_ref; }
      } else {
        const float b0 = slope2 * (float)(j * 64 + 4 * hi - tq0 - r32) - m_ref, s2 = slope2 + slope2, s3 = s2 + slope2, s8 = 8.f * slope2, s32 = 32.f * slope2;
        float bg = b0;
#pragma unroll
        for (int g = 0; g < 4; ++g) { p0[4 * g] = bg; p0[4 * g + 1] = bg + slope2; p0[4 * g + 2] = bg + s2; p0[4 * g + 3] = bg + s3; bg += s8; }
#pragma unroll
        for (int r = 0; r < 16; ++r) p1[r] = p0[r] + s32;
      }
      if constexpr (MASKED) {
#pragma unroll
        for (int r = 0; r < 16; ++r) { const int cr = (r & 3) + 8 * (r >> 2);
          if (!((mlo >> cr) & 1u)) p0[r] = -INFINITY; if (!((mhi >> cr) & 1u)) p1[r] = -INFINITY; }
      }
      { const LAS char* Kb = K_lds + buf * KBUF;
#pragma unroll
        for (int d0 = 0; d0 < ND0; ++d0) { const int cb = (d0 * 16 + hi * 8) * 2;
          const bf16x8 b0 = *(const LAS bf16x8*)(Kb + ATT_KSWZ(r32, cb));
          const bf16x8 b1 = *(const LAS bf16x8*)(Kb + ATT_KSWZ(32 + r32, cb));
          p0 = __builtin_amdgcn_mfma_f32_32x32x16_bf16(b0, qr[d0], p0, 0, 0, 0);
          p1 = __builtin_amdgcn_mfma_f32_32x32x16_bf16(b1, qr[d0], p1, 0, 0, 0); } }
      float pmax = fmaxf(p0[0], p1[0]);
#pragma unroll
      for (int r = 1; r < 16; ++r) pmax = fmaxf(pmax, fmaxf(p0[r], p1[r]));
      { float r0, r1; half_swap(pmax, r0, r1); pmax = fmaxf(r0, r1); }
      const bool first = (j == NTW - 1);
      if (first || __any(pmax > THR)) {
        const float dl = first ? ((pmax > -1e30f) ? pmax : 0.f) : fmaxf(pmax, 0.f);
        m_ref += dl; const float alpha = __builtin_amdgcn_exp2f(-dl); l_reg *= alpha;
#pragma unroll
        for (int r = 0; r < 16; ++r) { p0[r] -= dl; p1[r] -= dl; }
        if (!first) { if (hi == 0) al_l[r32] = alpha; asm volatile("s_waitcnt lgkmcnt(0)" ::: "memory");
#pragma unroll
          for (int d = 0; d < 4; ++d)
#pragma unroll
            for (int r = 0; r < 16; ++r) o[d][r] *= al_l[crow(r, hi)]; }
      }
#pragma unroll
      for (int r = 0; r < 16; ++r) { p0[r] = __builtin_amdgcn_exp2f(p0[r]); p1[r] = __builtin_amdgcn_exp2f(p1[r]); }
      bf16x8 pa0, pa1, pa2, pa3;
      finishSM(p0, p1, 1.f, l_reg, pa0, pa1, pa2, pa3); ATT_SBAR();
      const int vb = vb0 + buf * 16384;
      pv_one<0>(o[0], vb, pa0, pa1, pa2, pa3); pv_one<1>(o[1], vb, pa0, pa1, pa2, pa3); pv_one<2>(o[2], vb, pa0, pa1, pa2, pa3); pv_one<3>(o[3], vb, pa0, pa1, pa2, pa3);
    }
    if constexpr (!SD2) { if (j > 0) ATT_SWRITE(buf ^ 1); }
    else { if (j > 0) { if ((jj + 1) & 1) ATT_SWRITEB(buf ^ 1); else ATT_SWRITE(buf ^ 1); }
           if (j > 2) { if ((jj + 1) & 1) ATT_SLOADB((j - 3) * 64); else ATT_SLOAD((j - 3) * 64); } }
    __syncthreads();
  }
  l_out = l_reg;
#undef ATT_KSWZ
#undef ATT_SLOAD
#undef ATT_SWRITE
#undef ATT_SLOADB
#undef ATT_SWRITEB
#undef ATT_SLOADX
#undef ATT_SWRITEX
}
__device__ __forceinline__ void row_rcp(float l_reg, LAS char* lds, float (&rli)[16], const int wv) {
  const int tid_ = tid_of(wv);
  const int tid = tid_, wid = tid >> 6, lane = tid & 63, r32 = lane & 31, hi = lane >> 5;
  LAS float* li_l = (LAS float*)(lds + ATT_LDS_WS) + wid * 64;
  if (hi == 0) li_l[r32] = l_reg; asm volatile("s_waitcnt lgkmcnt(0)" ::: "memory");
#pragma unroll
  for (int r = 0; r < 16; ++r) rli[r] = __builtin_amdgcn_rcpf(li_l[crow(r, hi)]);
}
}
#define XB_TMO      128
#define XB_XCNT(j)  (256  + 64 * (j))
#define XB_XSUB(j)  (1280 + 64 * (j))
#define XB_XGEN(j)  (2304 + 64 * (j))
#define XB_TOP      3328
#define XB_TOPGEN   3392
#define XCD_BAR_WORDS 3456
#define XB_SPIN_CAP (1u << 18)

__device__ __forceinline__ unsigned xb_ld(unsigned* p)              { return __hip_atomic_load(p, __ATOMIC_RELAXED, __HIP_MEMORY_SCOPE_AGENT); }
__device__ __forceinline__ unsigned xb_add(unsigned* p, unsigned v) { return __hip_atomic_fetch_add(p, v, __ATOMIC_RELAXED, __HIP_MEMORY_SCOPE_AGENT); }
__device__ __forceinline__ unsigned xb_xcc_id() { return (unsigned)__builtin_amdgcn_s_getreg((3 << 11) | 20) & 0xFu; }
#define XB_SPIN(cond, bar) do { unsigned _sp = 0; while (cond) { __builtin_amdgcn_s_sleep(1); \
    if ((++_sp & 255u) == 0u) { if (xb_ld(&(bar)[XB_TMO])) break; if (_sp > XB_SPIN_CAP) { atomicAdd(&(bar)[XB_TMO], 1u); break; } } } } while (0)

struct XcdBarrier {
    unsigned* bar; unsigned x; unsigned w;
    volatile LAS unsigned* st;
};

__device__ __forceinline__ XcdBarrier xcd_barrier_post(unsigned* bar, volatile LAS unsigned* st) {
    XcdBarrier b; b.bar = bar; b.x = xb_xcc_id(); b.st = st; b.w = (unsigned)__builtin_amdgcn_readfirstlane((int)(threadIdx.x >> 6));
    if (threadIdx.x == 0) (void)xb_add(&bar[XB_XCNT(b.x)], 1u);
    return b;
}
__device__ __forceinline__ void xcd_barrier_complete(unsigned* bar, unsigned x, unsigned& nloc, unsigned& nx) {
    const unsigned G = gridDim.x * gridDim.y * gridDim.z;
    unsigned sum, cnt, mine, sp = 0u;
    for (;;) {
        sum = 0u; cnt = 0u; mine = 0u;
#pragma unroll
        for (unsigned j = 0; j < 16; ++j) { const unsigned c = xb_ld(&bar[XB_XCNT(j)]); sum += c; cnt += (c > 0u) ? 1u : 0u; mine = (j == x) ? c : mine; }
        if (sum == G) break;
        __builtin_amdgcn_s_sleep(1);
        if ((++sp & 255u) == 0u) { if (xb_ld(&bar[XB_TMO])) break; if (sp > XB_SPIN_CAP) { atomicAdd(&bar[XB_TMO], 1u); break; } }
    }
    nloc = mine > 0u ? mine : 1u; nx = cnt > 0u ? cnt : 1u;
}

__device__ __forceinline__ void xcd_barrier(const XcdBarrier& b) {
    asm volatile("s_waitcnt vmcnt(0)" ::: "memory");
    __syncthreads();
    if (b.w == 0u && lane_id() == 0) {
        unsigned* bar = b.bar;
        __builtin_amdgcn_s_waitcnt(0);
        unsigned nloc = b.st[0], nx = b.st[1];
        if (nloc == 0u) { xcd_barrier_complete(bar, b.x, nloc, nx); b.st[0] = nloc; b.st[1] = nx; }
        const unsigned old = xb_add(&bar[XB_XSUB(b.x)], 1u);
        const unsigned gen = old / nloc;
        if (old + 1u == (gen + 1u) * nloc) {
            __builtin_amdgcn_fence(__ATOMIC_RELEASE, "agent");
            asm volatile("s_waitcnt vmcnt(0)" ::: "memory");
            const unsigned og = xb_add(&bar[XB_TOP], 1u);
            const unsigned tg = og / nx;
            if (og + 1u == (tg + 1u) * nx) xb_add(&bar[XB_TOPGEN], 1u);
            else XB_SPIN(xb_ld(&bar[XB_TOPGEN]) == tg, bar);
            __builtin_amdgcn_fence(__ATOMIC_ACQUIRE, "agent");
            xb_add(&bar[XB_XGEN(b.x)], 1u);
            asm volatile("s_waitcnt vmcnt(0)" ::: "memory");
        } else {
            XB_SPIN(xb_ld(&bar[XB_XGEN(b.x)]) == gen, bar);
            __builtin_amdgcn_fence(__ATOMIC_ACQUIRE, "agent");
            asm volatile("s_waitcnt vmcnt(0)" ::: "memory");
        }
    }
    __syncthreads();
}
struct Args { const float* in[32]; float* out; unsigned char* ws; int l_lo, l_hi, p_lo, p_hi, do_pro, fused; };
enum { I_X = 0, I_EV_W_IN, I_EV_Q_NORM, I_EV_KV_NORM, I_EV_W_UQ, I_EV_W_UK, I_EV_W_UV, I_EV_W_IQ, I_EV_IDX_K_G, I_EV_IDX_K_B, I_EV_V_NORM_G, I_EV_V_NORM_B, I_EV_W_S, I_EV_B_S, I_EV_W_OUT,
       I_OD_W_IN, I_OD_LQ1, I_OD_LK1, I_OD_LQ2, I_OD_LK2, I_OD_SUBLN_G, I_OD_W_OUT, I_LN1_G, I_LN1_B, I_LN2_G, I_LN2_B, I_ROUTER_W, I_ROUTER_B, I_EXP_W_GU, I_EXP_B_GU, I_EXP_W_DN, I_EXP_B_DN };
struct Frame {
    LAS unsigned char* lds; char* ldsg; volatile LAS int* MISC; gu32* ctl;
    int tid, lane, wave, vcu, G;
    unsigned char* ws;
};
typedef const __attribute__((address_space(4))) Args* ArgsP;
#define WSP(T, off) ((T*)(ws_ + (off)))
#define PHASE_PROLOG() unsigned char* ws_ = F.ws; asm volatile("" : "+s"(ws_)); asm volatile("" : "+s"(a)); int vcu_ = F.vcu, G_ = F.G; asm volatile("" : "+s"(vcu_), "+s"(G_))
#define fresh_tid() tid_of(F.wave)

__device__ __forceinline__ void tr_block(const float* src, int ld, bf16_t* dst, int dld, float scale, LAS float* scr, int lane) {
#pragma unroll 8
    for (int i = 0; i < 32; ++i) { const int kk = 2 * i + (lane >> 5); scr[kk * 33 + (lane & 31)] = src[(size_t)kk * ld + (lane & 31)]; }
    LDS_WAIT(); asm volatile("" ::: "memory");
    const int c = lane & 7;
#pragma unroll
    for (int j = 0; j < 4; ++j) { const int n = (lane >> 3) + 8 * j; const LAS float* s = scr + (8 * c) * 33 + n;
        u32x4 o; o.x = pk2(s[0 * 33] * scale, s[1 * 33] * scale); o.y = pk2(s[2 * 33] * scale, s[3 * 33] * scale); o.z = pk2(s[4 * 33] * scale, s[5 * 33] * scale); o.w = pk2(s[6 * 33] * scale, s[7 * 33] * scale);
        *(GAS u32x4*)(dst + (size_t)n * dld + 8 * c) = o; }
    LDS_WAIT(); asm volatile("" ::: "memory");
}
__device__ __forceinline__ void tr_block8(const float* src, int ld, unsigned char* dst, int dld, float scale, LAS float* scr, int lane) {
#pragma unroll 8
    for (int i = 0; i < 32; ++i) { const int kk = 2 * i + (lane >> 5); scr[kk * 33 + (lane & 31)] = src[(size_t)kk * ld + (lane & 31)]; }
    LDS_WAIT(); asm volatile("" ::: "memory");
    const int n = lane >> 1, kh = (lane & 1) * 32; const LAS float* s = scr + kh * 33 + n;
#pragma unroll
    for (int j = 0; j < 2; ++j) { u32x4 o;
        o.x = pk4_fp8(s[(16 * j + 0) * 33] * scale, s[(16 * j + 1) * 33] * scale, s[(16 * j + 2) * 33] * scale, s[(16 * j + 3) * 33] * scale);
        o.y = pk4_fp8(s[(16 * j + 4) * 33] * scale, s[(16 * j + 5) * 33] * scale, s[(16 * j + 6) * 33] * scale, s[(16 * j + 7) * 33] * scale);
        o.z = pk4_fp8(s[(16 * j + 8) * 33] * scale, s[(16 * j + 9) * 33] * scale, s[(16 * j + 10) * 33] * scale, s[(16 * j + 11) * 33] * scale);
        o.w = pk4_fp8(s[(16 * j + 12) * 33] * scale, s[(16 * j + 13) * 33] * scale, s[(16 * j + 14) * 33] * scale, s[(16 * j + 15) * 33] * scale);
        *(GAS u32x4*)(dst + (size_t)n * dld + kh + 16 * j) = o; }
    LDS_WAIT(); asm volatile("" ::: "memory");
}
__device__ __forceinline__ void pro_phase(Frame& F, ArgsP a) {
    PHASE_PROLOG();
    const int ftid = fresh_tid(), flane = ftid & 63;
    LAS float* scr = (LAS float*)(F.lds + F.wave * 16384);
    const int gw = vcu_ * 8 + F.wave, NGW = G_ * 8;
    constexpr int IA = DEPTH * NEXP * 16 * 64, IB = DEPTH * NEXP * 16 * 32, IC = 2 * 16 * 46, ID = 2 * 16 * 96, IE = 2 * 16 * 32;
    for (int it = gw; it < IA + IB + IC + ID + IE; it += NGW) {
        int r = it;
        if (r < IA) { const int m = r >> 10, rem = r & 1023, kb = rem >> 6, nb = rem & 63, n0 = nb * 32;
            const int drow = 256 * ((n0 & 1023) >> 7) + 128 * (n0 >> 10) + (n0 & 127);
#if MOE_FP8
            tr_block8(a->in[I_EXP_W_GU] + (size_t)m * 1024 * 2048 + (size_t)(kb * 64) * 2048 + n0, 2048, WSP(unsigned char, WS_WGU) + ((size_t)m * 2048 + drow) * 1024 + kb * 64, 1024, 64.f, scr, flane); continue; }
#else
            tr_block(a->in[I_EXP_W_GU] + (size_t)m * 1024 * 2048 + (size_t)(kb * 64) * 2048 + n0, 2048, WSP(bf16_t, WS_WGU) + ((size_t)m * 2048 + drow) * 1024 + kb * 64, 1024, 1.f, scr, flane); continue; }
#endif
        r -= IA;
        if (r < IB) { const int m = r >> 9, rem = r & 511, kb = rem >> 5, nb = rem & 31;
#if MOE_FP8
            tr_block8(a->in[I_EXP_W_DN] + (size_t)m * 1024 * 1024 + (size_t)(kb * 64) * 1024 + nb * 32, 1024, WSP(unsigned char, WS_WDN) + ((size_t)m * 1024 + nb * 32) * 1024 + kb * 64, 1024, 64.f, scr, flane); continue; }
#else
            tr_block(a->in[I_EXP_W_DN] + (size_t)m * 1024 * 1024 + (size_t)(kb * 64) * 1024 + nb * 32, 1024, WSP(bf16_t, WS_WDN) + ((size_t)m * 1024 + nb * 32) * 1024 + kb * 64, 1024, 1.f, scr, flane); continue; }
#endif
        r -= IB;
        if (r < IC) { const int jj = r / 736, rem = r % 736, kb = rem / 46, nb = rem % 46;
            const int scol = nb < 14 ? nb * 32 : 452 + (nb - 14) * 32, drow = nb < 14 ? nb * 32 : 512 + (nb - 14) * 32;
            tr_block(a->in[I_EV_W_IN] + (size_t)jj * 1024 * E_IN_EVEN + (size_t)(kb * 64) * E_IN_EVEN + scol, E_IN_EVEN, WSP(bf16_t, WS_WINE) + ((size_t)jj * NE_PR + drow) * 1024 + kb * 64, 1024, 1.f, scr, flane); continue; }
        r -= IC;
        if (r < ID) { const int jj = r / 1536, rem = r % 1536, kb = rem / 96, nb = rem % 96;
            tr_block(a->in[I_OD_W_IN] + (size_t)jj * 1024 * NO_PR + (size_t)(kb * 64) * NO_PR + nb * 32, NO_PR, WSP(bf16_t, WS_WINO) + ((size_t)jj * NO_PR + nb * 32) * 1024 + kb * 64, 1024, nb < 32 ? 0.125f * LOG2E : 1.f, scr, flane); continue; }
        r -= ID;
        { const int jj = r / 512, rem = r % 512, kb = rem / 32, nb = rem % 32;
            tr_block(a->in[I_OD_W_OUT] + (size_t)jj * 1024 * 1024 + (size_t)(kb * 64) * 1024 + nb * 32, 1024, WSP(bf16_t, WS_WOUTO) + ((size_t)jj * 1024 + nb * 32) * 1024 + kb * 64, 1024, 1.f, scr, flane); }
    }
    const int gt = vcu_ * 512 + ftid, NGT = G_ * 512;
    for (int i = gt; i < 2 * 64 * 1024; i += NGT) { const int jj = i >> 16, rr = 448 + ((i >> 10) & 63), k = i & 1023;
        const float v = rr < 452 ? a->in[I_EV_W_IN][(size_t)jj * 1024 * E_IN_EVEN + (size_t)k * E_IN_EVEN + rr] : 0.f;
        WSP(bf16_t, WS_WINE)[((size_t)jj * NE_PR + rr) * 1024 + k] = (bf16_t)f2bf(v); }
    for (int i = gt; i < 2 * NQQ * 256; i += NGT) { const int jj = i / (NQQ * 256), rem = i % (NQQ * 256), n = rem >> 8, c = rem & 255; float v;
        if (n < 1024) { const int h = n >> 7, lat = n & 127; const float* uq = a->in[I_EV_W_UQ] + ((size_t)(jj * 256 + c) * 8 + h) * 64; const float* uk = a->in[I_EV_W_UK] + ((size_t)(jj * 8 + h) * 64) * 128 + lat;
            float s = 0.f;
            for (int d = 0; d < 64; ++d) s += uq[d] * uk[(size_t)d * 128];
            v = s * (0.125f * LOG2E); }
        else { const int hd = n - 1024; v = 0.125f * a->in[I_EV_W_IQ][(size_t)(jj * 256 + c) * 256 + hd]; }
        WSP(bf16_t, WS_WQE)[i] = (bf16_t)f2bf(v); }
    for (int i = gt; i < 2 * 1024 * NMX; i += NGT) { const int jj = i / (1024 * NMX), rem = i % (1024 * NMX), n = rem / NMX, k = rem % NMX; float v;
        const float* wo = a->in[I_EV_W_OUT] + (size_t)jj * 1024 * 1024 + n;
        if (k < 1024) { const int h = k >> 7, c = k & 127; const float* uv = a->in[I_EV_W_UV] + ((size_t)(jj * 8 + h) * 128 + c) * 64; float s = 0.f;
            for (int d = 0; d < 64; ++d) s += uv[d] * wo[(size_t)(h * 64 + d) * 1024];
            v = s; }
        else v = wo[(size_t)(512 + k - 1024) * 1024];
        WSP(bf16_t, WS_WOUTE)[i] = (bf16_t)f2bf(v); }
    for (int i = gt; i < DEPTH * 32768; i += NGT) { const int l = i >> 15, rem = i & 32767, k = rem >> 5, e = rem & 31; const float w = a->in[I_LN1_G][l * 1024 + k] * a->in[I_ROUTER_W][i];
        const unsigned h16 = f2bf(w), l16 = f2bf(w - bf2f((unsigned short)h16)); const int off = e * 2048 + (((k >> 3) ^ (e & 15)) << 4) + (k & 7) * 2;
        unsigned char* img = WSP(unsigned char, WS_WRT) + (size_t)l * 131072; *(bf16_t*)(img + off) = (bf16_t)h16; *(bf16_t*)(img + 65536 + off) = (bf16_t)l16; }
    for (int i = gw; i < DEPTH * 32; i += NGW) { const int l = i >> 5, e = i & 31; float s1 = 0.f, s2 = 0.f;
        for (int k = flane; k < 1024; k += 64) { const float wv = a->in[I_ROUTER_W][((size_t)l * 1024 + k) * 32 + e]; s1 += a->in[I_LN1_G][l * 1024 + k] * wv; s2 += a->in[I_LN1_B][l * 1024 + k] * wv; }
        s1 = wave_sum(s1); s2 = wave_sum(s2);
        if (flane == 0) { float* cc = WSP(float, WS_WRT + 512 * 1024) + l * 64; cc[e] = s1; cc[32 + e] = s2 + a->in[I_ROUTER_B][l * 32 + e]; } }
    for (int i = gt; i < 2 * 8 * 128 * 128; i += NGT) { const int ii = (i >> 7) & 127, jx = i & 127; WSP(bf16_t, WS_WS)[i] = (bf16_t)f2bf(jx <= ii ? a->in[I_EV_W_S][i] : 0.f); }
    for (int m = gw; m < T_TOK; m += NGW) { const GAS f32x4* xr = (const GAS f32x4*)(a->in[I_X] + (size_t)m * D_MODEL) + flane; GAS u32x2* o8 = (GAS u32x2*)(WSP(bf16_t, WS_HB) + (size_t)m * D_MODEL) + flane;
#pragma unroll
        for (int jx = 0; jx < 4; ++jx) { const f32x4 v = xr[64 * jx]; u32x2 w; w.x = pk2(v.x, v.y); w.y = pk2(v.z, v.w); o8[64 * jx] = w; } }
}

__device__ __forceinline__ void e1b_phase(Frame& F, ArgsP a, int l) {
    PHASE_PROLOG();
    const int j = l >> 1, lane = fresh_tid() & 63; const int gw = vcu_ * 8 + F.wave, NGW = G_ * 8;
    const float* qg = a->in[I_EV_Q_NORM] + j * 256; const float* kvg = a->in[I_EV_KV_NORM] + j * 128; const float* ig = a->in[I_EV_IDX_K_G] + j * 64; const float* ib = a->in[I_EV_IDX_K_B] + j * 64;
    const f32x4 g4 = *(const f32x4*)(qg + 4 * lane); const float kg0 = kvg[2 * lane], kg1 = kvg[2 * lane + 1], igl = ig[lane], ibl = ib[lane];
    const bf16_t* PR = WSP(bf16_t, WS_PR);
    for (int tok = gw; tok < T_TOK; tok += NGW) {
        const bf16_t* pr = PR + (size_t)tok * NE_PR;
        { const u32x2 w = *(const u32x2*)(pr + 4 * lane); const float a0 = bflo(w.x), a1 = bfhi(w.x), a2 = bflo(w.y), a3 = bfhi(w.y);
          const float ss = wave_sum(a0 * a0 + a1 * a1 + a2 * a2 + a3 * a3); const float rs = 1.0f / sqrtf(ss * (1.0f / 256.0f) + LN_EPS);
          u32x2 o; o.x = pk2(a0 * rs * g4.x, a1 * rs * g4.y); o.y = pk2(a2 * rs * g4.z, a3 * rs * g4.w); *(u32x2*)(WSP(bf16_t, WS_CQ) + (size_t)tok * 256 + 4 * lane) = o; }
        { const unsigned w = *(const unsigned*)(pr + 256 + 2 * lane); const float a0 = bflo(w), a1 = bfhi(w);
          const float ss = wave_sum(a0 * a0 + a1 * a1); const float rs = 1.0f / sqrtf(ss * (1.0f / 128.0f) + LN_EPS);
          *(unsigned*)(WSP(bf16_t, WS_CKV) + (size_t)tok * 128 + 2 * lane) = pk2(a0 * rs * kg0, a1 * rs * kg1); }
        { const float x = bf2f(pr[384 + lane]); const float mu = wave_sum(x) * (1.0f / 64.0f); const float d = x - mu; const float var = wave_sum(d * d) * (1.0f / 64.0f);
          WSP(bf16_t, WS_KI)[(size_t)tok * 64 + lane] = (bf16_t)f2bf(d * (1.0f / sqrtf(var + LN_EPS)) * igl + ibl); }
        if (lane < 4) WSP(float, WS_WI)[(size_t)tok * 4 + lane] = 0.5f * bf2f(pr[448 + lane]);
    }
}

__device__ __forceinline__ unsigned ord_key(float f) { const unsigned u = __builtin_bit_cast(unsigned, f); return (u & 0x80000000u) ? ~u : (u | 0x80000000u); }
__device__ __forceinline__ void e3a_phase(Frame& F, ArgsP a) {
    PHASE_PROLOG();
    const int tid = fresh_tid(), wid = F.wave, lane = tid & 63, fr = lane & 15, fq = lane >> 4;
    LAS float* sc = (LAS float*)F.lds;
    const bf16_t* QQ = WSP(bf16_t, WS_QQ); const bf16_t* KI = WSP(bf16_t, WS_KI); const float* WI = WSP(float, WS_WI);
    unsigned long long* MASK = WSP(unsigned long long, WS_MASK);
    for (int L = vcu_; L < BATCH * (SEQ / 16); L += G_) {
        const int b = L >> 7, qb = ((L & 127) + 8 * (L >> 8)) & 127, t0 = qb * 16, NT = t0 / 64 + 1;
        const size_t rb0 = (size_t)b * SEQ;
        bf16x8 qf[4][2]; f32x4 wq4;
        { const bf16_t* qp = QQ + (rb0 + t0 + fr) * NQQ + 1024 + fq * 8;
#pragma unroll
          for (int h = 0; h < 4; ++h)
#pragma unroll
              for (int ks = 0; ks < 2; ++ks) qf[h][ks] = *(const bf16x8*)(qp + h * 64 + ks * 32);
          wq4 = *(const f32x4*)(WI + (rb0 + t0 + fr) * 4); }
#ifndef E3A_REP_SC
#define E3A_REP_SC 1
#endif
#ifndef E3A_REP_SEL
#define E3A_REP_SEL 1
#endif
#pragma unroll 1
        for (int rsc = 0; rsc < E3A_REP_SC; ++rsc)
        for (int kt = wid; kt < NT; kt += 8) {
#pragma unroll
            for (int kb = 0; kb < 4; ++kb) { const bf16_t* kp = KI + (rb0 + kt * 64 + kb * 16 + fr) * 64 + fq * 8;
                const bf16x8 k0 = *(const bf16x8*)kp, k1 = *(const bf16x8*)(kp + 32);
                f32x4 s4 = (f32x4){0.f, 0.f, 0.f, 0.f};
#pragma unroll
                for (int h = 0; h < 4; ++h) { f32x4 acc = (f32x4){0.f, 0.f, 0.f, 0.f};
                    acc = __builtin_amdgcn_mfma_f32_16x16x32_bf16(k0, qf[h][0], acc, 0, 0, 0); acc = __builtin_amdgcn_mfma_f32_16x16x32_bf16(k1, qf[h][1], acc, 0, 0, 0);
#pragma unroll
                    for (int q = 0; q < 4; ++q) s4[q] += fmaxf(acc[q], 0.f) * wq4[h]; }
                s4 += 0.0f;
                *(LAS f32x4*)(sc + fr * 2048 + kt * 64 + kb * 16 + fq * 4) = s4; }
        }
        __syncthreads();
#pragma unroll 1
        for (int qq2 = 0; qq2 < 2 * E3A_REP_SEL; ++qq2) { const int qq = qq2 & 1; const int q = 2 * wid + qq; const int tq = t0 + q;
            unsigned long long myword = 0ull; int lane_q = lane; asm volatile("" : "+v"(lane_q));
            if (NT <= 4) { myword = (lane < NT) ? ~0ull : 0ull; }
            else {
                unsigned x[32];
                { float f[32];
#pragma unroll
                  for (int i = 0; i < 32; ++i) f[i] = sc[q * 2048 + i * 64 + lane_q];
#pragma unroll
                  for (int i = 0; i < 32; ++i) x[i] = (i * 64 + lane_q < NT * 64) ? ord_key(f[i]) : 0u; }
                unsigned prefix = 0u;
                bool exact = false;
                for (int bit = 31; bit >= 0; --bit) { const unsigned cand = prefix | (1u << bit); int cnt = 0;
#pragma unroll
                    for (int g = 0; g < 2; ++g) { if (16 * g < NT) { unsigned long long m[16];
#pragma unroll
                            for (int i = 0; i < 16; ++i) asm volatile("v_cmp_ge_u32_e64 %0, %1, %2" : "=s"(m[i]) : "v"(x[16 * g + i]), "s"(cand));
                            __builtin_amdgcn_sched_barrier(0);
#pragma unroll
                            for (int i = 0; i < 16; ++i) cnt += __builtin_popcountll(m[i]);
                            __builtin_amdgcn_sched_barrier(0); } }
                    if (cnt >= N_SEL) { prefix = cand; if (cnt == N_SEL) { exact = true; break; } } }
                int wlo = 0, whi = 0;
                if (exact) {
#pragma unroll
                    for (int i = 0; i < 32; ++i)
                        asm volatile("v_cmp_ge_u32_e64 vcc, %2, %3\n\ts_nop 4\n\tv_writelane_b32 %0, vcc_lo, %4\n\tv_writelane_b32 %1, vcc_hi, %4" : "+v"(wlo), "+v"(whi) : "v"(x[i]), "s"(prefix), "n"(i) : "vcc");
                } else {
                    const unsigned Tk = prefix; int cgt = 0;
#pragma unroll
                    for (int i = 0; i < 32; ++i) { cgt += __builtin_popcountll(__builtin_amdgcn_ballot_w64(x[i] > Tk)); if ((i & 7) == 7) __builtin_amdgcn_sched_barrier(0); }
                    int need = N_SEL - cgt;
#pragma unroll
                    for (int i = 0; i < 32; ++i) { const bool eq = x[i] == Tk; const unsigned long long meq = __builtin_amdgcn_ballot_w64(eq);
                        const int rank = (int)__builtin_amdgcn_mbcnt_hi((unsigned)(meq >> 32), __builtin_amdgcn_mbcnt_lo((unsigned)meq, 0u));
                        const unsigned long long sel = __builtin_amdgcn_ballot_w64((x[i] > Tk) || (eq && rank < need));
                        need = max(need - (int)__builtin_popcountll(meq), 0);
                        asm volatile("s_nop 4\n\tv_writelane_b32 %0, %2, %4\n\tv_writelane_b32 %1, %3, %4" : "+v"(wlo), "+v"(whi) : "s"((unsigned)sel), "s"((unsigned)(sel >> 32)), "n"(i));
                        __builtin_amdgcn_sched_barrier(0); }
                }
                myword = ((unsigned long long)(unsigned)whi << 32) | (unsigned long long)(unsigned)wlo;
            }
            if (lane < 32) MASK[(rb0 + tq) * 32 + lane] = myword;
        }
        __syncthreads();
    }
}

__device__ __forceinline__ void dsa_phase(Frame& F, ArgsP a) {
    PHASE_PROLOG();
    const int tid = fresh_tid(), wid = __builtin_amdgcn_readfirstlane(tid >> 6), lane = tid & 63, r32 = lane & 31, hi = lane >> 5;
    LAS char* lds = (LAS char*)F.lds; LAS unsigned long long* msk = (LAS unsigned long long*)(lds + att::ATT_LDS_CORE);
    const GAS bf16_t* QQ = (const GAS bf16_t*)WSP(bf16_t, WS_QQ); const GAS bf16_t* CKV = (const GAS bf16_t*)WSP(bf16_t, WS_CKV); const GAS unsigned long long* MASK = (const GAS unsigned long long*)WSP(unsigned long long, WS_MASK); GAS bf16_t* MX = (GAS bf16_t*)WSP(bf16_t, WS_MX);
    const float slope2 = exp2f(-(float)(wid + 1)) * LOG2E;
    for (int L = vcu_; L < BATCH * (SEQ / 32); L += G_) {
        const int i = L >> 8, v = L & 255, b = v >> 3, c8 = v & 7, jx = (i & 1) ? 7 - c8 : c8, qb = 63 - (8 * i + jx), t0 = qb * 32, NT = t0 / 64 + 1;
        const size_t rb0 = (size_t)b * SEQ;
        for (int k = tid; k < 1024; k += 512) { const int q = k >> 5, jj = k & 31; msk[jj * 32 + q] = MASK[(rb0 + t0 + q) * 32 + jj]; }
        f32x16 o[4]; float l_reg;
        att::attn_core<128, true, true>(QQ + (rb0 + t0) * NQQ + wid * 128, NQQ, CKV + rb0 * 128, 128, CKV + rb0 * 128, 128, NT, NT, slope2, t0, msk, lds, o, l_reg, wid);
        float rli[16]; att::row_rcp(l_reg, lds, rli, wid);
        GAS bf16_t* Ow = MX + (rb0 + t0) * NMX + wid * 128;
#pragma unroll
        for (int r = 0; r < 16; ++r) { int orow = att::crow(r, hi); asm volatile("" : "+v"(orow));
#pragma unroll
            for (int d0 = 0; d0 < 4; ++d0) Ow[(size_t)orow * NMX + d0 * 32 + r32] = (bf16_t)f2bf(o[d0][r] * rli[r]); }
    }
}

__device__ __forceinline__ void gml_phase(Frame& F, ArgsP a, int l) {
    PHASE_PROLOG();
    const int j = l >> 1, tid = fresh_tid(), g = F.wave, lane = tid & 63;
    LAS float* stat = (LAS float*)(F.lds + 131072 - 1024);
    stat = (LAS float*)(F.MISC + MI_REC);
    LAS unsigned char* vT = F.lds + g * 16384;
    const GAS bf16_t* PR = (const GAS bf16_t*)WSP(bf16_t, WS_PR); GAS bf16_t* MX = (GAS bf16_t*)WSP(bf16_t, WS_MX); const GAS bf16_t* Wt = (const GAS bf16_t*)WSP(bf16_t, WS_WS) + (size_t)(j * 8 + g) * 128 * 128;
    const float* vg = a->in[I_EV_V_NORM_G] + j * GW; const float* vb = a->in[I_EV_V_NORM_B] + j * GW; const float* bs = a->in[I_EV_B_S] + (size_t)(j * 8 + g) * 128;
    for (int L = vcu_; L < BATCH * (SEQ / GCH); L += G_) {
        const size_t tok0 = (size_t)(L >> 4) * SEQ + (size_t)(L & 15) * GCH;
        for (int tt = 0; tt < 16; ++tt) { const int tl = g * 16 + tt; const u32x4 w = *(const GAS u32x4*)(PR + (tok0 + tl) * NE_PR + 1024 + 8 * lane);
            const float x0 = bflo(w.x), x1 = bfhi(w.x), x2 = bflo(w.y), x3 = bfhi(w.y), x4 = bflo(w.z), x5 = bfhi(w.z), x6 = bflo(w.w), x7 = bfhi(w.w);
            const float mu = wave_sum(((x0 + x1) + (x2 + x3)) + ((x4 + x5) + (x6 + x7))) * (1.0f / 512.0f);
            const float d0 = x0 - mu, d1 = x1 - mu, d2 = x2 - mu, d3 = x3 - mu, d4 = x4 - mu, d5 = x5 - mu, d6 = x6 - mu, d7 = x7 - mu;
            const float var = wave_sum(((d0 * d0 + d1 * d1) + (d2 * d2 + d3 * d3)) + ((d4 * d4 + d5 * d5) + (d6 * d6 + d7 * d7))) * (1.0f / 512.0f);
            if (lane == 0) { stat[2 * tl] = mu; stat[2 * tl + 1] = 1.0f / sqrtf(var + LN_EPS); } }
        __syncthreads();
        for (int it = 0; it < 16; ++it) { const int idx = it * 64 + lane, tl = idx >> 3, ch8 = idx & 7;
            const u32x4 w = *(const GAS u32x4*)(PR + (tok0 + tl) * NE_PR + 1024 + g * 64 + ch8 * 8);
            const float mu = stat[2 * tl], rs = stat[2 * tl + 1];
            float xv[8] = {bflo(w.x), bfhi(w.x), bflo(w.y), bfhi(w.y), bflo(w.z), bfhi(w.z), bflo(w.w), bfhi(w.w)};
#pragma unroll
            for (int q = 0; q < 8; ++q) { const int c = ch8 * 8 + q; const float y = (xv[q] - mu) * rs * vg[g * 64 + c] + vb[g * 64 + c];
                *(LAS bf16_t*)(vT + c * 256 + ((((tl >> 3) ^ (c & 15)) << 4) | ((tl & 7) * 2))) = (bf16_t)f2bf(y); } }
        LDS_WAIT(); asm volatile("" ::: "memory");
#pragma unroll 1
        for (int mh = 0; mh < 2; ++mh) {
            f32x4 acc[4][4];
#pragma unroll
            for (int mi = 0; mi < 4; ++mi)
#pragma unroll
                for (int ni = 0; ni < 4; ++ni) acc[mi][ni] = (f32x4){0.f, 0.f, 0.f, 0.f};
#pragma unroll
            for (int ks = 0; ks < 4; ++ks) { bf16x8 bfr[4];
#pragma unroll
                for (int ni = 0; ni < 4; ++ni) { const int c = 16 * ni + (lane & 15), ch = (ks * 4 + (lane >> 4)) ^ (c & 15); bfr[ni] = *(const LAS bf16x8*)(vT + c * 256 + (ch << 4)); }
#pragma unroll
                for (int mi = 0; mi < 4; ++mi) { if (32 * ks <= 16 * (4 * mh + mi) + 15) { int wrow = 16 * (4 * mh + mi) + (lane & 15); asm volatile("" : "+v"(wrow)); const bf16x8 af = *(const GAS bf16x8*)(Wt + (size_t)wrow * 128 + 32 * ks + 8 * (lane >> 4));
#pragma unroll
                        for (int ni = 0; ni < 4; ++ni) acc[mi][ni] = __builtin_amdgcn_mfma_f32_16x16x32_bf16(af, bfr[ni], acc[mi][ni], 0, 0, 0); } } }
#pragma unroll
            for (int mi = 0; mi < 4; ++mi)
#pragma unroll
                for (int q = 0; q < 4; ++q) { int ii = 16 * (4 * mh + mi) + 4 * (lane >> 4) + q; asm volatile("" : "+v"(ii)); const float bsv = bs[ii];
#pragma unroll
                    for (int ni = 0; ni < 4; ++ni) { const int col = g * 64 + 16 * ni + (lane & 15); const float uv = bf2f(PR[(tok0 + ii) * NE_PR + 512 + col]);
                        MX[(tok0 + ii) * NMX + 1024 + col] = (bf16_t)f2bf(uv * (acc[mi][ni][q] + bsv)); }
                    __builtin_amdgcn_sched_barrier(0); }
        }
        __syncthreads();
    }
}

__device__ __forceinline__ void datt_phase(Frame& F, ArgsP a, int l) {
    PHASE_PROLOG();
    const int j = l >> 1, tid = fresh_tid(), wid = __builtin_amdgcn_readfirstlane(tid >> 6), lane = tid & 63, r32 = lane & 31, hi = lane >> 5;
    LAS char* lds = (LAS char*)F.lds; LAS unsigned* stash = (LAS unsigned*)(lds + att::ATT_LDS_CORE);
    const GAS bf16_t* PR = (const GAS bf16_t*)WSP(bf16_t, WS_PR); GAS bf16_t* OA = (GAS bf16_t*)WSP(bf16_t, WS_MX);
    const float lam_init = 0.8f - 0.6f * expf(-0.3f * (float)l);
    float lam;
    { const float s1 = wave_sum(a->in[I_OD_LQ1][j * 64 + lane] * a->in[I_OD_LK1][j * 64 + lane]), s2 = wave_sum(a->in[I_OD_LQ2][j * 64 + lane] * a->in[I_OD_LK2][j * 64 + lane]);
      lam = expf(s1) - expf(s2) + lam_init; }
    const float* sg = a->in[I_OD_SUBLN_G] + j * 128;
    for (int L = vcu_; L < BATCH * H_C * (SEQ / 256); L += G_) {
        const int qb = 7 - (L >> 8), v = L & 255, b = v >> 3, h = v & 7;
        const size_t rb0 = (size_t)b * SEQ; const int t0w = qb * 256 + 32 * wid, NTB = 4 * qb + 4, NTW = t0w / 64 + 1;
        const float slope2 = exp2f(-(float)(h + 1)) * LOG2E;
#pragma unroll 1
        for (int m = 0; m < 2; ++m) {
            f32x16 o[4]; float l_reg;
            att::attn_core<64, false, false>(PR + (rb0 + t0w) * NO_PR + h * 128 + m * 64, NO_PR, PR + rb0 * NO_PR + 1024 + h * 128 + m * 64, NO_PR, PR + rb0 * NO_PR + 2048 + h * 128, NO_PR,
                                             NTB, NTW, slope2, t0w, nullptr, lds, o, l_reg, wid);
            float rli[16]; att::row_rcp(l_reg, lds, rli, wid);
            if (m == 0) {
#pragma unroll
                for (int d0 = 0; d0 < 4; ++d0)
#pragma unroll
                    for (int r = 0; r < 16; r += 2) stash[(d0 * 8 + (r >> 1)) * 512 + tid] = att::cvtpk(o[d0][r] * rli[r], o[d0][r + 1] * rli[r + 1]);
            } else {
                float ssq[16];
#pragma unroll
                for (int r = 0; r < 16; ++r) ssq[r] = 0.f;
#pragma unroll
                for (int d0 = 0; d0 < 4; ++d0)
#pragma unroll
                    for (int r = 0; r < 16; r += 2) { const unsigned w = stash[(d0 * 8 + (r >> 1)) * 512 + tid];
                        const float y0 = bflo(w) - lam * (o[d0][r] * rli[r]), y1 = bfhi(w) - lam * (o[d0][r + 1] * rli[r + 1]);
                        o[d0][r] = y0; o[d0][r + 1] = y1; ssq[r] += y0 * y0; ssq[r + 1] += y1 * y1; if ((r & 6) == 6) __builtin_amdgcn_sched_barrier(0); }
#pragma unroll
                for (int r = 0; r < 16; ++r) { float s = ssq[r]; s += xshfl<1>(s, 0); s += xshfl<2>(s, 0); s += xshfl<4>(s, 0); s += xshfl<8>(s, 0); s += xshfl<16>(s, 0);
                    ssq[r] = (1.0f - lam_init) / sqrtf(s * (1.0f / 128.0f) + LN_EPS); }
                GAS bf16_t* Ow = OA + (rb0 + t0w) * D_MODEL + h * 128;
#pragma unroll
                for (int d0 = 0; d0 < 4; ++d0) { const float gv = sg[d0 * 32 + r32];
#pragma unroll
                    for (int r = 0; r < 16; ++r) { int orow = att::crow(r, hi); asm volatile("" : "+v"(orow)); Ow[(size_t)orow * D_MODEL + d0 * 32 + r32] = (bf16_t)f2bf(o[d0][r] * ssq[r] * gv); }
                    __builtin_amdgcn_sched_barrier(0); }
            }
        }
    }
}

template <int H, int BIT> __device__ __forceinline__ void rs_step(float (&p)[32], int lane) {
    if constexpr (BIT == 32) {
#pragma unroll
        for (int i = 0; i < H; ++i) { unsigned u0, u1; plswap(__builtin_bit_cast(unsigned, p[i]), __builtin_bit_cast(unsigned, p[H + i]), u0, u1);
            p[i] = __builtin_bit_cast(float, u0) + __builtin_bit_cast(float, u1); }
    } else {
        const bool up = (lane & BIT) != 0;
#pragma unroll
        for (int i = 0; i < H; ++i) { const float keep = up ? p[H + i] : p[i], send = up ? p[i] : p[H + i]; p[i] = keep + xshfl<BIT>(send, lane); }
    }
}
template <int N> __device__ __forceinline__ void ln16(float (&v)[16], const float (&gg)[16], const float (&bb)[16]) {
    float s = 0.f;
#pragma unroll
    for (int i = 0; i < 16; ++i) s += v[i];
    const float mean = wave_sum(s) * (1.0f / 1024.0f); float s2 = 0.f;
#pragma unroll
    for (int i = 0; i < 16; ++i) { v[i] -= mean; s2 += v[i] * v[i]; }
    const float rstd = 1.0f / sqrtf(wave_sum(s2) * (1.0f / 1024.0f) + LN_EPS);
#pragma unroll
    for (int i = 0; i < 16; ++i) v[i] = v[i] * rstd * gg[i] + bb[i];
}
__device__ __forceinline__ void lnr_load_ln(const bf16_t* zrow, float* hrow, bf16_t* hbrow, unsigned char* hb8row, const float* g1, const float* b1, int lane, float (&hv)[16]) {
    float gg[16], bb[16];
#pragma unroll
    for (int jj = 0; jj < 4; ++jj) { const u32x2 zw = *(const u32x2*)(zrow + 256 * jj + 4 * lane); const f32x4 z4 = (f32x4){bflo(zw.x), bfhi(zw.x), bflo(zw.y), bfhi(zw.y)}; const f32x4 g4 = *(const f32x4*)(g1 + 256 * jj + 4 * lane), b4 = *(const f32x4*)(b1 + 256 * jj + 4 * lane);
#pragma unroll
        for (int i = 0; i < 4; ++i) { hv[jj * 4 + i] = z4[i]; gg[jj * 4 + i] = g4[i]; bb[jj * 4 + i] = b4[i]; } }
    ln16<0>(hv, gg, bb);
#pragma unroll
    for (int jj = 0; jj < 4; ++jj) {
        u32x2 w; w.x = pk2(hv[jj * 4], hv[jj * 4 + 1]); w.y = pk2(hv[jj * 4 + 2], hv[jj * 4 + 3]); *(u32x2*)(hbrow + 256 * jj + 4 * lane) = w;
#if MOE_FP8
        *(unsigned*)(hb8row + 256 * jj + 4 * lane) = pk4_fp8(hv[jj * 4], hv[jj * 4 + 1], hv[jj * 4 + 2], hv[jj * 4 + 3]);
#endif
    }
}
__device__ __forceinline__ void lnr_tail(Frame& F, unsigned char* ws_, float* gate_out, float (&part)[32], float rbias, int tl, size_t tok, int lane) {
    rs_step<4, 8>(part, lane); rs_step<2, 4>(part, lane); rs_step<1, 2>(part, lane);
    float v = part[0] + xshfl<1>(part[0], lane) + rbias;
    float t0, t1, t2, t3; int e0, e1, e2, e3;
#define LNR_PICK(tk, ek) do { const float m_ = wave_max(v); const unsigned long long bm_ = __builtin_amdgcn_ballot_w64(v == m_); ek = __builtin_ctzll(bm_) >> 1; tk = m_; if ((lane >> 1) == ek) v = -INFINITY; } while (0)
    LNR_PICK(t0, e0); LNR_PICK(t1, e1); LNR_PICK(t2, e2); LNR_PICK(t3, e3);
#undef LNR_PICK
    const float x1 = fast_exp2((t1 - t0) * LOG2E), x2 = fast_exp2((t2 - t0) * LOG2E), x3 = fast_exp2((t3 - t0) * LOG2E);
    const float inv = 1.0f / (1.0f + x1 + x2 + x3);
    if (lane < 4) { const int ek = lane == 0 ? e0 : lane == 1 ? e1 : lane == 2 ? e2 : e3; const float gk = (lane == 0 ? 1.0f : lane == 1 ? x1 : lane == 2 ? x2 : x3) * inv;
        const int lr = __hip_atomic_fetch_add((LAS int*)&F.MISC[MI_LCNT + ek], 1, __ATOMIC_RELAXED, __HIP_MEMORY_SCOPE_WORKGROUP);
        F.MISC[MI_REC + tl * 4 + lane] = (ek << 16) | lr;
        gate_out[tok * 4 + lane] = gk; }
}
__device__ __forceinline__ void lnr_phase(Frame& F, ArgsP a, int l, bool dry = false) {
    PHASE_PROLOG();
    const int tid = fresh_tid(), wid = F.wave, lane = tid & 63;
    LAS float* rws = (LAS float*)F.lds;
    { const float* rw = a->in[I_ROUTER_W] + (size_t)l * 1024 * 32;
      for (int idx = tid; idx < 32768; idx += 512) { const int d = idx >> 5, e = idx & 31, jj = d >> 8, ln = (d & 255) >> 2, i = d & 3; rws[((jj * 4 + i) * 8 + (e >> 2)) * 256 + ln * 4 + (e & 3)] = rw[idx]; } }
    const float* g1 = a->in[I_LN1_G] + l * 1024; const float* b1 = a->in[I_LN1_B] + l * 1024;
    const float rbias = a->in[I_ROUTER_B][l * 32 + ((lane >> 1) & 31)];
    const bf16_t* Z = WSP(bf16_t, WS_Z); float* H32 = a->out; bf16_t* HB = dry ? WSP(bf16_t, WS_PR) : WSP(bf16_t, WS_HB); unsigned char* HB8 = dry ? WSP(unsigned char, WS_QQ) : WSP(unsigned char, WS_HB8);
    float* gate_out = dry ? WSP(float, WS_WI) : WSP(float, WS_GATE); int* rowtok = dry ? WSP(int, WS_MASK) : WSP(int, WS_ROWTOK); unsigned* slot_out = dry ? WSP(unsigned, WS_CKV) : WSP(unsigned, WS_SLOT);
    gu32* cur = F.ctl + CW_CUR + (size_t)(dry ? l + 4 : l) * 32 * 64;
    __syncthreads();
    for (int u = vcu_; u < T_TOK / 256; u += G_) {
        if (tid < 32) F.MISC[MI_LCNT + tid] = 0;
        __syncthreads();
#pragma unroll 1
        for (int tp = 0; tp < 16; ++tp) {
            const int tl0 = wid * 32 + 2 * tp; const size_t tok0 = (size_t)u * 256 + tl0;
            float hv0[16], hv1[16];
            lnr_load_ln(Z + tok0 * D_MODEL, H32 + tok0 * D_MODEL, HB + tok0 * D_MODEL, HB8 + tok0 * D_MODEL, g1, b1, lane, hv0);
            lnr_load_ln(Z + (tok0 + 1) * D_MODEL, H32 + (tok0 + 1) * D_MODEL, HB + (tok0 + 1) * D_MODEL, HB8 + (tok0 + 1) * D_MODEL, g1, b1, lane, hv1);
            __builtin_amdgcn_sched_barrier(0);
            f32x4 pv0[8], pv1[8]; LAS float* rw_ = rws + lane * 4; asm volatile("" : "+v"(rw_));
#pragma unroll
            for (int e = 0; e < 8; ++e) { pv0[e] = (f32x4){0.f, 0.f, 0.f, 0.f}; pv1[e] = (f32x4){0.f, 0.f, 0.f, 0.f}; }
#pragma unroll
            for (int ji = 0; ji < 16; ++ji) {
#pragma unroll
                for (int e4 = 0; e4 < 8; ++e4) { const f32x4 w4 = *(const LAS f32x4*)(rw_ + (ji * 8 + e4) * 256); pv0[e4] += w4 * hv0[ji]; pv1[e4] += w4 * hv1[ji]; }
                __builtin_amdgcn_sched_barrier(0); }
            float part0[32], part1[32];
#pragma unroll
            for (int e = 0; e < 32; ++e) part0[e] = pv0[e >> 2][e & 3];
            rs_step<16, 32>(part0, lane); rs_step<8, 16>(part0, lane);
            __builtin_amdgcn_sched_barrier(0);
#pragma unroll
            for (int e = 0; e < 32; ++e) part1[e] = pv1[e >> 2][e & 3];
            rs_step<16, 32>(part1, lane); rs_step<8, 16>(part1, lane);
            __builtin_amdgcn_sched_barrier(0);
            lnr_tail(F, ws_, gate_out, part0, rbias, tl0, tok0, lane);
            __builtin_amdgcn_sched_barrier(0);
            lnr_tail(F, ws_, gate_out, part1, rbias, tl0 + 1, tok0 + 1, lane);
            __builtin_amdgcn_sched_barrier(0);
        }
        __syncthreads();
        if (tid < 32) { const int c = F.MISC[MI_LCNT + tid]; F.MISC[MI_LBASE + tid] = c ? (int)__hip_atomic_fetch_add(cur + tid * 64, (unsigned)c, RLX_AGENT) : 0; }
        __syncthreads();
        for (int i = tid; i < 1024; i += 512) { const int rec = F.MISC[MI_REC + i], e = rec >> 16, rank = F.MISC[MI_LBASE + e] + (rec & 0xffff); const int tok = u * 256 + (i >> 2);
            rowtok[(size_t)(dry ? (e & 31) : e) * 65536 + (dry ? (rank & 32767) : rank)] = tok; slot_out[(size_t)tok * 4 + (i & 3)] = ((unsigned)e << 20) | (unsigned)rank; }
        __syncthreads();
    }
}

__device__ __forceinline__ void lnr2_phase(Frame& F, ArgsP a, int l, bool dry = false) {
    PHASE_PROLOG();
    const int tid = fresh_tid(), wid = __builtin_amdgcn_readfirstlane(tid >> 6), lane = tid & 63, r32 = lane & 31, hi = lane >> 5;
    LAS unsigned char* Wh = F.lds; LAS unsigned char* Wl = F.lds + 65536;
    LAS float* stats = (LAS float*)(F.lds + RING_BYTES);
    LAS float* cc = (LAS float*)(F.MISC + MI_RBE);
    const float* g1 = a->in[I_LN1_G] + l * 1024; const float* b1 = a->in[I_LN1_B] + l * 1024;
    { const GAS u32x4* img = (const GAS u32x4*)(WSP(unsigned char, WS_WRT) + (size_t)l * 131072);
      for (int i = tid; i < 8192; i += 512) *(LAS u32x4*)(F.lds + i * 16) = img[i];
      if (tid < 64) cc[tid] = WSP(float, WS_WRT + 512 * 1024)[l * 64 + tid]; }
    const GAS bf16_t* Z = (const GAS bf16_t*)WSP(bf16_t, WS_Z); GAS bf16_t* HB = (GAS bf16_t*)(dry ? WSP(bf16_t, WS_PR) : WSP(bf16_t, WS_HB)); GAS unsigned char* HB8 = (GAS unsigned char*)(dry ? WSP(unsigned char, WS_QQ) : WSP(unsigned char, WS_HB8));
    float* gate_out = dry ? WSP(float, WS_WI) : WSP(float, WS_GATE); int* rowtok = dry ? WSP(int, WS_MASK) : WSP(int, WS_ROWTOK); unsigned* slot_out = dry ? WSP(unsigned, WS_CKV) : WSP(unsigned, WS_SLOT);
    gu32* cur = F.ctl + CW_CUR + (size_t)(dry ? l + 4 : l) * 32 * 64;
    float gg[16], bb[16];
#pragma unroll
    for (int jj = 0; jj < 4; ++jj) { const f32x4 g4 = *(const f32x4*)(g1 + 256 * jj + 4 * lane), b4 = *(const f32x4*)(b1 + 256 * jj + 4 * lane);
#pragma unroll
        for (int i = 0; i < 4; ++i) { gg[jj * 4 + i] = g4[i]; bb[jj * 4 + i] = b4[i]; } }
    __syncthreads();
    for (int u = vcu_; u < T_TOK / 256; u += G_) {
        if (tid < 32) F.MISC[MI_LCNT + tid] = 0;
        __syncthreads();
        {
            const int tl = 32 * wid + r32; const size_t tok = (size_t)u * 256 + tl;
            const GAS bf16_t* zp = Z + tok * D_MODEL + 512 * hi;
            const LAS unsigned char* whp = Wh + r32 * 2048; const LAS unsigned char* wlp = Wl + r32 * 2048; const int sw = r32 & 15;
            f32x16 acc = f32x16{}; float sm = 0.f, sq = 0.f;
#pragma unroll 8
            for (int sx = 0; sx < 64; ++sx) { const u32x4 zw = *(const GAS u32x4*)(zp + 8 * sx); const bf16x8 zf = __builtin_bit_cast(bf16x8, zw);
                const int ch = ((64 * hi + sx) ^ sw) << 4;
                const bf16x8 ah = *(const LAS bf16x8*)(whp + ch), al = *(const LAS bf16x8*)(wlp + ch);
                acc = __builtin_amdgcn_mfma_f32_32x32x16_bf16(ah, zf, acc, 0, 0, 0); acc = __builtin_amdgcn_mfma_f32_32x32x16_bf16(al, zf, acc, 0, 0, 0);
#pragma unroll
                for (int q = 0; q < 4; ++q) { const float x0 = bflo(zw[q]), x1 = bfhi(zw[q]); sm += x0 + x1; sq += x0 * x0 + x1 * x1; } }
            { float r0, r1; half_swap(sm, r0, r1); sm = r0 + r1; half_swap(sq, r0, r1); sq = r0 + r1; }
            const float mu = sm * (1.0f / 1024.0f); const float rstd = 1.0f / sqrtf(fmaxf(sq * (1.0f / 1024.0f) - mu * mu, 0.f) + LN_EPS);
            if (hi == 0) { stats[2 * tl] = mu; stats[2 * tl + 1] = rstd; }
            float lg[16];
#pragma unroll
            for (int r = 0; r < 16; ++r) { const int e = att::crow(r, hi); lg[r] = rstd * (acc[r] - mu * cc[e]) + cc[32 + e]; }
            float cv[8]; int ci[8];
#pragma unroll
            for (int k = 0; k < 4; ++k) { float best = -INFINITY; int bid = 0;
#pragma unroll
                for (int r = 0; r < 16; ++r) { const int e = att::crow(r, hi); if (lg[r] > best) { best = lg[r]; bid = e; } }
                cv[k] = best; ci[k] = bid;
#pragma unroll
                for (int r = 0; r < 16; ++r) if (att::crow(r, hi) == bid) lg[r] = -INFINITY; }
#pragma unroll
            for (int k = 0; k < 4; ++k) { unsigned a0, a1, b0, b1; plswap(__builtin_bit_cast(unsigned, cv[k]), __builtin_bit_cast(unsigned, cv[k]), a0, a1); plswap((unsigned)ci[k], (unsigned)ci[k], b0, b1);
                cv[4 + k] = __builtin_bit_cast(float, hi ? a0 : a1); ci[4 + k] = (int)(hi ? b0 : b1); }
            float tv[4]; int te[4];
#pragma unroll
            for (int k = 0; k < 4; ++k) { float best = -INFINITY; int bid = 1 << 20;
#pragma unroll
                for (int i = 0; i < 8; ++i) if (cv[i] > best || (cv[i] == best && ci[i] < bid)) { best = cv[i]; bid = ci[i]; }
                tv[k] = best; te[k] = bid;
#pragma unroll
                for (int i = 0; i < 8; ++i) if (ci[i] == bid) cv[i] = -INFINITY; }
            const float x1 = fast_exp2((tv[1] - tv[0]) * LOG2E), x2 = fast_exp2((tv[2] - tv[0]) * LOG2E), x3 = fast_exp2((tv[3] - tv[0]) * LOG2E);
            const float inv = 1.0f / (1.0f + x1 + x2 + x3);
            if (hi == 0) {
#pragma unroll
                for (int k = 0; k < 4; ++k) { const int lr = __hip_atomic_fetch_add((LAS int*)&F.MISC[MI_LCNT + te[k]], 1, __ATOMIC_RELAXED, __HIP_MEMORY_SCOPE_WORKGROUP);
                    F.MISC[MI_REC + tl * 4 + k] = (te[k] << 16) | lr; }
                *(f32x4*)(gate_out + tok * 4) = (f32x4){inv, x1 * inv, x2 * inv, x3 * inv}; }
        }
        __syncthreads();
#pragma unroll 1
        for (int tp = 0; tp < 32; ++tp) { const int tl = 32 * wid + tp; const size_t tok = (size_t)u * 256 + tl; const float mu = stats[2 * tl], rstd = stats[2 * tl + 1];
#pragma unroll
            for (int jj = 0; jj < 4; ++jj) { const u32x2 zw = *(const GAS u32x2*)(Z + tok * D_MODEL + 256 * jj + 4 * lane);
                const float h0 = (bflo(zw.x) - mu) * rstd * gg[jj * 4] + bb[jj * 4], h1 = (bfhi(zw.x) - mu) * rstd * gg[jj * 4 + 1] + bb[jj * 4 + 1], h2 = (bflo(zw.y) - mu) * rstd * gg[jj * 4 + 2] + bb[jj * 4 + 2], h3 = (bfhi(zw.y) - mu) * rstd * gg[jj * 4 + 3] + bb[jj * 4 + 3];
                u32x2 w; w.x = pk2(h0, h1); w.y = pk2(h2, h3); *(GAS u32x2*)(HB + tok * D_MODEL + 256 * jj + 4 * lane) = w;
#if MOE_FP8
                *(GAS unsigned*)(HB8 + tok * D_MODEL + 256 * jj + 4 * lane) = pk4_fp8(h0, h1, h2, h3);
#endif
            } }
        if (tid < 32) { const int c = F.MISC[MI_LCNT + tid]; F.MISC[MI_LBASE + tid] = c ? (int)__hip_atomic_fetch_add(cur + tid * 64, (unsigned)c, RLX_AGENT) : 0; }
        __syncthreads();
        for (int i = tid; i < 1024; i += 512) { const int rec = F.MISC[MI_REC + i], e = rec >> 16, rank = F.MISC[MI_LBASE + e] + (rec & 0xffff); const int tok = u * 256 + (i >> 2);
            rowtok[(size_t)(dry ? (e & 31) : e) * 65536 + (dry ? (rank & 32767) : rank)] = tok; slot_out[(size_t)tok * 4 + (i & 3)] = ((unsigned)e << 20) | (unsigned)rank; }
        __syncthreads();
    }
}

__device__ __forceinline__ void moe_tables(Frame& F, int l) {
    const int tid = fresh_tid();
    __syncthreads();
    if (tid < 32) F.MISC[MI_CNT + tid] = (int)__hip_atomic_load(F.ctl + CW_CUR + (size_t)(l * 32 + tid) * 64, RLX_AGENT);
    __syncthreads();
    if (tid == 0) { int acc = 0; for (int e = 0; e < 32; ++e) { F.MISC[MI_RBSTART + e] = acc; acc += (F.MISC[MI_CNT + e] + 255) >> 8; } F.MISC[MI_RBSTART + 32] = acc; }
    __syncthreads();
    const int nrb = F.MISC[MI_RBSTART + 32];
    for (int rb = tid; rb < nrb; rb += 512) { int e = 0; while (e < 31 && F.MISC[MI_RBSTART + e + 1] <= rb) ++e; F.MISC[MI_RBE + rb] = e; }
    __syncthreads();
}

__device__ __forceinline__ void cmb_phase(Frame& F, ArgsP a, int l, bool dry = false) {
    PHASE_PROLOG();
    moe_tables(F, l);
    const int lane = fresh_tid() & 63; const int gw = vcu_ * 8 + F.wave, NGW = G_ * 8;
    float gg[16], bb[16];
#pragma unroll
    for (int jj = 0; jj < 4; ++jj) { const f32x4 g4 = *(const f32x4*)(a->in[I_LN2_G] + l * 1024 + 256 * jj + 4 * lane), b4 = *(const f32x4*)(a->in[I_LN2_B] + l * 1024 + 256 * jj + 4 * lane);
#pragma unroll
        for (int i = 0; i < 4; ++i) { gg[jj * 4 + i] = g4[i]; bb[jj * 4 + i] = b4[i]; } }
    GAS float* H32 = (GAS float*)(dry ? WSP(float, WS_Z) : a->out); const GAS bf16_t* HB = (const GAS bf16_t*)WSP(bf16_t, WS_HB); GAS bf16_t* HBo = (GAS bf16_t*)(dry ? WSP(bf16_t, WS_PR) : WSP(bf16_t, WS_HB)); const GAS bf16_t* Y = (const GAS bf16_t*)WSP(bf16_t, WS_Y);
    for (int tok = gw; tok < T_TOK; tok += NGW) {
        const unsigned sl = ((const GAS unsigned*)WSP(unsigned, WS_SLOT))[(size_t)tok * 4 + (lane & 3)]; const float gt = ((const GAS float*)WSP(float, WS_GATE))[(size_t)tok * 4 + (lane & 3)];
        float z[16];
#pragma unroll
        for (int jj = 0; jj < 4; ++jj) { const u32x2 hw = *(const GAS u32x2*)(HB + (size_t)tok * D_MODEL + 256 * jj + 4 * lane);
            z[jj * 4] = DN_ALPHA * bflo(hw.x); z[jj * 4 + 1] = DN_ALPHA * bfhi(hw.x); z[jj * 4 + 2] = DN_ALPHA * bflo(hw.y); z[jj * 4 + 3] = DN_ALPHA * bfhi(hw.y); }
#pragma unroll
        for (int k = 0; k < 4; ++k) { const unsigned sk = (unsigned)__builtin_amdgcn_readlane((int)sl, k); const float gk = __builtin_bit_cast(float, __builtin_amdgcn_readlane(__builtin_bit_cast(int, gt), k));
            const int e = (int)(sk >> 20), rank = (int)(sk & 0xfffffu); const size_t row = (size_t)F.MISC[MI_RBSTART + e] * 256 + rank;
#if MOE_FP8
            const GAS unsigned char* y = (const GAS unsigned char*)Y + row * D_MODEL + 4 * lane; const float gs = gk * (1.0f / 64.0f);
#pragma unroll
            for (int jj = 0; jj < 4; ++jj) { const int w = *(const GAS int*)(y + 256 * jj);
                z[jj * 4] += gs * __builtin_amdgcn_cvt_f32_fp8(w, 0); z[jj * 4 + 1] += gs * __builtin_amdgcn_cvt_f32_fp8(w, 1); z[jj * 4 + 2] += gs * __builtin_amdgcn_cvt_f32_fp8(w, 2); z[jj * 4 + 3] += gs * __builtin_amdgcn_cvt_f32_fp8(w, 3); } }
#else
            const bf16_t* y = Y + row * D_MODEL + 4 * lane;
#pragma unroll
            for (int jj = 0; jj < 4; ++jj) { const u32x2 w = *(const u32x2*)(y + 256 * jj); z[jj * 4] += gk * bflo(w.x); z[jj * 4 + 1] += gk * bfhi(w.x); z[jj * 4 + 2] += gk * bflo(w.y); z[jj * 4 + 3] += gk * bfhi(w.y); } }
#endif
        ln16<0>(z, gg, bb);
#pragma unroll
        for (int jj = 0; jj < 4; ++jj) { if (l == DEPTH - 1) *(GAS f32x4*)(H32 + (size_t)tok * D_MODEL + 256 * jj + 4 * lane) = (f32x4){z[jj * 4], z[jj * 4 + 1], z[jj * 4 + 2], z[jj * 4 + 3]};
            else { u32x2 w; w.x = pk2(z[jj * 4], z[jj * 4 + 1]); w.y = pk2(z[jj * 4 + 2], z[jj * 4 + 3]); *(GAS u32x2*)(HBo + (size_t)tok * D_MODEL + 256 * jj + 4 * lane) = w; } }
    }
}
#if MK_CHECK
constexpr int CW_CHK = 32768, N_CHK = 16, CHK_NS = 64;
__device__ __forceinline__ int chk_tok(int i) { return (i * 1021 + 77) & 65535; }
__device__ __forceinline__ void chk_put(Frame& F, int k, float err, float ref) {
    if (!(err == err)) err = 1e30f;
    err = wave_max(err); ref = wave_max(ref);
    if ((fresh_tid() & 63) == 0) { __hip_atomic_fetch_max(F.ctl + CW_CHK + 2 * k, __builtin_bit_cast(unsigned, err), RLX_AGENT); __hip_atomic_fetch_max(F.ctl + CW_CHK + 2 * k + 1, __builtin_bit_cast(unsigned, ref), RLX_AGENT); }
}
__device__ __forceinline__ float nanfix(float d) { return (d == d) ? d : 1e30f; }
__device__ __forceinline__ float chk_dot_bf(const bf16_t* x, const bf16_t* y, int n, int lane) { float s = 0.f; for (int k = lane; k < n; k += 64) s += bf2f(x[k]) * bf2f(y[k]); return wave_sum(s); }

__device__ __forceinline__ void chk_gemm(Frame& F, ArgsP a, int l, int which) {
    PHASE_PROLOG(); const int lane = fresh_tid() & 63, gw = vcu_ * 8 + F.wave, NGW = G_ * 8; const bool odd = l & 1; const int j = l >> 1;
    float err = 0.f, ref = 0.f, errg = 0.f, refg = 0.f;
    for (int si = gw; si < CHK_NS * 8; si += NGW) { const int tok = chk_tok(si >> 3), ci = si & 7;
        if (which == 1) { const int colsE[8] = {5, 300, 390, 449, 460, 700, 1100, 1500}, colsO[8] = {5, 1000, 1100, 2000, 2100, 3000, 3071, 64};
            int col = 0;
#pragma unroll
            for (int q = 0; q < 8; ++q) if (ci == q) col = odd ? colsO[q] : colsE[q];
            const int N = odd ? NO_PR : NE_PR; const bf16_t* W = odd ? WSP(bf16_t, WS_WINO) + ((size_t)j * NO_PR + col) * 1024 : WSP(bf16_t, WS_WINE) + ((size_t)j * NE_PR + col) * 1024;
            float v = chk_dot_bf(WSP(bf16_t, WS_HB) + (size_t)tok * 1024, W, 1024, lane); if (!odd && col >= 512) v = gelu_tanh(v);
            const float f = bf2f(WSP(bf16_t, WS_PR)[(size_t)tok * N + col]);
            if (!odd && col >= 512) { errg = fmaxf(errg, nanfix(fabsf(f - v))); refg = fmaxf(refg, fabsf(v)); } else { err = fmaxf(err, nanfix(fabsf(f - v))); ref = fmaxf(ref, fabsf(v)); } }
        else if (which == 3) { const int cols[8] = {3, 500, 1023, 1030, 1279, 1100, 128, 1200}; int col = 0;
#pragma unroll
            for (int q = 0; q < 8; ++q) if (ci == q) col = cols[q];
            const float v = chk_dot_bf(WSP(bf16_t, WS_CQ) + (size_t)tok * 256, WSP(bf16_t, WS_WQE) + ((size_t)j * NQQ + col) * 256, 256, lane);
            const float f = bf2f(WSP(bf16_t, WS_QQ)[(size_t)tok * NQQ + col]); err = fmaxf(err, nanfix(fabsf(f - v))); ref = fmaxf(ref, fabsf(v)); }
        else { const int cols[8] = {1, 300, 600, 1023, 255, 256, 777, 512}; int col = 0;
#pragma unroll
            for (int q = 0; q < 8; ++q) if (ci == q) col = cols[q];
            const int K = odd ? 1024 : NMX; const bf16_t* W = odd ? WSP(bf16_t, WS_WOUTO) + ((size_t)j * 1024 + col) * 1024 : WSP(bf16_t, WS_WOUTE) + ((size_t)j * 1024 + col) * NMX;
            const float hs = (l == 0 ? a->in[I_X] : (const float*)a->out)[(size_t)tok * 1024 + col];
            const float v = DN_ALPHA * hs + chk_dot_bf(WSP(bf16_t, WS_MX) + (size_t)tok * K, W, K, lane);
            const float f = WSP(float, WS_Z)[(size_t)tok * 1024 + col]; err = fmaxf(err, nanfix(fabsf(f - v))); ref = fmaxf(ref, fabsf(v)); }
    }
    if (which == 1) { if (odd) chk_put(F, 14, err, ref); else { chk_put(F, 1, err, ref); chk_put(F, 13, errg, refg); } } else chk_put(F, which, err, ref);
}
__device__ __forceinline__ void chk_e1b(Frame& F, ArgsP a, int l) {
    PHASE_PROLOG(); const int lane = fresh_tid() & 63, gw = vcu_ * 8 + F.wave, NGW = G_ * 8, j = l >> 1; float err = 0.f, ref = 0.f;
    for (int si = gw; si < CHK_NS; si += NGW) { const int tok = chk_tok(si); const bf16_t* pr = WSP(bf16_t, WS_PR) + (size_t)tok * NE_PR;
        float x[4], ss = 0.f;
#pragma unroll
        for (int i = 0; i < 4; ++i) { x[i] = bf2f(pr[lane + 64 * i]); ss += x[i] * x[i]; }
        ss = wave_sum(ss); float rs = 1.0f / sqrtf(ss / 256.0f + LN_EPS);
#pragma unroll
        for (int i = 0; i < 4; ++i) { const float v = x[i] * rs * a->in[I_EV_Q_NORM][j * 256 + lane + 64 * i]; err = fmaxf(err, nanfix(fabsf(v - bf2f(WSP(bf16_t, WS_CQ)[(size_t)tok * 256 + lane + 64 * i])))); ref = fmaxf(ref, fabsf(v)); }
        float y0 = bf2f(pr[256 + lane]), y1 = bf2f(pr[256 + 64 + lane]); ss = wave_sum(y0 * y0 + y1 * y1); rs = 1.0f / sqrtf(ss / 128.0f + LN_EPS);
        { const float v0 = y0 * rs * a->in[I_EV_KV_NORM][j * 128 + lane], v1 = y1 * rs * a->in[I_EV_KV_NORM][j * 128 + 64 + lane];
          err = fmaxf(err, nanfix(fabsf(v0 - bf2f(WSP(bf16_t, WS_CKV)[(size_t)tok * 128 + lane])))); err = fmaxf(err, nanfix(fabsf(v1 - bf2f(WSP(bf16_t, WS_CKV)[(size_t)tok * 128 + 64 + lane])))); }
        { const float z = bf2f(pr[384 + lane]); const float mu = wave_sum(z) / 64.0f; const float var = wave_sum((z - mu) * (z - mu)) / 64.0f;
          const float v = (z - mu) / sqrtf(var + LN_EPS) * a->in[I_EV_IDX_K_G][j * 64 + lane] + a->in[I_EV_IDX_K_B][j * 64 + lane];
          err = fmaxf(err, nanfix(fabsf(v - bf2f(WSP(bf16_t, WS_KI)[(size_t)tok * 64 + lane])))); ref = fmaxf(ref, fabsf(v)); }
        if (lane < 4) err = fmaxf(err, nanfix(fabsf(0.5f * bf2f(pr[448 + lane]) - WSP(float, WS_WI)[(size_t)tok * 4 + lane])));
    }
    chk_put(F, 2, err, ref);
}
__device__ __forceinline__ void chk_dsa(Frame& F, ArgsP a, int l) {
    PHASE_PROLOG(); const int lane = fresh_tid() & 63, gw = vcu_ * 8 + F.wave, NGW = G_ * 8; float err4 = 0.f, ref4 = 1e-20f, err5 = 0.f, ref5 = 0.f;
    LAS float* pl = (LAS float*)F.lds + F.wave * 2048;
    const bf16_t* QQ = WSP(bf16_t, WS_QQ); const bf16_t* KI = WSP(bf16_t, WS_KI); const bf16_t* CKV = WSP(bf16_t, WS_CKV);
    for (int si = gw; si < CHK_NS; si += NGW) { const int tok = chk_tok(si), b = tok >> 11, t = tok & 2047, NT = t / 64 + 1, N = NT * 64; const size_t rb0 = (size_t)b * SEQ;
        int npop = 0; float minsel = 1e30f, maxun = -1e30f, maxabs = 0.f; int maxselzero = -1, minunzero = 1 << 20;
        for (int i = 0; i < NT; ++i) { const int s = i * 64 + lane; float sc = 0.f;
            for (int h = 0; h < 4; ++h) { float d = 0.f; for (int k = 0; k < 64; ++k) d += bf2f(QQ[(size_t)tok * NQQ + 1024 + h * 64 + k]) * bf2f(KI[(rb0 + s) * 64 + k]); sc += fmaxf(d, 0.f) * WSP(float, WS_WI)[(size_t)tok * 4 + h]; }
            sc += 0.0f;
            const unsigned long long mw = WSP(unsigned long long, WS_MASK)[(size_t)tok * 32 + i]; const bool sel = (mw >> lane) & 1ull;
            npop += sel ? 1 : 0; maxabs = fmaxf(maxabs, fabsf(sc));
            if (sel) { minsel = fminf(minsel, sc); if (sc == 0.f) maxselzero = max(maxselzero, s); } else { maxun = fmaxf(maxun, sc); if (sc == 0.f) minunzero = min(minunzero, s); } }
        for (int i = NT; i < 32; ++i) if (WSP(unsigned long long, WS_MASK)[(size_t)tok * 32 + i] != 0ull) err4 = 1e30f;
        npop = (int)wave_sum((float)npop); minsel = -wave_max(-minsel); maxun = wave_max(maxun); maxabs = wave_max(maxabs);
        maxselzero = (int)wave_max((float)maxselzero); minunzero = -(int)wave_max(-(float)minunzero);
        if (npop != (N < N_SEL ? N : N_SEL)) err4 = 1e30f;
        if (N > N_SEL) { err4 = fmaxf(err4, maxun - minsel); if (minsel == 0.f && maxun == 0.f && maxselzero > minunzero) err4 = 1e30f; }
        ref4 = fmaxf(ref4, maxabs / 30.0f);
        const int h = si & 7; const float slope2 = exp2f(-(float)(h + 1)) * LOG2E; float mx = -1e30f;
        for (int i = 0; i < NT; ++i) { const int s = i * 64 + lane; float d = 0.f; for (int k = 0; k < 128; ++k) d += bf2f(QQ[(size_t)tok * NQQ + h * 128 + k]) * bf2f(CKV[(rb0 + s) * 128 + k]);
            d -= slope2 * fabsf((float)(t - s)); const unsigned long long mw = WSP(unsigned long long, WS_MASK)[(size_t)tok * 32 + i]; if (!((mw >> lane) & 1ull)) d = -1e30f; pl[s] = d; mx = fmaxf(mx, d); }
        mx = wave_max(mx); float sum = 0.f;
        for (int i = 0; i < NT; ++i) { const int s = i * 64 + lane; const float p = fast_exp2(pl[s] - mx); pl[s] = p; sum += p; }
        sum = wave_sum(sum); LDS_WAIT();
        for (int cc = 0; cc < 2; ++cc) { const int c = lane + 64 * cc; float o = 0.f; for (int s = 0; s < N; ++s) o += pl[s] * bf2f(CKV[(rb0 + s) * 128 + c]); o /= sum;
            const float f = bf2f(WSP(bf16_t, WS_MX)[(size_t)tok * NMX + h * 128 + c]); err5 = fmaxf(err5, nanfix(fabsf(f - o))); ref5 = fmaxf(ref5, fabsf(o)); }
        LDS_WAIT();
    }
    chk_put(F, 4, err4, ref4); chk_put(F, 5, err5, ref5);
}
__device__ __forceinline__ void chk_gml(Frame& F, ArgsP a, int l) {
    PHASE_PROLOG(); const int lane = fresh_tid() & 63, gw = vcu_ * 8 + F.wave, NGW = G_ * 8, j = l >> 1; float err = 0.f, ref = 0.f;
    const bf16_t* PR = WSP(bf16_t, WS_PR);
    for (int si = gw; si < CHK_NS; si += NGW) { const int tok = chk_tok(si), g = si & 7, ii = tok & 127; const size_t tok0 = (size_t)(tok - ii); float mixed = 0.f;
        for (int jx = 0; jx <= ii; ++jx) { const bf16_t* vr = PR + (tok0 + jx) * NE_PR + 1024; float xs[8], s = 0.f;
#pragma unroll
            for (int q = 0; q < 8; ++q) { xs[q] = bf2f(vr[lane + 64 * q]); s += xs[q]; }
            const float mu = wave_sum(s) / 512.0f; float s2 = 0.f;
#pragma unroll
            for (int q = 0; q < 8; ++q) s2 += (xs[q] - mu) * (xs[q] - mu);
            const float rs = 1.0f / sqrtf(wave_sum(s2) / 512.0f + LN_EPS);
            const float vln = (bf2f(vr[g * 64 + lane]) - mu) * rs * a->in[I_EV_V_NORM_G][j * GW + g * 64 + lane] + a->in[I_EV_V_NORM_B][j * GW + g * 64 + lane];
            mixed += a->in[I_EV_W_S][((size_t)(j * 8 + g) * 128 + ii) * 128 + jx] * vln; }
        mixed += a->in[I_EV_B_S][(size_t)(j * 8 + g) * 128 + ii];
        const float v = bf2f(PR[(size_t)tok * NE_PR + 512 + g * 64 + lane]) * mixed; const float f = bf2f(WSP(bf16_t, WS_MX)[(size_t)tok * NMX + 1024 + g * 64 + lane]);
        err = fmaxf(err, nanfix(fabsf(f - v))); ref = fmaxf(ref, fabsf(v)); }
    chk_put(F, 6, err, ref);
}
__device__ __forceinline__ void chk_lnr(Frame& F, ArgsP a, int l) {
    PHASE_PROLOG(); const int lane = fresh_tid() & 63, gw = vcu_ * 8 + F.wave, NGW = G_ * 8; float err = 0.f, ref = 0.f;
    for (int si = gw; si < CHK_NS; si += NGW) { const int tok = chk_tok(si); const float* z = WSP(float, WS_Z) + (size_t)tok * 1024; float x[16], s = 0.f;
#pragma unroll
        for (int i = 0; i < 16; ++i) { x[i] = z[lane + 64 * i]; s += x[i]; }
        const float mu = wave_sum(s) / 1024.0f; float s2 = 0.f;
#pragma unroll
        for (int i = 0; i < 16; ++i) s2 += (x[i] - mu) * (x[i] - mu);
        const float rs = 1.0f / sqrtf(wave_sum(s2) / 1024.0f + LN_EPS);
#pragma unroll
        for (int i = 0; i < 16; ++i) { x[i] = (x[i] - mu) * rs * a->in[I_LN1_G][l * 1024 + lane + 64 * i] + a->in[I_LN1_B][l * 1024 + lane + 64 * i];
            err = fmaxf(err, nanfix(fabsf(x[i] - a->out[(size_t)tok * 1024 + lane + 64 * i]))); err = fmaxf(err, nanfix(fabsf(x[i] - bf2f(WSP(bf16_t, WS_HB)[(size_t)tok * 1024 + lane + 64 * i])) * 0.25f)); ref = fmaxf(ref, fabsf(x[i])); }
        float lg = 0.f;
        for (int e = 0; e < 32; ++e) { float p = 0.f;
#pragma unroll
            for (int i = 0; i < 16; ++i) p += x[i] * a->in[I_ROUTER_W][((size_t)l * 1024 + lane + 64 * i) * 32 + e];
            p = wave_sum(p) + a->in[I_ROUTER_B][l * 32 + e]; if (lane == e) lg = p; }
        if (lane >= 32) lg = -1e30f;
        float tl[4]; int te[4]; float v = lg;
        for (int k = 0; k < 4; ++k) { const float m = wave_max(v); const unsigned long long bm = __builtin_amdgcn_ballot_w64(v == m); te[k] = __builtin_ctzll(bm); tl[k] = m; if (lane == te[k]) v = -1e30f; }
        const float den = 1.0f + expf(tl[1] - tl[0]) + expf(tl[2] - tl[0]) + expf(tl[3] - tl[0]);
        for (int k = 0; k < 4; ++k) { const unsigned sl = WSP(unsigned, WS_SLOT)[(size_t)tok * 4 + k]; const int e = (int)(sl >> 20), rank = (int)(sl & 0xfffffu);
            if (e != te[k]) {
                const float mine = __builtin_bit_cast(float, __builtin_amdgcn_ds_bpermute(e << 2, __builtin_bit_cast(int, lg)));
                if (fabsf(mine - tl[k]) > 1e-4f) err = 1e30f; }
            if (WSP(int, WS_ROWTOK)[(size_t)e * 65536 + rank] != tok) err = 1e30f;
            const float gk = expf(tl[k] - tl[0]) / den; err = fmaxf(err, nanfix(fabsf(gk - WSP(float, WS_GATE)[(size_t)tok * 4 + k]))); }
    }
    chk_put(F, 8, err, ref);
}
__device__ __forceinline__ void chk_moe(Frame& F, ArgsP a, int l) {
    PHASE_PROLOG(); const int lane = fresh_tid() & 63, gw = vcu_ * 8 + F.wave, NGW = G_ * 8; float err = 0.f, ref = 0.f;
    LAS float* al = (LAS float*)F.lds + F.wave * 1024;
    for (int si = gw; si < CHK_NS; si += NGW) { const int tok = chk_tok(si), k = si & 3; const unsigned sl = WSP(unsigned, WS_SLOT)[(size_t)tok * 4 + k]; const int e = (int)(sl >> 20), rank = (int)(sl & 0xfffffu);
        int rbs = 0; for (int q = 0; q < e; ++q) rbs += ((int)__hip_atomic_load(F.ctl + CW_CUR + (size_t)(l * 32 + q) * 64, RLX_AGENT) + 255) >> 8;
        const size_t crow = (size_t)rbs * 256 + rank;
        const float* wgu = a->in[I_EXP_W_GU] + ((size_t)l * NEXP + e) * 1024 * 2048; const float* wdn = a->in[I_EXP_W_DN] + ((size_t)l * NEXP + e) * 1024 * 1024;
        const bf16_t* hb = WSP(bf16_t, WS_HB) + (size_t)tok * 1024;
        float ag[16], au[16];
#pragma unroll
        for (int i = 0; i < 16; ++i) { ag[i] = 0.f; au[i] = 0.f; }
        for (int kk = 0; kk < 1024; ++kk) { const float hv = bf2f(hb[kk]);
#pragma unroll
            for (int i = 0; i < 16; ++i) { ag[i] += hv * wgu[(size_t)kk * 2048 + lane + 64 * i]; au[i] += hv * wgu[(size_t)kk * 2048 + 1024 + lane + 64 * i]; } }
#pragma unroll
        for (int i = 0; i < 16; ++i) { const int f = lane + 64 * i; float gt = ag[i] + a->in[I_EXP_B_GU][((size_t)l * NEXP + e) * 2048 + f], up = au[i] + a->in[I_EXP_B_GU][((size_t)l * NEXP + e) * 2048 + 1024 + f];
            gt = fminf(gt, 7.0f); up = fminf(fmaxf(up, -7.0f), 7.0f); const float act = (up + 1.0f) * gt / (1.0f + expf(-1.702f * gt)); al[f] = act;
            const float fa = bf2f(WSP(bf16_t, WS_ACT)[crow * 1024 + f]); err = fmaxf(err, nanfix(fabsf(fa - act))); ref = fmaxf(ref, fabsf(act)); }
        LDS_WAIT();
#pragma unroll
        for (int ci = 0; ci < 4; ++ci) { const int col = ci == 0 ? 0 : ci == 1 ? 511 : ci == 2 ? 1023 : 700; float s = 0.f; for (int f = lane; f < 1024; f += 64) s += al[f] * wdn[(size_t)f * 1024 + col];
            s = wave_sum(s) + a->in[I_EXP_B_DN][((size_t)l * NEXP + e) * 1024 + col]; const float fy = bf2f(WSP(bf16_t, WS_Y)[crow * 1024 + col]);
            err = fmaxf(err, nanfix(fabsf(fy - s)) * 2.0f); ref = fmaxf(ref, fabsf(s)); }
        LDS_WAIT();
    }
    chk_put(F, 9, err, ref);
}
__device__ __forceinline__ void chk_datt(Frame& F, ArgsP a, int l) {
    PHASE_PROLOG(); const int lane = fresh_tid() & 63, gw = vcu_ * 8 + F.wave, NGW = G_ * 8, j = l >> 1; float err = 0.f, ref = 0.f;
    LAS float* pl = (LAS float*)F.lds + F.wave * 2048; const bf16_t* PR = WSP(bf16_t, WS_PR);
    const float lam_init = 0.8f - 0.6f * expf(-0.3f * (float)l);
    const float lam = expf(wave_sum(a->in[I_OD_LQ1][j * 64 + lane] * a->in[I_OD_LK1][j * 64 + lane])) - expf(wave_sum(a->in[I_OD_LQ2][j * 64 + lane] * a->in[I_OD_LK2][j * 64 + lane])) + lam_init;
    for (int si = gw; si < CHK_NS; si += NGW) { const int tok = chk_tok(si), b = tok >> 11, t = tok & 2047, NT = t / 64 + 1, N = NT * 64, h = si & 7; const size_t rb0 = (size_t)b * SEQ;
        const float slope2 = exp2f(-(float)(h + 1)) * LOG2E; float oc[2][2];
        for (int m = 0; m < 2; ++m) { float mx = -1e30f;
            for (int i = 0; i < NT; ++i) { const int s = i * 64 + lane; float d = 0.f; for (int k = 0; k < 64; ++k) d += bf2f(PR[(size_t)tok * NO_PR + h * 128 + m * 64 + k]) * bf2f(PR[(rb0 + s) * NO_PR + 1024 + h * 128 + m * 64 + k]);
                d -= slope2 * fabsf((float)(t - s)); pl[s] = d; mx = fmaxf(mx, d); }
            mx = wave_max(mx); float sum = 0.f;
            for (int i = 0; i < NT; ++i) { const int s = i * 64 + lane; const float p = fast_exp2(pl[s] - mx); pl[s] = p; sum += p; }
            sum = wave_sum(sum); LDS_WAIT();
            for (int cc = 0; cc < 2; ++cc) { const int c = lane + 64 * cc; float o = 0.f; for (int s = 0; s < N; ++s) o += pl[s] * bf2f(PR[(rb0 + s) * NO_PR + 2048 + h * 128 + c]); oc[m][cc] = o / sum; }
            LDS_WAIT(); }
        const float y0 = oc[0][0] - lam * oc[1][0], y1 = oc[0][1] - lam * oc[1][1]; const float rs = (1.0f - lam_init) / sqrtf(wave_sum(y0 * y0 + y1 * y1) / 128.0f + LN_EPS);
        const float v0 = y0 * rs * a->in[I_OD_SUBLN_G][j * 128 + lane], v1 = y1 * rs * a->in[I_OD_SUBLN_G][j * 128 + 64 + lane];
        const float f0 = bf2f(WSP(bf16_t, WS_MX)[(size_t)tok * 1024 + h * 128 + lane]), f1 = bf2f(WSP(bf16_t, WS_MX)[(size_t)tok * 1024 + h * 128 + 64 + lane]);
        err = fmaxf(err, nanfix(fabsf(f0 - v0))); err = fmaxf(err, nanfix(fabsf(f1 - v1))); ref = fmaxf(ref, fmaxf(fabsf(v0), fabsf(v1))); }
    chk_put(F, 11, err, ref);
}
__device__ __forceinline__ void chk_final(Frame& F, ArgsP a) {
    PHASE_PROLOG(); int code = 0;
    for (int k = N_CHK - 1; k >= 1; --k) { const float e = __builtin_bit_cast(float, __hip_atomic_load(F.ctl + CW_CHK + 2 * k, RLX_AGENT)), r = __builtin_bit_cast(float, __hip_atomic_load(F.ctl + CW_CHK + 2 * k + 1, RLX_AGENT));
        if (e > 0.03f * r) code = k; }
    if (code == 0) return;
    const float sc = 1.0f + 0.05f * (float)code; const int gt = vcu_ * 512 + fresh_tid(), NGT = G_ * 512;
    for (size_t i = gt; i < (size_t)T_TOK * 1024; i += NGT) a->out[i] *= sc;
}
#endif
constexpr int N_PHASES = 10;
__global__ void __launch_bounds__(512, 2) mk_fwd(Args a) {
    extern __shared__ __attribute__((aligned(16))) unsigned char lds_raw[];
    Frame F;
    F.lds = (LAS unsigned char*)lds_raw; F.ldsg = (char*)lds_raw;
    F.MISC = (volatile LAS int*)(F.lds + MISC_OFF);
    F.tid = threadIdx.x; F.lane = F.tid & 63; F.wave = __builtin_amdgcn_readfirstlane(F.tid >> 6);
    F.G = gridDim.x; { const int bx = blockIdx.x; F.vcu = (F.G % 8 == 0) ? (bx % 8) * (F.G / 8) + bx / 8 : bx; }
    ArgsP ap = (ArgsP)__builtin_amdgcn_kernarg_segment_ptr();
    F.ws = ap->ws; F.ctl = (gu32*)(ap->ws + WS_CTL);
    const int a_fused = ap->fused, a_llo = ap->l_lo, a_lhi = ap->l_hi, a_plo0 = ap->p_lo, a_phi0 = ap->p_hi, a_pro = ap->do_pro;
    for (int u = F.tid; u < (LDS_BYTES - MISC_OFF) / 4; u += 512) F.MISC[u] = 0;
    __syncthreads();
    XcdBarrier bar; bar.bar = (unsigned*)(F.ctl + CW_BAR); bar.x = 0; bar.st = nullptr; bar.w = (unsigned)F.wave;
    if (a_fused) bar = xcd_barrier_post((unsigned*)(F.ctl + CW_BAR), (volatile LAS unsigned*)(F.MISC + MI_BAR));
#define GRID_BAR() do { if (a_fused) xcd_barrier(bar); } while (0)
#define KPROLOG() ArgsP a = ap; unsigned char* ws_ = F.ws; asm volatile("" : "+s"(ws_)); asm volatile("" : "+s"(a)); int vcu_ = F.vcu, G_ = F.G, bx_ = (int)blockIdx.x; asm volatile("" : "+s"(vcu_), "+s"(G_), "+s"(bx_))
#ifndef PHASE_MASK
#define PHASE_MASK 0x7ff
#endif
#define RUN(p) (((PHASE_MASK >> (p)) & 1) && a_plo <= (p) && (p) < a_phi)
#ifndef PROBE_REP
#define PROBE_REP 0
#endif
#ifndef PROBE_PAR
#define PROBE_PAR 0
#endif
#define REPS(p) _Pragma("unroll 1") for (int rep_ = 0; rep_ < 1 + (((PROBE_REP >> (p)) & 1) && (PROBE_PAR == 0 || (PROBE_PAR == 1 && !(l_probe & 1)) || (PROBE_PAR == 2 && (l_probe & 1))) ? 1 : 0); ++rep_)
    { const int l_probe = 0; if (((PHASE_MASK >> 10) & 1) && a_pro) { REPS(10) { pro_phase(F, ap); GRID_BAR(); } } }
    for (int l = a_llo; l < a_lhi; ++l) {
        int a_plo = a_plo0, a_phi = a_phi0; asm volatile("" : "+s"(a_plo), "+s"(a_phi));
        const bool odd = (l & 1) != 0; const int j = l >> 1; const int l_probe = l;
        if (RUN(0)) REPS(0) { KPROLOG();
            const bf16_t* Bt = odd ? WSP(bf16_t, WS_WINO) + (size_t)j * NO_PR * 1024 : WSP(bf16_t, WS_WINE) + (size_t)j * NE_PR * 1024; const int N = odd ? NO_PR : NE_PR;
            pg8::DenseOrder S; S.init(T_TOK, N, G_, bx_);
            pg8::EpiStoreBf16 E{WSP(bf16_t, WS_PR), N, odd ? (1 << 30) : 2};
            pg8::gemm_phase<pg8::EpiStoreBf16, pg8::DenseOrder, false>(F.lds, WSP(bf16_t, WS_HB), Bt, 1024, nullptr, S, E, F.wave);
            GRID_BAR();
        }
        if (!odd) {
            if (RUN(1)) REPS(1) { e1b_phase(F, ap, l); GRID_BAR(); }
            if (RUN(2)) REPS(2) { KPROLOG();
                pg8::DenseOrder S; S.init(T_TOK, NQQ, G_, bx_);
                pg8::EpiStoreBf16 E{WSP(bf16_t, WS_QQ), NQQ, 1 << 30};
                pg8::gemm_phase<pg8::EpiStoreBf16, pg8::DenseOrder, false>(F.lds, WSP(bf16_t, WS_CQ), WSP(bf16_t, WS_WQE) + (size_t)j * NQQ * 256, 256, nullptr, S, E, F.wave);
                GRID_BAR();
            }
            if (RUN(3)) REPS(3) { e3a_phase(F, ap); GRID_BAR(); }
        }
        if (RUN(4)) REPS(4) {
#ifndef ATT_SEL
#define ATT_SEL 7
#endif
            if (odd) { if (ATT_SEL & 4) datt_phase(F, ap, l); }
            else { if (ATT_SEL & 1) dsa_phase(F, ap); if (ATT_SEL & 2) gml_phase(F, ap, l); }
            GRID_BAR();
        }
        if (RUN(5)) REPS(5) { KPROLOG();
            const bf16_t* Bt = odd ? WSP(bf16_t, WS_WOUTO) + (size_t)j * 1024 * 1024 : WSP(bf16_t, WS_WOUTE) + (size_t)j * 1024 * NMX; const int K = odd ? 1024 : NMX;
            pg8::DenseOrder S; S.init(T_TOK, D_MODEL, G_, bx_);
            pg8::EpiResid E{WSP(bf16_t, WS_HB), WSP(bf16_t, WS_Z), DN_ALPHA};
            pg8::gemm_phase<pg8::EpiResid, pg8::DenseOrder, false>(F.lds, WSP(bf16_t, WS_MX), Bt, K, nullptr, S, E, F.wave);
            GRID_BAR();
        }
#ifndef LNR_MFMA
#define LNR_MFMA 1
#endif
        if (RUN(6)) { if ((PROBE_REP >> 6) & 1) { if (LNR_MFMA) lnr2_phase(F, ap, l, true); else lnr_phase(F, ap, l, true); GRID_BAR(); } if (LNR_MFMA) lnr2_phase(F, ap, l); else lnr_phase(F, ap, l); GRID_BAR(); }
        if (RUN(7)) REPS(7) { KPROLOG();
            moe_tables(F, l);
            pg8::MoeOrder S; S.npn = 8; S.nunits = __builtin_amdgcn_readfirstlane(F.MISC[MI_RBSTART + 32]) * 8; S.G = G_; S.c = vcu_; S.tab = (const LAS int*)F.MISC;
            pg8::EpiSwiglu E{WSP(bf16_t, WS_ACT), a->in[I_EXP_B_GU] + (size_t)l * NEXP * 2048};
#if MOE_FP8
            pg8::gemm_phase<pg8::EpiSwiglu, pg8::MoeOrder, true, true>(F.lds, WSP(bf16_t, WS_HB8), (const bf16_t*)(WSP(unsigned char, WS_WGU) + (size_t)l * NEXP * 2048 * 1024), 512, WSP(int, WS_ROWTOK), S, E, F.wave, 0x7f7f7f7f, 0x79797979);
#else
            pg8::gemm_phase<pg8::EpiSwiglu, pg8::MoeOrder, true>(F.lds, WSP(bf16_t, WS_HB), WSP(bf16_t, WS_WGU) + (size_t)l * NEXP * 2048 * 1024, 1024, WSP(int, WS_ROWTOK), S, E, F.wave);
#endif
            GRID_BAR();
        }
        if (RUN(8)) REPS(8) { KPROLOG();
            moe_tables(F, l);
            pg8::MoeOrder S; S.npn = 4; S.nunits = __builtin_amdgcn_readfirstlane(F.MISC[MI_RBSTART + 32]) * 4; S.G = G_; S.c = vcu_; S.tab = (const LAS int*)F.MISC;
            pg8::EpiBiasBf16 E{WSP(bf16_t, WS_Y), a->in[I_EXP_B_DN] + (size_t)l * NEXP * 1024};
#if MOE_FP8
            pg8::gemm_phase<pg8::EpiBiasBf16, pg8::MoeOrder, false, true>(F.lds, WSP(bf16_t, WS_ACT), (const bf16_t*)(WSP(unsigned char, WS_WDN) + (size_t)l * NEXP * 1024 * 1024), 512, nullptr, S, E, F.wave, 0x7c7c7c7c, 0x79797979);
#else
            pg8::gemm_phase<pg8::EpiBiasBf16, pg8::MoeOrder, false>(F.lds, WSP(bf16_t, WS_ACT), WSP(bf16_t, WS_WDN) + (size_t)l * NEXP * 1024 * 1024, 1024, nullptr, S, E, F.wave);
#endif
            GRID_BAR();
        }
        if (RUN(9)) { if ((PROBE_REP >> 9) & 1) { cmb_phase(F, ap, l, true); GRID_BAR(); } cmb_phase(F, ap, l); if (l + 1 < DEPTH) GRID_BAR(); }
    }
#undef GRID_BAR
#undef RUN
}

#if MK_CHECK
__global__ void __launch_bounds__(512, 2) mk_chk(Args a_) {
    extern __shared__ __attribute__((aligned(16))) unsigned char lds_raw[];
    Frame F;
    F.lds = (LAS unsigned char*)lds_raw; F.ldsg = (char*)lds_raw; F.MISC = (volatile LAS int*)(F.lds + MISC_OFF);
    F.tid = threadIdx.x; F.lane = F.tid & 63; F.wave = __builtin_amdgcn_readfirstlane(F.tid >> 6);
    F.G = gridDim.x; { const int bx = blockIdx.x; F.vcu = (F.G % 8 == 0) ? (bx % 8) * (F.G / 8) + bx / 8 : bx; }
    ArgsP ap = (ArgsP)__builtin_amdgcn_kernarg_segment_ptr();
    F.ws = ap->ws; F.ctl = (gu32*)(ap->ws + WS_CTL);
    const int l = ap->l_lo, p = ap->p_lo;
    if (p == 21) chk_gemm(F, ap, l, 1);
    if (p == 22) chk_e1b(F, ap, l);
    if (p == 23) chk_gemm(F, ap, l, 3);
    if (p == 24) chk_dsa(F, ap, l);
    if (p == 26) chk_gml(F, ap, l);
    if (p == 27) chk_gemm(F, ap, l, 7);
    if (p == 28) chk_lnr(F, ap, l);
    if (p == 29) chk_moe(F, ap, l);
    if (p == 31) chk_datt(F, ap, l);
    if (p == 40) chk_final(F, ap);
}
#endif

extern "C" void kernel_launch(void* const* d_in, const int* in_sizes, int n_in, void* d_out, int out_size, void* d_ws, size_t ws_size, hipStream_t stream) {
    static int grid = 0;
    if (grid == 0) {
        if (n_in != 32 || in_sizes[0] != T_TOK * D_MODEL || out_size != T_TOK * D_MODEL || ws_size < WS_END) {
            fprintf(stderr, "kernel_launch: shape mismatch: n_in %d in0 %d out %d ws %zu (need %zu)\n", n_in, n_in > 0 ? in_sizes[0] : -1, out_size, ws_size, (size_t)WS_END); grid = -1; return; }
        int dev = 0, cus = 0, per_cu = 0;
        if (hipGetDevice(&dev) != hipSuccess || hipDeviceGetAttribute(&cus, hipDeviceAttributeMultiprocessorCount, dev) != hipSuccess) { fprintf(stderr, "kernel_launch: device query failed\n"); grid = -1; return; }
#if MK_CHECK
        (void)hipFuncSetAttribute((const void*)mk_chk, hipFuncAttributeMaxDynamicSharedMemorySize, LDS_BYTES);
#endif
        if (hipFuncSetAttribute((const void*)mk_fwd, hipFuncAttributeMaxDynamicSharedMemorySize, LDS_BYTES) != hipSuccess) { fprintf(stderr, "kernel_launch: hipFuncSetAttribute failed\n"); grid = -1; return; }
        if (hipOccupancyMaxActiveBlocksPerMultiprocessor(&per_cu, (const void*)mk_fwd, 512, LDS_BYTES) != hipSuccess || per_cu < 1) { fprintf(stderr, "kernel_launch: occupancy query says %d\n", per_cu); }
        (void)hipGetLastError();
        grid = cus;
    }
    if (grid < 0) return;
    if (hipMemsetAsync((char*)d_ws + WS_CTL, 0, CTL_ZERO_BYTES, stream) != hipSuccess) { fprintf(stderr, "kernel_launch: memset failed\n"); return; }
    Args a{};
    for (int i = 0; i < 32; ++i) a.in[i] = (const float*)d_in[i];
    a.out = (float*)d_out; a.ws = (unsigned char*)d_ws;
#if MK_FUSED
    a.l_lo = 0; a.l_hi = DEPTH; a.p_lo = 0; a.p_hi = N_PHASES; a.do_pro = 1; a.fused = 1;
    hipLaunchKernelGGL(mk_fwd, dim3(grid), dim3(512), LDS_BYTES, stream, a);
#else
    a.fused = 0;
    a.l_lo = 0; a.l_hi = 0; a.p_lo = 0; a.p_hi = 0; a.do_pro = 1;
    hipLaunchKernelGGL(mk_fwd, dim3(grid), dim3(512), LDS_BYTES, stream, a);
    a.do_pro = 0;
    for (int l = 0; l < DEPTH; ++l)
        for (int p = 0; p < N_PHASES; ++p) {
            if ((l & 1) && p >= 1 && p <= 3) continue;
            a.l_lo = l; a.l_hi = l + 1; a.p_lo = p; a.p_hi = p + 1;
            hipLaunchKernelGGL(mk_fwd, dim3(grid), dim3(512), LDS_BYTES, stream, a);
#if MK_CHECK
            {
                int cks[3] = {0, 0, 0}; int nck = 0;
                if (l == 0) { if (p == 0) cks[nck++] = 21; if (p == 1) cks[nck++] = 22; if (p == 2) cks[nck++] = 23; if (p == 4) { cks[nck++] = 24; cks[nck++] = 26; } if (p == 5) cks[nck++] = 27; if (p == 6) cks[nck++] = 28; if (p == 8) cks[nck++] = 29; }
                if (l == 1) { if (p == 0) cks[nck++] = 21; if (p == 4) cks[nck++] = 31; if (p == 5) cks[nck++] = 27; }
                if (l == DEPTH - 1 && p == N_PHASES - 1) cks[nck++] = 40;
                for (int c = 0; c < nck; ++c) { a.p_lo = cks[c]; a.p_hi = cks[c] + 1; hipLaunchKernelGGL(mk_chk, dim3(grid), dim3(512), LDS_BYTES, stream, a); }
            }
#endif
        }
#endif
    const hipError_t le = hipPeekAtLastError();
    if (le != hipSuccess) fprintf(stderr, "kernel_launch: launch failed: %s\n", hipGetErrorName(le));
}
```

```cpp
#include <hip/hip_runtime.h>
#include <hip/hip_bf16.h>
#include <cstdio>
#include <cstdint>

#ifndef MK_CHECK
#define MK_CHECK 0
#endif
#ifndef MOE_FP8
#define MOE_FP8 1
#endif
#ifndef POUT_FP8
#define POUT_FP8 1
#endif
#ifndef MK_FUSED
#define MK_FUSED 1
#endif

constexpr int D_MODEL = 1024, BATCH = 32, SEQ = 2048, DEPTH = 4, T_TOK = BATCH * SEQ;
constexpr int CHUNK = 64;
constexpr int H_A = 8, D_CQ = 256, D_C = 128, H_IDX = 4, D_IDX = 64, N_SEL = 256;
constexpr int GW = 512, G_B = 8, CG_B = 64, GCH = 128;
constexpr int H_C = 8, DH_C = 64;
constexpr int NEXP = 32, TOPK = 4, D_FF = 1024;
constexpr int E_IN_EVEN = D_CQ + D_C + D_IDX + H_IDX + 2 * GW;
constexpr float LN_EPS = 1e-5f;
constexpr float DN_ALPHA = 1.681792830507429f;
constexpr float LOG2E = 1.4426950408889634f;
constexpr int NE_PR = 1536;
constexpr int NO_PR = 3072;
constexpr int NQQ = 1280;
constexpr int NMX = 1536;
constexpr int MOE_ROWS_MAX = (T_TOK * TOPK / 256 + NEXP) * 256;
constexpr int MOE_RB_MAX = MOE_ROWS_MAX / 256;

constexpr size_t MiB = 1u << 20;
constexpr size_t WS_CTL = 0, CTL_ZERO_BYTES = 1 * MiB;
constexpr size_t WS_WI = 1 * MiB;
constexpr size_t WS_GATE = 2 * MiB;
constexpr size_t WS_SLOT = 3 * MiB;
constexpr size_t WS_ROWTOK = 4 * MiB;
constexpr size_t WS_MASK = 12 * MiB;
constexpr size_t WS_WS = 28 * MiB;
constexpr size_t WS_WINE = 32 * MiB;
constexpr size_t WS_WQE = 38 * MiB;
constexpr size_t WS_WOUTE = 40 * MiB;
constexpr size_t WS_WINO = 46 * MiB;
constexpr size_t WS_WOUTO = 58 * MiB;
constexpr size_t WS_WRT = 62 * MiB;
constexpr size_t WS_WGU = 64 * MiB;
constexpr size_t WS_WDN = 576 * MiB;
constexpr size_t WS_HB = 832 * MiB;
constexpr size_t WS_Z = 960 * MiB;
constexpr size_t WS_PR = 1216 * MiB;
constexpr size_t WS_CQ = 1600 * MiB;
constexpr size_t WS_CKV = 1632 * MiB;
constexpr size_t WS_KI = 1648 * MiB;
constexpr size_t WS_QQ = 1656 * MiB;
constexpr size_t WS_MX = 1816 * MiB;
constexpr size_t WS_ACT = 2008 * MiB;
constexpr size_t WS_HB8 = 2272 * MiB;
constexpr size_t WS_Y = 2536 * MiB;
constexpr size_t WS_STAT = 3064 * MiB;
constexpr size_t WS_END = 3065 * MiB;
constexpr int CW_TMO = 0;
constexpr int CW_BAR = 4096;
constexpr int CW_CUR = 16384;

constexpr int RING_BYTES = 131072;
constexpr int MISC_OFF = RING_BYTES + 2048;
constexpr int LDS_BYTES = 147456;
constexpr int MI_BAR = 8;
constexpr int MI_RBSTART = 32;
constexpr int MI_CNT = 80;
constexpr int MI_LCNT = 112;
constexpr int MI_LBASE = 144;
constexpr int MI_NUNITS = 180;
constexpr int MI_RBE = 256;
constexpr int MI_REC = 1408;
constexpr int MI_END = MI_REC + 2048;
static_assert(MISC_OFF + MI_END * 4 <= LDS_BYTES, "LDS map");

#define GAS __attribute__((address_space(1)))
#define LAS __attribute__((address_space(3)))
typedef unsigned short bf16_t;
typedef short bf16x8 __attribute__((ext_vector_type(8)));
typedef short s16x4 __attribute__((ext_vector_type(4)));
typedef float f32x4 __attribute__((ext_vector_type(4)));
typedef float f32x2 __attribute__((ext_vector_type(2)));
typedef float f32x16 __attribute__((ext_vector_type(16)));
typedef unsigned u32x4 __attribute__((ext_vector_type(4)));
typedef unsigned u32x2 __attribute__((ext_vector_type(2)));
typedef GAS unsigned gu32;
typedef int v8i __attribute__((ext_vector_type(8)));
typedef int i32x4 __attribute__((ext_vector_type(4)));
#if POUT_FP8
typedef unsigned char mx_t;
__device__ __forceinline__ mx_t mx_cvt(float v) { v = fminf(fmaxf(8.0f * v, -448.f), 448.f); return (mx_t)__builtin_amdgcn_cvt_pk_fp8_f32(v, v, 0, false); }
#else
typedef unsigned short mx_t;
#endif
__device__ __forceinline__ unsigned pk4_fp8(float a, float b, float c, float d) { int p = __builtin_amdgcn_cvt_pk_fp8_f32(a, b, 0, false); return (unsigned)__builtin_amdgcn_cvt_pk_fp8_f32(c, d, p, true); }
#define RLX_AGENT __ATOMIC_RELAXED, __HIP_MEMORY_SCOPE_AGENT
#define LDS_WAIT() asm volatile("s_waitcnt lgkmcnt(0)" ::: "memory")
#define VM_WAIT() asm volatile("s_waitcnt vmcnt(0)" ::: "memory")

__device__ __forceinline__ unsigned f2bf(float f) { unsigned u = __builtin_bit_cast(unsigned, f); return (u + 0x7fffu + ((u >> 16) & 1u)) >> 16; }
#if !POUT_FP8
__device__ __forceinline__ mx_t mx_cvt(float v) { return (mx_t)f2bf(v); }
#endif
__device__ __forceinline__ unsigned pk2(float lo, float hi) { return f2bf(lo) | (f2bf(hi) << 16); }
__device__ __forceinline__ float bf2f(unsigned short v) { return __builtin_bit_cast(float, (unsigned)v << 16); }
__device__ __forceinline__ float bflo(unsigned w) { return __builtin_bit_cast(float, w << 16); }
__device__ __forceinline__ float bfhi(unsigned w) { return __builtin_bit_cast(float, w & 0xffff0000u); }
__device__ __forceinline__ unsigned cvt_pk_bf16(float lo, float hi) { unsigned r; asm volatile("v_cvt_pk_bf16_f32 %0, %1, %2" : "=v"(r) : "v"(lo), "v"(hi)); return r; }
template <int CTRL> __device__ __forceinline__ float dppx(float v) { return __builtin_bit_cast(float, __builtin_amdgcn_update_dpp(0, __builtin_bit_cast(int, v), CTRL, 0xf, 0xf, true)); }
template <int M> __device__ __forceinline__ float xshfl(float v, int) {
    static_assert(M == 1 || M == 2 || M == 4 || M == 8 || M == 16, "xshfl: inside a 32-lane half only");
    if constexpr (M == 1) return dppx<0xB1>(v);
    else if constexpr (M == 2) return dppx<0x4E>(v);
    else if constexpr (M == 4) return dppx<0x141>(v);
    else if constexpr (M == 8) return dppx<0x128>(v);
    else return __builtin_bit_cast(float, __builtin_amdgcn_ds_swizzle(__builtin_bit_cast(int, v), (16 << 10) | 0x1f));
}
__device__ __forceinline__ void plswap(unsigned a, unsigned b, unsigned& r0, unsigned& r1) {
    asm volatile("" : "+v"(a), "+v"(b));
    auto rr = __builtin_amdgcn_permlane32_swap(a, b, false, false); r0 = rr[0]; r1 = rr[1];
    asm volatile("" : "+v"(r0), "+v"(r1));
}
__device__ __forceinline__ void half_swap(float v, float& r0, float& r1) {
    unsigned u0, u1; plswap(__builtin_bit_cast(unsigned, v), __builtin_bit_cast(unsigned, v), u0, u1); r0 = __builtin_bit_cast(float, u0); r1 = __builtin_bit_cast(float, u1);
}
__device__ __forceinline__ float rdl(float v, int l) { return __builtin_bit_cast(float, __builtin_amdgcn_readlane(__builtin_bit_cast(int, v), l)); }
__device__ __forceinline__ float wave_sum(float v) {
    v += dppx<0xB1>(v); v += dppx<0x4E>(v); v += dppx<0x141>(v); v += dppx<0x140>(v);
    return (rdl(v, 0) + rdl(v, 16)) + (rdl(v, 32) + rdl(v, 48));
}
__device__ __forceinline__ float wave_max(float v) {
    v = fmaxf(v, dppx<0xB1>(v)); v = fmaxf(v, dppx<0x4E>(v)); v = fmaxf(v, dppx<0x141>(v)); v = fmaxf(v, dppx<0x140>(v));
    return fmaxf(fmaxf(rdl(v, 0), rdl(v, 16)), fmaxf(rdl(v, 32), rdl(v, 48)));
}
__device__ __forceinline__ int lane_id() { int l; asm volatile("v_mbcnt_lo_u32_b32 %0, -1, 0\n\tv_mbcnt_hi_u32_b32 %0, -1, %0" : "=v"(l)); return l; }
__device__ __forceinline__ int tid_of(int wv) { int t = (wv << 6) + lane_id(); asm volatile("" : "+v"(t)); return t; }
__device__ __forceinline__ float fast_exp2(float x) { return __builtin_amdgcn_exp2f(x); }
__device__ __forceinline__ float fast_rcp(float x) { return __builtin_amdgcn_rcpf(x); }
__device__ __forceinline__ float gelu_tanh(float x) {
    const float u = x * (0.7978845608028654f + 0.035677408136300125f * x * x);
    return x * fast_rcp(1.0f + fast_exp2(-2.0f * LOG2E * u));
}
namespace pg8 {
constexpr int BM = 256, BK = 64, HALF = 128, HTB = HALF * BK * 2  , STAGE_BYTES = 8 * HTB, NXCD = 8, WGM = 8;
__host__ __device__ __forceinline__ int lds_byte(int r, int c) { const int st = (r >> 4) * 2 + (c >> 5), rr = r & 15, cc = c & 31, ob = rr * 64 + cc * 2; return st * 1024 + (ob ^ (((ob >> 9) & 1) << 5)); }
__host__ __device__ __forceinline__ void stage_rc(int b, int& R, int& C) { const int st = b / 1024, sb = b % 1024, swz = sb ^ (((sb >> 9) & 1) << 5); R = (st >> 1) * 16 + swz / 64; C = (st & 1) * 32 + (swz % 64) / 2; }
__host__ __device__ __forceinline__ int perm16x(int R) { return 64 * (R >> 5) + 16 * ((R & 15) >> 2) + 4 * ((R >> 4) & 1) + (R & 3); }
__host__ __device__ __forceinline__ int perm32(int rho) { const int n = rho >> 4, i = rho & 15; return 8 * (i >> 2) + 4 * n + (i & 3); }

#ifndef PG8_NT
#define PG8_NT 0
#endif
#if PG8_NT
#define PG8_ST(T_, p_, v_) __builtin_nontemporal_store((v_), (GAS T_*)(p_))
#else
#define PG8_ST(T_, p_, v_) (*(GAS T_*)(p_) = (v_))
#endif
#ifndef PG8_NT_PIN
#define PG8_NT_PIN 0
#endif
#if PG8_NT_PIN
#define PG8_STP(T_, p_, v_) __builtin_nontemporal_store((v_), (GAS T_*)(p_))
#else
#define PG8_STP(T_, p_, v_) (*(GAS T_*)(p_) = (v_))
#endif
struct Unit { int pm, pn, bt, e, blk; };

struct DenseOrder {
    int nM, nN, nwg, G, c;
    __device__ void init(int M, int N, int G_, int c_) { nM = M / BM; nN = N / BM; nwg = nM * nN; G = G_; c = c_; }
    __device__ bool next(int i, Unit& u) const {
        const long L = (long)i * G + c; if (L >= nwg) return false;
        int wgid = (int)L; { const int q = nwg / NXCD, r = nwg % NXCD, xcd = wgid % NXCD, off = wgid / NXCD; wgid = (xcd < r ? xcd * (q + 1) : r * (q + 1) + (xcd - r) * q) + off; }
        const int nig = WGM * nN, gid = wgid / nig, fm = gid * WGM, gsz = (nM - fm) < WGM ? (nM - fm) : WGM;
        u.pm = fm + ((wgid % nig) % gsz); u.pn = (wgid % nig) / gsz; u.bt = u.pn; u.e = 0; u.blk = 0; return true;
    }
    __device__ __forceinline__ int count(int) const { return 0; }
};
struct MoeOrder {
    int nunits, npn, G, c; const LAS int* tab; int rev = 0;
    __device__ bool next(int i, Unit& u) const {
        const long L = (long)i * G + c; if (L >= nunits) return false;
        const int rb0_ = (int)L / npn, rb = rev ? nunits / npn - 1 - rb0_ : rb0_, pn = (int)L % npn, e = __builtin_amdgcn_readfirstlane(tab[MI_RBE + rb]);
        u.pm = rb; u.pn = pn; u.e = e; u.bt = e * npn + pn; u.blk = rb - __builtin_amdgcn_readfirstlane(tab[MI_RBSTART + e]); return true;
    }
    __device__ __forceinline__ int count(int e) const { return __builtin_amdgcn_readfirstlane(tab[MI_CNT + e]); }
};

template <int PV> struct EpiStoreBf16T {
    static constexpr bool RELAX = false;
    static constexpr int NST = (PV == 2) ? 8 : 16;
    static constexpr bool PERM = true; static constexpr bool PERM16 = false;
    bf16_t* O; int ldc; int gelu_from;
    struct Pre {};
    __device__ __forceinline__ void pre(Pre&, const Unit&, int, int) const {}
    __device__ __forceinline__ void fill(f32x4 (&acc)[2][2][4][2], const Pre&) const {
#pragma unroll
        for (int a = 0; a < 2; ++a)
#pragma unroll
            for (int b = 0; b < 2; ++b)
#pragma unroll
                for (int m = 0; m < 4; ++m)
#pragma unroll
                    for (int n = 0; n < 2; ++n) acc[a][b][m][n] = (f32x4){0.f, 0.f, 0.f, 0.f};
    }
    __device__ __forceinline__ void operator()(const f32x4 (&acc)[2][2][4][2], const Unit& u, int wr, int wc, int fr, int fq) const {
        const int row0 = u.pm * BM + wr * 64 + fr; const int col0 = u.pn * BM + wc * 32 + 8 * fq; const bool g = u.pn >= gelu_from;
#pragma unroll
        for (int ai = 0; ai < 2; ++ai)
#pragma unroll
            for (int m = 0; m < 4; ++m) { GAS bf16_t* rowp = (GAS bf16_t*)O + (size_t)(row0 + ai * HALF + m * 16) * ldc + col0;
#pragma unroll
                for (int bj = 0; bj < 2; ++bj) { f32x4 v0 = acc[ai][bj][m][0], v1 = acc[ai][bj][m][1];
                    if (g) {
#pragma unroll
                        for (int q = 0; q < 4; ++q) { v0[q] = gelu_tanh(v0[q]); v1[q] = gelu_tanh(v1[q]); } }
                    u32x4 w; w.x = cvt_pk_bf16(v0[0], v0[1]); w.y = cvt_pk_bf16(v0[2], v0[3]); w.z = cvt_pk_bf16(v1[0], v1[1]); w.w = cvt_pk_bf16(v1[2], v1[3]);
                    if constexpr (PV == 1) { u32x2 w2; w2.x = w.x; w2.y = w.y; *(GAS u32x2*)(rowp + bj * HALF) = w2; }
                    else if constexpr (PV == 5) { if (((blockIdx.x >> 3) & 3) == 0) *(GAS u32x4*)(rowp + bj * HALF) = w; }
                    else if constexpr (PV == 4) { if ((blockIdx.x >> 3) & 1) *(GAS u32x4*)(rowp + bj * HALF) = w; }
                    else if constexpr (PV == 2) { if (bj == 0) *(GAS u32x4*)(rowp + bj * HALF) = w; }
                    else if constexpr (PV == 3) {
                        GAS bf16_t* q = (GAS bf16_t*)O + (size_t)(u.pm * BM + wr * 64 + ai * HALF + m * 16 + (wc >> 1) * 8 + (fr >> 1)) * ldc + u.pn * BM + bj * HALF + (wc & 1) * 64 + (fr & 1) * 32 + 8 * fq;
                        *(GAS u32x4*)q = w; }
                    else PG8_STP(u32x4, rowp + bj * HALF, w); } }
    }
};
typedef EpiStoreBf16T<0> EpiStoreBf16;
struct EpiResid {
    static constexpr bool PERM = true; static constexpr bool PERM16 = false;
    static constexpr bool RELAX = false; static constexpr int NST = 16;
    const bf16_t* Hs; bf16_t* Z; float alpha;
    struct Pre {};
    __device__ __forceinline__ void pre(Pre&, const Unit&, int, int) const {}
    __device__ __forceinline__ void fill(f32x4 (&acc)[2][2][4][2], const Pre&) const {
#pragma unroll
        for (int a = 0; a < 2; ++a)
#pragma unroll
            for (int b = 0; b < 2; ++b)
#pragma unroll
                for (int m = 0; m < 4; ++m)
#pragma unroll
                    for (int n = 0; n < 2; ++n) acc[a][b][m][n] = (f32x4){0.f, 0.f, 0.f, 0.f};
    }
    __device__ __forceinline__ void operator()(const f32x4 (&acc)[2][2][4][2], const Unit& u, int wr, int wc, int fr, int fq) const {
        const int row0 = u.pm * BM + wr * 64 + fr; const int col0 = u.pn * BM + wc * 32 + 8 * fq;
        u32x4 hw[2][4][2];
#pragma unroll
        for (int ai = 0; ai < 2; ++ai)
#pragma unroll
            for (int m = 0; m < 4; ++m)
#pragma unroll
                for (int bj = 0; bj < 2; ++bj) hw[ai][m][bj] = *(const GAS u32x4*)((const GAS bf16_t*)Hs + (size_t)(row0 + ai * HALF + m * 16) * D_MODEL + col0 + bj * HALF);
#pragma unroll
        for (int ai = 0; ai < 2; ++ai) {
#pragma unroll
            for (int m = 0; m < 4; ++m) { const size_t off = (size_t)(row0 + ai * HALF + m * 16) * D_MODEL + col0;
#pragma unroll
                for (int bj = 0; bj < 2; ++bj) { const u32x4 h = hw[ai][m][bj];
                    const f32x4 v0 = (f32x4){bflo(h.x), bfhi(h.x), bflo(h.y), bfhi(h.y)} * alpha + acc[ai][bj][m][0], v1 = (f32x4){bflo(h.z), bfhi(h.z), bflo(h.w), bfhi(h.w)} * alpha + acc[ai][bj][m][1];
                    u32x4 w; w.x = cvt_pk_bf16(v0[0], v0[1]); w.y = cvt_pk_bf16(v0[2], v0[3]); w.z = cvt_pk_bf16(v1[0], v1[1]); w.w = cvt_pk_bf16(v1[2], v1[3]);
                    PG8_ST(u32x4, (GAS bf16_t*)Z + off + bj * HALF, w); } } }
    }
};
__device__ __forceinline__ f32x2 pk_add(f32x2 a, f32x2 b) { f32x2 d; asm("v_pk_add_f32 %0, %1, %2" : "=v"(d) : "v"(a), "v"(b)); return d; }
__device__ __forceinline__ f32x2 pk_mul(f32x2 a, f32x2 b) { f32x2 d; asm("v_pk_mul_f32 %0, %1, %2" : "=v"(d) : "v"(a), "v"(b)); return d; }
__device__ __forceinline__ f32x2 pk_fma(f32x2 a, f32x2 b, f32x2 c) { f32x2 d; asm("v_pk_fma_f32 %0, %1, %2, %3" : "=v"(d) : "v"(a), "v"(b), "v"(c)); return d; }
__device__ __forceinline__ float a_min(float a, float b) { float d; asm("v_min_f32 %0, %1, %2" : "=v"(d) : "v"(a), "v"(b)); return d; }
__device__ __forceinline__ float a_med3(float a, float lo, float hi) { float d; asm("v_med3_f32 %0, %1, %2, %3" : "=v"(d) : "v"(a), "v"(lo), "v"(hi)); return d; }
__device__ __forceinline__ f32x2 pk_add_t(f32x2 a, f32x2 b) { f32x2 d; asm("s_nop 0\n\tv_pk_add_f32 %0, %1, %2" : "=v"(d) : "v"(a), "v"(b)); return d; }
__device__ __forceinline__ f32x2 pk_mul_t(f32x2 a, f32x2 b) { f32x2 d; asm("s_nop 0\n\tv_pk_mul_f32 %0, %1, %2" : "=v"(d) : "v"(a), "v"(b)); return d; }
struct EpiSwiglu {
    static constexpr bool PERM = true; static constexpr bool PERM16 = false;
#if MOE_FP8
    static constexpr float OSC = 8.0f;
#else
    static constexpr float OSC = 1.0f;
#endif
    static constexpr bool RELAX = true; static constexpr int NST = 8;
    bf16_t* ACT; const float* bgu;
    struct Pre { f32x4 g[2], u[2]; };
    __device__ __forceinline__ void pre(Pre& p, const Unit& u, int wc, int fq) const {
        const float* bb = bgu + (size_t)u.e * 2048 + u.pn * HALF + wc * 32 + 8 * fq;
#pragma unroll
        for (int n = 0; n < 2; ++n) { p.g[n] = *(const GAS f32x4*)((const GAS float*)bb + 4 * n); p.u[n] = *(const GAS f32x4*)((const GAS float*)bb + 1024 + 4 * n); }
    }
    __device__ __forceinline__ void fill(f32x4 (&acc)[2][2][4][2], const Pre& p) const {
#pragma unroll
        for (int n = 0; n < 2; ++n) { const f32x4 un = (p.u[n] + 1.0f) * OSC;
#pragma unroll
            for (int a = 0; a < 2; ++a)
#pragma unroll
                for (int m = 0; m < 4; ++m) { acc[a][0][m][n] = p.g[n]; acc[a][1][m][n] = un; } }
    }
    __device__ __forceinline__ void operator()(const f32x4 (&acc)[2][2][4][2], const Unit& u, int wr, int wc, int fr, int fq) const {
        const int row0 = u.pm * BM + wr * 64 + fr; const int oc0 = u.pn * HALF + wc * 32 + 8 * fq;
        f32x2 c_z = {-1.702f * LOG2E, -1.702f * LOG2E}, c_one = {1.0f, 1.0f};
        f32x2 c_lim = {7.0f, -6.0f * OSC}; float c_hi = 8.0f * OSC;
        asm volatile("" : "+v"(c_z), "+v"(c_one), "+v"(c_lim), "+v"(c_hi));
#pragma unroll
        for (int ai = 0; ai < 2; ++ai)
#pragma unroll
            for (int m = 0; m < 4; ++m) { float o[8];
#pragma unroll
                for (int n = 0; n < 2; ++n)
#pragma unroll
                    for (int h = 0; h < 2; ++h) {
                        f32x2 gt, up;
                        gt.x = a_min(acc[ai][0][m][n][2 * h], c_lim.x); gt.y = a_min(acc[ai][0][m][n][2 * h + 1], c_lim.x);
                        up.x = a_med3(acc[ai][1][m][n][2 * h], c_lim.y, c_hi); up.y = a_med3(acc[ai][1][m][n][2 * h + 1], c_lim.y, c_hi);
                        f32x2 e = pk_mul(gt, c_z);
                        e.x = fast_exp2(e.x); e.y = fast_exp2(e.y);
                        f32x2 r = pk_add_t(e, c_one);
                        r.x = fast_rcp(r.x); r.y = fast_rcp(r.y);
                        const f32x2 ov = pk_mul_t(pk_mul(up, gt), r);
                        o[4 * n + 2 * h] = ov.x; o[4 * n + 2 * h + 1] = ov.y; }
#if MOE_FP8
                u32x2 w; w.x = pk4_fp8(o[0], o[1], o[2], o[3]); w.y = pk4_fp8(o[4], o[5], o[6], o[7]);
                PG8_ST(u32x2, (GAS unsigned char*)ACT + (size_t)(row0 + ai * HALF + m * 16) * D_FF + oc0, w); }
#else
                u32x4 w; w.x = cvt_pk_bf16(o[0], o[1]); w.y = cvt_pk_bf16(o[2], o[3]); w.z = cvt_pk_bf16(o[4], o[5]); w.w = cvt_pk_bf16(o[6], o[7]);
                *(GAS u32x4*)((GAS bf16_t*)ACT + (size_t)(row0 + ai * HALF + m * 16) * D_FF + oc0) = w; }
#endif
    }
};
struct EpiBiasBf16 {
    static constexpr bool PERM = true; static constexpr bool PERM16 = (MOE_FP8 != 0);
#if MOE_FP8
    static constexpr float OSC = 64.0f;
#else
    static constexpr float OSC = 1.0f;
#endif
    static constexpr bool RELAX = true; static constexpr int NST = MOE_FP8 ? 8 : 16;
    bf16_t* Y; const float* bdn;
    struct Pre { f32x4 v[2][2]; };
    __device__ __forceinline__ void pre(Pre& p, const Unit& u, int wc, int fq) const {
        const float* bb = bdn + (size_t)u.e * 1024 + u.pn * BM + (PERM16 ? wc * 64 + 16 * fq : wc * 32 + 8 * fq);
#pragma unroll
        for (int bj = 0; bj < 2; ++bj)
#pragma unroll
            for (int n = 0; n < 2; ++n) p.v[bj][n] = *(const GAS f32x4*)((const GAS float*)bb + (PERM16 ? 8 * bj : bj * HALF) + 4 * n);
    }
    __device__ __forceinline__ void fill(f32x4 (&acc)[2][2][4][2], const Pre& p) const {
#pragma unroll
        for (int bj = 0; bj < 2; ++bj)
#pragma unroll
            for (int n = 0; n < 2; ++n) { const f32x4 v = p.v[bj][n] * OSC;
#pragma unroll
                for (int a = 0; a < 2; ++a)
#pragma unroll
                    for (int m = 0; m < 4; ++m) acc[a][bj][m][n] = v; }
    }
    __device__ __forceinline__ void operator()(const f32x4 (&acc)[2][2][4][2], const Unit& u, int wr, int wc, int fr, int fq) const {
        const int row0 = u.pm * BM + wr * 64 + fr; const int col0 = u.pn * BM + (PERM16 ? wc * 64 + 16 * fq : wc * 32 + 8 * fq);
#if MOE_FP8
        float c_lo = -448.f, c_hi = 448.f; asm volatile("" : "+v"(c_lo), "+v"(c_hi));
#endif
#pragma unroll
        for (int ai = 0; ai < 2; ++ai)
#pragma unroll
            for (int m = 0; m < 4; ++m) { const size_t roff = (size_t)(row0 + ai * HALF + m * 16) * D_MODEL + col0;
#if MOE_FP8
                u32x4 w;
#pragma unroll
                for (int bj = 0; bj < 2; ++bj)
#pragma unroll
                    for (int n = 0; n < 2; ++n) { const f32x4 v = acc[ai][bj][m][n]; w[2 * bj + n] = pk4_fp8(a_med3(v[0], c_lo, c_hi), a_med3(v[1], c_lo, c_hi), a_med3(v[2], c_lo, c_hi), a_med3(v[3], c_lo, c_hi)); }
                PG8_ST(u32x4, (GAS unsigned char*)Y + roff, w); }
#else
#pragma unroll
                for (int bj = 0; bj < 2; ++bj) { const f32x4 v0 = acc[ai][bj][m][0], v1 = acc[ai][bj][m][1];
                    u32x4 w; w.x = cvt_pk_bf16(v0[0], v0[1]); w.y = cvt_pk_bf16(v0[2], v0[3]); w.z = cvt_pk_bf16(v1[0], v1[1]); w.w = cvt_pk_bf16(v1[2], v1[3]);
                    *(GAS u32x4*)((GAS bf16_t*)Y + roff + bj * HALF) = w; } }
#endif
    }
};

template <class Epi, class Sched, bool GATHER, bool FP8 = false>
__device__ __forceinline__ void gemm_phase(LAS unsigned char* lds, const bf16_t* A, const bf16_t* Bt, const int K_, const int* __restrict__ rowidx, const Sched& S, const Epi& E, const int wv, int sclA = 0x7f7f7f7f, int sclB = 0x7f7f7f7f, int sclB1 = 0x7f7f7f7f, int krep = 1, int erep = 1, int stagger = 0) {
    int Kh_ = K_; asm volatile("" : "+s"(Kh_)); const int K = Kh_;
    asm volatile("" : "+v"(sclA), "+v"(sclB), "+v"(sclB1));
    const int tid_ = tid_of(wv);
    const int tid = tid_, wid = __builtin_amdgcn_readfirstlane(tid >> 6), lane = tid & 63, wr = wid >> 2, wc = wid & 3, fr = lane & 15, fq = lane >> 4;
    const int nt = K / BK;
    unsigned voffB[2]; unsigned oc0[2], oc1[2];
    LAS unsigned* gnx = (LAS unsigned*)(lds + MISC_OFF + MI_REC * 4) + tid * 4;
    const size_t kstep = (size_t)(BK * 2);
    const size_t hstep = (size_t)HALF * K * 2;
    const size_t tstep = 2 * hstep;
    const size_t bhstep = Epi::PERM16 ? (size_t)8 * K * 2 : hstep;
#pragma unroll
    for (int i = 0; i < 2; ++i) { int R, C; stage_rc(tid * 16 + i * 8192, R, C); const int Rb = Epi::PERM16 ? perm16x(R) : Epi::PERM ? ((R & ~31) + perm32(R & 31)) : R;
        oc0[i] = (unsigned)(R * K + C) * 2u; oc1[i] = oc0[i] + (unsigned)hstep;
        voffB[i] = (unsigned)(Rb * K + C) * 2u; }
    const unsigned ldsw = (unsigned)wid * 1024u;
    const int aoff = lds_byte(wr * 64 + fr, fq * 8), boff = lds_byte(wc * 32 + fr, fq * 8);
#define PG8_SA(b, h) (((b) * 2 + (h)) * HTB)
#define PG8_SB(b, h) ((4 + (b) * 2 + (h)) * HTB)
#define PG8_STAGE(bufoff, gbase, voff) do { _Pragma("unroll") for (int _i = 0; _i < 2; ++_i) { unsigned keep_; \
        asm volatile("s_mov_b32 %0, m0\n\ts_mov_b32 m0, %3\n\ts_nop 0\n\tglobal_load_lds_dwordx4 %1, %2\n\ts_mov_b32 m0, %0" \
            : "=&s"(keep_) : "v"((voff)[_i]), "s"((const char*)(gbase)), "s"((unsigned)(size_t)(lds + (bufoff) + ldsw + _i * 8192)) : "memory"); } } while (0)
#define PG8_RD8(p) __builtin_shufflevector(*(const LAS i32x4*)(p), *(const LAS i32x4*)((p) + 1024), 0, 1, 2, 3, 4, 5, 6, 7)
#define PG8_LDA(dst, b, h) do { if constexpr (FP8) { _Pragma("unroll") for (int m = 0; m < 4; ++m) dst##8[m] = PG8_RD8(lds + PG8_SA(b, h) + aoff + m * 2048); } \
        else { _Pragma("unroll") for (int m = 0; m < 4; ++m) _Pragma("unroll") for (int k = 0; k < 2; ++k) dst[m][k] = *(const LAS bf16x8*)(lds + PG8_SA(b, h) + aoff + m * 2048 + k * 1024); } } while (0)
#define PG8_LDB(dst, b, h) do { if constexpr (FP8) { _Pragma("unroll") for (int n = 0; n < 2; ++n) dst##8[n] = PG8_RD8(lds + PG8_SB(b, h) + boff + n * 2048); } \
        else { _Pragma("unroll") for (int n = 0; n < 2; ++n) _Pragma("unroll") for (int k = 0; k < 2; ++k) dst[n][k] = *(const LAS bf16x8*)(lds + PG8_SB(b, h) + boff + n * 2048 + k * 1024); } } while (0)
#define PG8_MMA(ai, bj, At, Bt_) do { __builtin_amdgcn_s_setprio(1); _Pragma("unroll") for (int m = 0; m < 4; ++m) _Pragma("unroll") for (int n = 0; n < 2; ++n) { \
        if constexpr (FP8) asm volatile("v_mfma_scale_f32_16x16x128_f8f6f4 %0, %1, %2, %0, %3, %4 op_sel_hi:[0,0,0]" : "+v"(acc[ai][bj][m][n]) : "v"(Bt_##8[n]), "v"(At##8[m]), "v"((bj) ? sclB1 : sclB), "v"(sclA));   \
        else { _Pragma("unroll") for (int k = 0; k < 2; ++k) acc[ai][bj][m][n] = __builtin_amdgcn_mfma_f32_16x16x32_bf16(Bt_[n][k], At[m][k], acc[ai][bj][m][n], 0, 0, 0); } } \
        __builtin_amdgcn_s_setprio(0); } while (0)
#define PG8_WAIT_V(n) asm volatile("s_waitcnt vmcnt(" #n ")" ::: "memory")
#define PG8_WAIT_VN(N) asm volatile("s_waitcnt vmcnt(%0)" :: "n"(N) : "memory")
#define PG8_WAIT_RX() do { if (rx) PG8_WAIT_VN(8 + Epi::NST); else PG8_WAIT_V(8); } while (0)
#define PG8_WAIT_L(n) asm volatile("s_waitcnt lgkmcnt(" #n ")" ::: "memory")
#define PG8_BAR __builtin_amdgcn_s_barrier()
#define PG8_SCHED __builtin_amdgcn_sched_barrier(0)
#define PG8_GOFF(u, g0, g1) do { const int cn_ = S.count((u).e); const GAS int* rp_ = (const GAS int*)rowidx + (size_t)(u).e * 65536 + (u).blk * 256; \
        _Pragma("unroll") for (int i_ = 0; i_ < 2; ++i_) { int r0_, c0_; stage_rc(tid * 16 + i_ * 8192, r0_, c0_); const unsigned gc_ = (unsigned)c0_ * 2u; \
            const int t0_ = ((u).blk * 256 + r0_ < cn_) ? rp_[r0_] : 0; const int t1_ = ((u).blk * 256 + 128 + r0_ < cn_) ? rp_[128 + r0_] : 0; \
            g0[i_] = (unsigned)t0_ * (unsigned)(K * 2) + gc_; g1[i_] = (unsigned)t1_ * (unsigned)(K * 2) + gc_; asm volatile("" : "+v"(g0[i_]), "+v"(g1[i_])); } } while (0)
    Unit cur, nxt; int ui = 0;
    if (!S.next(0, cur)) return;
    for (int sgi = 0; sgi < stagger * ((int)(blockIdx.x >> 3) & 3); ++sgi) __builtin_amdgcn_s_sleep(1);
    f32x4 acc[2][2][4][2];
    { typename Epi::Pre p0; E.pre(p0, cur, wc, fq); E.fill(acc, p0); }
    bf16x8 At[4][2], B0[2][2], B1[2][2]; v8i At8[4], B08[2], B18[2];
    if constexpr (GATHER) { PG8_GOFF(cur, oc0, oc1); gnx[0] = oc0[0]; gnx[1] = oc0[1]; gnx[2] = oc1[0]; gnx[3] = oc1[1]; }
    const char* cA = GATHER ? (const char*)A : (const char*)A + (size_t)cur.pm * tstep; const char* cB = (const char*)Bt + (size_t)cur.bt * tstep;
    PG8_STAGE(PG8_SB(0, 0), cB, voffB); PG8_STAGE(PG8_SB(0, 1), cB + bhstep, voffB); PG8_STAGE(PG8_SA(0, 0), cA, oc0); PG8_STAGE(PG8_SA(0, 1), cA, oc1);
    if (wr == 1) PG8_BAR;
    PG8_WAIT_V(2); PG8_BAR;
    PG8_STAGE(PG8_SB(1, 0), cB + kstep, voffB); PG8_STAGE(PG8_SA(1, 0), cA + kstep, oc0); PG8_STAGE(PG8_SB(1, 1), cB + bhstep + kstep, voffB);
    PG8_WAIT_V(6); PG8_BAR;
    for (;;) {
        const bool has_next = S.next(ui + 1, nxt);
        int ix0 = 0, ix1 = 0, ix2 = 0, ix3 = 0;
        if constexpr (GATHER) { if (has_next) { const char* rp_ = (const char*)rowidx + ((size_t)nxt.e * 65536 + (size_t)nxt.blk * 256) * 4;
            int ra, rb_, cdum; stage_rc(tid * 16, ra, cdum); stage_rc(tid * 16 + 8192, rb_, cdum);
            asm volatile("global_load_dword %0, %4, %6\n\tglobal_load_dword %1, %4, %6 offset:512\n\tglobal_load_dword %2, %5, %6\n\tglobal_load_dword %3, %5, %6 offset:512"
                         : "=&v"(ix0), "=&v"(ix1), "=&v"(ix2), "=&v"(ix3) : "v"(ra * 4), "v"(rb_ * 4), "s"(rp_) : "memory"); } }
        const char* nA = GATHER ? (const char*)A : (has_next ? (const char*)A + (size_t)nxt.pm * tstep : cA); const char* nB = has_next ? (const char*)Bt + (size_t)nxt.bt * tstep : cB;
#pragma unroll 1
        for (int kk = 0; kk < krep; ++kk)
        for (int t = 0; t < nt; t += 2) {
            const bool last = (t == nt - 2);
            const bool fin = (kk == krep - 1);
            const char* a1 = cA + (size_t)(t + 1) * kstep;
            const char* a2 = last ? (fin ? nA : cA) : cA + (size_t)(t + 2) * kstep; const char* b2 = last ? (fin ? nB : cB) : cB + (size_t)(t + 2) * kstep;
            const char* a3 = a2 + kstep; const char* b3 = b2 + kstep;
            unsigned s0[2], s1[2];
#pragma unroll
            for (int i = 0; i < 2; ++i) { s0[i] = oc0[i]; s1[i] = oc1[i]; }
            if constexpr (GATHER) { if (t == 2 && kk == 0 && has_next) {
                    const int cn_ = S.count(nxt.e); int ra, rb_, ca, cb; stage_rc(tid * 16, ra, ca); stage_rc(tid * 16 + 8192, rb_, cb); const int b0_ = nxt.blk * 256;
                    gnx[0] = (unsigned)((b0_ + ra < cn_) ? ix0 : 0) * (unsigned)(K * 2) + (unsigned)ca * 2u; gnx[2] = (unsigned)((b0_ + 128 + ra < cn_) ? ix1 : 0) * (unsigned)(K * 2) + (unsigned)ca * 2u;
                    gnx[1] = (unsigned)((b0_ + rb_ < cn_) ? ix2 : 0) * (unsigned)(K * 2) + (unsigned)cb * 2u; gnx[3] = (unsigned)((b0_ + 128 + rb_ < cn_) ? ix3 : 0) * (unsigned)(K * 2) + (unsigned)cb * 2u; }
                if (last && fin) { s0[0] = gnx[0]; s0[1] = gnx[1]; s1[0] = gnx[2]; s1[1] = gnx[3]; } }
            const bool rx = Epi::RELAX && (erep == 1) && ui > 0 && t == 0 && kk == 0;
            PG8_LDB(B0, 0, 0); PG8_LDB(B1, 0, 1); PG8_SCHED; PG8_LDA(At, 0, 0); if (!rx) PG8_STAGE(PG8_SA(1, 1), a1, oc1);
            PG8_WAIT_RX(); PG8_WAIT_L(0); PG8_BAR; PG8_MMA(0, 0, At, B0); PG8_MMA(0, 1, At, B1); PG8_BAR; PG8_SCHED;
            PG8_LDA(At, 0, 1); PG8_STAGE(PG8_SB(0, 0), b2, voffB); PG8_STAGE(PG8_SB(0, 1), b2 + bhstep, voffB); PG8_STAGE(PG8_SA(0, 0), a2, s0);
            PG8_WAIT_RX(); PG8_WAIT_L(0); PG8_BAR; PG8_MMA(1, 0, At, B0); PG8_MMA(1, 1, At, B1); PG8_BAR; PG8_SCHED;
            PG8_LDB(B0, 1, 0); PG8_LDB(B1, 1, 1); PG8_SCHED; PG8_LDA(At, 1, 0); PG8_STAGE(PG8_SA(0, 1), a2, s1);
            PG8_WAIT_RX(); PG8_WAIT_L(0); PG8_BAR; PG8_MMA(0, 0, At, B0); PG8_MMA(0, 1, At, B1); PG8_BAR; PG8_SCHED;
            PG8_LDA(At, 1, 1); PG8_STAGE(PG8_SB(1, 0), b3, voffB); PG8_STAGE(PG8_SB(1, 1), b3 + bhstep, voffB); PG8_STAGE(PG8_SA(1, 0), a3, s0);
            PG8_WAIT_V(8); PG8_WAIT_L(0); PG8_BAR; PG8_MMA(1, 0, At, B0); PG8_MMA(1, 1, At, B1); PG8_BAR; PG8_SCHED;
        }
        if (wr == 0) PG8_BAR;
        const bool pre_st = Epi::RELAX && has_next && erep == 1;
        if (pre_st) { if constexpr (GATHER) { unsigned q1[2]; q1[0] = gnx[2]; q1[1] = gnx[3]; PG8_STAGE(PG8_SA(1, 1), nA + kstep, q1); } else PG8_STAGE(PG8_SA(1, 1), nA + kstep, oc1); }
        if constexpr (FP8) asm volatile("s_nop 15\n\ts_nop 15" ::: "memory");
        Unit pu; pu.pm = has_next ? nxt.pm : cur.pm; pu.pn = has_next ? nxt.pn : cur.pn; pu.bt = has_next ? nxt.bt : cur.bt; pu.e = has_next ? nxt.e : cur.e; pu.blk = has_next ? nxt.blk : cur.blk;
        typename Epi::Pre pn; E.pre(pn, pu, wc, fq);
#pragma unroll 1
        for (int er = 0; er < erep; ++er) { E(acc, cur, wr, wc, fr, fq); asm volatile("" ::: "memory"); }
        if (!has_next) break;
        E.fill(acc, pn);
        cur = nxt; cA = nA; cB = nB; ++ui;
        if constexpr (GATHER) { oc0[0] = gnx[0]; oc0[1] = gnx[1]; oc1[0] = gnx[2]; oc1[1] = gnx[3]; }
        if (wr == 1) PG8_BAR;
    }
    PG8_WAIT_V(0);
    PG8_BAR;
#undef PG8_SA
#undef PG8_SB
#undef PG8_STAGE
#undef PG8_LDA
#undef PG8_LDB
#undef PG8_MMA
#undef PG8_RD8
#undef PG8_WAIT_V
#undef PG8_WAIT_VN
#undef PG8_WAIT_RX
#undef PG8_WAIT_L
#undef PG8_BAR
#undef PG8_SCHED
#undef PG8_GOFF
}
}
namespace att {
#define ATT_SBAR() __builtin_amdgcn_sched_barrier(0)
constexpr float THR = 8.f;
__device__ __forceinline__ int crow(int r, int hi) { return (r & 3) + 8 * (r >> 2) + 4 * hi; }
__device__ __forceinline__ unsigned cvtpk(float lo, float hi) { unsigned r; asm volatile("v_cvt_pk_bf16_f32 %0, %1, %2" : "=v"(r) : "v"(lo), "v"(hi)); return r; }

__device__ __forceinline__ void partialSM(f32x16& p0, f32x16& p1, float& m_reg, float& alpha) {
  float pmax = p0[0];
#pragma unroll
  for (int r = 1; r < 16; ++r) pmax = fmaxf(pmax, p0[r]);
#pragma unroll
  for (int r = 0; r < 16; ++r) pmax = fmaxf(pmax, p1[r]);
  { float r0, r1; half_swap(pmax, r0, r1); pmax = fmaxf(r0, r1); }
  float mn;
  if (__builtin_expect(__all(pmax - m_reg <= THR), 1)) { mn = m_reg; alpha = 1.f; }
  else { mn = fmaxf(m_reg, pmax); alpha = __builtin_amdgcn_exp2f(m_reg - mn); m_reg = mn; }
#pragma unroll
  for (int r = 0; r < 16; ++r) { p0[r] = __builtin_amdgcn_exp2f(p0[r] - mn); p1[r] = __builtin_amdgcn_exp2f(p1[r] - mn); }
}
__device__ __forceinline__ void finishSM(const f32x16& p0, const f32x16& p1, float alpha, float& l_reg, bf16x8& pa0, bf16x8& pa1, bf16x8& pa2, bf16x8& pa3) {
  float ps = 0;
#pragma unroll
  for (int r = 0; r < 16; ++r) ps += p0[r];
#pragma unroll
  for (int r = 0; r < 16; ++r) ps += p1[r];
  { float r0, r1; half_swap(ps, r0, r1); ps = r0 + r1; }
  l_reg = l_reg * alpha + ps;
#define ATT_PK4(P, BASE, OUT) do { unsigned a0 = cvtpk(P[BASE + 0], P[BASE + 1]), a1 = cvtpk(P[BASE + 2], P[BASE + 3]);   \
    unsigned b0 = cvtpk(P[BASE + 4], P[BASE + 5]), b1 = cvtpk(P[BASE + 6], P[BASE + 7]);                              \
    unsigned r00, r01, r10, r11; plswap(a0, b0, r00, r01); plswap(a1, b1, r10, r11); \
    u32x4 w = {r00, r10, r01, r11}; OUT = __builtin_bit_cast(bf16x8, w); } while (0)
  ATT_PK4(p0, 0, pa0); ATT_PK4(p0, 8, pa1); ATT_PK4(p1, 0, pa2); ATT_PK4(p1, 8, pa3);
#undef ATT_PK4
}
__device__ __forceinline__ int v_st(int k, int c) { const int kk = (k & ~0xC) | ((k & 4) << 1) | ((k & 8) >> 1); return ((kk >> 3) * 4 + (c >> 5)) * 512 + ((kk & 7) * 32 + (c & 31)) * 2; }
__device__ __forceinline__ int v_rd_base(int lane) { return ((lane & 3) << 3) | (((lane >> 2) & 3) << 6) | (((lane >> 4) & 1) << 5) | (((lane >> 5) & 1) << 8); }
constexpr int v_rd_off(int d0, int ks, int half) { return d0 * 512 + ks * 4096 + half * 2048; }
template <int OFF> __device__ __forceinline__ s16x4 tr_read(int vb) {
  s16x4 r; asm volatile("ds_read_b64_tr_b16 %0, %1 offset:%2" : "=&v"(r) : "v"(vb), "i"(OFF) : "memory"); return r;
}
template <int D0> __device__ __forceinline__ void pv_one(f32x16& od, int vb, bf16x8 pa0, bf16x8 pa1, bf16x8 pa2, bf16x8 pa3) {
  const s16x4 l0 = tr_read<v_rd_off(D0, 0, 0)>(vb), h0 = tr_read<v_rd_off(D0, 0, 1)>(vb), l1 = tr_read<v_rd_off(D0, 1, 0)>(vb), h1 = tr_read<v_rd_off(D0, 1, 1)>(vb);
  const s16x4 l2 = tr_read<v_rd_off(D0, 2, 0)>(vb), h2 = tr_read<v_rd_off(D0, 2, 1)>(vb), l3 = tr_read<v_rd_off(D0, 3, 0)>(vb), h3 = tr_read<v_rd_off(D0, 3, 1)>(vb);
  asm volatile("s_waitcnt lgkmcnt(0)" ::: "memory"); ATT_SBAR();
#define ATT_PK(L, H) (bf16x8){L[0], L[1], L[2], L[3], H[0], H[1], H[2], H[3]}
  od = __builtin_amdgcn_mfma_f32_32x32x16_bf16(pa0, ATT_PK(l0, h0), od, 0, 0, 0);
  od = __builtin_amdgcn_mfma_f32_32x32x16_bf16(pa1, ATT_PK(l1, h1), od, 0, 0, 0);
  od = __builtin_amdgcn_mfma_f32_32x32x16_bf16(pa2, ATT_PK(l2, h2), od, 0, 0, 0);
  od = __builtin_amdgcn_mfma_f32_32x32x16_bf16(pa3, ATT_PK(l3, h3), od, 0, 0, 0);
#undef ATT_PK
}
constexpr int ATT_LDS_V = 0, ATT_LDS_K = 32768, ATT_LDS_WS = 65536, ATT_LDS_CORE = 65536 + 2048;
template <int DQK, bool MASKED, bool KVSAME>
__device__ __forceinline__ void attn_core(const GAS bf16_t* __restrict__ Qrow0, int ldq, const GAS bf16_t* __restrict__ Kh, int ldk, const GAS bf16_t* __restrict__ Vh, int ldv,
                                          int NTB, int NTW, float slope2, int tq0, const LAS unsigned long long* mask, LAS char* lds, f32x16 (&o)[4], float& l_out, const int wv) {
  static_assert(DQK == 64 || DQK == 128, "DQK"); static_assert(!KVSAME || DQK == 128, "KVSAME needs DQK 128");
  constexpr int KROWB = DQK * 2, KBUF = 64 * KROWB, ND0 = DQK / 16;
  const int tid_ = tid_of(wv);
  const int tid = tid_, wid = tid >> 6, lane = tid & 63, r32 = lane & 31, hi = lane >> 5;
  LAS char* V_lds = lds + ATT_LDS_V; LAS char* K_lds = lds + ATT_LDS_K;
  LAS float* wsf = (LAS float*)(lds + ATT_LDS_WS) + wid * 64; LAS float* al_l = wsf + 32;
  float m_reg = -1e30f, l_reg = 0.f;
#pragma unroll
  for (int d = 0; d < 4; ++d) o[d] = f32x16{};
  bf16x8 qr[ND0];
  { const GAS bf16_t* Qp = Qrow0 + (size_t)r32 * ldq + hi * 8;
#pragma unroll
    for (int d0 = 0; d0 < ND0; ++d0) qr[d0] = *(const GAS bf16x8*)(Qp + d0 * 16); }
  const int sr = tid >> 4, sc = (tid & 15) * 8, vst0 = v_st(sr, sc), vst1 = v_st(32 + sr, sc);
  const int kr = tid >> 3, kc = (tid & 7) * 8;
  const int vb0 = (int)(unsigned)(size_t)V_lds + v_rd_base(lane);
  bf16x8 vs0, vs1, ks0, ks1, wv0, wv1, wk0, wk1;
#define ATT_KSWZ(row, colB) ((row) * KROWB + ((colB) ^ (((row) & 7) << 4)))
#define ATT_SLOADX(k0, vs0, vs1, ks0, ks1) do { vs0 = *(const GAS bf16x8*)(&Vh[(size_t)((k0) + sr) * ldv + sc]); vs1 = *(const GAS bf16x8*)(&Vh[(size_t)((k0) + 32 + sr) * ldv + sc]); \
    if constexpr (!KVSAME) { if constexpr (DQK == 128) { ks0 = *(const GAS bf16x8*)(&Kh[(size_t)((k0) + sr) * ldk + sc]); ks1 = *(const GAS bf16x8*)(&Kh[(size_t)((k0) + 32 + sr) * ldk + sc]); } \
                             else { ks0 = *(const GAS bf16x8*)(&Kh[(size_t)((k0) + kr) * ldk + kc]); } } } while (0)
#define ATT_SLOAD(k0) ATT_SLOADX(k0, vs0, vs1, ks0, ks1)
#define ATT_SLOADB(k0) ATT_SLOADX(k0, wv0, wv1, wk0, wk1)
#define ATT_SWRITEX(b, vs0, vs1, ks0, ks1) do { *(LAS bf16x8*)(V_lds + (b) * 16384 + vst0) = vs0; *(LAS bf16x8*)(V_lds + (b) * 16384 + vst1) = vs1; \
    if constexpr (KVSAME) { *(LAS bf16x8*)(K_lds + (b) * KBUF + ATT_KSWZ(sr, sc * 2)) = vs0; *(LAS bf16x8*)(K_lds + (b) * KBUF + ATT_KSWZ(32 + sr, sc * 2)) = vs1; } \
    else if constexpr (DQK == 128) { *(LAS bf16x8*)(K_lds + (b) * KBUF + ATT_KSWZ(sr, sc * 2)) = ks0; *(LAS bf16x8*)(K_lds + (b) * KBUF + ATT_KSWZ(32 + sr, sc * 2)) = ks1; } \
    else { *(LAS bf16x8*)(K_lds + (b) * KBUF + ATT_KSWZ(kr, kc * 2)) = ks0; } } while (0)
#define ATT_SWRITE(b) ATT_SWRITEX(b, vs0, vs1, ks0, ks1)
#define ATT_SWRITEB(b) ATT_SWRITEX(b, wv0, wv1, wk0, wk1)
  constexpr bool SD2 = false;
  ATT_SLOAD((NTB - 1) * 64); ATT_SWRITE(0);
  if constexpr (SD2) { if (NTB > 1) ATT_SLOADB((NTB - 2) * 64); if (NTB > 2) ATT_SLOAD((NTB - 3) * 64); }
  __syncthreads();
  float m_ref = 0.f;
  const int jdiag = tq0 >> 6;
  for (int jj = 0; jj < NTB; ++jj) {
    const int j = NTB - 1 - jj, buf = jj & 1;
    if constexpr (!SD2) { if (j > 0) ATT_SLOAD((j - 1) * 64); }
    if (j < NTW) {
      f32x16 p0, p1;
      unsigned mlo = 0xffffffffu, mhi = 0xffffffffu;
      if constexpr (MASKED) { const unsigned long long mw = mask[j * 32 + r32]; mlo = (unsigned)mw >> (4 * hi); mhi = (unsigned)(mw >> 32) >> (4 * hi); }
      if (j == jdiag) {
        const float x = (float)(tq0 + r32 - j * 64 - 4 * hi);
#pragma unroll
        for (int r = 0; r < 16; ++r) { const int cr = (r & 3) + 8 * (r >> 2); const float d = x - (float)cr; p0[r] = -slope2 * fabsf(d) - m_ref; p1[r] = -slope2 * fabsf(d - 32.f) - m_ref; }
      } else {
        const float b0 = slope2 * (float)(j * 64 + 4 * hi - tq0 - r32) - m_ref, s2 = slope2 + slope2, s3 = s2 + slope2, s8 = 8.f * slope2, s32 = 32.f * slope2;
        float bg = b0;
#pragma unroll
        for (int g = 0; g < 4; ++g) { p0[4 * g] = bg; p0[4 * g + 1] = bg + slope2; p0[4 * g + 2] = bg + s2; p0[4 * g + 3] = bg + s3; bg += s8; }
#pragma unroll
        for (int r = 0; r < 16; ++r) p1[r] = p0[r] + s32;
      }
      if constexpr (MASKED) {
#pragma unroll
        for (int r = 0; r < 16; ++r) { const int cr = (r & 3) + 8 * (r >> 2);
          if (!((mlo >> cr) & 1u)) p0[r] = -INFINITY; if (!((mhi >> cr) & 1u)) p1[r] = -INFINITY; }
      }
      { const LAS char* Kb = K_lds + buf * KBUF;
#pragma unroll
        for (int d0 = 0; d0 < ND0; ++d0) { const int cb = (d0 * 16 + hi * 8) * 2;
          const bf16x8 b0 = *(const LAS bf16x8*)(Kb + ATT_KSWZ(r32, cb));
          const bf16x8 b1 = *(const LAS bf16x8*)(Kb + ATT_KSWZ(32 + r32, cb));
          p0 = __builtin_amdgcn_mfma_f32_32x32x16_bf16(b0, qr[d0], p0, 0, 0, 0);
          p1 = __builtin_amdgcn_mfma_f32_32x32x16_bf16(b1, qr[d0], p1, 0, 0, 0); } }
      float pmax = fmaxf(p0[0], p1[0]);
      asm("v_max3_f32 %0, %0, %1, %2\n\tv_max3_f32 %0, %0, %3, %4\n\tv_max3_f32 %0, %0, %5, %6\n\tv_max3_f32 %0, %0, %7, %8\n\tv_max3_f32 %0, %0, %9, %10\n\tv_max3_f32 %0, %0, %11, %12\n\tv_max3_f32 %0, %0, %13, %14\n\tv_max3_f32 %0, %0, %15, %16"
          : "+v"(pmax) : "v"(p0[1]), "v"(p1[1]), "v"(p0[2]), "v"(p1[2]), "v"(p0[3]), "v"(p1[3]), "v"(p0[4]), "v"(p1[4]), "v"(p0[5]), "v"(p1[5]), "v"(p0[6]), "v"(p1[6]), "v"(p0[7]), "v"(p1[7]), "v"(p0[8]), "v"(p1[8]));
      asm("v_max3_f32 %0, %0, %1, %2\n\tv_max3_f32 %0, %0, %3, %4\n\tv_max3_f32 %0, %0, %5, %6\n\tv_max3_f32 %0, %0, %7, %8\n\tv_max3_f32 %0, %0, %9, %10\n\tv_max3_f32 %0, %0, %11, %12\n\tv_max3_f32 %0, %0, %13, %14"
          : "+v"(pmax) : "v"(p0[9]), "v"(p1[9]), "v"(p0[10]), "v"(p1[10]), "v"(p0[11]), "v"(p1[11]), "v"(p0[12]), "v"(p1[12]), "v"(p0[13]), "v"(p1[13]), "v"(p0[14]), "v"(p1[14]), "v"(p0[15]), "v"(p1[15]));
      { float r0, r1; half_swap(pmax, r0, r1); asm("v_max_f32 %0, %1, %2" : "=v"(pmax) : "v"(r0), "v"(r1)); }
      const bool first = (j == NTW - 1);
      if (first || __any(pmax > THR)) {
        const float dl = first ? ((pmax > -1e30f) ? pmax : 0.f) : fmaxf(pmax, 0.f);
        m_ref += dl; const float alpha = __builtin_amdgcn_exp2f(-dl); l_reg *= alpha;
#pragma unroll
        for (int r = 0; r < 16; ++r) { p0[r] -= dl; p1[r] -= dl; }
        if (!first) { if (hi == 0) al_l[r32] = alpha; asm volatile("s_waitcnt lgkmcnt(0)" ::: "memory");
#pragma unroll
          for (int d = 0; d < 4; ++d)
#pragma unroll
            for (int r = 0; r < 16; ++r) o[d][r] *= al_l[crow(r, hi)]; }
      }
#pragma unroll
      for (int r = 0; r < 16; ++r) { p0[r] = __builtin_amdgcn_exp2f(p0[r]); p1[r] = __builtin_amdgcn_exp2f(p1[r]); }
      bf16x8 pa0, pa1, pa2, pa3;
      finishSM(p0, p1, 1.f, l_reg, pa0, pa1, pa2, pa3); ATT_SBAR();
      const int vb = vb0 + buf * 16384;
      pv_one<0>(o[0], vb, pa0, pa1, pa2, pa3); pv_one<1>(o[1], vb, pa0, pa1, pa2, pa3); pv_one<2>(o[2], vb, pa0, pa1, pa2, pa3); pv_one<3>(o[3], vb, pa0, pa1, pa2, pa3);
    }
    if constexpr (!SD2) { if (j > 0) ATT_SWRITE(buf ^ 1); }
    else { if (j > 0) { if ((jj + 1) & 1) ATT_SWRITEB(buf ^ 1); else ATT_SWRITE(buf ^ 1); }
           if (j > 2) { if ((jj + 1) & 1) ATT_SLOADB((j - 3) * 64); else ATT_SLOAD((j - 3) * 64); } }
    __syncthreads();
  }
  l_out = l_reg;
#undef ATT_KSWZ
#undef ATT_SLOAD
#undef ATT_SWRITE
#undef ATT_SLOADB
#undef ATT_SWRITEB
#undef ATT_SLOADX
#undef ATT_SWRITEX
}
__device__ __forceinline__ void row_rcp(float l_reg, LAS char* lds, float (&rli)[16], const int wv) {
  const int tid_ = tid_of(wv);
  const int tid = tid_, wid = tid >> 6, lane = tid & 63, r32 = lane & 31, hi = lane >> 5;
  LAS float* li_l = (LAS float*)(lds + ATT_LDS_WS) + wid * 64;
  if (hi == 0) li_l[r32] = l_reg; asm volatile("s_waitcnt lgkmcnt(0)" ::: "memory");
#pragma unroll
  for (int r = 0; r < 16; ++r) rli[r] = __builtin_amdgcn_rcpf(li_l[crow(r, hi)]);
}
}
#define XB_TMO      128
#define XB_XCNT(j)  (256  + 64 * (j))
#define XB_XSUB(j)  (1280 + 64 * (j))
#define XB_XGEN(j)  (2304 + 64 * (j))
#define XB_TOP      3328
#define XB_TOPGEN   3392
#define XCD_BAR_WORDS 3456
#define XB_SPIN_CAP (1u << 18)

__device__ __forceinline__ unsigned xb_ld(unsigned* p)              { return __hip_atomic_load(p, __ATOMIC_RELAXED, __HIP_MEMORY_SCOPE_AGENT); }
__device__ __forceinline__ unsigned xb_add(unsigned* p, unsigned v) { return __hip_atomic_fetch_add(p, v, __ATOMIC_RELAXED, __HIP_MEMORY_SCOPE_AGENT); }
__device__ __forceinline__ unsigned xb_xcc_id() { return (unsigned)__builtin_amdgcn_s_getreg((3 << 11) | 20) & 0xFu; }
#define XB_SPIN(cond, bar) do { unsigned _sp = 0; while (cond) { __builtin_amdgcn_s_sleep(1); \
    if ((++_sp & 255u) == 0u) { if (xb_ld(&(bar)[XB_TMO])) break; if (_sp > XB_SPIN_CAP) { atomicAdd(&(bar)[XB_TMO], 1u); break; } } } } while (0)

struct XcdBarrier {
    unsigned* bar; unsigned x; unsigned w;
    volatile LAS unsigned* st;
};

__device__ __forceinline__ XcdBarrier xcd_barrier_post(unsigned* bar, volatile LAS unsigned* st) {
    XcdBarrier b; b.bar = bar; b.x = xb_xcc_id(); b.st = st; b.w = (unsigned)__builtin_amdgcn_readfirstlane((int)(threadIdx.x >> 6));
    if (threadIdx.x == 0) (void)xb_add(&bar[XB_XCNT(b.x)], 1u);
    return b;
}
__device__ __forceinline__ void xcd_barrier_complete(unsigned* bar, unsigned x, unsigned& nloc, unsigned& nx) {
    const unsigned G = gridDim.x * gridDim.y * gridDim.z;
    unsigned sum, cnt, mine, sp = 0u;
    for (;;) {
        sum = 0u; cnt = 0u; mine = 0u;
#pragma unroll
        for (unsigned j = 0; j < 16; ++j) { const unsigned c = xb_ld(&bar[XB_XCNT(j)]); sum += c; cnt += (c > 0u) ? 1u : 0u; mine = (j == x) ? c : mine; }
        if (sum == G) break;
        __builtin_amdgcn_s_sleep(1);
        if ((++sp & 255u) == 0u) { if (xb_ld(&bar[XB_TMO])) break; if (sp > XB_SPIN_CAP) { atomicAdd(&bar[XB_TMO], 1u); break; } }
    }
    nloc = mine > 0u ? mine : 1u; nx = cnt > 0u ? cnt : 1u;
}

__device__ __forceinline__ void xcd_barrier(const XcdBarrier& b) {
    asm volatile("s_waitcnt vmcnt(0)" ::: "memory");
    __syncthreads();
    if (b.w == 0u && lane_id() == 0) {
        unsigned* bar = b.bar;
        __builtin_amdgcn_s_waitcnt(0);
        unsigned nloc = b.st[0], nx = b.st[1];
        if (nloc == 0u) { xcd_barrier_complete(bar, b.x, nloc, nx); b.st[0] = nloc; b.st[1] = nx; }
        const unsigned old = xb_add(&bar[XB_XSUB(b.x)], 1u);
        const unsigned gen = old / nloc;
        if (old + 1u == (gen + 1u) * nloc) {
            __builtin_amdgcn_fence(__ATOMIC_RELEASE, "agent");
            asm volatile("s_waitcnt vmcnt(0)" ::: "memory");
            const unsigned og = xb_add(&bar[XB_TOP], 1u);
            const unsigned tg = og / nx;
            if (og + 1u == (tg + 1u) * nx) xb_add(&bar[XB_TOPGEN], 1u);
            else XB_SPIN(xb_ld(&bar[XB_TOPGEN]) == tg, bar);
            __builtin_amdgcn_fence(__ATOMIC_ACQUIRE, "agent");
            xb_add(&bar[XB_XGEN(b.x)], 1u);
            asm volatile("s_waitcnt vmcnt(0)" ::: "memory");
        } else {
            XB_SPIN(xb_ld(&bar[XB_XGEN(b.x)]) == gen, bar);
            __builtin_amdgcn_fence(__ATOMIC_ACQUIRE, "agent");
            asm volatile("s_waitcnt vmcnt(0)" ::: "memory");
        }
    }
    __syncthreads();
}
struct Args { const float* in[32]; float* out; unsigned char* ws; int l_lo, l_hi, p_lo, p_hi, do_pro, fused; };
enum { I_X = 0, I_EV_W_IN, I_EV_Q_NORM, I_EV_KV_NORM, I_EV_W_UQ, I_EV_W_UK, I_EV_W_UV, I_EV_W_IQ, I_EV_IDX_K_G, I_EV_IDX_K_B, I_EV_V_NORM_G, I_EV_V_NORM_B, I_EV_W_S, I_EV_B_S, I_EV_W_OUT,
       I_OD_W_IN, I_OD_LQ1, I_OD_LK1, I_OD_LQ2, I_OD_LK2, I_OD_SUBLN_G, I_OD_W_OUT, I_LN1_G, I_LN1_B, I_LN2_G, I_LN2_B, I_ROUTER_W, I_ROUTER_B, I_EXP_W_GU, I_EXP_B_GU, I_EXP_W_DN, I_EXP_B_DN };
struct Frame {
    LAS unsigned char* lds; char* ldsg; volatile LAS int* MISC; gu32* ctl;
    int tid, lane, wave, vcu, G;
    unsigned char* ws;
};
typedef const __attribute__((address_space(4))) Args* ArgsP;
#define WSP(T, off) ((T*)(ws_ + (off)))
#define PHASE_PROLOG() unsigned char* ws_ = F.ws; asm volatile("" : "+s"(ws_)); asm volatile("" : "+s"(a)); int vcu_ = F.vcu, G_ = F.G; asm volatile("" : "+s"(vcu_), "+s"(G_))
#define fresh_tid() tid_of(F.wave)

__device__ __forceinline__ void tr_block(const float* src, int ld, bf16_t* dst, int dld, float scale, LAS float* scr, int lane) {
#pragma unroll 8
    for (int i = 0; i < 32; ++i) { const int kk = 2 * i + (lane >> 5); scr[kk * 33 + (lane & 31)] = src[(size_t)kk * ld + (lane & 31)]; }
    LDS_WAIT(); asm volatile("" ::: "memory");
    const int c = lane & 7;
#pragma unroll
    for (int j = 0; j < 4; ++j) { const int n = (lane >> 3) + 8 * j; const LAS float* s = scr + (8 * c) * 33 + n;
        u32x4 o; o.x = pk2(s[0 * 33] * scale, s[1 * 33] * scale); o.y = pk2(s[2 * 33] * scale, s[3 * 33] * scale); o.z = pk2(s[4 * 33] * scale, s[5 * 33] * scale); o.w = pk2(s[6 * 33] * scale, s[7 * 33] * scale);
        *(GAS u32x4*)(dst + (size_t)n * dld + 8 * c) = o; }
    LDS_WAIT(); asm volatile("" ::: "memory");
}
__device__ __forceinline__ void tr_block8(const float* src, int ld, unsigned char* dst, int dld, float scale, LAS float* scr, int lane) {
#pragma unroll 8
    for (int i = 0; i < 32; ++i) { const int kk = 2 * i + (lane >> 5); scr[kk * 33 + (lane & 31)] = src[(size_t)kk * ld + (lane & 31)]; }
    LDS_WAIT(); asm volatile("" ::: "memory");
    const int n = lane >> 1, kh = (lane & 1) * 32; const LAS float* s = scr + kh * 33 + n;
#pragma unroll
    for (int j = 0; j < 2; ++j) { u32x4 o;
        o.x = pk4_fp8(s[(16 * j + 0) * 33] * scale, s[(16 * j + 1) * 33] * scale, s[(16 * j + 2) * 33] * scale, s[(16 * j + 3) * 33] * scale);
        o.y = pk4_fp8(s[(16 * j + 4) * 33] * scale, s[(16 * j + 5) * 33] * scale, s[(16 * j + 6) * 33] * scale, s[(16 * j + 7) * 33] * scale);
        o.z = pk4_fp8(s[(16 * j + 8) * 33] * scale, s[(16 * j + 9) * 33] * scale, s[(16 * j + 10) * 33] * scale, s[(16 * j + 11) * 33] * scale);
        o.w = pk4_fp8(s[(16 * j + 12) * 33] * scale, s[(16 * j + 13) * 33] * scale, s[(16 * j + 14) * 33] * scale, s[(16 * j + 15) * 33] * scale);
        *(GAS u32x4*)(dst + (size_t)n * dld + kh + 16 * j) = o; }
    LDS_WAIT(); asm volatile("" ::: "memory");
}
__device__ __forceinline__ void pro_phase(Frame& F, ArgsP a) {
    PHASE_PROLOG();
    const int ftid = fresh_tid(), flane = ftid & 63;
    LAS float* scr = (LAS float*)(F.lds + F.wave * 16384);
    const int gw = vcu_ * 8 + F.wave, NGW = G_ * 8;
    constexpr int IA = DEPTH * NEXP * 16 * 64, IB = DEPTH * NEXP * 16 * 32, IC = 2 * 16 * 46, ID = 2 * 16 * 96, IE = 2 * 16 * 32;
    for (int it = gw; it < IA + IB + IC + ID + IE; it += NGW) {
        int r = it;
        if (r < IA) { const int m = r >> 10, rem = r & 1023, kb = rem >> 6, nb = rem & 63, n0 = nb * 32;
            const int drow = 256 * ((n0 & 1023) >> 7) + 128 * (n0 >> 10) + (n0 & 127);
#if MOE_FP8
            tr_block8(a->in[I_EXP_W_GU] + (size_t)m * 1024 * 2048 + (size_t)(kb * 64) * 2048 + n0, 2048, WSP(unsigned char, WS_WGU) + ((size_t)m * 2048 + drow) * 1024 + kb * 64, 1024, 64.f, scr, flane); continue; }
#else
            tr_block(a->in[I_EXP_W_GU] + (size_t)m * 1024 * 2048 + (size_t)(kb * 64) * 2048 + n0, 2048, WSP(bf16_t, WS_WGU) + ((size_t)m * 2048 + drow) * 1024 + kb * 64, 1024, 1.f, scr, flane); continue; }
#endif
        r -= IA;
        if (r < IB) { const int m = r >> 9, rem = r & 511, kb = rem >> 5, nb = rem & 31;
#if MOE_FP8
            tr_block8(a->in[I_EXP_W_DN] + (size_t)m * 1024 * 1024 + (size_t)(kb * 64) * 1024 + nb * 32, 1024, WSP(unsigned char, WS_WDN) + ((size_t)m * 1024 + nb * 32) * 1024 + kb * 64, 1024, 64.f, scr, flane); continue; }
#else
            tr_block(a->in[I_EXP_W_DN] + (size_t)m * 1024 * 1024 + (size_t)(kb * 64) * 1024 + nb * 32, 1024, WSP(bf16_t, WS_WDN) + ((size_t)m * 1024 + nb * 32) * 1024 + kb * 64, 1024, 1.f, scr, flane); continue; }
#endif
        r -= IB;
        if (r < IC) { const int jj = r / 736, rem = r % 736, kb = rem / 46, nb = rem % 46;
            const int scol = nb < 14 ? nb * 32 : 452 + (nb - 14) * 32, drow = nb < 14 ? nb * 32 : 512 + (nb - 14) * 32;
            tr_block(a->in[I_EV_W_IN] + (size_t)jj * 1024 * E_IN_EVEN + (size_t)(kb * 64) * E_IN_EVEN + scol, E_IN_EVEN, WSP(bf16_t, WS_WINE) + ((size_t)jj * NE_PR + drow) * 1024 + kb * 64, 1024, 1.f, scr, flane); continue; }
        r -= IC;
        if (r < ID) { const int jj = r / 1536, rem = r % 1536, kb = rem / 96, nb = rem % 96;
            tr_block(a->in[I_OD_W_IN] + (size_t)jj * 1024 * NO_PR + (size_t)(kb * 64) * NO_PR + nb * 32, NO_PR, WSP(bf16_t, WS_WINO) + ((size_t)jj * NO_PR + nb * 32) * 1024 + kb * 64, 1024, nb < 32 ? 0.125f * LOG2E : 1.f, scr, flane); continue; }
        r -= ID;
        { const int jj = r / 512, rem = r % 512, kb = rem / 32, nb = rem % 32;
#if POUT_FP8
            tr_block8(a->in[I_OD_W_OUT] + (size_t)jj * 1024 * 1024 + (size_t)(kb * 64) * 1024 + nb * 32, 1024, WSP(unsigned char, WS_WOUTO) + ((size_t)jj * 1024 + nb * 32) * 1024 + kb * 64, 1024, 64.f, scr, flane); }
#else
            tr_block(a->in[I_OD_W_OUT] + (size_t)jj * 1024 * 1024 + (size_t)(kb * 64) * 1024 + nb * 32, 1024, WSP(bf16_t, WS_WOUTO) + ((size_t)jj * 1024 + nb * 32) * 1024 + kb * 64, 1024, 1.f, scr, flane); }
#endif
    }
    const int gt = vcu_ * 512 + ftid, NGT = G_ * 512;
    for (int i = gt; i < 2 * 64 * 1024; i += NGT) { const int jj = i >> 16, rr = 448 + ((i >> 10) & 63), k = i & 1023;
        const float v = rr < 452 ? a->in[I_EV_W_IN][(size_t)jj * 1024 * E_IN_EVEN + (size_t)k * E_IN_EVEN + rr] : 0.f;
        WSP(bf16_t, WS_WINE)[((size_t)jj * NE_PR + rr) * 1024 + k] = (bf16_t)f2bf(v); }
    for (int i = gt; i < 2 * NQQ * 256; i += NGT) { const int jj = i / (NQQ * 256), rem = i % (NQQ * 256), n = rem >> 8, c = rem & 255; float v;
        if (n < 1024) { const int h = n >> 7, lat = n & 127; const float* uq = a->in[I_EV_W_UQ] + ((size_t)(jj * 256 + c) * 8 + h) * 64; const float* uk = a->in[I_EV_W_UK] + ((size_t)(jj * 8 + h) * 64) * 128 + lat;
            float s = 0.f;
            for (int d = 0; d < 64; ++d) s += uq[d] * uk[(size_t)d * 128];
            v = s * (0.125f * LOG2E); }
        else { const int hd = n - 1024; v = 0.125f * a->in[I_EV_W_IQ][(size_t)(jj * 256 + c) * 256 + hd]; }
        WSP(bf16_t, WS_WQE)[i] = (bf16_t)f2bf(v); }
    for (int i = gt; i < 2 * 1024 * NMX; i += NGT) { const int jj = i / (1024 * NMX), rem = i % (1024 * NMX), n = rem / NMX, k = rem % NMX; float v;
        const float* wo = a->in[I_EV_W_OUT] + (size_t)jj * 1024 * 1024 + n;
        if (k < 1024) { const int h = k >> 7, c = k & 127; const float* uv = a->in[I_EV_W_UV] + ((size_t)(jj * 8 + h) * 128 + c) * 64; float s = 0.f;
            for (int d = 0; d < 64; ++d) s += uv[d] * wo[(size_t)(h * 64 + d) * 1024];
            v = s; }
        else v = wo[(size_t)(512 + k - 1024) * 1024];
#if POUT_FP8
        WSP(unsigned char, WS_WOUTE)[i] = (unsigned char)__builtin_amdgcn_cvt_pk_fp8_f32(128.f * v, 0.f, 0, false); }
#else
        WSP(bf16_t, WS_WOUTE)[i] = (bf16_t)f2bf(v); }
#endif
    for (int i = gt; i < DEPTH * 32768; i += NGT) { const int l = i >> 15, rem = i & 32767, k = rem >> 5, e = rem & 31; const float w = a->in[I_LN1_G][l * 1024 + k] * a->in[I_ROUTER_W][i];
        const unsigned h16 = f2bf(w), l16 = f2bf(w - bf2f((unsigned short)h16)); const int off = e * 2048 + (((k >> 3) ^ (e & 15)) << 4) + (k & 7) * 2;
        unsigned char* img = WSP(unsigned char, WS_WRT) + (size_t)l * 131072; *(bf16_t*)(img + off) = (bf16_t)h16; *(bf16_t*)(img + 65536 + off) = (bf16_t)l16; }
    for (int i = gw; i < DEPTH * 32; i += NGW) { const int l = i >> 5, e = i & 31; float s1 = 0.f, s2 = 0.f;
        for (int k = flane; k < 1024; k += 64) { const float wv = a->in[I_ROUTER_W][((size_t)l * 1024 + k) * 32 + e]; s1 += a->in[I_LN1_G][l * 1024 + k] * wv; s2 += a->in[I_LN1_B][l * 1024 + k] * wv; }
        s1 = wave_sum(s1); s2 = wave_sum(s2);
        if (flane == 0) { float* cc = WSP(float, WS_WRT + 512 * 1024) + l * 64; cc[e] = s1; cc[32 + e] = s2 + a->in[I_ROUTER_B][l * 32 + e]; } }
    for (int i = gt; i < 2 * 8 * 128 * 128; i += NGT) { const int ii = (i >> 7) & 127, jx = i & 127; WSP(bf16_t, WS_WS)[i] = (bf16_t)f2bf(jx <= ii ? a->in[I_EV_W_S][i] : 0.f); }
    for (int m = gw; m < T_TOK; m += NGW) { const GAS f32x4* xr = (const GAS f32x4*)(a->in[I_X] + (size_t)m * D_MODEL) + flane; GAS u32x2* o8 = (GAS u32x2*)(WSP(bf16_t, WS_HB) + (size_t)m * D_MODEL) + flane;
#pragma unroll
        for (int jx = 0; jx < 4; ++jx) { const f32x4 v = xr[64 * jx]; u32x2 w; w.x = pk2(v.x, v.y); w.y = pk2(v.z, v.w); o8[64 * jx] = w; } }
}

__device__ __forceinline__ void e1b_phase(Frame& F, ArgsP a, int l) {
    PHASE_PROLOG();
    const int j = l >> 1, lane = fresh_tid() & 63; const int gw = vcu_ * 8 + F.wave, NGW = G_ * 8;
    const float* qg = a->in[I_EV_Q_NORM] + j * 256; const float* kvg = a->in[I_EV_KV_NORM] + j * 128; const float* ig = a->in[I_EV_IDX_K_G] + j * 64; const float* ib = a->in[I_EV_IDX_K_B] + j * 64;
    const f32x4 g4 = *(const f32x4*)(qg + 4 * lane); const float kg0 = kvg[2 * lane], kg1 = kvg[2 * lane + 1], igl = ig[lane], ibl = ib[lane];
    const GAS bf16_t* PR = (const GAS bf16_t*)WSP(bf16_t, WS_PR);
    GAS bf16_t* CQo = (GAS bf16_t*)WSP(bf16_t, WS_CQ); GAS bf16_t* CKVo = (GAS bf16_t*)WSP(bf16_t, WS_CKV); GAS bf16_t* KIo = (GAS bf16_t*)WSP(bf16_t, WS_KI); GAS float* WIo = (GAS float*)WSP(float, WS_WI);
    static_assert(T_TOK % (4 * 8) == 0, "token batches");
    for (int tok0 = gw; tok0 < T_TOK; tok0 += 4 * NGW) {
        u32x2 wq[4]; unsigned wk[4]; unsigned short wi[4], ww[4];
#pragma unroll
        for (int q = 0; q < 4; ++q) { const GAS bf16_t* pr = PR + (size_t)(tok0 + q * NGW) * NE_PR;
            wq[q] = *(const GAS u32x2*)(pr + 4 * lane); wk[q] = *(const GAS unsigned*)(pr + 256 + 2 * lane); wi[q] = pr[384 + lane]; ww[q] = pr[448 + (lane & 3)]; }
        u32x2 oq[4]; unsigned ok[4]; unsigned short oi[4];
#pragma unroll
        for (int q = 0; q < 4; ++q) {
            { const u32x2 w = wq[q]; const float a0 = bflo(w.x), a1 = bfhi(w.x), a2 = bflo(w.y), a3 = bfhi(w.y);
              const float ss = wave_sum(a0 * a0 + a1 * a1 + a2 * a2 + a3 * a3); const float rs = 1.0f / sqrtf(ss * (1.0f / 256.0f) + LN_EPS);
              oq[q].x = pk2(a0 * rs * g4.x, a1 * rs * g4.y); oq[q].y = pk2(a2 * rs * g4.z, a3 * rs * g4.w); }
            { const unsigned w = wk[q]; const float a0 = bflo(w), a1 = bfhi(w);
              const float ss = wave_sum(a0 * a0 + a1 * a1); const float rs = 1.0f / sqrtf(ss * (1.0f / 128.0f) + LN_EPS);
              ok[q] = pk2(a0 * rs * kg0, a1 * rs * kg1); }
            { const float x = bf2f(wi[q]); const float mu = wave_sum(x) * (1.0f / 64.0f); const float d = x - mu; const float var = wave_sum(d * d) * (1.0f / 64.0f);
              oi[q] = (unsigned short)f2bf(d * (1.0f / sqrtf(var + LN_EPS)) * igl + ibl); } }
#pragma unroll
        for (int q = 0; q < 4; ++q) { const size_t tok = (size_t)(tok0 + q * NGW);
            *(GAS u32x2*)(CQo + tok * 256 + 4 * lane) = oq[q]; *(GAS unsigned*)(CKVo + tok * 128 + 2 * lane) = ok[q]; KIo[tok * 64 + lane] = oi[q];
            if (lane < 4) WIo[tok * 4 + lane] = 0.5f * bf2f(ww[q]); }
    }
}

__device__ __forceinline__ unsigned ord_key(float f) { const unsigned u = __builtin_bit_cast(unsigned, f); return (u & 0x80000000u) ? ~u : (u | 0x80000000u); }
__device__ __forceinline__ void e3a_phase(Frame& F, ArgsP a) {
    PHASE_PROLOG();
    const int tid = fresh_tid(), wid = F.wave, lane = tid & 63, fr = lane & 15, fq = lane >> 4;
    LAS float* sc = (LAS float*)F.lds;
    const bf16_t* QQ = WSP(bf16_t, WS_QQ); const bf16_t* KI = WSP(bf16_t, WS_KI); const float* WI = WSP(float, WS_WI);
    unsigned long long* MASK = WSP(unsigned long long, WS_MASK);
    for (int L = vcu_; L < BATCH * (SEQ / 16); L += G_) {
        const int b = L >> 7, qb = ((L & 127) + 8 * (L >> 8)) & 127, t0 = qb * 16, NT = t0 / 64 + 1;
        const size_t rb0 = (size_t)b * SEQ;
        bf16x8 qf[4][2]; f32x4 wq4;
        { const bf16_t* qp = QQ + (rb0 + t0 + fr) * NQQ + 1024 + fq * 8;
#pragma unroll
          for (int h = 0; h < 4; ++h)
#pragma unroll
              for (int ks = 0; ks < 2; ++ks) qf[h][ks] = *(const bf16x8*)(qp + h * 64 + ks * 32);
          wq4 = *(const f32x4*)(WI + (rb0 + t0 + fr) * 4); }
        const f32x4 wqh = wq4 * 0.5f;
#ifndef E3A_REP_SC
#define E3A_REP_SC 1
#endif
#ifndef E3A_REP_SEL
#define E3A_REP_SEL 1
#endif
#pragma unroll 1
        for (int rsc = 0; rsc < E3A_REP_SC; ++rsc)
        for (int kt = wid; kt < NT; kt += 8) {
            bf16x8 kk0[4], kk1[4];
#pragma unroll
            for (int kb = 0; kb < 4; ++kb) { const GAS bf16_t* kp = (const GAS bf16_t*)KI + (rb0 + kt * 64 + kb * 16 + fr) * 64 + fq * 8; kk0[kb] = *(const GAS bf16x8*)kp; kk1[kb] = *(const GAS bf16x8*)(kp + 32); }
#pragma unroll
            for (int kb = 0; kb < 4; ++kb) { const bf16x8 k0 = kk0[kb], k1 = kk1[kb];
                f32x4 s4 = (f32x4){0.f, 0.f, 0.f, 0.f};
#pragma unroll
                for (int h = 0; h < 4; ++h) { f32x4 acc = (f32x4){0.f, 0.f, 0.f, 0.f};
                    acc = __builtin_amdgcn_mfma_f32_16x16x32_bf16(k0, qf[h][0], acc, 0, 0, 0); acc = __builtin_amdgcn_mfma_f32_16x16x32_bf16(k1, qf[h][1], acc, 0, 0, 0);
#pragma unroll
                    for (int q = 0; q < 4; ++q) s4[q] += (acc[q] + fabsf(acc[q])) * wqh[h]; }
                s4 += 0.0f;
                *(LAS f32x4*)(sc + fr * 2048 + kt * 64 + kb * 16 + fq * 4) = s4; }
        }
        __syncthreads();
#pragma unroll 1
        for (int qq2 = 0; qq2 < 2 * E3A_REP_SEL; ++qq2) { const int qq = qq2 & 1; const int q = 2 * wid + qq; const int tq = t0 + q;
            unsigned long long myword = 0ull; int lane_q = lane; asm volatile("" : "+v"(lane_q));
            if (NT <= 4) { myword = (lane < NT) ? ~0ull : 0ull; }
            else {
                unsigned x[32];
                { float f[32];
#pragma unroll
                  for (int i = 0; i < 32; ++i) f[i] = sc[q * 2048 + i * 64 + lane_q];
#pragma unroll
                  for (int i = 0; i < 32; ++i) x[i] = (i * 64 + lane_q < NT * 64) ? ord_key(f[i]) : 0u; }
                unsigned prefix = 0u;
                bool exact = false;
                for (int bit = 31; bit >= 0; --bit) { const unsigned cand = prefix | (1u << bit); int cnt = 0;
#pragma unroll
                    for (int g = 0; g < 4; ++g) { if (8 * g < NT) { unsigned long long m[8];
#pragma unroll
                            for (int i = 0; i < 8; ++i) asm volatile("v_cmp_ge_u32_e64 %0, %1, %2" : "=s"(m[i]) : "v"(x[8 * g + i]), "s"(cand));
                            __builtin_amdgcn_sched_barrier(0);
#pragma unroll
                            for (int i = 0; i < 8; ++i) cnt += __builtin_popcountll(m[i]);
                            __builtin_amdgcn_sched_barrier(0); } }
                    if (cnt >= N_SEL) { prefix = cand; if (cnt == N_SEL) { exact = true; break; } } }
                int wlo = 0, whi = 0;
                if (exact) {
#pragma unroll
                    for (int i = 0; i < 32; ++i)
                        asm volatile("v_cmp_ge_u32_e64 vcc, %2, %3\n\ts_nop 4\n\tv_writelane_b32 %0, vcc_lo, %4\n\tv_writelane_b32 %1, vcc_hi, %4" : "+v"(wlo), "+v"(whi) : "v"(x[i]), "s"(prefix), "n"(i) : "vcc");
                } else {
                    const unsigned Tk = prefix; int cgt = 0;
#pragma unroll
                    for (int i = 0; i < 32; ++i) { cgt += __builtin_popcountll(__builtin_amdgcn_ballot_w64(x[i] > Tk)); if ((i & 7) == 7) __builtin_amdgcn_sched_barrier(0); }
                    int need = N_SEL - cgt;
#pragma unroll
                    for (int i = 0; i < 32; ++i) { const bool eq = x[i] == Tk; const unsigned long long meq = __builtin_amdgcn_ballot_w64(eq);
                        const int rank = (int)__builtin_amdgcn_mbcnt_hi((unsigned)(meq >> 32), __builtin_amdgcn_mbcnt_lo((unsigned)meq, 0u));
                        const unsigned long long sel = __builtin_amdgcn_ballot_w64((x[i] > Tk) || (eq && rank < need));
                        need = max(need - (int)__builtin_popcountll(meq), 0);
                        asm volatile("s_nop 4\n\tv_writelane_b32 %0, %2, %4\n\tv_writelane_b32 %1, %3, %4" : "+v"(wlo), "+v"(whi) : "s"((unsigned)sel), "s"((unsigned)(sel >> 32)), "n"(i));
                        __builtin_amdgcn_sched_barrier(0); }
                }
                myword = ((unsigned long long)(unsigned)whi << 32) | (unsigned long long)(unsigned)wlo;
            }
            if (lane < 32) MASK[(rb0 + tq) * 32 + lane] = myword;
        }
        __syncthreads();
    }
}

__device__ __forceinline__ void dsa_phase(Frame& F, ArgsP a) {
    PHASE_PROLOG();
    const int tid = fresh_tid(), wid = __builtin_amdgcn_readfirstlane(tid >> 6), lane = tid & 63, r32 = lane & 31, hi = lane >> 5;
    LAS char* lds = (LAS char*)F.lds; LAS unsigned long long* msk = (LAS unsigned long long*)(lds + att::ATT_LDS_CORE);
    const GAS bf16_t* QQ = (const GAS bf16_t*)WSP(bf16_t, WS_QQ); const GAS bf16_t* CKV = (const GAS bf16_t*)WSP(bf16_t, WS_CKV); const GAS unsigned long long* MASK = (const GAS unsigned long long*)WSP(unsigned long long, WS_MASK); GAS mx_t* MX = (GAS mx_t*)WSP(mx_t, WS_MX);
    const float slope2 = exp2f(-(float)(wid + 1)) * LOG2E;
    for (int L = vcu_; L < BATCH * (SEQ / 32); L += G_) {
        const int i = L >> 8, v = L & 255, b = v >> 3, c8 = v & 7, jx = (i & 1) ? 7 - c8 : c8, qb = 63 - (8 * i + jx), t0 = qb * 32, NT = t0 / 64 + 1;
        const size_t rb0 = (size_t)b * SEQ;
        for (int k = tid; k < 1024; k += 512) { const int q = k >> 5, jj = k & 31; msk[jj * 32 + q] = MASK[(rb0 + t0 + q) * 32 + jj]; }
        f32x16 o[4]; float l_reg;
        att::attn_core<128, true, true>(QQ + (rb0 + t0) * NQQ + wid * 128, NQQ, CKV + rb0 * 128, 128, CKV + rb0 * 128, 128, NT, NT, slope2, t0, msk, lds, o, l_reg, wid);
        float rli[16]; att::row_rcp(l_reg, lds, rli, wid);
        GAS mx_t* Ow = MX + (rb0 + t0) * NMX + wid * 128;
#pragma unroll
        for (int r = 0; r < 16; ++r) { int orow = att::crow(r, hi); asm volatile("" : "+v"(orow));
#pragma unroll
            for (int d0 = 0; d0 < 4; ++d0) Ow[(size_t)orow * NMX + d0 * 32 + r32] = mx_cvt(o[d0][r] * rli[r]); }
    }
}

__device__ __forceinline__ void gml_phase(Frame& F, ArgsP a, int l) {
    PHASE_PROLOG();
    const int j = l >> 1, tid = fresh_tid(), g = F.wave, lane = tid & 63;
    LAS float* stat = (LAS float*)(F.MISC + MI_REC);
    LAS unsigned char* vT = F.lds + g * 16384;
    const GAS bf16_t* PR = (const GAS bf16_t*)WSP(bf16_t, WS_PR); GAS mx_t* MX = (GAS mx_t*)WSP(mx_t, WS_MX); const GAS bf16_t* Wt = (const GAS bf16_t*)WSP(bf16_t, WS_WS) + (size_t)(j * 8 + g) * 128 * 128;
    const GAS float* vg = (const GAS float*)(a->in[I_EV_V_NORM_G] + j * GW); const GAS float* vb = (const GAS float*)(a->in[I_EV_V_NORM_B] + j * GW); const GAS float* bs = (const GAS float*)(a->in[I_EV_B_S] + (size_t)(j * 8 + g) * 128);
    float vgl[8], vbl[8];
    { const f32x4 g0 = *(const GAS f32x4*)(vg + g * 64 + (lane & 7) * 8), g1 = *(const GAS f32x4*)(vg + g * 64 + (lane & 7) * 8 + 4), b0 = *(const GAS f32x4*)(vb + g * 64 + (lane & 7) * 8), b1 = *(const GAS f32x4*)(vb + g * 64 + (lane & 7) * 8 + 4);
#pragma unroll
      for (int q = 0; q < 4; ++q) { vgl[q] = g0[q]; vgl[4 + q] = g1[q]; vbl[q] = b0[q]; vbl[4 + q] = b1[q]; } }
    for (int L = vcu_; L < BATCH * (SEQ / GCH); L += G_) {
        const size_t tok0 = (size_t)(L >> 4) * SEQ + (size_t)(L & 15) * GCH;
#pragma unroll 1
        for (int t4 = 0; t4 < 16; t4 += 4) { u32x4 wq[4];
#pragma unroll
            for (int q = 0; q < 4; ++q) wq[q] = *(const GAS u32x4*)(PR + (tok0 + g * 16 + t4 + q) * NE_PR + 1024 + 8 * lane);
#pragma unroll
            for (int q = 0; q < 4; ++q) { const int tl = g * 16 + t4 + q; const u32x4 w = wq[q];
                const float x0 = bflo(w.x), x1 = bfhi(w.x), x2 = bflo(w.y), x3 = bfhi(w.y), x4 = bflo(w.z), x5 = bfhi(w.z), x6 = bflo(w.w), x7 = bfhi(w.w);
                const float mu = wave_sum(((x0 + x1) + (x2 + x3)) + ((x4 + x5) + (x6 + x7))) * (1.0f / 512.0f);
                const float d0 = x0 - mu, d1 = x1 - mu, d2 = x2 - mu, d3 = x3 - mu, d4 = x4 - mu, d5 = x5 - mu, d6 = x6 - mu, d7 = x7 - mu;
                const float var = wave_sum(((d0 * d0 + d1 * d1) + (d2 * d2 + d3 * d3)) + ((d4 * d4 + d5 * d5) + (d6 * d6 + d7 * d7))) * (1.0f / 512.0f);
                if (lane == 0) { stat[2 * tl] = mu; stat[2 * tl + 1] = 1.0f / sqrtf(var + LN_EPS); } } }
        __syncthreads();
#pragma unroll 1
        for (int i4 = 0; i4 < 16; i4 += 4) { u32x4 wv[4];
#pragma unroll
            for (int q4 = 0; q4 < 4; ++q4) { const int tl = ((i4 + q4) * 64 + lane) >> 3; wv[q4] = *(const GAS u32x4*)(PR + (tok0 + tl) * NE_PR + 1024 + g * 64 + (lane & 7) * 8); }
#pragma unroll
            for (int q4 = 0; q4 < 4; ++q4) { const int tl = ((i4 + q4) * 64 + lane) >> 3, ch8 = lane & 7; const u32x4 w = wv[q4];
                const float mu = stat[2 * tl], rs = stat[2 * tl + 1];
                float xv[8] = {bflo(w.x), bfhi(w.x), bflo(w.y), bfhi(w.y), bflo(w.z), bfhi(w.z), bflo(w.w), bfhi(w.w)};
#pragma unroll
                for (int q = 0; q < 8; ++q) { const int c = ch8 * 8 + q; const float y = (xv[q] - mu) * rs * vgl[q] + vbl[q];
                    *(LAS bf16_t*)(vT + c * 256 + ((((tl >> 3) ^ (c & 15)) << 4) | ((tl & 7) * 2))) = (bf16_t)f2bf(y); } } }
        LDS_WAIT(); asm volatile("" ::: "memory");
#pragma unroll 1
        for (int mh = 0; mh < 2; ++mh) {
            f32x4 acc[4][4];
#pragma unroll
            for (int mi = 0; mi < 4; ++mi)
#pragma unroll
                for (int ni = 0; ni < 4; ++ni) acc[mi][ni] = (f32x4){0.f, 0.f, 0.f, 0.f};
            bf16x8 afr[4][4];
            { int wrow0 = 64 * mh + (lane & 15); asm volatile("" : "+v"(wrow0));
#pragma unroll
              for (int ks = 0; ks < 4; ++ks)
#pragma unroll
                  for (int mi = 0; mi < 4; ++mi) afr[ks][mi] = *(const GAS bf16x8*)(Wt + (size_t)(wrow0 + 16 * mi) * 128 + 32 * ks + 8 * (lane >> 4)); }
#pragma unroll
            for (int ks = 0; ks < 4; ++ks) { bf16x8 bfr[4];
#pragma unroll
                for (int ni = 0; ni < 4; ++ni) { const int c = 16 * ni + (lane & 15), ch = (ks * 4 + (lane >> 4)) ^ (c & 15); bfr[ni] = *(const LAS bf16x8*)(vT + c * 256 + (ch << 4)); }
#pragma unroll
                for (int mi = 0; mi < 4; ++mi) { if (32 * ks <= 16 * (4 * mh + mi) + 15) {
#pragma unroll
                        for (int ni = 0; ni < 4; ++ni) acc[mi][ni] = __builtin_amdgcn_mfma_f32_16x16x32_bf16(afr[ks][mi], bfr[ni], acc[mi][ni], 0, 0, 0); } } }
#pragma unroll
            for (int mi = 0; mi < 4; ++mi) { int ii0 = 16 * (4 * mh + mi) + 4 * (lane >> 4); asm volatile("" : "+v"(ii0));
                const f32x4 bsv = *(const GAS f32x4*)(bs + ii0); unsigned short uu[4][4];
#pragma unroll
                for (int q = 0; q < 4; ++q)
#pragma unroll
                    for (int ni = 0; ni < 4; ++ni) uu[q][ni] = PR[(tok0 + ii0 + q) * NE_PR + 512 + g * 64 + 16 * ni + (lane & 15)];
#pragma unroll
                for (int q = 0; q < 4; ++q)
#pragma unroll
                    for (int ni = 0; ni < 4; ++ni) MX[(tok0 + ii0 + q) * NMX + 1024 + g * 64 + 16 * ni + (lane & 15)] = mx_cvt(bf2f(uu[q][ni]) * (acc[mi][ni][q] + bsv[q]));
                __builtin_amdgcn_sched_barrier(0); }
        }
        __syncthreads();
    }
}

__device__ __forceinline__ void datt_phase(Frame& F, ArgsP a, int l) {
    PHASE_PROLOG();
    const int j = l >> 1, tid = fresh_tid(), wid = __builtin_amdgcn_readfirstlane(tid >> 6), lane = tid & 63, r32 = lane & 31, hi = lane >> 5;
    LAS char* lds = (LAS char*)F.lds; LAS unsigned* stash = (LAS unsigned*)(lds + att::ATT_LDS_CORE);
    const GAS bf16_t* PR = (const GAS bf16_t*)WSP(bf16_t, WS_PR); GAS mx_t* OA = (GAS mx_t*)WSP(mx_t, WS_MX);
    const float lam_init = 0.8f - 0.6f * expf(-0.3f * (float)l);
    float lam;
    { const float s1 = wave_sum(a->in[I_OD_LQ1][j * 64 + lane] * a->in[I_OD_LK1][j * 64 + lane]), s2 = wave_sum(a->in[I_OD_LQ2][j * 64 + lane] * a->in[I_OD_LK2][j * 64 + lane]);
      lam = expf(s1) - expf(s2) + lam_init; }
    const float* sg = a->in[I_OD_SUBLN_G] + j * 128;
    for (int L = vcu_; L < BATCH * H_C * (SEQ / 256); L += G_) {
        const int qb = 7 - (L >> 8), v = L & 255, b = v >> 3, h = v & 7;
        const size_t rb0 = (size_t)b * SEQ; const int t0w = qb * 256 + 32 * wid, NTB = 4 * qb + 4, NTW = t0w / 64 + 1;
        const float slope2 = exp2f(-(float)(h + 1)) * LOG2E;
#pragma unroll 1
        for (int m = 0; m < 2; ++m) {
            f32x16 o[4]; float l_reg;
            att::attn_core<64, false, false>(PR + (rb0 + t0w) * NO_PR + h * 128 + m * 64, NO_PR, PR + rb0 * NO_PR + 1024 + h * 128 + m * 64, NO_PR, PR + rb0 * NO_PR + 2048 + h * 128, NO_PR,
                                             NTB, NTW, slope2, t0w, nullptr, lds, o, l_reg, wid);
            float rli[16]; att::row_rcp(l_reg, lds, rli, wid);
            if (m == 0) {
#pragma unroll
                for (int d0 = 0; d0 < 4; ++d0)
#pragma unroll
                    for (int r = 0; r < 16; r += 2) stash[(d0 * 8 + (r >> 1)) * 512 + tid] = att::cvtpk(o[d0][r] * rli[r], o[d0][r + 1] * rli[r + 1]);
            } else {
                float ssq[16];
#pragma unroll
                for (int r = 0; r < 16; ++r) ssq[r] = 0.f;
#pragma unroll
                for (int d0 = 0; d0 < 4; ++d0)
#pragma unroll
                    for (int r = 0; r < 16; r += 2) { const unsigned w = stash[(d0 * 8 + (r >> 1)) * 512 + tid];
                        const float y0 = bflo(w) - lam * (o[d0][r] * rli[r]), y1 = bfhi(w) - lam * (o[d0][r + 1] * rli[r + 1]);
                        o[d0][r] = y0; o[d0][r + 1] = y1; ssq[r] += y0 * y0; ssq[r + 1] += y1 * y1; if ((r & 6) == 6) __builtin_amdgcn_sched_barrier(0); }
#pragma unroll
                for (int r = 0; r < 16; ++r) { float s = ssq[r]; s += xshfl<1>(s, 0); s += xshfl<2>(s, 0); s += xshfl<4>(s, 0); s += xshfl<8>(s, 0); s += xshfl<16>(s, 0);
                    ssq[r] = (1.0f - lam_init) / sqrtf(s * (1.0f / 128.0f) + LN_EPS); }
                GAS mx_t* Ow = OA + (rb0 + t0w) * D_MODEL + h * 128;
#pragma unroll
                for (int d0 = 0; d0 < 4; ++d0) { const float gv = sg[d0 * 32 + r32];
#pragma unroll
                    for (int r = 0; r < 16; ++r) { int orow = att::crow(r, hi); asm volatile("" : "+v"(orow)); Ow[(size_t)orow * D_MODEL + d0 * 32 + r32] = mx_cvt(o[d0][r] * ssq[r] * gv); }
                    __builtin_amdgcn_sched_barrier(0); }
            }
        }
    }
}

template <int H, int BIT> __device__ __forceinline__ void rs_step(float (&p)[32], int lane) {
    if constexpr (BIT == 32) {
#pragma unroll
        for (int i = 0; i < H; ++i) { unsigned u0, u1; plswap(__builtin_bit_cast(unsigned, p[i]), __builtin_bit_cast(unsigned, p[H + i]), u0, u1);
            p[i] = __builtin_bit_cast(float, u0) + __builtin_bit_cast(float, u1); }
    } else {
        const bool up = (lane & BIT) != 0;
#pragma unroll
        for (int i = 0; i < H; ++i) { const float keep = up ? p[H + i] : p[i], send = up ? p[i] : p[H + i]; p[i] = keep + xshfl<BIT>(send, lane); }
    }
}
template <int N> __device__ __forceinline__ void ln16(float (&v)[16], const float (&gg)[16], const float (&bb)[16]) {
    float s = 0.f;
#pragma unroll
    for (int i = 0; i < 16; ++i) s += v[i];
    const float mean = wave_sum(s) * (1.0f / 1024.0f); float s2 = 0.f;
#pragma unroll
    for (int i = 0; i < 16; ++i) { v[i] -= mean; s2 += v[i] * v[i]; }
    const float rstd = 1.0f / sqrtf(wave_sum(s2) * (1.0f / 1024.0f) + LN_EPS);
#pragma unroll
    for (int i = 0; i < 16; ++i) v[i] = v[i] * rstd * gg[i] + bb[i];
}
__device__ __forceinline__ void lnr_load_ln(const bf16_t* zrow, float* hrow, bf16_t* hbrow, unsigned char* hb8row, const float* g1, const float* b1, int lane, float (&hv)[16]) {
    float gg[16], bb[16];
#pragma unroll
    for (int jj = 0; jj < 4; ++jj) { const u32x2 zw = *(const u32x2*)(zrow + 256 * jj + 4 * lane); const f32x4 z4 = (f32x4){bflo(zw.x), bfhi(zw.x), bflo(zw.y), bfhi(zw.y)}; const f32x4 g4 = *(const f32x4*)(g1 + 256 * jj + 4 * lane), b4 = *(const f32x4*)(b1 + 256 * jj + 4 * lane);
#pragma unroll
        for (int i = 0; i < 4; ++i) { hv[jj * 4 + i] = z4[i]; gg[jj * 4 + i] = g4[i]; bb[jj * 4 + i] = b4[i]; } }
    ln16<0>(hv, gg, bb);
#pragma unroll
    for (int jj = 0; jj < 4; ++jj) {
        u32x2 w; w.x = pk2(hv[jj * 4], hv[jj * 4 + 1]); w.y = pk2(hv[jj * 4 + 2], hv[jj * 4 + 3]); *(u32x2*)(hbrow + 256 * jj + 4 * lane) = w;
#if MOE_FP8
        *(unsigned*)(hb8row + 256 * jj + 4 * lane) = pk4_fp8(hv[jj * 4], hv[jj * 4 + 1], hv[jj * 4 + 2], hv[jj * 4 + 3]);
#endif
    }
}
__device__ __forceinline__ void lnr_tail(Frame& F, unsigned char* ws_, float* gate_out, float (&part)[32], float rbias, int tl, size_t tok, int lane) {
    rs_step<4, 8>(part, lane); rs_step<2, 4>(part, lane); rs_step<1, 2>(part, lane);
    float v = part[0] + xshfl<1>(part[0], lane) + rbias;
    float t0, t1, t2, t3; int e0, e1, e2, e3;
#define LNR_PICK(tk, ek) do { const float m_ = wave_max(v); const unsigned long long bm_ = __builtin_amdgcn_ballot_w64(v == m_); ek = __builtin_ctzll(bm_) >> 1; tk = m_; if ((lane >> 1) == ek) v = -INFINITY; } while (0)
    LNR_PICK(t0, e0); LNR_PICK(t1, e1); LNR_PICK(t2, e2); LNR_PICK(t3, e3);
#undef LNR_PICK
    const float x1 = fast_exp2((t1 - t0) * LOG2E), x2 = fast_exp2((t2 - t0) * LOG2E), x3 = fast_exp2((t3 - t0) * LOG2E);
    const float inv = 1.0f / (1.0f + x1 + x2 + x3);
    if (lane < 4) { const int ek = lane == 0 ? e0 : lane == 1 ? e1 : lane == 2 ? e2 : e3; const float gk = (lane == 0 ? 1.0f : lane == 1 ? x1 : lane == 2 ? x2 : x3) * inv;
        const int lr = __hip_atomic_fetch_add((LAS int*)&F.MISC[MI_LCNT + ek], 1, __ATOMIC_RELAXED, __HIP_MEMORY_SCOPE_WORKGROUP);
        F.MISC[MI_REC + tl * 4 + lane] = (ek << 16) | lr;
        gate_out[tok * 4 + lane] = gk; }
}
__device__ __forceinline__ void lnr_phase(Frame& F, ArgsP a, int l, bool dry = false) {
    PHASE_PROLOG();
    const int tid = fresh_tid(), wid = F.wave, lane = tid & 63;
    LAS float* rws = (LAS float*)F.lds;
    { const float* rw = a->in[I_ROUTER_W] + (size_t)l * 1024 * 32;
      for (int idx = tid; idx < 32768; idx += 512) { const int d = idx >> 5, e = idx & 31, jj = d >> 8, ln = (d & 255) >> 2, i = d & 3; rws[((jj * 4 + i) * 8 + (e >> 2)) * 256 + ln * 4 + (e & 3)] = rw[idx]; } }
    const float* g1 = a->in[I_LN1_G] + l * 1024; const float* b1 = a->in[I_LN1_B] + l * 1024;
    const float rbias = a->in[I_ROUTER_B][l * 32 + ((lane >> 1) & 31)];
    const bf16_t* Z = WSP(bf16_t, WS_Z); float* H32 = a->out; bf16_t* HB = dry ? WSP(bf16_t, WS_PR) : WSP(bf16_t, WS_HB); unsigned char* HB8 = dry ? WSP(unsigned char, WS_QQ) : WSP(unsigned char, WS_HB8);
    float* gate_out = dry ? WSP(float, WS_WI) : WSP(float, WS_GATE); int* rowtok = dry ? WSP(int, WS_MASK) : WSP(int, WS_ROWTOK); unsigned* slot_out = dry ? WSP(unsigned, WS_CKV) : WSP(unsigned, WS_SLOT);
    gu32* cur = F.ctl + CW_CUR + (size_t)(dry ? l + 4 : l) * 32 * 64;
    __syncthreads();
    for (int u = vcu_; u < T_TOK / 256; u += G_) {
        if (tid < 32) F.MISC[MI_LCNT + tid] = 0;
        __syncthreads();
#pragma unroll 1
        for (int tp = 0; tp < 16; ++tp) {
            const int tl0 = wid * 32 + 2 * tp; const size_t tok0 = (size_t)u * 256 + tl0;
            float hv0[16], hv1[16];
            lnr_load_ln(Z + tok0 * D_MODEL, H32 + tok0 * D_MODEL, HB + tok0 * D_MODEL, HB8 + tok0 * D_MODEL, g1, b1, lane, hv0);
            lnr_load_ln(Z + (tok0 + 1) * D_MODEL, H32 + (tok0 + 1) * D_MODEL, HB + (tok0 + 1) * D_MODEL, HB8 + (tok0 + 1) * D_MODEL, g1, b1, lane, hv1);
            __builtin_amdgcn_sched_barrier(0);
            f32x4 pv0[8], pv1[8]; LAS float* rw_ = rws + lane * 4; asm volatile("" : "+v"(rw_));
#pragma unroll
            for (int e = 0; e < 8; ++e) { pv0[e] = (f32x4){0.f, 0.f, 0.f, 0.f}; pv1[e] = (f32x4){0.f, 0.f, 0.f, 0.f}; }
#pragma unroll
            for (int ji = 0; ji < 16; ++ji) {
#pragma unroll
                for (int e4 = 0; e4 < 8; ++e4) { const f32x4 w4 = *(const LAS f32x4*)(rw_ + (ji * 8 + e4) * 256); pv0[e4] += w4 * hv0[ji]; pv1[e4] += w4 * hv1[ji]; }
                __builtin_amdgcn_sched_barrier(0); }
            float part0[32], part1[32];
#pragma unroll
            for (int e = 0; e < 32; ++e) part0[e] = pv0[e >> 2][e & 3];
            rs_step<16, 32>(part0, lane); rs_step<8, 16>(part0, lane);
            __builtin_amdgcn_sched_barrier(0);
#pragma unroll
            for (int e = 0; e < 32; ++e) part1[e] = pv1[e >> 2][e & 3];
            rs_step<16, 32>(part1, lane); rs_step<8, 16>(part1, lane);
            __builtin_amdgcn_sched_barrier(0);
            lnr_tail(F, ws_, gate_out, part0, rbias, tl0, tok0, lane);
            __builtin_amdgcn_sched_barrier(0);
            lnr_tail(F, ws_, gate_out, part1, rbias, tl0 + 1, tok0 + 1, lane);
            __builtin_amdgcn_sched_barrier(0);
        }
        __syncthreads();
        if (tid < 32) { const int c = F.MISC[MI_LCNT + tid]; F.MISC[MI_LBASE + tid] = c ? (int)__hip_atomic_fetch_add(cur + tid * 64, (unsigned)c, RLX_AGENT) : 0; }
        __syncthreads();
        for (int i = tid; i < 1024; i += 512) { const int rec = F.MISC[MI_REC + i], e = rec >> 16, rank = F.MISC[MI_LBASE + e] + (rec & 0xffff); const int tok = u * 256 + (i >> 2);
            rowtok[(size_t)(dry ? (e & 31) : e) * 65536 + (dry ? (rank & 32767) : rank)] = tok; slot_out[(size_t)tok * 4 + (i & 3)] = ((unsigned)e << 20) | (unsigned)rank; }
        __syncthreads();
    }
}

__device__ __forceinline__ void lnr2_phase(Frame& F, ArgsP a, int l, bool dry = false) {
    PHASE_PROLOG();
    const int tid = fresh_tid(), wid = __builtin_amdgcn_readfirstlane(tid >> 6), lane = tid & 63, r32 = lane & 31, hi = lane >> 5;
    LAS unsigned char* Wh = F.lds; LAS unsigned char* Wl = F.lds + 65536;
    LAS float* stats = (LAS float*)(F.lds + RING_BYTES);
    LAS float* cc = (LAS float*)(F.MISC + MI_RBE);
    const float* g1 = a->in[I_LN1_G] + l * 1024; const float* b1 = a->in[I_LN1_B] + l * 1024;
    { const GAS u32x4* img = (const GAS u32x4*)(WSP(unsigned char, WS_WRT) + (size_t)l * 131072);
      u32x4 t_[16];
#pragma unroll
      for (int i = 0; i < 16; ++i) t_[i] = img[tid + 512 * i];
#pragma unroll
      for (int i = 0; i < 16; ++i) *(LAS u32x4*)(F.lds + (tid + 512 * i) * 16) = t_[i];
      if (tid < 64) cc[tid] = WSP(float, WS_WRT + 512 * 1024)[l * 64 + tid]; }
    const GAS bf16_t* Z = (const GAS bf16_t*)WSP(bf16_t, WS_Z); GAS bf16_t* HB = (GAS bf16_t*)(dry ? WSP(bf16_t, WS_PR) : WSP(bf16_t, WS_HB)); GAS unsigned char* HB8 = (GAS unsigned char*)(dry ? WSP(unsigned char, WS_QQ) : WSP(unsigned char, WS_HB8));
    float* gate_out = dry ? WSP(float, WS_WI) : WSP(float, WS_GATE); int* rowtok = dry ? WSP(int, WS_MASK) : WSP(int, WS_ROWTOK); unsigned* slot_out = dry ? WSP(unsigned, WS_CKV) : WSP(unsigned, WS_SLOT);
    GAS float* ST = (GAS float*)(dry ? WSP(float, WS_KI) : WSP(float, WS_STAT));
    gu32* cur = F.ctl + CW_CUR + (size_t)(dry ? l + 4 : l) * 32 * 64;
    float gg[16], bb[16];
#pragma unroll
    for (int jj = 0; jj < 4; ++jj) { const f32x4 g4 = *(const f32x4*)(g1 + 256 * jj + 4 * lane), b4 = *(const f32x4*)(b1 + 256 * jj + 4 * lane);
#pragma unroll
        for (int i = 0; i < 4; ++i) { gg[jj * 4 + i] = g4[i]; bb[jj * 4 + i] = b4[i]; } }
    __syncthreads();
    for (int u = vcu_; u < T_TOK / 256; u += G_) {
        if (tid < 32) F.MISC[MI_LCNT + tid] = 0;
        __syncthreads();
        {
            const int tl = 32 * wid + r32; const size_t tok = (size_t)u * 256 + tl;
            const GAS bf16_t* zp = Z + tok * D_MODEL + 512 * hi;
            const LAS unsigned char* whp = Wh + r32 * 2048; const LAS unsigned char* wlp = Wl + r32 * 2048; const int sw = r32 & 15;
            f32x16 acc = f32x16{}; float sm = 0.f, sq = 0.f;
#pragma unroll 8
            for (int sx = 0; sx < 64; ++sx) { const u32x4 zw = *(const GAS u32x4*)(zp + 8 * sx); const bf16x8 zf = __builtin_bit_cast(bf16x8, zw);
                const int ch = ((64 * hi + sx) ^ sw) << 4;
                const bf16x8 ah = *(const LAS bf16x8*)(whp + ch), al = *(const LAS bf16x8*)(wlp + ch);
                acc = __builtin_amdgcn_mfma_f32_32x32x16_bf16(ah, zf, acc, 0, 0, 0); acc = __builtin_amdgcn_mfma_f32_32x32x16_bf16(al, zf, acc, 0, 0, 0);
#pragma unroll
                for (int q = 0; q < 4; ++q) { const float x0 = bflo(zw[q]), x1 = bfhi(zw[q]); sm += x0 + x1; sq += x0 * x0 + x1 * x1; } }
            { float r0, r1; half_swap(sm, r0, r1); sm = r0 + r1; half_swap(sq, r0, r1); sq = r0 + r1; }
            const float mu = sm * (1.0f / 1024.0f); const float rstd = 1.0f / sqrtf(fmaxf(sq * (1.0f / 1024.0f) - mu * mu, 0.f) + LN_EPS);
            if (hi == 0) { stats[2 * tl] = mu; stats[2 * tl + 1] = rstd; *(GAS f32x2*)(ST + tok * 2) = (f32x2){mu, rstd}; }
            float lg[16];
#pragma unroll
            for (int r = 0; r < 16; ++r) { const int e = att::crow(r, hi); lg[r] = rstd * (acc[r] - mu * cc[e]) + cc[32 + e]; }
            float cv[8]; int ci[8];
#pragma unroll
            for (int k = 0; k < 4; ++k) { float best = -INFINITY; int bid = 0;
#pragma unroll
                for (int r = 0; r < 16; ++r) { const int e = att::crow(r, hi); if (lg[r] > best) { best = lg[r]; bid = e; } }
                cv[k] = best; ci[k] = bid;
#pragma unroll
                for (int r = 0; r < 16; ++r) if (att::crow(r, hi) == bid) lg[r] = -INFINITY; }
#pragma unroll
            for (int k = 0; k < 4; ++k) { unsigned a0, a1, b0, b1; plswap(__builtin_bit_cast(unsigned, cv[k]), __builtin_bit_cast(unsigned, cv[k]), a0, a1); plswap((unsigned)ci[k], (unsigned)ci[k], b0, b1);
                cv[4 + k] = __builtin_bit_cast(float, hi ? a0 : a1); ci[4 + k] = (int)(hi ? b0 : b1); }
            float tv[4]; int te[4];
#pragma unroll
            for (int k = 0; k < 4; ++k) { float best = -INFINITY; int bid = 1 << 20;
#pragma unroll
                for (int i = 0; i < 8; ++i) if (cv[i] > best || (cv[i] == best && ci[i] < bid)) { best = cv[i]; bid = ci[i]; }
                tv[k] = best; te[k] = bid;
#pragma unroll
                for (int i = 0; i < 8; ++i) if (ci[i] == bid) cv[i] = -INFINITY; }
            const float x1 = fast_exp2((tv[1] - tv[0]) * LOG2E), x2 = fast_exp2((tv[2] - tv[0]) * LOG2E), x3 = fast_exp2((tv[3] - tv[0]) * LOG2E);
            const float inv = 1.0f / (1.0f + x1 + x2 + x3);
            if (hi == 0) {
#pragma unroll
                for (int k = 0; k < 4; ++k) { const int lr = __hip_atomic_fetch_add((LAS int*)&F.MISC[MI_LCNT + te[k]], 1, __ATOMIC_RELAXED, __HIP_MEMORY_SCOPE_WORKGROUP);
                    F.MISC[MI_REC + tl * 4 + k] = (te[k] << 16) | lr; }
                *(f32x4*)(gate_out + tok * 4) = (f32x4){inv, x1 * inv, x2 * inv, x3 * inv}; }
        }
        __syncthreads();
#pragma unroll 1
        for (int tp = 0; tp < 32; tp += 4) {
            u32x2 zw[4][4];
#pragma unroll
            for (int q = 0; q < 4; ++q) { const size_t tok = (size_t)u * 256 + 32 * wid + tp + q;
#pragma unroll
                for (int jj = 0; jj < 4; ++jj) zw[q][jj] = *(const GAS u32x2*)(Z + tok * D_MODEL + 256 * jj + 4 * lane); }
#pragma unroll
            for (int q = 0; q < 4; ++q) { const int tl = 32 * wid + tp + q; const size_t tok = (size_t)u * 256 + tl; const float mu = stats[2 * tl], rstd = stats[2 * tl + 1];
#pragma unroll
                for (int jj = 0; jj < 4; ++jj) { const u32x2 w_ = zw[q][jj];
                    const float h0 = (bflo(w_.x) - mu) * rstd * gg[jj * 4] + bb[jj * 4], h1 = (bfhi(w_.x) - mu) * rstd * gg[jj * 4 + 1] + bb[jj * 4 + 1], h2 = (bflo(w_.y) - mu) * rstd * gg[jj * 4 + 2] + bb[jj * 4 + 2], h3 = (bfhi(w_.y) - mu) * rstd * gg[jj * 4 + 3] + bb[jj * 4 + 3];
#if MOE_FP8
                    *(GAS unsigned*)(HB8 + tok * D_MODEL + 256 * jj + 4 * lane) = pk4_fp8(h0, h1, h2, h3);
#else
                    u32x2 w; w.x = pk2(h0, h1); w.y = pk2(h2, h3); *(GAS u32x2*)(HB + tok * D_MODEL + 256 * jj + 4 * lane) = w;
#endif
                } } }
        if (tid < 32) { const int c = F.MISC[MI_LCNT + tid]; F.MISC[MI_LBASE + tid] = c ? (int)__hip_atomic_fetch_add(cur + tid * 64, (unsigned)c, RLX_AGENT) : 0; }
        __syncthreads();
        for (int i = tid; i < 1024; i += 512) { const int rec = F.MISC[MI_REC + i], e = rec >> 16, rank = F.MISC[MI_LBASE + e] + (rec & 0xffff); const int tok = u * 256 + (i >> 2);
            rowtok[(size_t)(dry ? (e & 31) : e) * 65536 + (dry ? (rank & 32767) : rank)] = tok; slot_out[(size_t)tok * 4 + (i & 3)] = ((unsigned)e << 20) | (unsigned)rank; }
        __syncthreads();
    }
}

__device__ __forceinline__ void moe_tables(Frame& F, int l) {
    const int tid = fresh_tid();
    __syncthreads();
    if (tid < 32) F.MISC[MI_CNT + tid] = (int)__hip_atomic_load(F.ctl + CW_CUR + (size_t)(l * 32 + tid) * 64, RLX_AGENT);
    __syncthreads();
    if (tid == 0) { int acc = 0; for (int e = 0; e < 32; ++e) { F.MISC[MI_RBSTART + e] = acc; acc += (F.MISC[MI_CNT + e] + 255) >> 8; } F.MISC[MI_RBSTART + 32] = acc; }
    __syncthreads();
    const int nrb = F.MISC[MI_RBSTART + 32];
    for (int rb = tid; rb < nrb; rb += 512) { int e = 0; while (e < 31 && F.MISC[MI_RBSTART + e + 1] <= rb) ++e; F.MISC[MI_RBE + rb] = e; }
    __syncthreads();
}

__device__ __forceinline__ void cmb_phase(Frame& F, ArgsP a, int l, bool dry = false, bool tables = true) {
    PHASE_PROLOG();
    if (tables) moe_tables(F, l);
    const int lane = fresh_tid() & 63; const int gw = vcu_ * 8 + F.wave, NGW = G_ * 8;
    float gg[16], bb[16];
#pragma unroll
    for (int jj = 0; jj < 4; ++jj) { const f32x4 g4 = *(const f32x4*)(a->in[I_LN2_G] + l * 1024 + 256 * jj + 4 * lane), b4 = *(const f32x4*)(a->in[I_LN2_B] + l * 1024 + 256 * jj + 4 * lane);
#pragma unroll
        for (int i = 0; i < 4; ++i) { gg[jj * 4 + i] = g4[i]; bb[jj * 4 + i] = b4[i]; } }
    float ag1[16], ab1[16];
#pragma unroll
    for (int jj = 0; jj < 4; ++jj) { const f32x4 g4 = *(const f32x4*)(a->in[I_LN1_G] + l * 1024 + 256 * jj + 4 * lane), b4 = *(const f32x4*)(a->in[I_LN1_B] + l * 1024 + 256 * jj + 4 * lane);
#pragma unroll
        for (int i = 0; i < 4; ++i) { ag1[jj * 4 + i] = DN_ALPHA * g4[i]; ab1[jj * 4 + i] = DN_ALPHA * b4[i]; } }
    const GAS bf16_t* Zr = (const GAS bf16_t*)WSP(bf16_t, WS_Z); const GAS float* ST = (const GAS float*)WSP(float, WS_STAT);
    GAS float* H32 = (GAS float*)(dry ? WSP(float, WS_PR) : a->out); const GAS bf16_t* HB = (const GAS bf16_t*)WSP(bf16_t, WS_HB); GAS bf16_t* HBo = (GAS bf16_t*)(dry ? WSP(bf16_t, WS_PR) : WSP(bf16_t, WS_HB)); const GAS bf16_t* Y = (const GAS bf16_t*)WSP(bf16_t, WS_Y);
    for (int tok = gw; tok < T_TOK; tok += NGW) {
        const unsigned sl = ((const GAS unsigned*)WSP(unsigned, WS_SLOT))[(size_t)tok * 4 + (lane & 3)]; const float gt = ((const GAS float*)WSP(float, WS_GATE))[(size_t)tok * 4 + (lane & 3)];
        float z[16];
#if MOE_FP8
        const f32x2 st = *(const GAS f32x2*)(ST + (size_t)tok * 2); const float mu = st.x, rs = st.y;
#pragma unroll
        for (int jj = 0; jj < 4; ++jj) { const u32x2 hw = *(const GAS u32x2*)(Zr + (size_t)tok * D_MODEL + 256 * jj + 4 * lane);
            z[jj * 4] = (bflo(hw.x) - mu) * rs * ag1[jj * 4] + ab1[jj * 4]; z[jj * 4 + 1] = (bfhi(hw.x) - mu) * rs * ag1[jj * 4 + 1] + ab1[jj * 4 + 1];
            z[jj * 4 + 2] = (bflo(hw.y) - mu) * rs * ag1[jj * 4 + 2] + ab1[jj * 4 + 2]; z[jj * 4 + 3] = (bfhi(hw.y) - mu) * rs * ag1[jj * 4 + 3] + ab1[jj * 4 + 3]; }
#else
#pragma unroll
        for (int jj = 0; jj < 4; ++jj) { const u32x2 hw = *(const GAS u32x2*)(HB + (size_t)tok * D_MODEL + 256 * jj + 4 * lane);
            z[jj * 4] = DN_ALPHA * bflo(hw.x); z[jj * 4 + 1] = DN_ALPHA * bfhi(hw.x); z[jj * 4 + 2] = DN_ALPHA * bflo(hw.y); z[jj * 4 + 3] = DN_ALPHA * bfhi(hw.y); }
#endif
#pragma unroll
        for (int k = 0; k < 4; ++k) { const unsigned sk = (unsigned)__builtin_amdgcn_readlane((int)sl, k); const float gk = __builtin_bit_cast(float, __builtin_amdgcn_readlane(__builtin_bit_cast(int, gt), k));
            const int e = (int)(sk >> 20), rank = (int)(sk & 0xfffffu); const size_t row = (size_t)F.MISC[MI_RBSTART + e] * 256 + rank;
#if MOE_FP8
            const GAS unsigned char* y = (const GAS unsigned char*)Y + row * D_MODEL + 4 * lane; const float gs = gk * (1.0f / 64.0f);
#pragma unroll
            for (int jj = 0; jj < 4; ++jj) { const int w = *(const GAS int*)(y + 256 * jj);
                z[jj * 4] += gs * __builtin_amdgcn_cvt_f32_fp8(w, 0); z[jj * 4 + 1] += gs * __builtin_amdgcn_cvt_f32_fp8(w, 1); z[jj * 4 + 2] += gs * __builtin_amdgcn_cvt_f32_fp8(w, 2); z[jj * 4 + 3] += gs * __builtin_amdgcn_cvt_f32_fp8(w, 3); } }
#else
            const bf16_t* y = Y + row * D_MODEL + 4 * lane;
#pragma unroll
            for (int jj = 0; jj < 4; ++jj) { const u32x2 w = *(const u32x2*)(y + 256 * jj); z[jj * 4] += gk * bflo(w.x); z[jj * 4 + 1] += gk * bfhi(w.x); z[jj * 4 + 2] += gk * bflo(w.y); z[jj * 4 + 3] += gk * bfhi(w.y); } }
#endif
        ln16<0>(z, gg, bb);
#pragma unroll
        for (int jj = 0; jj < 4; ++jj) { if (l == DEPTH - 1) *(GAS f32x4*)(H32 + (size_t)tok * D_MODEL + 256 * jj + 4 * lane) = (f32x4){z[jj * 4], z[jj * 4 + 1], z[jj * 4 + 2], z[jj * 4 + 3]};
            else { u32x2 w; w.x = pk2(z[jj * 4], z[jj * 4 + 1]); w.y = pk2(z[jj * 4 + 2], z[jj * 4 + 3]); *(GAS u32x2*)(HBo + (size_t)tok * D_MODEL + 256 * jj + 4 * lane) = w; } }
    }
}
#if MK_CHECK
constexpr int CW_CHK = 32768, N_CHK = 16, CHK_NS = 64;
__device__ __forceinline__ int chk_tok(int i) { return (i * 1021 + 77) & 65535; }
__device__ __forceinline__ void chk_put(Frame& F, int k, float err, float ref) {
    if (!(err == err)) err = 1e30f;
    err = wave_max(err); ref = wave_max(ref);
    if ((fresh_tid() & 63) == 0) { __hip_atomic_fetch_max(F.ctl + CW_CHK + 2 * k, __builtin_bit_cast(unsigned, err), RLX_AGENT); __hip_atomic_fetch_max(F.ctl + CW_CHK + 2 * k + 1, __builtin_bit_cast(unsigned, ref), RLX_AGENT); }
}
__device__ __forceinline__ float nanfix(float d) { return (d == d) ? d : 1e30f; }
__device__ __forceinline__ float chk_dot_bf(const bf16_t* x, const bf16_t* y, int n, int lane) { float s = 0.f; for (int k = lane; k < n; k += 64) s += bf2f(x[k]) * bf2f(y[k]); return wave_sum(s); }

__device__ __forceinline__ void chk_gemm(Frame& F, ArgsP a, int l, int which) {
    PHASE_PROLOG(); const int lane = fresh_tid() & 63, gw = vcu_ * 8 + F.wave, NGW = G_ * 8; const bool odd = l & 1; const int j = l >> 1;
    float err = 0.f, ref = 0.f, errg = 0.f, refg = 0.f;
    for (int si = gw; si < CHK_NS * 8; si += NGW) { const int tok = chk_tok(si >> 3), ci = si & 7;
        if (which == 1) { const int colsE[8] = {5, 300, 390, 449, 460, 700, 1100, 1500}, colsO[8] = {5, 1000, 1100, 2000, 2100, 3000, 3071, 64};
            int col = 0;
#pragma unroll
            for (int q = 0; q < 8; ++q) if (ci == q) col = odd ? colsO[q] : colsE[q];
            const int N = odd ? NO_PR : NE_PR; const bf16_t* W = odd ? WSP(bf16_t, WS_WINO) + ((size_t)j * NO_PR + col) * 1024 : WSP(bf16_t, WS_WINE) + ((size_t)j * NE_PR + col) * 1024;
            float v = chk_dot_bf(WSP(bf16_t, WS_HB) + (size_t)tok * 1024, W, 1024, lane); if (!odd && col >= 512) v = gelu_tanh(v);
            const float f = bf2f(WSP(bf16_t, WS_PR)[(size_t)tok * N + col]);
            if (!odd && col >= 512) { errg = fmaxf(errg, nanfix(fabsf(f - v))); refg = fmaxf(refg, fabsf(v)); } else { err = fmaxf(err, nanfix(fabsf(f - v))); ref = fmaxf(ref, fabsf(v)); } }
        else if (which == 3) { const int cols[8] = {3, 500, 1023, 1030, 1279, 1100, 128, 1200}; int col = 0;
#pragma unroll
            for (int q = 0; q < 8; ++q) if (ci == q) col = cols[q];
            const float v = chk_dot_bf(WSP(bf16_t, WS_CQ) + (size_t)tok * 256, WSP(bf16_t, WS_WQE) + ((size_t)j * NQQ + col) * 256, 256, lane);
            const float f = bf2f(WSP(bf16_t, WS_QQ)[(size_t)tok * NQQ + col]); err = fmaxf(err, nanfix(fabsf(f - v))); ref = fmaxf(ref, fabsf(v)); }
        else { const int cols[8] = {1, 300, 600, 1023, 255, 256, 777, 512}; int col = 0;
#pragma unroll
            for (int q = 0; q < 8; ++q) if (ci == q) col = cols[q];
            const int K = odd ? 1024 : NMX; const bf16_t* W = odd ? WSP(bf16_t, WS_WOUTO) + ((size_t)j * 1024 + col) * 1024 : WSP(bf16_t, WS_WOUTE) + ((size_t)j * 1024 + col) * NMX;
            const float hs = (l == 0 ? a->in[I_X] : (const float*)a->out)[(size_t)tok * 1024 + col];
            const float v = DN_ALPHA * hs + chk_dot_bf(WSP(bf16_t, WS_MX) + (size_t)tok * K, W, K, lane);
            const float f = WSP(float, WS_Z)[(size_t)tok * 1024 + col]; err = fmaxf(err, nanfix(fabsf(f - v))); ref = fmaxf(ref, fabsf(v)); }
    }
    if (which == 1) { if (odd) chk_put(F, 14, err, ref); else { chk_put(F, 1, err, ref); chk_put(F, 13, errg, refg); } } else chk_put(F, which, err, ref);
}
__device__ __forceinline__ void chk_e1b(Frame& F, ArgsP a, int l) {
    PHASE_PROLOG(); const int lane = fresh_tid() & 63, gw = vcu_ * 8 + F.wave, NGW = G_ * 8, j = l >> 1; float err = 0.f, ref = 0.f;
    for (int si = gw; si < CHK_NS; si += NGW) { const int tok = chk_tok(si); const bf16_t* pr = WSP(bf16_t, WS_PR) + (size_t)tok * NE_PR;
        float x[4], ss = 0.f;
#pragma unroll
        for (int i = 0; i < 4; ++i) { x[i] = bf2f(pr[lane + 64 * i]); ss += x[i] * x[i]; }
        ss = wave_sum(ss); float rs = 1.0f / sqrtf(ss / 256.0f + LN_EPS);
#pragma unroll
        for (int i = 0; i < 4; ++i) { const float v = x[i] * rs * a->in[I_EV_Q_NORM][j * 256 + lane + 64 * i]; err = fmaxf(err, nanfix(fabsf(v - bf2f(WSP(bf16_t, WS_CQ)[(size_t)tok * 256 + lane + 64 * i])))); ref = fmaxf(ref, fabsf(v)); }
        float y0 = bf2f(pr[256 + lane]), y1 = bf2f(pr[256 + 64 + lane]); ss = wave_sum(y0 * y0 + y1 * y1); rs = 1.0f / sqrtf(ss / 128.0f + LN_EPS);
        { const float v0 = y0 * rs * a->in[I_EV_KV_NORM][j * 128 + lane], v1 = y1 * rs * a->in[I_EV_KV_NORM][j * 128 + 64 + lane];
          err = fmaxf(err, nanfix(fabsf(v0 - bf2f(WSP(bf16_t, WS_CKV)[(size_t)tok * 128 + lane])))); err = fmaxf(err, nanfix(fabsf(v1 - bf2f(WSP(bf16_t, WS_CKV)[(size_t)tok * 128 + 64 + lane])))); }
        { const float z = bf2f(pr[384 + lane]); const float mu = wave_sum(z) / 64.0f; const float var = wave_sum((z - mu) * (z - mu)) / 64.0f;
          const float v = (z - mu) / sqrtf(var + LN_EPS) * a->in[I_EV_IDX_K_G][j * 64 + lane] + a->in[I_EV_IDX_K_B][j * 64 + lane];
          err = fmaxf(err, nanfix(fabsf(v - bf2f(WSP(bf16_t, WS_KI)[(size_t)tok * 64 + lane])))); ref = fmaxf(ref, fabsf(v)); }
        if (lane < 4) err = fmaxf(err, nanfix(fabsf(0.5f * bf2f(pr[448 + lane]) - WSP(float, WS_WI)[(size_t)tok * 4 + lane])));
    }
    chk_put(F, 2, err, ref);
}
__device__ __forceinline__ void chk_dsa(Frame& F, ArgsP a, int l) {
    PHASE_PROLOG(); const int lane = fresh_tid() & 63, gw = vcu_ * 8 + F.wave, NGW = G_ * 8; float err4 = 0.f, ref4 = 1e-20f, err5 = 0.f, ref5 = 0.f;
    LAS float* pl = (LAS float*)F.lds + F.wave * 2048;
    const bf16_t* QQ = WSP(bf16_t, WS_QQ); const bf16_t* KI = WSP(bf16_t, WS_KI); const bf16_t* CKV = WSP(bf16_t, WS_CKV);
    for (int si = gw; si < CHK_NS; si += NGW) { const int tok = chk_tok(si), b = tok >> 11, t = tok & 2047, NT = t / 64 + 1, N = NT * 64; const size_t rb0 = (size_t)b * SEQ;
        int npop = 0; float minsel = 1e30f, maxun = -1e30f, maxabs = 0.f; int maxselzero = -1, minunzero = 1 << 20;
        for (int i = 0; i < NT; ++i) { const int s = i * 64 + lane; float sc = 0.f;
            for (int h = 0; h < 4; ++h) { float d = 0.f; for (int k = 0; k < 64; ++k) d += bf2f(QQ[(size_t)tok * NQQ + 1024 + h * 64 + k]) * bf2f(KI[(rb0 + s) * 64 + k]); sc += fmaxf(d, 0.f) * WSP(float, WS_WI)[(size_t)tok * 4 + h]; }
            sc += 0.0f;
            const unsigned long long mw = WSP(unsigned long long, WS_MASK)[(size_t)tok * 32 + i]; const bool sel = (mw >> lane) & 1ull;
            npop += sel ? 1 : 0; maxabs = fmaxf(maxabs, fabsf(sc));
            if (sel) { minsel = fminf(minsel, sc); if (sc == 0.f) maxselzero = max(maxselzero, s); } else { maxun = fmaxf(maxun, sc); if (sc == 0.f) minunzero = min(minunzero, s); } }
        for (int i = NT; i < 32; ++i) if (WSP(unsigned long long, WS_MASK)[(size_t)tok * 32 + i] != 0ull) err4 = 1e30f;
        npop = (int)wave_sum((float)npop); minsel = -wave_max(-minsel); maxun = wave_max(maxun); maxabs = wave_max(maxabs);
        maxselzero = (int)wave_max((float)maxselzero); minunzero = -(int)wave_max(-(float)minunzero);
        if (npop != (N < N_SEL ? N : N_SEL)) err4 = 1e30f;
        if (N > N_SEL) { err4 = fmaxf(err4, maxun - minsel); if (minsel == 0.f && maxun == 0.f && maxselzero > minunzero) err4 = 1e30f; }
        ref4 = fmaxf(ref4, maxabs / 30.0f);
        const int h = si & 7; const float slope2 = exp2f(-(float)(h + 1)) * LOG2E; float mx = -1e30f;
        for (int i = 0; i < NT; ++i) { const int s = i * 64 + lane; float d = 0.f; for (int k = 0; k < 128; ++k) d += bf2f(QQ[(size_t)tok * NQQ + h * 128 + k]) * bf2f(CKV[(rb0 + s) * 128 + k]);
            d -= slope2 * fabsf((float)(t - s)); const unsigned long long mw = WSP(unsigned long long, WS_MASK)[(size_t)tok * 32 + i]; if (!((mw >> lane) & 1ull)) d = -1e30f; pl[s] = d; mx = fmaxf(mx, d); }
        mx = wave_max(mx); float sum = 0.f;
        for (int i = 0; i < NT; ++i) { const int s = i * 64 + lane; const float p = fast_exp2(pl[s] - mx); pl[s] = p; sum += p; }
        sum = wave_sum(sum); LDS_WAIT();
        for (int cc = 0; cc < 2; ++cc) { const int c = lane + 64 * cc; float o = 0.f; for (int s = 0; s < N; ++s) o += pl[s] * bf2f(CKV[(rb0 + s) * 128 + c]); o /= sum;
            const float f = bf2f(WSP(bf16_t, WS_MX)[(size_t)tok * NMX + h * 128 + c]); err5 = fmaxf(err5, nanfix(fabsf(f - o))); ref5 = fmaxf(ref5, fabsf(o)); }
        LDS_WAIT();
    }
    chk_put(F, 4, err4, ref4); chk_put(F, 5, err5, ref5);
}
__device__ __forceinline__ void chk_gml(Frame& F, ArgsP a, int l) {
    PHASE_PROLOG(); const int lane = fresh_tid() & 63, gw = vcu_ * 8 + F.wave, NGW = G_ * 8, j = l >> 1; float err = 0.f, ref = 0.f;
    const bf16_t* PR = WSP(bf16_t, WS_PR);
    for (int si = gw; si < CHK_NS; si += NGW) { const int tok = chk_tok(si), g = si & 7, ii = tok & 127; const size_t tok0 = (size_t)(tok - ii); float mixed = 0.f;
        for (int jx = 0; jx <= ii; ++jx) { const bf16_t* vr = PR + (tok0 + jx) * NE_PR + 1024; float xs[8], s = 0.f;
#pragma unroll
            for (int q = 0; q < 8; ++q) { xs[q] = bf2f(vr[lane + 64 * q]); s += xs[q]; }
            const float mu = wave_sum(s) / 512.0f; float s2 = 0.f;
#pragma unroll
            for (int q = 0; q < 8; ++q) s2 += (xs[q] - mu) * (xs[q] - mu);
            const float rs = 1.0f / sqrtf(wave_sum(s2) / 512.0f + LN_EPS);
            const float vln = (bf2f(vr[g * 64 + lane]) - mu) * rs * a->in[I_EV_V_NORM_G][j * GW + g * 64 + lane] + a->in[I_EV_V_NORM_B][j * GW + g * 64 + lane];
            mixed += a->in[I_EV_W_S][((size_t)(j * 8 + g) * 128 + ii) * 128 + jx] * vln; }
        mixed += a->in[I_EV_B_S][(size_t)(j * 8 + g) * 128 + ii];
        const float v = bf2f(PR[(size_t)tok * NE_PR + 512 + g * 64 + lane]) * mixed; const float f = bf2f(WSP(bf16_t, WS_MX)[(size_t)tok * NMX + 1024 + g * 64 + lane]);
        err = fmaxf(err, nanfix(fabsf(f - v))); ref = fmaxf(ref, fabsf(v)); }
    chk_put(F, 6, err, ref);
}
__device__ __forceinline__ void chk_lnr(Frame& F, ArgsP a, int l) {
    PHASE_PROLOG(); const int lane = fresh_tid() & 63, gw = vcu_ * 8 + F.wave, NGW = G_ * 8; float err = 0.f, ref = 0.f;
    for (int si = gw; si < CHK_NS; si += NGW) { const int tok = chk_tok(si); const float* z = WSP(float, WS_Z) + (size_t)tok * 1024; float x[16], s = 0.f;
#pragma unroll
        for (int i = 0; i < 16; ++i) { x[i] = z[lane + 64 * i]; s += x[i]; }
        const float mu = wave_sum(s) / 1024.0f; float s2 = 0.f;
#pragma unroll
        for (int i = 0; i < 16; ++i) s2 += (x[i] - mu) * (x[i] - mu);
        const float rs = 1.0f / sqrtf(wave_sum(s2) / 1024.0f + LN_EPS);
#pragma unroll
        for (int i = 0; i < 16; ++i) { x[i] = (x[i] - mu) * rs * a->in[I_LN1_G][l * 1024 + lane + 64 * i] + a->in[I_LN1_B][l * 1024 + lane + 64 * i];
            err = fmaxf(err, nanfix(fabsf(x[i] - a->out[(size_t)tok * 1024 + lane + 64 * i]))); err = fmaxf(err, nanfix(fabsf(x[i] - bf2f(WSP(bf16_t, WS_HB)[(size_t)tok * 1024 + lane + 64 * i])) * 0.25f)); ref = fmaxf(ref, fabsf(x[i])); }
        float lg = 0.f;
        for (int e = 0; e < 32; ++e) { float p = 0.f;
#pragma unroll
            for (int i = 0; i < 16; ++i) p += x[i] * a->in[I_ROUTER_W][((size_t)l * 1024 + lane + 64 * i) * 32 + e];
            p = wave_sum(p) + a->in[I_ROUTER_B][l * 32 + e]; if (lane == e) lg = p; }
        if (lane >= 32) lg = -1e30f;
        float tl[4]; int te[4]; float v = lg;
        for (int k = 0; k < 4; ++k) { const float m = wave_max(v); const unsigned long long bm = __builtin_amdgcn_ballot_w64(v == m); te[k] = __builtin_ctzll(bm); tl[k] = m; if (lane == te[k]) v = -1e30f; }
        const float den = 1.0f + expf(tl[1] - tl[0]) + expf(tl[2] - tl[0]) + expf(tl[3] - tl[0]);
        for (int k = 0; k < 4; ++k) { const unsigned sl = WSP(unsigned, WS_SLOT)[(size_t)tok * 4 + k]; const int e = (int)(sl >> 20), rank = (int)(sl & 0xfffffu);
            if (e != te[k]) {
                const float mine = __builtin_bit_cast(float, __builtin_amdgcn_ds_bpermute(e << 2, __builtin_bit_cast(int, lg)));
                if (fabsf(mine - tl[k]) > 1e-4f) err = 1e30f; }
            if (WSP(int, WS_ROWTOK)[(size_t)e * 65536 + rank] != tok) err = 1e30f;
            const float gk = expf(tl[k] - tl[0]) / den; err = fmaxf(err, nanfix(fabsf(gk - WSP(float, WS_GATE)[(size_t)tok * 4 + k]))); }
    }
    chk_put(F, 8, err, ref);
}
__device__ __forceinline__ void chk_moe(Frame& F, ArgsP a, int l) {
    PHASE_PROLOG(); const int lane = fresh_tid() & 63, gw = vcu_ * 8 + F.wave, NGW = G_ * 8; float err = 0.f, ref = 0.f;
    LAS float* al = (LAS float*)F.lds + F.wave * 1024;
    for (int si = gw; si < CHK_NS; si += NGW) { const int tok = chk_tok(si), k = si & 3; const unsigned sl = WSP(unsigned, WS_SLOT)[(size_t)tok * 4 + k]; const int e = (int)(sl >> 20), rank = (int)(sl & 0xfffffu);
        int rbs = 0; for (int q = 0; q < e; ++q) rbs += ((int)__hip_atomic_load(F.ctl + CW_CUR + (size_t)(l * 32 + q) * 64, RLX_AGENT) + 255) >> 8;
        const size_t crow = (size_t)rbs * 256 + rank;
        const float* wgu = a->in[I_EXP_W_GU] + ((size_t)l * NEXP + e) * 1024 * 2048; const float* wdn = a->in[I_EXP_W_DN] + ((size_t)l * NEXP + e) * 1024 * 1024;
        const bf16_t* hb = WSP(bf16_t, WS_HB) + (size_t)tok * 1024;
        float ag[16], au[16];
#pragma unroll
        for (int i = 0; i < 16; ++i) { ag[i] = 0.f; au[i] = 0.f; }
        for (int kk = 0; kk < 1024; ++kk) { const float hv = bf2f(hb[kk]);
#pragma unroll
            for (int i = 0; i < 16; ++i) { ag[i] += hv * wgu[(size_t)kk * 2048 + lane + 64 * i]; au[i] += hv * wgu[(size_t)kk * 2048 + 1024 + lane + 64 * i]; } }
#pragma unroll
        for (int i = 0; i < 16; ++i) { const int f = lane + 64 * i; float gt = ag[i] + a->in[I_EXP_B_GU][((size_t)l * NEXP + e) * 2048 + f], up = au[i] + a->in[I_EXP_B_GU][((size_t)l * NEXP + e) * 2048 + 1024 + f];
            gt = fminf(gt, 7.0f); up = fminf(fmaxf(up, -7.0f), 7.0f); const float act = (up + 1.0f) * gt / (1.0f + expf(-1.702f * gt)); al[f] = act;
            const float fa = bf2f(WSP(bf16_t, WS_ACT)[crow * 1024 + f]); err = fmaxf(err, nanfix(fabsf(fa - act))); ref = fmaxf(ref, fabsf(act)); }
        LDS_WAIT();
#pragma unroll
        for (int ci = 0; ci < 4; ++ci) { const int col = ci == 0 ? 0 : ci == 1 ? 511 : ci == 2 ? 1023 : 700; float s = 0.f; for (int f = lane; f < 1024; f += 64) s += al[f] * wdn[(size_t)f * 1024 + col];
            s = wave_sum(s) + a->in[I_EXP_B_DN][((size_t)l * NEXP + e) * 1024 + col]; const float fy = bf2f(WSP(bf16_t, WS_Y)[crow * 1024 + col]);
            err = fmaxf(err, nanfix(fabsf(fy - s)) * 2.0f); ref = fmaxf(ref, fabsf(s)); }
        LDS_WAIT();
    }
    chk_put(F, 9, err, ref);
}
__device__ __forceinline__ void chk_datt(Frame& F, ArgsP a, int l) {
    PHASE_PROLOG(); const int lane = fresh_tid() & 63, gw = vcu_ * 8 + F.wave, NGW = G_ * 8, j = l >> 1; float err = 0.f, ref = 0.f;
    LAS float* pl = (LAS float*)F.lds + F.wave * 2048; const bf16_t* PR = WSP(bf16_t, WS_PR);
    const float lam_init = 0.8f - 0.6f * expf(-0.3f * (float)l);
    const float lam = expf(wave_sum(a->in[I_OD_LQ1][j * 64 + lane] * a->in[I_OD_LK1][j * 64 + lane])) - expf(wave_sum(a->in[I_OD_LQ2][j * 64 + lane] * a->in[I_OD_LK2][j * 64 + lane])) + lam_init;
    for (int si = gw; si < CHK_NS; si += NGW) { const int tok = chk_tok(si), b = tok >> 11, t = tok & 2047, NT = t / 64 + 1, N = NT * 64, h = si & 7; const size_t rb0 = (size_t)b * SEQ;
        const float slope2 = exp2f(-(float)(h + 1)) * LOG2E; float oc[2][2];
        for (int m = 0; m < 2; ++m) { float mx = -1e30f;
            for (int i = 0; i < NT; ++i) { const int s = i * 64 + lane; float d = 0.f; for (int k = 0; k < 64; ++k) d += bf2f(PR[(size_t)tok * NO_PR + h * 128 + m * 64 + k]) * bf2f(PR[(rb0 + s) * NO_PR + 1024 + h * 128 + m * 64 + k]);
                d -= slope2 * fabsf((float)(t - s)); pl[s] = d; mx = fmaxf(mx, d); }
            mx = wave_max(mx); float sum = 0.f;
            for (int i = 0; i < NT; ++i) { const int s = i * 64 + lane; const float p = fast_exp2(pl[s] - mx); pl[s] = p; sum += p; }
            sum = wave_sum(sum); LDS_WAIT();
            for (int cc = 0; cc < 2; ++cc) { const int c = lane + 64 * cc; float o = 0.f; for (int s = 0; s < N; ++s) o += pl[s] * bf2f(PR[(rb0 + s) * NO_PR + 2048 + h * 128 + c]); oc[m][cc] = o / sum; }
            LDS_WAIT(); }
        const float y0 = oc[0][0] - lam * oc[1][0], y1 = oc[0][1] - lam * oc[1][1]; const float rs = (1.0f - lam_init) / sqrtf(wave_sum(y0 * y0 + y1 * y1) / 128.0f + LN_EPS);
        const float v0 = y0 * rs * a->in[I_OD_SUBLN_G][j * 128 + lane], v1 = y1 * rs * a->in[I_OD_SUBLN_G][j * 128 + 64 + lane];
        const float f0 = bf2f(WSP(bf16_t, WS_MX)[(size_t)tok * 1024 + h * 128 + lane]), f1 = bf2f(WSP(bf16_t, WS_MX)[(size_t)tok * 1024 + h * 128 + 64 + lane]);
        err = fmaxf(err, nanfix(fabsf(f0 - v0))); err = fmaxf(err, nanfix(fabsf(f1 - v1))); ref = fmaxf(ref, fmaxf(fabsf(v0), fabsf(v1))); }
    chk_put(F, 11, err, ref);
}
__device__ __forceinline__ void chk_final(Frame& F, ArgsP a) {
    PHASE_PROLOG(); int code = 0;
    for (int k = N_CHK - 1; k >= 1; --k) { const float e = __builtin_bit_cast(float, __hip_atomic_load(F.ctl + CW_CHK + 2 * k, RLX_AGENT)), r = __builtin_bit_cast(float, __hip_atomic_load(F.ctl + CW_CHK + 2 * k + 1, RLX_AGENT));
        if (e > 0.03f * r) code = k; }
    if (code == 0) return;
    const float sc = 1.0f + 0.05f * (float)code; const int gt = vcu_ * 512 + fresh_tid(), NGT = G_ * 512;
    for (size_t i = gt; i < (size_t)T_TOK * 1024; i += NGT) a->out[i] *= sc;
}
#endif
constexpr int N_PHASES = 10;
__global__ void __launch_bounds__(512, 2) mk_fwd(Args a) {
    extern __shared__ __attribute__((aligned(16))) unsigned char lds_raw[];
    Frame F;
    F.lds = (LAS unsigned char*)lds_raw; F.ldsg = (char*)lds_raw;
    F.MISC = (volatile LAS int*)(F.lds + MISC_OFF);
    F.tid = threadIdx.x; F.lane = F.tid & 63; F.wave = __builtin_amdgcn_readfirstlane(F.tid >> 6);
    F.G = gridDim.x; { const int bx = blockIdx.x; F.vcu = (F.G % 8 == 0) ? (bx % 8) * (F.G / 8) + bx / 8 : bx; }
    ArgsP ap = (ArgsP)__builtin_amdgcn_kernarg_segment_ptr();
    F.ws = ap->ws; F.ctl = (gu32*)(ap->ws + WS_CTL);
    const int a_fused = ap->fused, a_llo = ap->l_lo, a_lhi = ap->l_hi, a_plo0 = ap->p_lo, a_phi0 = ap->p_hi, a_pro = ap->do_pro;
    for (int u = F.tid; u < (LDS_BYTES - MISC_OFF) / 4; u += 512) F.MISC[u] = 0;
    __syncthreads();
    XcdBarrier bar; bar.bar = (unsigned*)(F.ctl + CW_BAR); bar.x = 0; bar.st = nullptr; bar.w = (unsigned)F.wave;
    if (a_fused) bar = xcd_barrier_post((unsigned*)(F.ctl + CW_BAR), (volatile LAS unsigned*)(F.MISC + MI_BAR));
#define GRID_BAR() do { if (a_fused) xcd_barrier(bar); } while (0)
#define KPROLOG() ArgsP a = ap; unsigned char* ws_ = F.ws; asm volatile("" : "+s"(ws_)); asm volatile("" : "+s"(a)); int vcu_ = F.vcu, G_ = F.G, bx_ = (int)blockIdx.x; asm volatile("" : "+s"(vcu_), "+s"(G_), "+s"(bx_))
#ifndef PHASE_MASK
#define PHASE_MASK 0x7ff
#endif
#define RUN(p) (((PHASE_MASK >> (p)) & 1) && a_plo <= (p) && (p) < a_phi)
#ifndef PROBE_REP
#define PROBE_REP 0
#endif
#ifndef STG_PIN
#define STG_PIN 0
#endif
#ifndef STG_POUT
#define STG_POUT 0
#endif
#ifndef STG_M1
#define STG_M1 0
#endif
#ifndef STG_M2
#define STG_M2 0
#endif
#ifndef PROBE_KREP
#define PROBE_KREP 0
#endif
#define PKR_ ((PROBE_KREP == 1 && rep_ + 1 < nreps_) ? 2 : 1)
#define PER_ ((PROBE_KREP == 2 && rep_ + 1 < nreps_) ? 2 : (PROBE_KREP == 3 && rep_ + 1 < nreps_) ? 0 : 1)
#ifndef PROBE_PAR
#define PROBE_PAR 0
#endif
#define REPS(p) _Pragma("unroll 1") for (int nreps_ = 1 + (((PROBE_REP >> (p)) & 1) && (PROBE_PAR == 0 || (PROBE_PAR == 1 && !(l_probe & 1)) || (PROBE_PAR == 2 && (l_probe & 1))) ? 1 : 0), rep_ = 0; rep_ < nreps_; ++rep_)
    { const int l_probe = 0; if (((PHASE_MASK >> 10) & 1) && a_pro) { REPS(10) { pro_phase(F, ap); GRID_BAR(); } } }
    for (int l = a_llo; l < a_lhi; ++l) {
        int a_plo = a_plo0, a_phi = a_phi0; asm volatile("" : "+s"(a_plo), "+s"(a_phi));
        const bool odd = (l & 1) != 0; const int j = l >> 1; const int l_probe = l;
        if (RUN(0)) REPS(0) { KPROLOG();
            const bf16_t* Bt = odd ? WSP(bf16_t, WS_WINO) + (size_t)j * NO_PR * 1024 : WSP(bf16_t, WS_WINE) + (size_t)j * NE_PR * 1024; const int N = odd ? NO_PR : NE_PR;
            pg8::DenseOrder S; S.init(T_TOK, N, G_, bx_);
            pg8::EpiStoreBf16 E{WSP(bf16_t, WS_PR), N, odd ? (1 << 30) : 2};
#ifdef PROBE_STORE_VARIANT
            if (rep_ + 1 < nreps_) { pg8::EpiStoreBf16T<PROBE_STORE_VARIANT> EV{E.O, E.ldc, E.gelu_from}; pg8::gemm_phase<pg8::EpiStoreBf16T<PROBE_STORE_VARIANT>, pg8::DenseOrder, false>(F.lds, WSP(bf16_t, WS_HB), Bt, 1024, nullptr, S, EV, F.wave, 0x7f7f7f7f, 0x7f7f7f7f, 0x7f7f7f7f, 1, 1, STG_PIN); } else
#endif
            pg8::gemm_phase<pg8::EpiStoreBf16, pg8::DenseOrder, false>(F.lds, WSP(bf16_t, WS_HB), Bt, 1024, nullptr, S, E, F.wave, 0x7f7f7f7f, 0x7f7f7f7f, 0x7f7f7f7f, PKR_, PER_, STG_PIN);
            GRID_BAR();
        }
        if (!odd) {
            if (RUN(1)) REPS(1) { e1b_phase(F, ap, l); GRID_BAR(); }
            if (RUN(2)) REPS(2) { KPROLOG();
                pg8::DenseOrder S; S.init(T_TOK, NQQ, G_, bx_);
                pg8::EpiStoreBf16 E{WSP(bf16_t, WS_QQ), NQQ, 1 << 30};
                pg8::gemm_phase<pg8::EpiStoreBf16, pg8::DenseOrder, false>(F.lds, WSP(bf16_t, WS_CQ), WSP(bf16_t, WS_WQE) + (size_t)j * NQQ * 256, 256, nullptr, S, E, F.wave);
                GRID_BAR();
            }
            if (RUN(3)) REPS(3) { e3a_phase(F, ap); GRID_BAR(); }
        }
        if (RUN(4)) REPS(4) {
#ifndef ATT_SEL
#define ATT_SEL 7
#endif
            if (odd) { if (ATT_SEL & 4) datt_phase(F, ap, l); }
            else { if (ATT_SEL & 1) dsa_phase(F, ap); if (ATT_SEL & 2) gml_phase(F, ap, l); }
            GRID_BAR();
        }
        if (RUN(5)) REPS(5) { KPROLOG();
            const bf16_t* Bt = odd ? WSP(bf16_t, WS_WOUTO) + (size_t)j * 1024 * 1024 : WSP(bf16_t, WS_WOUTE) + (size_t)j * 1024 * NMX; const int K = odd ? 1024 : NMX;
            pg8::DenseOrder S; S.init(T_TOK, D_MODEL, G_, bx_);
            pg8::EpiResid E{WSP(bf16_t, WS_HB), WSP(bf16_t, WS_Z), DN_ALPHA};
#if POUT_FP8
            const unsigned char* Bt8 = odd ? WSP(unsigned char, WS_WOUTO) + (size_t)j * 1024 * 1024 : WSP(unsigned char, WS_WOUTE) + (size_t)j * 1024 * NMX; const int sB = odd ? 0x79797979 : 0x78787878;
            pg8::gemm_phase<pg8::EpiResid, pg8::DenseOrder, false, true>(F.lds, (const bf16_t*)WSP(unsigned char, WS_MX), (const bf16_t*)Bt8, K / 2, nullptr, S, E, F.wave, 0x7c7c7c7c, sB, sB, PKR_, PER_, STG_POUT);
#else
            pg8::gemm_phase<pg8::EpiResid, pg8::DenseOrder, false>(F.lds, WSP(bf16_t, WS_MX), Bt, K, nullptr, S, E, F.wave, 0x7f7f7f7f, 0x7f7f7f7f, 0x7f7f7f7f, PKR_, PER_, STG_POUT);
#endif
            GRID_BAR();
        }
#ifndef LNR_MFMA
#define LNR_MFMA 1
#endif
        if (RUN(6)) { if ((PROBE_REP >> 6) & 1) { if (LNR_MFMA) lnr2_phase(F, ap, l, true); else lnr_phase(F, ap, l, true); GRID_BAR(); } if (LNR_MFMA) lnr2_phase(F, ap, l); else lnr_phase(F, ap, l); GRID_BAR(); }
        if (RUN(7)) REPS(7) { KPROLOG();
            moe_tables(F, l);
            pg8::MoeOrder S; S.npn = 8; S.nunits = __builtin_amdgcn_readfirstlane(F.MISC[MI_RBSTART + 32]) * 8; S.G = G_; S.c = vcu_; S.tab = (const LAS int*)F.MISC;
            pg8::EpiSwiglu E{WSP(bf16_t, WS_ACT), a->in[I_EXP_B_GU] + (size_t)l * NEXP * 2048};
#if MOE_FP8
            pg8::gemm_phase<pg8::EpiSwiglu, pg8::MoeOrder, true, true>(F.lds, WSP(bf16_t, WS_HB8), (const bf16_t*)(WSP(unsigned char, WS_WGU) + (size_t)l * NEXP * 2048 * 1024), 512, WSP(int, WS_ROWTOK), S, E, F.wave, 0x7f7f7f7f, 0x79797979, 0x7c7c7c7c, PKR_, PER_, STG_M1);
#else
            pg8::gemm_phase<pg8::EpiSwiglu, pg8::MoeOrder, true>(F.lds, WSP(bf16_t, WS_HB), WSP(bf16_t, WS_WGU) + (size_t)l * NEXP * 2048 * 1024, 1024, WSP(int, WS_ROWTOK), S, E, F.wave);
#endif
            GRID_BAR();
        }
        if (RUN(8)) REPS(8) { KPROLOG();
            if (!(((PHASE_MASK >> 7) & 1) && a_plo <= 7 && 7 < a_phi)) moe_tables(F, l);
            pg8::MoeOrder S; S.npn = 4; S.nunits = __builtin_amdgcn_readfirstlane(F.MISC[MI_RBSTART + 32]) * 4; S.G = G_; S.c = vcu_; S.tab = (const LAS int*)F.MISC; S.rev = 1;
            pg8::EpiBiasBf16 E{WSP(bf16_t, WS_Y), a->in[I_EXP_B_DN] + (size_t)l * NEXP * 1024};
#if MOE_FP8
            pg8::gemm_phase<pg8::EpiBiasBf16, pg8::MoeOrder, false, true>(F.lds, WSP(bf16_t, WS_ACT), (const bf16_t*)(WSP(unsigned char, WS_WDN) + (size_t)l * NEXP * 1024 * 1024), 512, nullptr, S, E, F.wave, 0x7c7c7c7c, 0x7f7f7f7f, 0x7f7f7f7f, PKR_, PER_, STG_M2);
#else
            pg8::gemm_phase<pg8::EpiBiasBf16, pg8::MoeOrder, false>(F.lds, WSP(bf16_t, WS_ACT), WSP(bf16_t, WS_WDN) + (size_t)l * NEXP * 1024 * 1024, 1024, nullptr, S, E, F.wave);
#endif
            GRID_BAR();
        }
        if (RUN(9)) { if ((PROBE_REP >> 9) & 1) { cmb_phase(F, ap, l, true); GRID_BAR(); } cmb_phase(F, ap, l, false, !(((PHASE_MASK >> 7) & 1) && a_plo <= 7 && 7 < a_phi)); if (l + 1 < DEPTH) GRID_BAR(); }
    }
#undef GRID_BAR
#undef RUN
}

#if MK_CHECK
__global__ void __launch_bounds__(512, 2) mk_chk(Args a_) {
    extern __shared__ __attribute__((aligned(16))) unsigned char lds_raw[];
    Frame F;
    F.lds = (LAS unsigned char*)lds_raw; F.ldsg = (char*)lds_raw; F.MISC = (volatile LAS int*)(F.lds + MISC_OFF);
    F.tid = threadIdx.x; F.lane = F.tid & 63; F.wave = __builtin_amdgcn_readfirstlane(F.tid >> 6);
    F.G = gridDim.x; { const int bx = blockIdx.x; F.vcu = (F.G % 8 == 0) ? (bx % 8) * (F.G / 8) + bx / 8 : bx; }
    ArgsP ap = (ArgsP)__builtin_amdgcn_kernarg_segment_ptr();
    F.ws = ap->ws; F.ctl = (gu32*)(ap->ws + WS_CTL);
    const int l = ap->l_lo, p = ap->p_lo;
    if (p == 21) chk_gemm(F, ap, l, 1);
    if (p == 22) chk_e1b(F, ap, l);
    if (p == 23) chk_gemm(F, ap, l, 3);
    if (p == 24) chk_dsa(F, ap, l);
    if (p == 26) chk_gml(F, ap, l);
    if (p == 27) chk_gemm(F, ap, l, 7);
    if (p == 28) chk_lnr(F, ap, l);
    if (p == 29) chk_moe(F, ap, l);
    if (p == 31) chk_datt(F, ap, l);
    if (p == 40) chk_final(F, ap);
}
#endif

extern "C" void kernel_launch(void* const* d_in, const int* in_sizes, int n_in, void* d_out, int out_size, void* d_ws, size_t ws_size, hipStream_t stream) {
    static int grid = 0;
    if (grid == 0) {
        if (n_in != 32 || in_sizes[0] != T_TOK * D_MODEL || out_size != T_TOK * D_MODEL || ws_size < WS_END) {
            fprintf(stderr, "kernel_launch: shape mismatch: n_in %d in0 %d out %d ws %zu (need %zu)\n", n_in, n_in > 0 ? in_sizes[0] : -1, out_size, ws_size, (size_t)WS_END); grid = -1; return; }
        int dev = 0, cus = 0, per_cu = 0;
        if (hipGetDevice(&dev) != hipSuccess || hipDeviceGetAttribute(&cus, hipDeviceAttributeMultiprocessorCount, dev) != hipSuccess) { fprintf(stderr, "kernel_launch: device query failed\n"); grid = -1; return; }
#if MK_CHECK
        (void)hipFuncSetAttribute((const void*)mk_chk, hipFuncAttributeMaxDynamicSharedMemorySize, LDS_BYTES);
#endif
        if (hipFuncSetAttribute((const void*)mk_fwd, hipFuncAttributeMaxDynamicSharedMemorySize, LDS_BYTES) != hipSuccess) { fprintf(stderr, "kernel_launch: hipFuncSetAttribute failed\n"); grid = -1; return; }
        if (hipOccupancyMaxActiveBlocksPerMultiprocessor(&per_cu, (const void*)mk_fwd, 512, LDS_BYTES) != hipSuccess || per_cu < 1) { fprintf(stderr, "kernel_launch: occupancy query says %d\n", per_cu); }
        (void)hipGetLastError();
        grid = cus;
    }
    if (grid < 0) return;
    if (hipMemsetAsync((char*)d_ws + WS_CTL, 0, CTL_ZERO_BYTES, stream) != hipSuccess) { fprintf(stderr, "kernel_launch: memset failed\n"); return; }
    Args a{};
    for (int i = 0; i < 32; ++i) a.in[i] = (const float*)d_in[i];
    a.out = (float*)d_out; a.ws = (unsigned char*)d_ws;
#if MK_FUSED
    a.l_lo = 0; a.l_hi = DEPTH; a.p_lo = 0; a.p_hi = N_PHASES; a.do_pro = 1; a.fused = 1;
    hipLaunchKernelGGL(mk_fwd, dim3(grid), dim3(512), LDS_BYTES, stream, a);
#else
    a.fused = 0;
    a.l_lo = 0; a.l_hi = 0; a.p_lo = 0; a.p_hi = 0; a.do_pro = 1;
    hipLaunchKernelGGL(mk_fwd, dim3(grid), dim3(512), LDS_BYTES, stream, a);
    a.do_pro = 0;
    for (int l = 0; l < DEPTH; ++l)
        for (int p = 0; p < N_PHASES; ++p) {
            if ((l & 1) && p >= 1 && p <= 3) continue;
            a.l_lo = l; a.l_hi = l + 1; a.p_lo = p; a.p_hi = p + 1;
            hipLaunchKernelGGL(mk_fwd, dim3(grid), dim3(512), LDS_BYTES, stream, a);
#if MK_CHECK
            {
                int cks[3] = {0, 0, 0}; int nck = 0;
                if (l == 0) { if (p == 0) cks[nck++] = 21; if (p == 1) cks[nck++] = 22; if (p == 2) cks[nck++] = 23; if (p == 4) { cks[nck++] = 24; cks[nck++] = 26; } if (p == 5) cks[nck++] = 27; if (p == 6) cks[nck++] = 28; if (p == 8) cks[nck++] = 29; }
                if (l == 1) { if (p == 0) cks[nck++] = 21; if (p == 4) cks[nck++] = 31; if (p == 5) cks[nck++] = 27; }
                if (l == DEPTH - 1 && p == N_PHASES - 1) cks[nck++] = 40;
                for (int c = 0; c < nck; ++c) { a.p_lo = cks[c]; a.p_hi = cks[c] + 1; hipLaunchKernelGGL(mk_chk, dim3(grid), dim3(512), LDS_BYTES, stream, a); }
            }
#endif
        }
#endif
    const hipError_t le = hipPeekAtLastError();
    if (le != hipSuccess) fprintf(stderr, "kernel_launch: launch failed: %s\n", hipGetErrorName(le));
}
```

```cpp
#include <hip/hip_runtime.h>
#include <hip/hip_bf16.h>
#include <cstdio>
#include <cstdint>

#ifndef MK_CHECK
#define MK_CHECK 0
#endif
#ifndef MOE_FP8
#define MOE_FP8 1
#endif
#ifndef POUT_FP8
#define POUT_FP8 1
#endif
#ifndef MK_FUSED
#define MK_FUSED 1
#endif

constexpr int D_MODEL = 1024, BATCH = 32, SEQ = 2048, DEPTH = 4, T_TOK = BATCH * SEQ;
constexpr int CHUNK = 64;
constexpr int H_A = 8, D_CQ = 256, D_C = 128, H_IDX = 4, D_IDX = 64, N_SEL = 256;
constexpr int GW = 512, G_B = 8, CG_B = 64, GCH = 128;
constexpr int H_C = 8, DH_C = 64;
constexpr int NEXP = 32, TOPK = 4, D_FF = 1024;
constexpr int E_IN_EVEN = D_CQ + D_C + D_IDX + H_IDX + 2 * GW;
constexpr float LN_EPS = 1e-5f;
constexpr float DN_ALPHA = 1.681792830507429f;
constexpr float LOG2E = 1.4426950408889634f;
constexpr int NE_PR = 1536;
constexpr int NO_PR = 3072;
constexpr int NQQ = 1280;
constexpr int NMX = 1536;
constexpr int MOE_ROWS_MAX = (T_TOK * TOPK / 256 + NEXP) * 256;
constexpr int MOE_RB_MAX = MOE_ROWS_MAX / 256;

constexpr size_t MiB = 1u << 20;
constexpr size_t WS_CTL = 0, CTL_ZERO_BYTES = 1 * MiB;
constexpr size_t WS_WI = 1 * MiB;
constexpr size_t WS_GATE = 2 * MiB;
constexpr size_t WS_SLOT = 3 * MiB;
constexpr size_t WS_ROWTOK = 4 * MiB;
constexpr size_t WS_MASK = 12 * MiB;
constexpr size_t WS_WS = 28 * MiB;
constexpr size_t WS_WINE = 32 * MiB;
constexpr size_t WS_WQE = 38 * MiB;
constexpr size_t WS_WOUTE = 40 * MiB;
constexpr size_t WS_WINO = 46 * MiB;
constexpr size_t WS_WOUTO = 58 * MiB;
constexpr size_t WS_WRT = 62 * MiB;
constexpr size_t WS_WGU = 64 * MiB;
constexpr size_t WS_WDN = 576 * MiB;
constexpr size_t WS_HB = 832 * MiB;
constexpr size_t WS_Z = 960 * MiB;
constexpr size_t WS_PR = 1216 * MiB;
constexpr size_t WS_CQ = 1600 * MiB;
constexpr size_t WS_CKV = 1632 * MiB;
constexpr size_t WS_KI = 1648 * MiB;
constexpr size_t WS_QQ = 1656 * MiB;
constexpr size_t WS_MX = 1816 * MiB;
constexpr size_t WS_ACT = 2008 * MiB;
constexpr size_t WS_HB8 = 2272 * MiB;
constexpr size_t WS_Y = 2536 * MiB;
constexpr size_t WS_STAT = 3064 * MiB;
constexpr size_t WS_END = 3065 * MiB;
constexpr int CW_TMO = 0;
constexpr int CW_BAR = 4096;
constexpr int CW_CUR = 16384;

constexpr int RING_BYTES = 131072;
constexpr int MISC_OFF = RING_BYTES + 2048;
constexpr int LDS_BYTES = 147456;
constexpr int MI_BAR = 8;
constexpr int MI_RBSTART = 32;
constexpr int MI_CNT = 80;
constexpr int MI_LCNT = 112;
constexpr int MI_LBASE = 144;
constexpr int MI_NUNITS = 180;
constexpr int MI_RBE = 256;
constexpr int MI_REC = 1408;
constexpr int MI_END = MI_REC + 2048;
static_assert(MISC_OFF + MI_END * 4 <= LDS_BYTES, "LDS map");

#define GAS __attribute__((address_space(1)))
#define LAS __attribute__((address_space(3)))
typedef unsigned short bf16_t;
typedef short bf16x8 __attribute__((ext_vector_type(8)));
typedef short s16x4 __attribute__((ext_vector_type(4)));
typedef float f32x4 __attribute__((ext_vector_type(4)));
typedef float f32x2 __attribute__((ext_vector_type(2)));
typedef float f32x16 __attribute__((ext_vector_type(16)));
typedef unsigned u32x4 __attribute__((ext_vector_type(4)));
typedef unsigned u32x2 __attribute__((ext_vector_type(2)));
typedef GAS unsigned gu32;
typedef int v8i __attribute__((ext_vector_type(8)));
typedef int i32x4 __attribute__((ext_vector_type(4)));
#if POUT_FP8
typedef unsigned char mx_t;
__device__ __forceinline__ mx_t mx_cvt(float v) { v = fminf(fmaxf(8.0f * v, -448.f), 448.f); return (mx_t)__builtin_amdgcn_cvt_pk_fp8_f32(v, v, 0, false); }
constexpr float MX_SCALE = 8.0f;
__device__ __forceinline__ mx_t mx_cvt_s(float v) { v = fminf(fmaxf(v, -448.f), 448.f); return (mx_t)__builtin_amdgcn_cvt_pk_fp8_f32(v, v, 0, false); }
#else
typedef unsigned short mx_t;
#endif
__device__ __forceinline__ unsigned pk4_fp8(float a, float b, float c, float d) { int p = __builtin_amdgcn_cvt_pk_fp8_f32(a, b, 0, false); return (unsigned)__builtin_amdgcn_cvt_pk_fp8_f32(c, d, p, true); }
#define RLX_AGENT __ATOMIC_RELAXED, __HIP_MEMORY_SCOPE_AGENT
#define LDS_WAIT() asm volatile("s_waitcnt lgkmcnt(0)" ::: "memory")
#define VM_WAIT() asm volatile("s_waitcnt vmcnt(0)" ::: "memory")

__device__ __forceinline__ unsigned f2bf(float f) { unsigned u = __builtin_bit_cast(unsigned, f); return (u + 0x7fffu + ((u >> 16) & 1u)) >> 16; }
#if !POUT_FP8
__device__ __forceinline__ mx_t mx_cvt(float v) { return (mx_t)f2bf(v); }
constexpr float MX_SCALE = 1.0f;
__device__ __forceinline__ mx_t mx_cvt_s(float v) { return (mx_t)f2bf(v); }
#endif
__device__ __forceinline__ unsigned pk2(float lo, float hi) { return f2bf(lo) | (f2bf(hi) << 16); }
__device__ __forceinline__ float bf2f(unsigned short v) { return __builtin_bit_cast(float, (unsigned)v << 16); }
__device__ __forceinline__ float bflo(unsigned w) { return __builtin_bit_cast(float, w << 16); }
__device__ __forceinline__ float bfhi(unsigned w) { return __builtin_bit_cast(float, w & 0xffff0000u); }
__device__ __forceinline__ unsigned cvt_pk_bf16(float lo, float hi) { unsigned r; asm volatile("v_cvt_pk_bf16_f32 %0, %1, %2" : "=v"(r) : "v"(lo), "v"(hi)); return r; }
template <int CTRL> __device__ __forceinline__ float dppx(float v) { return __builtin_bit_cast(float, __builtin_amdgcn_update_dpp(0, __builtin_bit_cast(int, v), CTRL, 0xf, 0xf, true)); }
template <int M> __device__ __forceinline__ float xshfl(float v, int) {
    static_assert(M == 1 || M == 2 || M == 4 || M == 8 || M == 16, "xshfl: inside a 32-lane half only");
    if constexpr (M == 1) return dppx<0xB1>(v);
    else if constexpr (M == 2) return dppx<0x4E>(v);
    else if constexpr (M == 4) return dppx<0x141>(v);
    else if constexpr (M == 8) return dppx<0x128>(v);
    else return __builtin_bit_cast(float, __builtin_amdgcn_ds_swizzle(__builtin_bit_cast(int, v), (16 << 10) | 0x1f));
}
__device__ __forceinline__ void plswap(unsigned a, unsigned b, unsigned& r0, unsigned& r1) {
    asm volatile("" : "+v"(a), "+v"(b));
    auto rr = __builtin_amdgcn_permlane32_swap(a, b, false, false); r0 = rr[0]; r1 = rr[1];
    asm volatile("" : "+v"(r0), "+v"(r1));
}
__device__ __forceinline__ void half_swap(float v, float& r0, float& r1) {
    unsigned u0, u1; plswap(__builtin_bit_cast(unsigned, v), __builtin_bit_cast(unsigned, v), u0, u1); r0 = __builtin_bit_cast(float, u0); r1 = __builtin_bit_cast(float, u1);
}
__device__ __forceinline__ float rdl(float v, int l) { return __builtin_bit_cast(float, __builtin_amdgcn_readlane(__builtin_bit_cast(int, v), l)); }
__device__ __forceinline__ float wave_sum(float v) {
    v += dppx<0xB1>(v); v += dppx<0x4E>(v); v += dppx<0x141>(v); v += dppx<0x140>(v);
    return (rdl(v, 0) + rdl(v, 16)) + (rdl(v, 32) + rdl(v, 48));
}
__device__ __forceinline__ float wave_max(float v) {
    v = fmaxf(v, dppx<0xB1>(v)); v = fmaxf(v, dppx<0x4E>(v)); v = fmaxf(v, dppx<0x141>(v)); v = fmaxf(v, dppx<0x140>(v));
    return fmaxf(fmaxf(rdl(v, 0), rdl(v, 16)), fmaxf(rdl(v, 32), rdl(v, 48)));
}
__device__ __forceinline__ int lane_id() { int l; asm volatile("v_mbcnt_lo_u32_b32 %0, -1, 0\n\tv_mbcnt_hi_u32_b32 %0, -1, %0" : "=v"(l)); return l; }
__device__ __forceinline__ int tid_of(int wv) { int t = (wv << 6) + lane_id(); asm volatile("" : "+v"(t)); return t; }
__device__ __forceinline__ float fast_exp2(float x) { return __builtin_amdgcn_exp2f(x); }
__device__ __forceinline__ float fast_rcp(float x) { return __builtin_amdgcn_rcpf(x); }
__device__ __forceinline__ float gelu_tanh(float x) {
    const float u = x * (0.7978845608028654f + 0.035677408136300125f * x * x);
    return x * fast_rcp(1.0f + fast_exp2(-2.0f * LOG2E * u));
}
namespace pg8 {
constexpr int BM = 256, BK = 64, HALF = 128, HTB = HALF * BK * 2  , STAGE_BYTES = 8 * HTB, NXCD = 8, WGM = 8;
__host__ __device__ __forceinline__ int lds_byte(int r, int c) { const int st = (r >> 4) * 2 + (c >> 5), rr = r & 15, cc = c & 31, ob = rr * 64 + cc * 2; return st * 1024 + (ob ^ (((ob >> 9) & 1) << 5)); }
__host__ __device__ __forceinline__ void stage_rc(int b, int& R, int& C) { const int st = b / 1024, sb = b % 1024, swz = sb ^ (((sb >> 9) & 1) << 5); R = (st >> 1) * 16 + swz / 64; C = (st & 1) * 32 + (swz % 64) / 2; }
__host__ __device__ __forceinline__ int perm16x(int R) { return 64 * (R >> 5) + 16 * ((R & 15) >> 2) + 4 * ((R >> 4) & 1) + (R & 3); }
__host__ __device__ __forceinline__ int perm32(int rho) { const int n = rho >> 4, i = rho & 15; return 8 * (i >> 2) + 4 * n + (i & 3); }

#ifndef PG8_NT
#define PG8_NT 0
#endif
#if PG8_NT
#define PG8_ST(T_, p_, v_) __builtin_nontemporal_store((v_), (GAS T_*)(p_))
#else
#define PG8_ST(T_, p_, v_) (*(GAS T_*)(p_) = (v_))
#endif
#ifndef PG8_NT_PIN
#define PG8_NT_PIN 0
#endif
#if PG8_NT_PIN
#define PG8_STP(T_, p_, v_) __builtin_nontemporal_store((v_), (GAS T_*)(p_))
#else
#define PG8_STP(T_, p_, v_) (*(GAS T_*)(p_) = (v_))
#endif
struct Unit { int pm, pn, bt, e, blk; };

struct DenseOrder {
    int nM, nN, nwg, G, c;
    __device__ void init(int M, int N, int G_, int c_) { nM = M / BM; nN = N / BM; nwg = nM * nN; G = G_; c = c_; }
    __device__ bool next(int i, Unit& u) const {
        const long L = (long)i * G + c; if (L >= nwg) return false;
        int wgid = (int)L; { const int q = nwg / NXCD, r = nwg % NXCD, xcd = wgid % NXCD, off = wgid / NXCD; wgid = (xcd < r ? xcd * (q + 1) : r * (q + 1) + (xcd - r) * q) + off; }
        const int nig = WGM * nN, gid = wgid / nig, fm = gid * WGM, gsz = (nM - fm) < WGM ? (nM - fm) : WGM;
        u.pm = fm + ((wgid % nig) % gsz); u.pn = (wgid % nig) / gsz; u.bt = u.pn; u.e = 0; u.blk = 0; return true;
    }
    __device__ __forceinline__ int count(int) const { return 0; }
};
struct MoeOrder {
    int nunits, npn, G, c; const LAS int* tab; int rev = 0;
    __device__ bool next(int i, Unit& u) const {
        const long L = (long)i * G + c; if (L >= nunits) return false;
        const int rb0_ = (int)L / npn, rb = rev ? nunits / npn - 1 - rb0_ : rb0_, pn = (int)L % npn, e = __builtin_amdgcn_readfirstlane(tab[MI_RBE + rb]);
        u.pm = rb; u.pn = pn; u.e = e; u.bt = e * npn + pn; u.blk = rb - __builtin_amdgcn_readfirstlane(tab[MI_RBSTART + e]); return true;
    }
    __device__ __forceinline__ int count(int e) const { return __builtin_amdgcn_readfirstlane(tab[MI_CNT + e]); }
};

template <int PV> struct EpiStoreBf16T {
    static constexpr bool RELAX = false;
    static constexpr int NST = (PV == 2) ? 8 : 16;
    static constexpr bool PERM = true; static constexpr bool PERM16 = false;
    bf16_t* O; int ldc; int gelu_from;
    struct Pre {};
    __device__ __forceinline__ void pre(Pre&, const Unit&, int, int) const {}
    __device__ __forceinline__ void fill(f32x4 (&acc)[2][2][4][2], const Pre&) const {
#pragma unroll
        for (int a = 0; a < 2; ++a)
#pragma unroll
            for (int b = 0; b < 2; ++b)
#pragma unroll
                for (int m = 0; m < 4; ++m)
#pragma unroll
                    for (int n = 0; n < 2; ++n) acc[a][b][m][n] = (f32x4){0.f, 0.f, 0.f, 0.f};
    }
    __device__ __forceinline__ void operator()(const f32x4 (&acc)[2][2][4][2], const Unit& u, int wr, int wc, int fr, int fq) const {
        const int row0 = u.pm * BM + wr * 64 + fr; const int col0 = u.pn * BM + wc * 32 + 8 * fq; const bool g = u.pn >= gelu_from;
#pragma unroll
        for (int ai = 0; ai < 2; ++ai)
#pragma unroll
            for (int m = 0; m < 4; ++m) { GAS bf16_t* rowp = (GAS bf16_t*)O + (size_t)(row0 + ai * HALF + m * 16) * ldc + col0;
#pragma unroll
                for (int bj = 0; bj < 2; ++bj) { f32x4 v0 = acc[ai][bj][m][0], v1 = acc[ai][bj][m][1];
                    if (g) {
#pragma unroll
                        for (int q = 0; q < 4; ++q) { v0[q] = gelu_tanh(v0[q]); v1[q] = gelu_tanh(v1[q]); } }
                    u32x4 w; w.x = cvt_pk_bf16(v0[0], v0[1]); w.y = cvt_pk_bf16(v0[2], v0[3]); w.z = cvt_pk_bf16(v1[0], v1[1]); w.w = cvt_pk_bf16(v1[2], v1[3]);
                    if constexpr (PV == 1) { u32x2 w2; w2.x = w.x; w2.y = w.y; *(GAS u32x2*)(rowp + bj * HALF) = w2; }
                    else if constexpr (PV == 5) { if (((blockIdx.x >> 3) & 3) == 0) *(GAS u32x4*)(rowp + bj * HALF) = w; }
                    else if constexpr (PV == 4) { if ((blockIdx.x >> 3) & 1) *(GAS u32x4*)(rowp + bj * HALF) = w; }
                    else if constexpr (PV == 2) { if (bj == 0) *(GAS u32x4*)(rowp + bj * HALF) = w; }
                    else if constexpr (PV == 3) {
                        GAS bf16_t* q = (GAS bf16_t*)O + (size_t)(u.pm * BM + wr * 64 + ai * HALF + m * 16 + (wc >> 1) * 8 + (fr >> 1)) * ldc + u.pn * BM + bj * HALF + (wc & 1) * 64 + (fr & 1) * 32 + 8 * fq;
                        *(GAS u32x4*)q = w; }
                    else PG8_STP(u32x4, rowp + bj * HALF, w); } }
    }
};
typedef EpiStoreBf16T<0> EpiStoreBf16;
struct EpiResid {
    static constexpr bool PERM = true; static constexpr bool PERM16 = false;
    static constexpr bool RELAX = false; static constexpr int NST = 16;
    const bf16_t* Hs; bf16_t* Z; float alpha;
    struct Pre {};
    __device__ __forceinline__ void pre(Pre&, const Unit&, int, int) const {}
    __device__ __forceinline__ void fill(f32x4 (&acc)[2][2][4][2], const Pre&) const {
#pragma unroll
        for (int a = 0; a < 2; ++a)
#pragma unroll
            for (int b = 0; b < 2; ++b)
#pragma unroll
                for (int m = 0; m < 4; ++m)
#pragma unroll
                    for (int n = 0; n < 2; ++n) acc[a][b][m][n] = (f32x4){0.f, 0.f, 0.f, 0.f};
    }
    __device__ __forceinline__ void operator()(const f32x4 (&acc)[2][2][4][2], const Unit& u, int wr, int wc, int fr, int fq) const {
        const int row0 = u.pm * BM + wr * 64 + fr; const int col0 = u.pn * BM + wc * 32 + 8 * fq;
#pragma unroll
        for (int ai = 0; ai < 2; ++ai) {
            u32x4 hw[4][2];
#pragma unroll
            for (int m = 0; m < 4; ++m)
#pragma unroll
                for (int bj = 0; bj < 2; ++bj) hw[m][bj] = *(const GAS u32x4*)((const GAS bf16_t*)Hs + (size_t)(row0 + ai * HALF + m * 16) * D_MODEL + col0 + bj * HALF);
#pragma unroll
            for (int m = 0; m < 4; ++m) { const size_t off = (size_t)(row0 + ai * HALF + m * 16) * D_MODEL + col0;
#pragma unroll
                for (int bj = 0; bj < 2; ++bj) { const u32x4 h = hw[m][bj];
                    const f32x4 v0 = (f32x4){bflo(h.x), bfhi(h.x), bflo(h.y), bfhi(h.y)} * alpha + acc[ai][bj][m][0], v1 = (f32x4){bflo(h.z), bfhi(h.z), bflo(h.w), bfhi(h.w)} * alpha + acc[ai][bj][m][1];
                    u32x4 w; w.x = cvt_pk_bf16(v0[0], v0[1]); w.y = cvt_pk_bf16(v0[2], v0[3]); w.z = cvt_pk_bf16(v1[0], v1[1]); w.w = cvt_pk_bf16(v1[2], v1[3]);
                    PG8_ST(u32x4, (GAS bf16_t*)Z + off + bj * HALF, w); } } }
    }
};
__device__ __forceinline__ f32x2 pk_add(f32x2 a, f32x2 b) { f32x2 d; asm("v_pk_add_f32 %0, %1, %2" : "=v"(d) : "v"(a), "v"(b)); return d; }
__device__ __forceinline__ f32x2 pk_mul(f32x2 a, f32x2 b) { f32x2 d; asm("v_pk_mul_f32 %0, %1, %2" : "=v"(d) : "v"(a), "v"(b)); return d; }
__device__ __forceinline__ f32x2 pk_fma(f32x2 a, f32x2 b, f32x2 c) { f32x2 d; asm("v_pk_fma_f32 %0, %1, %2, %3" : "=v"(d) : "v"(a), "v"(b), "v"(c)); return d; }
__device__ __forceinline__ float a_min(float a, float b) { float d; asm("v_min_f32 %0, %1, %2" : "=v"(d) : "v"(a), "v"(b)); return d; }
__device__ __forceinline__ float a_med3(float a, float lo, float hi) { float d; asm("v_med3_f32 %0, %1, %2, %3" : "=v"(d) : "v"(a), "v"(lo), "v"(hi)); return d; }
__device__ __forceinline__ f32x2 pk_add_t(f32x2 a, f32x2 b) { f32x2 d; asm("s_nop 0\n\tv_pk_add_f32 %0, %1, %2" : "=v"(d) : "v"(a), "v"(b)); return d; }
__device__ __forceinline__ f32x2 pk_mul_t(f32x2 a, f32x2 b) { f32x2 d; asm("s_nop 0\n\tv_pk_mul_f32 %0, %1, %2" : "=v"(d) : "v"(a), "v"(b)); return d; }
struct EpiSwiglu {
    static constexpr bool PERM = true; static constexpr bool PERM16 = false;
#if MOE_FP8
    static constexpr float OSC = 8.0f;
#else
    static constexpr float OSC = 1.0f;
#endif
    static constexpr bool RELAX = true; static constexpr int NST = 8;
    bf16_t* ACT; const float* bgu;
    struct Pre { f32x4 g[2], u[2]; };
    __device__ __forceinline__ void pre(Pre& p, const Unit& u, int wc, int fq) const {
        const float* bb = bgu + (size_t)u.e * 2048 + u.pn * HALF + wc * 32 + 8 * fq;
#pragma unroll
        for (int n = 0; n < 2; ++n) { p.g[n] = *(const GAS f32x4*)((const GAS float*)bb + 4 * n); p.u[n] = *(const GAS f32x4*)((const GAS float*)bb + 1024 + 4 * n); }
    }
    __device__ __forceinline__ void fill(f32x4 (&acc)[2][2][4][2], const Pre& p) const {
#pragma unroll
        for (int n = 0; n < 2; ++n) { const f32x4 un = (p.u[n] + 1.0f) * OSC;
#pragma unroll
            for (int a = 0; a < 2; ++a)
#pragma unroll
                for (int m = 0; m < 4; ++m) { acc[a][0][m][n] = p.g[n]; acc[a][1][m][n] = un; } }
    }
    __device__ __forceinline__ void operator()(const f32x4 (&acc)[2][2][4][2], const Unit& u, int wr, int wc, int fr, int fq) const {
        const int row0 = u.pm * BM + wr * 64 + fr; const int oc0 = u.pn * HALF + wc * 32 + 8 * fq;
        f32x2 c_z = {-1.702f * LOG2E, -1.702f * LOG2E}, c_one = {1.0f, 1.0f};
        f32x2 c_lim = {7.0f, -6.0f * OSC}; float c_hi = 8.0f * OSC;
        asm volatile("" : "+v"(c_z), "+v"(c_one), "+v"(c_lim), "+v"(c_hi));
#pragma unroll
        for (int ai = 0; ai < 2; ++ai)
#pragma unroll
            for (int m = 0; m < 4; ++m) { float o[8];
#pragma unroll
                for (int n = 0; n < 2; ++n)
#pragma unroll
                    for (int h = 0; h < 2; ++h) {
                        f32x2 gt, up;
                        gt.x = a_min(acc[ai][0][m][n][2 * h], c_lim.x); gt.y = a_min(acc[ai][0][m][n][2 * h + 1], c_lim.x);
                        up.x = a_med3(acc[ai][1][m][n][2 * h], c_lim.y, c_hi); up.y = a_med3(acc[ai][1][m][n][2 * h + 1], c_lim.y, c_hi);
                        f32x2 e = pk_mul(gt, c_z);
                        e.x = fast_exp2(e.x); e.y = fast_exp2(e.y);
                        f32x2 r = pk_add_t(e, c_one);
                        r.x = fast_rcp(r.x); r.y = fast_rcp(r.y);
                        const f32x2 ov = pk_mul_t(pk_mul(up, gt), r);
                        o[4 * n + 2 * h] = ov.x; o[4 * n + 2 * h + 1] = ov.y; }
#if MOE_FP8
                u32x2 w; w.x = pk4_fp8(o[0], o[1], o[2], o[3]); w.y = pk4_fp8(o[4], o[5], o[6], o[7]);
                PG8_ST(u32x2, (GAS unsigned char*)ACT + (size_t)(row0 + ai * HALF + m * 16) * D_FF + oc0, w); }
#else
                u32x4 w; w.x = cvt_pk_bf16(o[0], o[1]); w.y = cvt_pk_bf16(o[2], o[3]); w.z = cvt_pk_bf16(o[4], o[5]); w.w = cvt_pk_bf16(o[6], o[7]);
                *(GAS u32x4*)((GAS bf16_t*)ACT + (size_t)(row0 + ai * HALF + m * 16) * D_FF + oc0) = w; }
#endif
    }
};
struct EpiBiasBf16 {
    static constexpr bool PERM = true; static constexpr bool PERM16 = (MOE_FP8 != 0);
#if MOE_FP8
    static constexpr float OSC = 64.0f;
#else
    static constexpr float OSC = 1.0f;
#endif
    static constexpr bool RELAX = true; static constexpr int NST = MOE_FP8 ? 8 : 16;
    bf16_t* Y; const float* bdn;
    struct Pre { f32x4 v[2][2]; };
    __device__ __forceinline__ void pre(Pre& p, const Unit& u, int wc, int fq) const {
        const float* bb = bdn + (size_t)u.e * 1024 + u.pn * BM + (PERM16 ? wc * 64 + 16 * fq : wc * 32 + 8 * fq);
#pragma unroll
        for (int bj = 0; bj < 2; ++bj)
#pragma unroll
            for (int n = 0; n < 2; ++n) p.v[bj][n] = *(const GAS f32x4*)((const GAS float*)bb + (PERM16 ? 8 * bj : bj * HALF) + 4 * n);
    }
    __device__ __forceinline__ void fill(f32x4 (&acc)[2][2][4][2], const Pre& p) const {
#pragma unroll
        for (int bj = 0; bj < 2; ++bj)
#pragma unroll
            for (int n = 0; n < 2; ++n) { const f32x4 v = p.v[bj][n] * OSC;
#pragma unroll
                for (int a = 0; a < 2; ++a)
#pragma unroll
                    for (int m = 0; m < 4; ++m) acc[a][bj][m][n] = v; }
    }
    __device__ __forceinline__ void operator()(const f32x4 (&acc)[2][2][4][2], const Unit& u, int wr, int wc, int fr, int fq) const {
        const int row0 = u.pm * BM + wr * 64 + fr; const int col0 = u.pn * BM + (PERM16 ? wc * 64 + 16 * fq : wc * 32 + 8 * fq);
#if MOE_FP8
        float c_lo = -448.f, c_hi = 448.f; asm volatile("" : "+v"(c_lo), "+v"(c_hi));
#endif
#pragma unroll
        for (int ai = 0; ai < 2; ++ai)
#pragma unroll
            for (int m = 0; m < 4; ++m) { const size_t roff = (size_t)(row0 + ai * HALF + m * 16) * D_MODEL + col0;
#if MOE_FP8
                u32x4 w;
#pragma unroll
                for (int bj = 0; bj < 2; ++bj)
#pragma unroll
                    for (int n = 0; n < 2; ++n) { const f32x4 v = acc[ai][bj][m][n]; w[2 * bj + n] = pk4_fp8(a_med3(v[0], c_lo, c_hi), a_med3(v[1], c_lo, c_hi), a_med3(v[2], c_lo, c_hi), a_med3(v[3], c_lo, c_hi)); }
                PG8_ST(u32x4, (GAS unsigned char*)Y + roff, w); }
#else
#pragma unroll
                for (int bj = 0; bj < 2; ++bj) { const f32x4 v0 = acc[ai][bj][m][0], v1 = acc[ai][bj][m][1];
                    u32x4 w; w.x = cvt_pk_bf16(v0[0], v0[1]); w.y = cvt_pk_bf16(v0[2], v0[3]); w.z = cvt_pk_bf16(v1[0], v1[1]); w.w = cvt_pk_bf16(v1[2], v1[3]);
                    *(GAS u32x4*)((GAS bf16_t*)Y + roff + bj * HALF) = w; } }
#endif
    }
};

template <class Epi, class Sched, bool GATHER, bool FP8 = false>
__device__ __forceinline__ void gemm_phase(LAS unsigned char* lds, const bf16_t* A, const bf16_t* Bt, const int K_, const int* __restrict__ rowidx, const Sched& S, const Epi& E, const int wv, int sclA = 0x7f7f7f7f, int sclB = 0x7f7f7f7f, int sclB1 = 0x7f7f7f7f, int krep = 1, int erep = 1, int stagger = 0) {
    int Kh_ = K_; asm volatile("" : "+s"(Kh_)); const int K = Kh_;
    asm volatile("" : "+v"(sclA), "+v"(sclB), "+v"(sclB1));
    const int tid_ = tid_of(wv);
    const int tid = tid_, wid = __builtin_amdgcn_readfirstlane(tid >> 6), lane = tid & 63, wr = wid >> 2, wc = wid & 3, fr = lane & 15, fq = lane >> 4;
    const int nt = K / BK;
    unsigned voffB[2]; unsigned oc0[2], oc1[2];
    LAS unsigned* gnx = (LAS unsigned*)(lds + MISC_OFF + MI_REC * 4) + tid * 4;
    const size_t kstep = (size_t)(BK * 2);
    const size_t hstep = (size_t)HALF * K * 2;
    const size_t tstep = 2 * hstep;
    const size_t bhstep = Epi::PERM16 ? (size_t)8 * K * 2 : hstep;
#pragma unroll
    for (int i = 0; i < 2; ++i) { int R, C; stage_rc(tid * 16 + i * 8192, R, C); const int Rb = Epi::PERM16 ? perm16x(R) : Epi::PERM ? ((R & ~31) + perm32(R & 31)) : R;
        oc0[i] = (unsigned)(R * K + C) * 2u; oc1[i] = oc0[i] + (unsigned)hstep;
        voffB[i] = (unsigned)(Rb * K + C) * 2u; }
    const unsigned ldsw = (unsigned)wid * 1024u;
    const int aoff = lds_byte(wr * 64 + fr, fq * 8), boff = lds_byte(wc * 32 + fr, fq * 8);
#define PG8_SA(b, h) (((b) * 2 + (h)) * HTB)
#define PG8_SB(b, h) ((4 + (b) * 2 + (h)) * HTB)
#define PG8_STAGE(bufoff, gbase, voff) do { _Pragma("unroll") for (int _i = 0; _i < 2; ++_i) { unsigned keep_; \
        asm volatile("s_mov_b32 %0, m0\n\ts_mov_b32 m0, %3\n\ts_nop 0\n\tglobal_load_lds_dwordx4 %1, %2\n\ts_mov_b32 m0, %0" \
            : "=&s"(keep_) : "v"((voff)[_i]), "s"((const char*)(gbase)), "s"((unsigned)(size_t)(lds + (bufoff) + ldsw + _i * 8192)) : "memory"); } } while (0)
#define PG8_RD8(p) __builtin_shufflevector(*(const LAS i32x4*)(p), *(const LAS i32x4*)((p) + 1024), 0, 1, 2, 3, 4, 5, 6, 7)
#define PG8_LDA(dst, b, h) do { if constexpr (FP8) { _Pragma("unroll") for (int m = 0; m < 4; ++m) dst##8[m] = PG8_RD8(lds + PG8_SA(b, h) + aoff + m * 2048); } \
        else { _Pragma("unroll") for (int m = 0; m < 4; ++m) _Pragma("unroll") for (int k = 0; k < 2; ++k) dst[m][k] = *(const LAS bf16x8*)(lds + PG8_SA(b, h) + aoff + m * 2048 + k * 1024); } } while (0)
#define PG8_LDB(dst, b, h) do { if constexpr (FP8) { _Pragma("unroll") for (int n = 0; n < 2; ++n) dst##8[n] = PG8_RD8(lds + PG8_SB(b, h) + boff + n * 2048); } \
        else { _Pragma("unroll") for (int n = 0; n < 2; ++n) _Pragma("unroll") for (int k = 0; k < 2; ++k) dst[n][k] = *(const LAS bf16x8*)(lds + PG8_SB(b, h) + boff + n * 2048 + k * 1024); } } while (0)
#define PG8_MMA(ai, bj, At, Bt_) do { __builtin_amdgcn_s_setprio(1); _Pragma("unroll") for (int m = 0; m < 4; ++m) _Pragma("unroll") for (int n = 0; n < 2; ++n) { \
        if constexpr (FP8) asm volatile("v_mfma_scale_f32_16x16x128_f8f6f4 %0, %1, %2, %0, %3, %4 op_sel_hi:[0,0,0]" : "+v"(acc[ai][bj][m][n]) : "v"(Bt_##8[n]), "v"(At##8[m]), "v"((bj) ? sclB1 : sclB), "v"(sclA));   \
        else { _Pragma("unroll") for (int k = 0; k < 2; ++k) acc[ai][bj][m][n] = __builtin_amdgcn_mfma_f32_16x16x32_bf16(Bt_[n][k], At[m][k], acc[ai][bj][m][n], 0, 0, 0); } } \
        __builtin_amdgcn_s_setprio(0); } while (0)
#define PG8_WAIT_V(n) asm volatile("s_waitcnt vmcnt(" #n ")" ::: "memory")
#define PG8_WAIT_VN(N) asm volatile("s_waitcnt vmcnt(%0)" :: "n"(N) : "memory")
#define PG8_WAIT_RX() do { if (rx) PG8_WAIT_VN(8 + Epi::NST); else PG8_WAIT_V(8); } while (0)
#define PG8_WAIT_L(n) asm volatile("s_waitcnt lgkmcnt(" #n ")" ::: "memory")
#define PG8_BAR __builtin_amdgcn_s_barrier()
#define PG8_SCHED __builtin_amdgcn_sched_barrier(0)
#define PG8_GOFF(u, g0, g1) do { const int cn_ = S.count((u).e); const GAS int* rp_ = (const GAS int*)rowidx + (size_t)(u).e * 65536 + (u).blk * 256; \
        _Pragma("unroll") for (int i_ = 0; i_ < 2; ++i_) { int r0_, c0_; stage_rc(tid * 16 + i_ * 8192, r0_, c0_); const unsigned gc_ = (unsigned)c0_ * 2u; \
            const int t0_ = ((u).blk * 256 + r0_ < cn_) ? rp_[r0_] : 0; const int t1_ = ((u).blk * 256 + 128 + r0_ < cn_) ? rp_[128 + r0_] : 0; \
            g0[i_] = (unsigned)t0_ * (unsigned)(K * 2) + gc_; g1[i_] = (unsigned)t1_ * (unsigned)(K * 2) + gc_; asm volatile("" : "+v"(g0[i_]), "+v"(g1[i_])); } } while (0)
    Unit cur, nxt; int ui = 0;
    if (!S.next(0, cur)) return;
    for (int sgi = 0; sgi < stagger * ((int)(blockIdx.x >> 3) & 3); ++sgi) __builtin_amdgcn_s_sleep(1);
    f32x4 acc[2][2][4][2];
    { typename Epi::Pre p0; E.pre(p0, cur, wc, fq); E.fill(acc, p0); }
    bf16x8 At[4][2], B0[2][2], B1[2][2]; v8i At8[4], B08[2], B18[2];
    if constexpr (GATHER) { PG8_GOFF(cur, oc0, oc1); gnx[0] = oc0[0]; gnx[1] = oc0[1]; gnx[2] = oc1[0]; gnx[3] = oc1[1]; }
    const char* cA = GATHER ? (const char*)A : (const char*)A + (size_t)cur.pm * tstep; const char* cB = (const char*)Bt + (size_t)cur.bt * tstep;
    PG8_STAGE(PG8_SB(0, 0), cB, voffB); PG8_STAGE(PG8_SB(0, 1), cB + bhstep, voffB); PG8_STAGE(PG8_SA(0, 0), cA, oc0); PG8_STAGE(PG8_SA(0, 1), cA, oc1);
    if (wr == 1) PG8_BAR;
    PG8_WAIT_V(2); PG8_BAR;
    PG8_STAGE(PG8_SB(1, 0), cB + kstep, voffB); PG8_STAGE(PG8_SA(1, 0), cA + kstep, oc0); PG8_STAGE(PG8_SB(1, 1), cB + bhstep + kstep, voffB);
    PG8_WAIT_V(6); PG8_BAR;
    for (;;) {
        const bool has_next = S.next(ui + 1, nxt);
        int ix0 = 0, ix1 = 0, ix2 = 0, ix3 = 0;
        if constexpr (GATHER) { if (has_next) { const char* rp_ = (const char*)rowidx + ((size_t)nxt.e * 65536 + (size_t)nxt.blk * 256) * 4;
            int ra, rb_, cdum; stage_rc(tid * 16, ra, cdum); stage_rc(tid * 16 + 8192, rb_, cdum);
            asm volatile("global_load_dword %0, %4, %6\n\tglobal_load_dword %1, %4, %6 offset:512\n\tglobal_load_dword %2, %5, %6\n\tglobal_load_dword %3, %5, %6 offset:512"
                         : "=&v"(ix0), "=&v"(ix1), "=&v"(ix2), "=&v"(ix3) : "v"(ra * 4), "v"(rb_ * 4), "s"(rp_) : "memory"); } }
        const char* nA = GATHER ? (const char*)A : (has_next ? (const char*)A + (size_t)nxt.pm * tstep : cA); const char* nB = has_next ? (const char*)Bt + (size_t)nxt.bt * tstep : cB;
#pragma unroll 1
        for (int kk = 0; kk < krep; ++kk)
        for (int t = 0; t < nt; t += 2) {
            const bool last = (t == nt - 2);
            const bool fin = (kk == krep - 1);
            const char* a1 = cA + (size_t)(t + 1) * kstep;
            const char* a2 = last ? (fin ? nA : cA) : cA + (size_t)(t + 2) * kstep; const char* b2 = last ? (fin ? nB : cB) : cB + (size_t)(t + 2) * kstep;
            const char* a3 = a2 + kstep; const char* b3 = b2 + kstep;
            unsigned s0[2], s1[2];
#pragma unroll
            for (int i = 0; i < 2; ++i) { s0[i] = oc0[i]; s1[i] = oc1[i]; }
            if constexpr (GATHER) { if (t == 2 && kk == 0 && has_next) {
                    const int cn_ = S.count(nxt.e); int ra, rb_, ca, cb; stage_rc(tid * 16, ra, ca); stage_rc(tid * 16 + 8192, rb_, cb); const int b0_ = nxt.blk * 256;
                    gnx[0] = (unsigned)((b0_ + ra < cn_) ? ix0 : 0) * (unsigned)(K * 2) + (unsigned)ca * 2u; gnx[2] = (unsigned)((b0_ + 128 + ra < cn_) ? ix1 : 0) * (unsigned)(K * 2) + (unsigned)ca * 2u;
                    gnx[1] = (unsigned)((b0_ + rb_ < cn_) ? ix2 : 0) * (unsigned)(K * 2) + (unsigned)cb * 2u; gnx[3] = (unsigned)((b0_ + 128 + rb_ < cn_) ? ix3 : 0) * (unsigned)(K * 2) + (unsigned)cb * 2u; }
                if (last && fin) { s0[0] = gnx[0]; s0[1] = gnx[1]; s1[0] = gnx[2]; s1[1] = gnx[3]; } }
            const bool rx = Epi::RELAX && (erep == 1) && ui > 0 && t == 0 && kk == 0;
            PG8_LDB(B0, 0, 0); PG8_LDB(B1, 0, 1); PG8_SCHED; PG8_LDA(At, 0, 0); if (!rx) PG8_STAGE(PG8_SA(1, 1), a1, oc1);
            PG8_WAIT_RX(); PG8_WAIT_L(0); PG8_BAR; PG8_MMA(0, 0, At, B0); PG8_MMA(0, 1, At, B1); PG8_BAR; PG8_SCHED;
            PG8_LDA(At, 0, 1); PG8_STAGE(PG8_SB(0, 0), b2, voffB); PG8_STAGE(PG8_SB(0, 1), b2 + bhstep, voffB); PG8_STAGE(PG8_SA(0, 0), a2, s0);
            PG8_WAIT_RX(); PG8_WAIT_L(0); PG8_BAR; PG8_MMA(1, 0, At, B0); PG8_MMA(1, 1, At, B1); PG8_BAR; PG8_SCHED;
            PG8_LDB(B0, 1, 0); PG8_LDB(B1, 1, 1); PG8_SCHED; PG8_LDA(At, 1, 0); PG8_STAGE(PG8_SA(0, 1), a2, s1);
            PG8_WAIT_RX(); PG8_WAIT_L(0); PG8_BAR; PG8_MMA(0, 0, At, B0); PG8_MMA(0, 1, At, B1); PG8_BAR; PG8_SCHED;
            PG8_LDA(At, 1, 1); PG8_STAGE(PG8_SB(1, 0), b3, voffB); PG8_STAGE(PG8_SB(1, 1), b3 + bhstep, voffB); PG8_STAGE(PG8_SA(1, 0), a3, s0);
            PG8_WAIT_V(8); PG8_WAIT_L(0); PG8_BAR; PG8_MMA(1, 0, At, B0); PG8_MMA(1, 1, At, B1); PG8_BAR; PG8_SCHED;
        }
        if (wr == 0) PG8_BAR;
        const bool pre_st = Epi::RELAX && has_next && erep == 1;
        if (pre_st) { if constexpr (GATHER) { unsigned q1[2]; q1[0] = gnx[2]; q1[1] = gnx[3]; PG8_STAGE(PG8_SA(1, 1), nA + kstep, q1); } else PG8_STAGE(PG8_SA(1, 1), nA + kstep, oc1); }
        if constexpr (FP8) asm volatile("s_nop 15\n\ts_nop 15" ::: "memory");
        Unit pu; pu.pm = has_next ? nxt.pm : cur.pm; pu.pn = has_next ? nxt.pn : cur.pn; pu.bt = has_next ? nxt.bt : cur.bt; pu.e = has_next ? nxt.e : cur.e; pu.blk = has_next ? nxt.blk : cur.blk;
        typename Epi::Pre pn; E.pre(pn, pu, wc, fq);
#pragma unroll 1
        for (int er = 0; er < erep; ++er) { E(acc, cur, wr, wc, fr, fq); asm volatile("" ::: "memory"); }
        if (!has_next) break;
        E.fill(acc, pn);
        cur = nxt; cA = nA; cB = nB; ++ui;
        if constexpr (GATHER) { oc0[0] = gnx[0]; oc0[1] = gnx[1]; oc1[0] = gnx[2]; oc1[1] = gnx[3]; }
        if (wr == 1) PG8_BAR;
    }
    PG8_WAIT_V(0);
    PG8_BAR;
#undef PG8_SA
#undef PG8_SB
#undef PG8_STAGE
#undef PG8_LDA
#undef PG8_LDB
#undef PG8_MMA
#undef PG8_RD8
#undef PG8_WAIT_V
#undef PG8_WAIT_VN
#undef PG8_WAIT_RX
#undef PG8_WAIT_L
#undef PG8_BAR
#undef PG8_SCHED
#undef PG8_GOFF
}
}
namespace att {
#define ATT_SBAR() __builtin_amdgcn_sched_barrier(0)
constexpr float THR = 8.f;
__device__ __forceinline__ int crow(int r, int hi) { return (r & 3) + 8 * (r >> 2) + 4 * hi; }
__device__ __forceinline__ unsigned cvtpk(float lo, float hi) { unsigned r; asm volatile("v_cvt_pk_bf16_f32 %0, %1, %2" : "=v"(r) : "v"(lo), "v"(hi)); return r; }

__device__ __forceinline__ void partialSM(f32x16& p0, f32x16& p1, float& m_reg, float& alpha) {
  float pmax = p0[0];
#pragma unroll
  for (int r = 1; r < 16; ++r) pmax = fmaxf(pmax, p0[r]);
#pragma unroll
  for (int r = 0; r < 16; ++r) pmax = fmaxf(pmax, p1[r]);
  { float r0, r1; half_swap(pmax, r0, r1); pmax = fmaxf(r0, r1); }
  float mn;
  if (__builtin_expect(__all(pmax - m_reg <= THR), 1)) { mn = m_reg; alpha = 1.f; }
  else { mn = fmaxf(m_reg, pmax); alpha = __builtin_amdgcn_exp2f(m_reg - mn); m_reg = mn; }
#pragma unroll
  for (int r = 0; r < 16; ++r) { p0[r] = __builtin_amdgcn_exp2f(p0[r] - mn); p1[r] = __builtin_amdgcn_exp2f(p1[r] - mn); }
}
__device__ __forceinline__ void finishSM(const f32x16& p0, const f32x16& p1, float alpha, float& l_reg, bf16x8& pa0, bf16x8& pa1, bf16x8& pa2, bf16x8& pa3) {
  float ps = 0;
#pragma unroll
  for (int r = 0; r < 16; ++r) ps += p0[r];
#pragma unroll
  for (int r = 0; r < 16; ++r) ps += p1[r];
  { float r0, r1; half_swap(ps, r0, r1); ps = r0 + r1; }
  l_reg = l_reg * alpha + ps;
#define ATT_PK4(P, BASE, OUT) do { unsigned a0 = cvtpk(P[BASE + 0], P[BASE + 1]), a1 = cvtpk(P[BASE + 2], P[BASE + 3]);   \
    unsigned b0 = cvtpk(P[BASE + 4], P[BASE + 5]), b1 = cvtpk(P[BASE + 6], P[BASE + 7]);                              \
    unsigned r00, r01, r10, r11; plswap(a0, b0, r00, r01); plswap(a1, b1, r10, r11); \
    u32x4 w = {r00, r10, r01, r11}; OUT = __builtin_bit_cast(bf16x8, w); } while (0)
  ATT_PK4(p0, 0, pa0); ATT_PK4(p0, 8, pa1); ATT_PK4(p1, 0, pa2); ATT_PK4(p1, 8, pa3);
#undef ATT_PK4
}
__device__ __forceinline__ int v_st(int k, int c) { const int kk = (k & ~0xC) | ((k & 4) << 1) | ((k & 8) >> 1); return ((kk >> 3) * 4 + (c >> 5)) * 512 + ((kk & 7) * 32 + (c & 31)) * 2; }
__device__ __forceinline__ int v_rd_base(int lane) { return ((lane & 3) << 3) | (((lane >> 2) & 3) << 6) | (((lane >> 4) & 1) << 5) | (((lane >> 5) & 1) << 8); }
constexpr int v_rd_off(int d0, int ks, int half) { return d0 * 512 + ks * 4096 + half * 2048; }
template <int OFF> __device__ __forceinline__ s16x4 tr_read(int vb) {
  s16x4 r; asm volatile("ds_read_b64_tr_b16 %0, %1 offset:%2" : "=&v"(r) : "v"(vb), "i"(OFF) : "memory"); return r;
}
template <int D0> __device__ __forceinline__ void pv_one(f32x16& od, int vb, bf16x8 pa0, bf16x8 pa1, bf16x8 pa2, bf16x8 pa3) {
  const s16x4 l0 = tr_read<v_rd_off(D0, 0, 0)>(vb), h0 = tr_read<v_rd_off(D0, 0, 1)>(vb), l1 = tr_read<v_rd_off(D0, 1, 0)>(vb), h1 = tr_read<v_rd_off(D0, 1, 1)>(vb);
  const s16x4 l2 = tr_read<v_rd_off(D0, 2, 0)>(vb), h2 = tr_read<v_rd_off(D0, 2, 1)>(vb), l3 = tr_read<v_rd_off(D0, 3, 0)>(vb), h3 = tr_read<v_rd_off(D0, 3, 1)>(vb);
  asm volatile("s_waitcnt lgkmcnt(0)" ::: "memory"); ATT_SBAR();
#define ATT_PK(L, H) (bf16x8){L[0], L[1], L[2], L[3], H[0], H[1], H[2], H[3]}
  od = __builtin_amdgcn_mfma_f32_32x32x16_bf16(pa0, ATT_PK(l0, h0), od, 0, 0, 0);
  od = __builtin_amdgcn_mfma_f32_32x32x16_bf16(pa1, ATT_PK(l1, h1), od, 0, 0, 0);
  od = __builtin_amdgcn_mfma_f32_32x32x16_bf16(pa2, ATT_PK(l2, h2), od, 0, 0, 0);
  od = __builtin_amdgcn_mfma_f32_32x32x16_bf16(pa3, ATT_PK(l3, h3), od, 0, 0, 0);
#undef ATT_PK
}
constexpr int ATT_LDS_V = 0, ATT_LDS_K = 32768, ATT_LDS_WS = 65536, ATT_LDS_CORE = 65536 + 2048;
template <int DQK, bool MASKED, bool KVSAME>
__device__ __forceinline__ void attn_core(const GAS bf16_t* __restrict__ Qrow0, int ldq, const GAS bf16_t* __restrict__ Kh, int ldk, const GAS bf16_t* __restrict__ Vh, int ldv,
                                          int NTB, int NTW, float slope2, int tq0, const LAS unsigned long long* mask, LAS char* lds, f32x16 (&o)[4], float& l_out, const int wv) {
  static_assert(DQK == 64 || DQK == 128, "DQK"); static_assert(!KVSAME || DQK == 128, "KVSAME needs DQK 128");
  constexpr int KROWB = DQK * 2, KBUF = 64 * KROWB, ND0 = DQK / 16;
  const int tid_ = tid_of(wv);
  const int tid = tid_, wid = tid >> 6, lane = tid & 63, r32 = lane & 31, hi = lane >> 5;
  LAS char* V_lds = lds + ATT_LDS_V; LAS char* K_lds = lds + ATT_LDS_K;
  LAS float* wsf = (LAS float*)(lds + ATT_LDS_WS) + wid * 64; LAS float* al_l = wsf + 32;
  float m_reg = -1e30f, l_reg = 0.f;
#pragma unroll
  for (int d = 0; d < 4; ++d) o[d] = f32x16{};
  bf16x8 qr[ND0];
  { const GAS bf16_t* Qp = Qrow0 + (size_t)r32 * ldq + hi * 8;
#pragma unroll
    for (int d0 = 0; d0 < ND0; ++d0) qr[d0] = *(const GAS bf16x8*)(Qp + d0 * 16); }
  const int sr = tid >> 4, sc = (tid & 15) * 8, vst0 = v_st(sr, sc), vst1 = v_st(32 + sr, sc);
  const int kr = tid >> 3, kc = (tid & 7) * 8;
  const int vb0 = (int)(unsigned)(size_t)V_lds + v_rd_base(lane);
  bf16x8 vs0, vs1, ks0, ks1, wv0, wv1, wk0, wk1;
#define ATT_KSWZ(row, colB) ((row) * KROWB + ((colB) ^ (((row) & 7) << 4)))
#define ATT_SLOADX(k0, vs0, vs1, ks0, ks1) do { vs0 = *(const GAS bf16x8*)(&Vh[(size_t)((k0) + sr) * ldv + sc]); vs1 = *(const GAS bf16x8*)(&Vh[(size_t)((k0) + 32 + sr) * ldv + sc]); \
    if constexpr (!KVSAME) { if constexpr (DQK == 128) { ks0 = *(const GAS bf16x8*)(&Kh[(size_t)((k0) + sr) * ldk + sc]); ks1 = *(const GAS bf16x8*)(&Kh[(size_t)((k0) + 32 + sr) * ldk + sc]); } \
                             else { ks0 = *(const GAS bf16x8*)(&Kh[(size_t)((k0) + kr) * ldk + kc]); } } } while (0)
#define ATT_SLOAD(k0) ATT_SLOADX(k0, vs0, vs1, ks0, ks1)
#define ATT_SLOADB(k0) ATT_SLOADX(k0, wv0, wv1, wk0, wk1)
#define ATT_SWRITEX(b, vs0, vs1, ks0, ks1) do { *(LAS bf16x8*)(V_lds + (b) * 16384 + vst0) = vs0; *(LAS bf16x8*)(V_lds + (b) * 16384 + vst1) = vs1; \
    if constexpr (KVSAME) { *(LAS bf16x8*)(K_lds + (b) * KBUF + ATT_KSWZ(sr, sc * 2)) = vs0; *(LAS bf16x8*)(K_lds + (b) * KBUF + ATT_KSWZ(32 + sr, sc * 2)) = vs1; } \
    else if constexpr (DQK == 128) { *(LAS bf16x8*)(K_lds + (b) * KBUF + ATT_KSWZ(sr, sc * 2)) = ks0; *(LAS bf16x8*)(K_lds + (b) * KBUF + ATT_KSWZ(32 + sr, sc * 2)) = ks1; } \
    else { *(LAS bf16x8*)(K_lds + (b) * KBUF + ATT_KSWZ(kr, kc * 2)) = ks0; } } while (0)
#define ATT_SWRITE(b) ATT_SWRITEX(b, vs0, vs1, ks0, ks1)
#define ATT_SWRITEB(b) ATT_SWRITEX(b, wv0, wv1, wk0, wk1)
  constexpr bool SD2 = false;
  ATT_SLOAD((NTB - 1) * 64); ATT_SWRITE(0);
  if constexpr (SD2) { if (NTB > 1) ATT_SLOADB((NTB - 2) * 64); if (NTB > 2) ATT_SLOAD((NTB - 3) * 64); }
  __syncthreads();
  float m_ref = 0.f;
  const int jdiag = tq0 >> 6;
  for (int jj = 0; jj < NTB; ++jj) {
    const int j = NTB - 1 - jj, buf = jj & 1;
    if constexpr (!SD2) { if (j > 0) ATT_SLOAD((j - 1) * 64); }
    if (j < NTW) {
      f32x16 p0, p1;
      unsigned mlo = 0xffffffffu, mhi = 0xffffffffu;
      if constexpr (MASKED) { const unsigned long long mw = mask[j * 32 + r32]; mlo = (unsigned)mw >> (4 * hi); mhi = (unsigned)(mw >> 32) >> (4 * hi); }
      if (j == jdiag) {
        const float x = (float)(tq0 + r32 - j * 64 - 4 * hi);
#pragma unroll
        for (int r = 0; r < 16; ++r) { const int cr = (r & 3) + 8 * (r >> 2); const float d = x - (float)cr; p0[r] = -slope2 * fabsf(d) - m_ref; p1[r] = -slope2 * fabsf(d - 32.f) - m_ref; }
      } else {
        const float b0 = slope2 * (float)(j * 64 + 4 * hi - tq0 - r32) - m_ref, s2 = slope2 + slope2, s3 = s2 + slope2, s8 = 8.f * slope2, s32 = 32.f * slope2;
        float bg = b0;
#pragma unroll
        for (int g = 0; g < 4; ++g) { p0[4 * g] = bg; p0[4 * g + 1] = bg + slope2; p0[4 * g + 2] = bg + s2; p0[4 * g + 3] = bg + s3; bg += s8; }
#pragma unroll
        for (int r = 0; r < 16; ++r) p1[r] = p0[r] + s32;
      }
      if constexpr (MASKED) {
#pragma unroll
        for (int r = 0; r < 16; ++r) { const int cr = (r & 3) + 8 * (r >> 2);
          if (!((mlo >> cr) & 1u)) p0[r] = -INFINITY; if (!((mhi >> cr) & 1u)) p1[r] = -INFINITY; }
      }
      { const LAS char* Kb = K_lds + buf * KBUF;
#pragma unroll
        for (int d0 = 0; d0 < ND0; ++d0) { const int cb = (d0 * 16 + hi * 8) * 2;
          const bf16x8 b0 = *(const LAS bf16x8*)(Kb + ATT_KSWZ(r32, cb));
          const bf16x8 b1 = *(const LAS bf16x8*)(Kb + ATT_KSWZ(32 + r32, cb));
          p0 = __builtin_amdgcn_mfma_f32_32x32x16_bf16(b0, qr[d0], p0, 0, 0, 0);
          p1 = __builtin_amdgcn_mfma_f32_32x32x16_bf16(b1, qr[d0], p1, 0, 0, 0); } }
      float pmax = fmaxf(p0[0], p1[0]);
      asm("v_max3_f32 %0, %0, %1, %2\n\tv_max3_f32 %0, %0, %3, %4\n\tv_max3_f32 %0, %0, %5, %6\n\tv_max3_f32 %0, %0, %7, %8\n\tv_max3_f32 %0, %0, %9, %10\n\tv_max3_f32 %0, %0, %11, %12\n\tv_max3_f32 %0, %0, %13, %14\n\tv_max3_f32 %0, %0, %15, %16"
          : "+v"(pmax) : "v"(p0[1]), "v"(p1[1]), "v"(p0[2]), "v"(p1[2]), "v"(p0[3]), "v"(p1[3]), "v"(p0[4]), "v"(p1[4]), "v"(p0[5]), "v"(p1[5]), "v"(p0[6]), "v"(p1[6]), "v"(p0[7]), "v"(p1[7]), "v"(p0[8]), "v"(p1[8]));
      asm("v_max3_f32 %0, %0, %1, %2\n\tv_max3_f32 %0, %0, %3, %4\n\tv_max3_f32 %0, %0, %5, %6\n\tv_max3_f32 %0, %0, %7, %8\n\tv_max3_f32 %0, %0, %9, %10\n\tv_max3_f32 %0, %0, %11, %12\n\tv_max3_f32 %0, %0, %13, %14"
          : "+v"(pmax) : "v"(p0[9]), "v"(p1[9]), "v"(p0[10]), "v"(p1[10]), "v"(p0[11]), "v"(p1[11]), "v"(p0[12]), "v"(p1[12]), "v"(p0[13]), "v"(p1[13]), "v"(p0[14]), "v"(p1[14]), "v"(p0[15]), "v"(p1[15]));
      { float r0, r1; half_swap(pmax, r0, r1); asm("v_max_f32 %0, %1, %2" : "=v"(pmax) : "v"(r0), "v"(r1)); }
      const bool first = (j == NTW - 1);
      if (first || __any(pmax > THR)) {
        const float dl = first ? ((pmax > -1e30f) ? pmax : 0.f) : fmaxf(pmax, 0.f);
        m_ref += dl; const float alpha = __builtin_amdgcn_exp2f(-dl); l_reg *= alpha;
#pragma unroll
        for (int r = 0; r < 16; ++r) { p0[r] -= dl; p1[r] -= dl; }
        if (!first) { if (hi == 0) al_l[r32] = alpha; asm volatile("s_waitcnt lgkmcnt(0)" ::: "memory");
#pragma unroll
          for (int d = 0; d < 4; ++d)
#pragma unroll
            for (int r = 0; r < 16; ++r) o[d][r] *= al_l[crow(r, hi)]; }
      }
#pragma unroll
      for (int r = 0; r < 16; ++r) { p0[r] = __builtin_amdgcn_exp2f(p0[r]); p1[r] = __builtin_amdgcn_exp2f(p1[r]); }
      bf16x8 pa0, pa1, pa2, pa3;
      finishSM(p0, p1, 1.f, l_reg, pa0, pa1, pa2, pa3); ATT_SBAR();
      const int vb = vb0 + buf * 16384;
      pv_one<0>(o[0], vb, pa0, pa1, pa2, pa3); pv_one<1>(o[1], vb, pa0, pa1, pa2, pa3); pv_one<2>(o[2], vb, pa0, pa1, pa2, pa3); pv_one<3>(o[3], vb, pa0, pa1, pa2, pa3);
    }
    if constexpr (!SD2) { if (j > 0) ATT_SWRITE(buf ^ 1); }
    else { if (j > 0) { if ((jj + 1) & 1) ATT_SWRITEB(buf ^ 1); else ATT_SWRITE(buf ^ 1); }
           if (j > 2) { if ((jj + 1) & 1) ATT_SLOADB((j - 3) * 64); else ATT_SLOAD((j - 3) * 64); } }
    __syncthreads();
  }
  l_out = l_reg;
#undef ATT_KSWZ
#undef ATT_SLOAD
#undef ATT_SWRITE
#undef ATT_SLOADB
#undef ATT_SWRITEB
#undef ATT_SLOADX
#undef ATT_SWRITEX
}
__device__ __forceinline__ void row_rcp(float l_reg, LAS char* lds, float (&rli)[16], const int wv) {
  const int tid_ = tid_of(wv);
  const int tid = tid_, wid = tid >> 6, lane = tid & 63, r32 = lane & 31, hi = lane >> 5;
  LAS float* li_l = (LAS float*)(lds + ATT_LDS_WS) + wid * 64;
  if (hi == 0) li_l[r32] = l_reg; asm volatile("s_waitcnt lgkmcnt(0)" ::: "memory");
#pragma unroll
  for (int r = 0; r < 16; ++r) rli[r] = __builtin_amdgcn_rcpf(li_l[crow(r, hi)]);
}
}
#define XB_TMO      128
#define XB_XCNT(j)  (256  + 64 * (j))
#define XB_XSUB(j)  (1280 + 64 * (j))
#define XB_XGEN(j)  (2304 + 64 * (j))
#define XB_TOP      3328
#define XB_TOPGEN   3392
#define XCD_BAR_WORDS 3456
#define XB_SPIN_CAP (1u << 18)

__device__ __forceinline__ unsigned xb_ld(unsigned* p)              { return __hip_atomic_load(p, __ATOMIC_RELAXED, __HIP_MEMORY_SCOPE_AGENT); }
__device__ __forceinline__ unsigned xb_add(unsigned* p, unsigned v) { return __hip_atomic_fetch_add(p, v, __ATOMIC_RELAXED, __HIP_MEMORY_SCOPE_AGENT); }
__device__ __forceinline__ unsigned xb_xcc_id() { return (unsigned)__builtin_amdgcn_s_getreg((3 << 11) | 20) & 0xFu; }
#define XB_SPIN(cond, bar) do { unsigned _sp = 0; while (cond) { __builtin_amdgcn_s_sleep(1); \
    if ((++_sp & 255u) == 0u) { if (xb_ld(&(bar)[XB_TMO])) break; if (_sp > XB_SPIN_CAP) { atomicAdd(&(bar)[XB_TMO], 1u); break; } } } } while (0)

struct XcdBarrier {
    unsigned* bar; unsigned x; unsigned w;
    volatile LAS unsigned* st;
};

__device__ __forceinline__ XcdBarrier xcd_barrier_post(unsigned* bar, volatile LAS unsigned* st) {
    XcdBarrier b; b.bar = bar; b.x = xb_xcc_id(); b.st = st; b.w = (unsigned)__builtin_amdgcn_readfirstlane((int)(threadIdx.x >> 6));
    if (threadIdx.x == 0) (void)xb_add(&bar[XB_XCNT(b.x)], 1u);
    return b;
}
__device__ __forceinline__ void xcd_barrier_complete(unsigned* bar, unsigned x, unsigned& nloc, unsigned& nx) {
    const unsigned G = gridDim.x * gridDim.y * gridDim.z;
    unsigned sum, cnt, mine, sp = 0u;
    for (;;) {
        sum = 0u; cnt = 0u; mine = 0u;
#pragma unroll
        for (unsigned j = 0; j < 16; ++j) { const unsigned c = xb_ld(&bar[XB_XCNT(j)]); sum += c; cnt += (c > 0u) ? 1u : 0u; mine = (j == x) ? c : mine; }
        if (sum == G) break;
        __builtin_amdgcn_s_sleep(1);
        if ((++sp & 255u) == 0u) { if (xb_ld(&bar[XB_TMO])) break; if (sp > XB_SPIN_CAP) { atomicAdd(&bar[XB_TMO], 1u); break; } }
    }
    nloc = mine > 0u ? mine : 1u; nx = cnt > 0u ? cnt : 1u;
}

__device__ __forceinline__ void xcd_barrier(const XcdBarrier& b) {
    asm volatile("s_waitcnt vmcnt(0)" ::: "memory");
    __syncthreads();
    if (b.w == 0u && lane_id() == 0) {
        unsigned* bar = b.bar;
        __builtin_amdgcn_s_waitcnt(0);
        unsigned nloc = b.st[0], nx = b.st[1];
        if (nloc == 0u) { xcd_barrier_complete(bar, b.x, nloc, nx); b.st[0] = nloc; b.st[1] = nx; }
        const unsigned old = xb_add(&bar[XB_XSUB(b.x)], 1u);
        const unsigned gen = old / nloc;
        if (old + 1u == (gen + 1u) * nloc) {
            __builtin_amdgcn_fence(__ATOMIC_RELEASE, "agent");
            asm volatile("s_waitcnt vmcnt(0)" ::: "memory");
            const unsigned og = xb_add(&bar[XB_TOP], 1u);
            const unsigned tg = og / nx;
            if (og + 1u == (tg + 1u) * nx) xb_add(&bar[XB_TOPGEN], 1u);
            else XB_SPIN(xb_ld(&bar[XB_TOPGEN]) == tg, bar);
            __builtin_amdgcn_fence(__ATOMIC_ACQUIRE, "agent");
            xb_add(&bar[XB_XGEN(b.x)], 1u);
            asm volatile("s_waitcnt vmcnt(0)" ::: "memory");
        } else {
            XB_SPIN(xb_ld(&bar[XB_XGEN(b.x)]) == gen, bar);
            __builtin_amdgcn_fence(__ATOMIC_ACQUIRE, "agent");
            asm volatile("s_waitcnt vmcnt(0)" ::: "memory");
        }
    }
    __syncthreads();
}
struct Args { const float* in[32]; float* out; unsigned char* ws; int l_lo, l_hi, p_lo, p_hi, do_pro, fused; };
enum { I_X = 0, I_EV_W_IN, I_EV_Q_NORM, I_EV_KV_NORM, I_EV_W_UQ, I_EV_W_UK, I_EV_W_UV, I_EV_W_IQ, I_EV_IDX_K_G, I_EV_IDX_K_B, I_EV_V_NORM_G, I_EV_V_NORM_B, I_EV_W_S, I_EV_B_S, I_EV_W_OUT,
       I_OD_W_IN, I_OD_LQ1, I_OD_LK1, I_OD_LQ2, I_OD_LK2, I_OD_SUBLN_G, I_OD_W_OUT, I_LN1_G, I_LN1_B, I_LN2_G, I_LN2_B, I_ROUTER_W, I_ROUTER_B, I_EXP_W_GU, I_EXP_B_GU, I_EXP_W_DN, I_EXP_B_DN };
struct Frame {
    LAS unsigned char* lds; char* ldsg; volatile LAS int* MISC; gu32* ctl;
    int tid, lane, wave, vcu, G;
    unsigned char* ws;
};
typedef const __attribute__((address_space(4))) Args* ArgsP;
#define WSP(T, off) ((T*)(ws_ + (off)))
#define PHASE_PROLOG() unsigned char* ws_ = F.ws; asm volatile("" : "+s"(ws_)); asm volatile("" : "+s"(a)); int vcu_ = F.vcu, G_ = F.G; asm volatile("" : "+s"(vcu_), "+s"(G_))
#define fresh_tid() tid_of(F.wave)

__device__ __forceinline__ void tr_block(const float* src, int ld, bf16_t* dst, int dld, float scale, LAS float* scr, int lane) {
#pragma unroll 8
    for (int i = 0; i < 32; ++i) { const int kk = 2 * i + (lane >> 5); scr[kk * 33 + (lane & 31)] = src[(size_t)kk * ld + (lane & 31)]; }
    LDS_WAIT(); asm volatile("" ::: "memory");
    const int c = lane & 7;
#pragma unroll
    for (int j = 0; j < 4; ++j) { const int n = (lane >> 3) + 8 * j; const LAS float* s = scr + (8 * c) * 33 + n;
        u32x4 o; o.x = pk2(s[0 * 33] * scale, s[1 * 33] * scale); o.y = pk2(s[2 * 33] * scale, s[3 * 33] * scale); o.z = pk2(s[4 * 33] * scale, s[5 * 33] * scale); o.w = pk2(s[6 * 33] * scale, s[7 * 33] * scale);
        *(GAS u32x4*)(dst + (size_t)n * dld + 8 * c) = o; }
    LDS_WAIT(); asm volatile("" ::: "memory");
}
__device__ __forceinline__ void tr_block8(const float* src, int ld, unsigned char* dst, int dld, float scale, LAS float* scr, int lane) {
#pragma unroll 8
    for (int i = 0; i < 32; ++i) { const int kk = 2 * i + (lane >> 5); scr[kk * 33 + (lane & 31)] = src[(size_t)kk * ld + (lane & 31)]; }
    LDS_WAIT(); asm volatile("" ::: "memory");
    const int n = lane >> 1, kh = (lane & 1) * 32; const LAS float* s = scr + kh * 33 + n;
#pragma unroll
    for (int j = 0; j < 2; ++j) { u32x4 o;
        o.x = pk4_fp8(s[(16 * j + 0) * 33] * scale, s[(16 * j + 1) * 33] * scale, s[(16 * j + 2) * 33] * scale, s[(16 * j + 3) * 33] * scale);
        o.y = pk4_fp8(s[(16 * j + 4) * 33] * scale, s[(16 * j + 5) * 33] * scale, s[(16 * j + 6) * 33] * scale, s[(16 * j + 7) * 33] * scale);
        o.z = pk4_fp8(s[(16 * j + 8) * 33] * scale, s[(16 * j + 9) * 33] * scale, s[(16 * j + 10) * 33] * scale, s[(16 * j + 11) * 33] * scale);
        o.w = pk4_fp8(s[(16 * j + 12) * 33] * scale, s[(16 * j + 13) * 33] * scale, s[(16 * j + 14) * 33] * scale, s[(16 * j + 15) * 33] * scale);
        *(GAS u32x4*)(dst + (size_t)n * dld + kh + 16 * j) = o; }
    LDS_WAIT(); asm volatile("" ::: "memory");
}
__device__ __forceinline__ void pro_phase(Frame& F, ArgsP a) {
    PHASE_PROLOG();
    const int ftid = fresh_tid(), flane = ftid & 63;
    LAS float* scr = (LAS float*)(F.lds + F.wave * 16384);
    const int gw = vcu_ * 8 + F.wave, NGW = G_ * 8;
    constexpr int IA = DEPTH * NEXP * 16 * 64, IB = DEPTH * NEXP * 16 * 32, IC = 2 * 16 * 46, ID = 2 * 16 * 96, IE = 2 * 16 * 32;
    for (int it = gw; it < IA + IB + IC + ID + IE; it += NGW) {
        int r = it;
        if (r < IA) { const int m = r >> 10, rem = r & 1023, kb = rem >> 6, nb = rem & 63, n0 = nb * 32;
            const int drow = 256 * ((n0 & 1023) >> 7) + 128 * (n0 >> 10) + (n0 & 127);
#if MOE_FP8
            tr_block8(a->in[I_EXP_W_GU] + (size_t)m * 1024 * 2048 + (size_t)(kb * 64) * 2048 + n0, 2048, WSP(unsigned char, WS_WGU) + ((size_t)m * 2048 + drow) * 1024 + kb * 64, 1024, 64.f, scr, flane); continue; }
#else
            tr_block(a->in[I_EXP_W_GU] + (size_t)m * 1024 * 2048 + (size_t)(kb * 64) * 2048 + n0, 2048, WSP(bf16_t, WS_WGU) + ((size_t)m * 2048 + drow) * 1024 + kb * 64, 1024, 1.f, scr, flane); continue; }
#endif
        r -= IA;
        if (r < IB) { const int m = r >> 9, rem = r & 511, kb = rem >> 5, nb = rem & 31;
#if MOE_FP8
            tr_block8(a->in[I_EXP_W_DN] + (size_t)m * 1024 * 1024 + (size_t)(kb * 64) * 1024 + nb * 32, 1024, WSP(unsigned char, WS_WDN) + ((size_t)m * 1024 + nb * 32) * 1024 + kb * 64, 1024, 64.f, scr, flane); continue; }
#else
            tr_block(a->in[I_EXP_W_DN] + (size_t)m * 1024 * 1024 + (size_t)(kb * 64) * 1024 + nb * 32, 1024, WSP(bf16_t, WS_WDN) + ((size_t)m * 1024 + nb * 32) * 1024 + kb * 64, 1024, 1.f, scr, flane); continue; }
#endif
        r -= IB;
        if (r < IC) { const int jj = r / 736, rem = r % 736, kb = rem / 46, nb = rem % 46;
            const int scol = nb < 14 ? nb * 32 : 452 + (nb - 14) * 32, drow = nb < 14 ? nb * 32 : 512 + (nb - 14) * 32;
            tr_block(a->in[I_EV_W_IN] + (size_t)jj * 1024 * E_IN_EVEN + (size_t)(kb * 64) * E_IN_EVEN + scol, E_IN_EVEN, WSP(bf16_t, WS_WINE) + ((size_t)jj * NE_PR + drow) * 1024 + kb * 64, 1024, 1.f, scr, flane); continue; }
        r -= IC;
        if (r < ID) { const int jj = r / 1536, rem = r % 1536, kb = rem / 96, nb = rem % 96;
            tr_block(a->in[I_OD_W_IN] + (size_t)jj * 1024 * NO_PR + (size_t)(kb * 64) * NO_PR + nb * 32, NO_PR, WSP(bf16_t, WS_WINO) + ((size_t)jj * NO_PR + nb * 32) * 1024 + kb * 64, 1024, nb < 32 ? 0.125f * LOG2E : 1.f, scr, flane); continue; }
        r -= ID;
        { const int jj = r / 512, rem = r % 512, kb = rem / 32, nb = rem % 32;
#if POUT_FP8
            tr_block8(a->in[I_OD_W_OUT] + (size_t)jj * 1024 * 1024 + (size_t)(kb * 64) * 1024 + nb * 32, 1024, WSP(unsigned char, WS_WOUTO) + ((size_t)jj * 1024 + nb * 32) * 1024 + kb * 64, 1024, 64.f, scr, flane); }
#else
            tr_block(a->in[I_OD_W_OUT] + (size_t)jj * 1024 * 1024 + (size_t)(kb * 64) * 1024 + nb * 32, 1024, WSP(bf16_t, WS_WOUTO) + ((size_t)jj * 1024 + nb * 32) * 1024 + kb * 64, 1024, 1.f, scr, flane); }
#endif
    }
    const int gt = vcu_ * 512 + ftid, NGT = G_ * 512;
    for (int i = gt; i < 2 * 64 * 1024; i += NGT) { const int jj = i >> 16, rr = 448 + ((i >> 10) & 63), k = i & 1023;
        const float v = rr < 452 ? a->in[I_EV_W_IN][(size_t)jj * 1024 * E_IN_EVEN + (size_t)k * E_IN_EVEN + rr] : 0.f;
        WSP(bf16_t, WS_WINE)[((size_t)jj * NE_PR + rr) * 1024 + k] = (bf16_t)f2bf(v); }
    for (int i = gt; i < 2 * NQQ * 256; i += NGT) { const int jj = i / (NQQ * 256), rem = i % (NQQ * 256), n = rem >> 8, c = rem & 255; float v;
        if (n < 1024) { const int h = n >> 7, lat = n & 127; const float* uq = a->in[I_EV_W_UQ] + ((size_t)(jj * 256 + c) * 8 + h) * 64; const float* uk = a->in[I_EV_W_UK] + ((size_t)(jj * 8 + h) * 64) * 128 + lat;
            float s = 0.f;
            for (int d = 0; d < 64; ++d) s += uq[d] * uk[(size_t)d * 128];
            v = s * (0.125f * LOG2E); }
        else { const int hd = n - 1024; v = 0.125f * a->in[I_EV_W_IQ][(size_t)(jj * 256 + c) * 256 + hd]; }
        WSP(bf16_t, WS_WQE)[i] = (bf16_t)f2bf(v); }
    for (int i = gt; i < 2 * 1024 * NMX; i += NGT) { const int jj = i / (1024 * NMX), rem = i % (1024 * NMX), n = rem / NMX, k = rem % NMX; float v;
        const float* wo = a->in[I_EV_W_OUT] + (size_t)jj * 1024 * 1024 + n;
        if (k < 1024) { const int h = k >> 7, c = k & 127; const float* uv = a->in[I_EV_W_UV] + ((size_t)(jj * 8 + h) * 128 + c) * 64; float s = 0.f;
            for (int d = 0; d < 64; ++d) s += uv[d] * wo[(size_t)(h * 64 + d) * 1024];
            v = s; }
        else v = wo[(size_t)(512 + k - 1024) * 1024];
#if POUT_FP8
        WSP(unsigned char, WS_WOUTE)[i] = (unsigned char)__builtin_amdgcn_cvt_pk_fp8_f32(128.f * v, 0.f, 0, false); }
#else
        WSP(bf16_t, WS_WOUTE)[i] = (bf16_t)f2bf(v); }
#endif
    for (int i = gt; i < DEPTH * 32768; i += NGT) { const int l = i >> 15, rem = i & 32767, k = rem >> 5, e = rem & 31; const float w = a->in[I_LN1_G][l * 1024 + k] * a->in[I_ROUTER_W][i];
        const unsigned h16 = f2bf(w), l16 = f2bf(w - bf2f((unsigned short)h16)); const int off = e * 2048 + (((k >> 3) ^ (e & 15)) << 4) + (k & 7) * 2;
        unsigned char* img = WSP(unsigned char, WS_WRT) + (size_t)l * 131072; *(bf16_t*)(img + off) = (bf16_t)h16; *(bf16_t*)(img + 65536 + off) = (bf16_t)l16; }
    for (int i = gw; i < DEPTH * 32; i += NGW) { const int l = i >> 5, e = i & 31; float s1 = 0.f, s2 = 0.f;
        for (int k = flane; k < 1024; k += 64) { const float wv = a->in[I_ROUTER_W][((size_t)l * 1024 + k) * 32 + e]; s1 += a->in[I_LN1_G][l * 1024 + k] * wv; s2 += a->in[I_LN1_B][l * 1024 + k] * wv; }
        s1 = wave_sum(s1); s2 = wave_sum(s2);
        if (flane == 0) { float* cc = WSP(float, WS_WRT + 512 * 1024) + l * 64; cc[e] = s1; cc[32 + e] = s2 + a->in[I_ROUTER_B][l * 32 + e]; } }
    for (int i = gt; i < 2 * 8 * 128 * 128; i += NGT) { const int ii = (i >> 7) & 127, jx = i & 127; WSP(bf16_t, WS_WS)[i] = (bf16_t)f2bf(jx <= ii ? a->in[I_EV_W_S][i] : 0.f); }
    for (int m = gw; m < T_TOK; m += NGW) { const GAS f32x4* xr = (const GAS f32x4*)(a->in[I_X] + (size_t)m * D_MODEL) + flane; GAS u32x2* o8 = (GAS u32x2*)(WSP(bf16_t, WS_HB) + (size_t)m * D_MODEL) + flane;
#pragma unroll
        for (int jx = 0; jx < 4; ++jx) { const f32x4 v = xr[64 * jx]; u32x2 w; w.x = pk2(v.x, v.y); w.y = pk2(v.z, v.w); o8[64 * jx] = w; } }
}

__device__ __forceinline__ void e1b_phase(Frame& F, ArgsP a, int l) {
    PHASE_PROLOG();
    const int j = l >> 1, lane = fresh_tid() & 63; const int gw = vcu_ * 8 + F.wave, NGW = G_ * 8;
    const float* qg = a->in[I_EV_Q_NORM] + j * 256; const float* kvg = a->in[I_EV_KV_NORM] + j * 128; const float* ig = a->in[I_EV_IDX_K_G] + j * 64; const float* ib = a->in[I_EV_IDX_K_B] + j * 64;
    const f32x4 g4 = *(const f32x4*)(qg + 4 * lane); const float kg0 = kvg[2 * lane], kg1 = kvg[2 * lane + 1], igl = ig[lane], ibl = ib[lane];
    const GAS bf16_t* PR = (const GAS bf16_t*)WSP(bf16_t, WS_PR);
    GAS bf16_t* CQo = (GAS bf16_t*)WSP(bf16_t, WS_CQ); GAS bf16_t* CKVo = (GAS bf16_t*)WSP(bf16_t, WS_CKV); GAS bf16_t* KIo = (GAS bf16_t*)WSP(bf16_t, WS_KI); GAS float* WIo = (GAS float*)WSP(float, WS_WI);
    static_assert(T_TOK % (4 * 8) == 0, "token batches");
    for (int tok0 = gw; tok0 < T_TOK; tok0 += 4 * NGW) {
        u32x2 wq[4]; unsigned wk[4]; unsigned short wi[4], ww[4];
#pragma unroll
        for (int q = 0; q < 4; ++q) { const GAS bf16_t* pr = PR + (size_t)(tok0 + q * NGW) * NE_PR;
            wq[q] = *(const GAS u32x2*)(pr + 4 * lane); wk[q] = *(const GAS unsigned*)(pr + 256 + 2 * lane); wi[q] = pr[384 + lane]; ww[q] = pr[448 + (lane & 3)]; }
        u32x2 oq[4]; unsigned ok[4]; unsigned short oi[4];
#pragma unroll
        for (int q = 0; q < 4; ++q) {
            { const u32x2 w = wq[q]; const float a0 = bflo(w.x), a1 = bfhi(w.x), a2 = bflo(w.y), a3 = bfhi(w.y);
              const float ss = wave_sum(a0 * a0 + a1 * a1 + a2 * a2 + a3 * a3); const float rs = 1.0f / sqrtf(ss * (1.0f / 256.0f) + LN_EPS);
              oq[q].x = pk2(a0 * rs * g4.x, a1 * rs * g4.y); oq[q].y = pk2(a2 * rs * g4.z, a3 * rs * g4.w); }
            { const unsigned w = wk[q]; const float a0 = bflo(w), a1 = bfhi(w);
              const float ss = wave_sum(a0 * a0 + a1 * a1); const float rs = 1.0f / sqrtf(ss * (1.0f / 128.0f) + LN_EPS);
              ok[q] = pk2(a0 * rs * kg0, a1 * rs * kg1); }
            { const float x = bf2f(wi[q]); const float mu = wave_sum(x) * (1.0f / 64.0f); const float d = x - mu; const float var = wave_sum(d * d) * (1.0f / 64.0f);
              oi[q] = (unsigned short)f2bf(d * (1.0f / sqrtf(var + LN_EPS)) * igl + ibl); } }
#pragma unroll
        for (int q = 0; q < 4; ++q) { const size_t tok = (size_t)(tok0 + q * NGW);
            *(GAS u32x2*)(CQo + tok * 256 + 4 * lane) = oq[q]; *(GAS unsigned*)(CKVo + tok * 128 + 2 * lane) = ok[q]; KIo[tok * 64 + lane] = oi[q];
            if (lane < 4) WIo[tok * 4 + lane] = 0.5f * bf2f(ww[q]); }
    }
}

__device__ __forceinline__ unsigned ord_key(float f) { const unsigned u = __builtin_bit_cast(unsigned, f); return (u & 0x80000000u) ? ~u : (u | 0x80000000u); }
__device__ __forceinline__ void e3a_phase(Frame& F, ArgsP a) {
    PHASE_PROLOG();
    const int tid = fresh_tid(), wid = F.wave, lane = tid & 63, fr = lane & 15, fq = lane >> 4;
    LAS float* sc = (LAS float*)F.lds;
    const bf16_t* QQ = WSP(bf16_t, WS_QQ); const bf16_t* KI = WSP(bf16_t, WS_KI); const float* WI = WSP(float, WS_WI);
    unsigned long long* MASK = WSP(unsigned long long, WS_MASK);
    for (int L = vcu_; L < BATCH * (SEQ / 16); L += G_) {
        const int b = L >> 7, qb = ((L & 127) + 8 * (L >> 8)) & 127, t0 = qb * 16, NT = t0 / 64 + 1;
        const size_t rb0 = (size_t)b * SEQ;
        bf16x8 qf[4][2]; f32x4 wq4;
        { const bf16_t* qp = QQ + (rb0 + t0 + fr) * NQQ + 1024 + fq * 8;
#pragma unroll
          for (int h = 0; h < 4; ++h)
#pragma unroll
              for (int ks = 0; ks < 2; ++ks) qf[h][ks] = *(const bf16x8*)(qp + h * 64 + ks * 32);
          wq4 = *(const f32x4*)(WI + (rb0 + t0 + fr) * 4); }
        const f32x4 wqh = wq4 * 0.5f;
#ifndef E3A_REP_SC
#define E3A_REP_SC 1
#endif
#ifndef E3A_REP_SEL
#define E3A_REP_SEL 1
#endif
#pragma unroll 1
        for (int rsc = 0; rsc < E3A_REP_SC; ++rsc)
        for (int kt = wid; kt < NT; kt += 8) {
            bf16x8 kk0[4], kk1[4];
#pragma unroll
            for (int kb = 0; kb < 4; ++kb) { const GAS bf16_t* kp = (const GAS bf16_t*)KI + (rb0 + kt * 64 + kb * 16 + fr) * 64 + fq * 8; kk0[kb] = *(const GAS bf16x8*)kp; kk1[kb] = *(const GAS bf16x8*)(kp + 32); }
#pragma unroll
            for (int kb = 0; kb < 4; ++kb) { const bf16x8 k0 = kk0[kb], k1 = kk1[kb];
                f32x4 s4 = (f32x4){0.f, 0.f, 0.f, 0.f};
#pragma unroll
                for (int h = 0; h < 4; ++h) { f32x4 acc = (f32x4){0.f, 0.f, 0.f, 0.f};
                    acc = __builtin_amdgcn_mfma_f32_16x16x32_bf16(k0, qf[h][0], acc, 0, 0, 0); acc = __builtin_amdgcn_mfma_f32_16x16x32_bf16(k1, qf[h][1], acc, 0, 0, 0);
#pragma unroll
                    for (int q = 0; q < 4; ++q) s4[q] += (acc[q] + fabsf(acc[q])) * wqh[h]; }
                s4 += 0.0f;
                *(LAS f32x4*)(sc + fr * 2048 + kt * 64 + kb * 16 + fq * 4) = s4; }
        }
        __syncthreads();
#pragma unroll 1
        for (int qq2 = 0; qq2 < 2 * E3A_REP_SEL; ++qq2) { const int qq = qq2 & 1; const int q = 2 * wid + qq; const int tq = t0 + q;
            unsigned long long myword = 0ull; int lane_q = lane; asm volatile("" : "+v"(lane_q));
            if (NT <= 4) { myword = (lane < NT) ? ~0ull : 0ull; }
            else {
                unsigned x[32];
                { float f[32];
#pragma unroll
                  for (int i = 0; i < 32; ++i) f[i] = sc[q * 2048 + i * 64 + lane_q];
#pragma unroll
                  for (int i = 0; i < 32; ++i) x[i] = (i * 64 + lane_q < NT * 64) ? ord_key(f[i]) : 0u; }
                unsigned prefix = 0u;
                bool exact = false;
                for (int bit = 31; bit >= 0; --bit) { const unsigned cand = prefix | (1u << bit); int cnt = 0;
#pragma unroll
                    for (int g = 0; g < 4; ++g) { if (8 * g < NT) { unsigned long long m[8];
#pragma unroll
                            for (int i = 0; i < 8; ++i) asm volatile("v_cmp_ge_u32_e64 %0, %1, %2" : "=s"(m[i]) : "v"(x[8 * g + i]), "s"(cand));
                            __builtin_amdgcn_sched_barrier(0);
#pragma unroll
                            for (int i = 0; i < 8; ++i) cnt += __builtin_popcountll(m[i]);
                            __builtin_amdgcn_sched_barrier(0); } }
                    if (cnt >= N_SEL) { prefix = cand; if (cnt == N_SEL) { exact = true; break; } } }
                int wlo = 0, whi = 0;
                if (exact) {
#pragma unroll
                    for (int i = 0; i < 32; ++i)
                        asm volatile("v_cmp_ge_u32_e64 vcc, %2, %3\n\ts_nop 4\n\tv_writelane_b32 %0, vcc_lo, %4\n\tv_writelane_b32 %1, vcc_hi, %4" : "+v"(wlo), "+v"(whi) : "v"(x[i]), "s"(prefix), "n"(i) : "vcc");
                } else {
                    const unsigned Tk = prefix; int cgt = 0;
#pragma unroll
                    for (int i = 0; i < 32; ++i) { cgt += __builtin_popcountll(__builtin_amdgcn_ballot_w64(x[i] > Tk)); if ((i & 7) == 7) __builtin_amdgcn_sched_barrier(0); }
                    int need = N_SEL - cgt;
#pragma unroll
                    for (int i = 0; i < 32; ++i) { const bool eq = x[i] == Tk; const unsigned long long meq = __builtin_amdgcn_ballot_w64(eq);
                        const int rank = (int)__builtin_amdgcn_mbcnt_hi((unsigned)(meq >> 32), __builtin_amdgcn_mbcnt_lo((unsigned)meq, 0u));
                        const unsigned long long sel = __builtin_amdgcn_ballot_w64((x[i] > Tk) || (eq && rank < need));
                        need = max(need - (int)__builtin_popcountll(meq), 0);
                        asm volatile("s_nop 4\n\tv_writelane_b32 %0, %2, %4\n\tv_writelane_b32 %1, %3, %4" : "+v"(wlo), "+v"(whi) : "s"((unsigned)sel), "s"((unsigned)(sel >> 32)), "n"(i));
                        __builtin_amdgcn_sched_barrier(0); }
                }
                myword = ((unsigned long long)(unsigned)whi << 32) | (unsigned long long)(unsigned)wlo;
            }
            if (lane < 32) MASK[(rb0 + tq) * 32 + lane] = myword;
        }
        __syncthreads();
    }
}

__device__ __forceinline__ void dsa_phase(Frame& F, ArgsP a) {
    PHASE_PROLOG();
    const int tid = fresh_tid(), wid = __builtin_amdgcn_readfirstlane(tid >> 6), lane = tid & 63, r32 = lane & 31, hi = lane >> 5;
    LAS char* lds = (LAS char*)F.lds; LAS unsigned long long* msk = (LAS unsigned long long*)(lds + att::ATT_LDS_CORE);
    const GAS bf16_t* QQ = (const GAS bf16_t*)WSP(bf16_t, WS_QQ); const GAS bf16_t* CKV = (const GAS bf16_t*)WSP(bf16_t, WS_CKV); const GAS unsigned long long* MASK = (const GAS unsigned long long*)WSP(unsigned long long, WS_MASK); GAS mx_t* MX = (GAS mx_t*)WSP(mx_t, WS_MX);
    const float slope2 = exp2f(-(float)(wid + 1)) * LOG2E;
    for (int L = vcu_; L < BATCH * (SEQ / 32); L += G_) {
        const int i = L >> 8, v = L & 255, b = v >> 3, c8 = v & 7, jx = (i & 1) ? 7 - c8 : c8, qb = 63 - (8 * i + jx), t0 = qb * 32, NT = t0 / 64 + 1;
        const size_t rb0 = (size_t)b * SEQ;
        for (int k = tid; k < 1024; k += 512) { const int q = k >> 5, jj = k & 31; msk[jj * 32 + q] = MASK[(rb0 + t0 + q) * 32 + jj]; }
        f32x16 o[4]; float l_reg;
        att::attn_core<128, true, true>(QQ + (rb0 + t0) * NQQ + wid * 128, NQQ, CKV + rb0 * 128, 128, CKV + rb0 * 128, 128, NT, NT, slope2, t0, msk, lds, o, l_reg, wid);
        float rli[16]; att::row_rcp(l_reg, lds, rli, wid);
        GAS mx_t* Ow = MX + (rb0 + t0) * NMX + wid * 128;
        unsigned lo_ = (unsigned)(hi * 4 * NMX + r32); asm volatile("" : "+v"(lo_));
#pragma unroll
        for (int r = 0; r < 16; ++r) { const float rs_ = rli[r] * MX_SCALE;
#pragma unroll
            for (int d0 = 0; d0 < 4; ++d0) Ow[lo_ + (unsigned)(((r & 3) + 8 * (r >> 2)) * NMX + d0 * 32)] = mx_cvt_s(o[d0][r] * rs_); }
    }
}

__device__ __forceinline__ void gml_phase(Frame& F, ArgsP a, int l) {
    PHASE_PROLOG();
    const int j = l >> 1, tid = fresh_tid(), g = F.wave, lane = tid & 63;
    LAS float* stat = (LAS float*)(F.MISC + MI_REC);
    LAS unsigned char* vT = F.lds + g * 16384;
    const GAS bf16_t* PR = (const GAS bf16_t*)WSP(bf16_t, WS_PR); GAS mx_t* MX = (GAS mx_t*)WSP(mx_t, WS_MX); const GAS bf16_t* Wt = (const GAS bf16_t*)WSP(bf16_t, WS_WS) + (size_t)(j * 8 + g) * 128 * 128;
    const GAS float* vg = (const GAS float*)(a->in[I_EV_V_NORM_G] + j * GW); const GAS float* vb = (const GAS float*)(a->in[I_EV_V_NORM_B] + j * GW); const GAS float* bs = (const GAS float*)(a->in[I_EV_B_S] + (size_t)(j * 8 + g) * 128);
    float vgl[8], vbl[8];
    { const f32x4 g0 = *(const GAS f32x4*)(vg + g * 64 + (lane & 7) * 8), g1 = *(const GAS f32x4*)(vg + g * 64 + (lane & 7) * 8 + 4), b0 = *(const GAS f32x4*)(vb + g * 64 + (lane & 7) * 8), b1 = *(const GAS f32x4*)(vb + g * 64 + (lane & 7) * 8 + 4);
#pragma unroll
      for (int q = 0; q < 4; ++q) { vgl[q] = g0[q]; vgl[4 + q] = g1[q]; vbl[q] = b0[q]; vbl[4 + q] = b1[q]; } }
    for (int L = vcu_; L < BATCH * (SEQ / GCH); L += G_) {
        const size_t tok0 = (size_t)(L >> 4) * SEQ + (size_t)(L & 15) * GCH;
#pragma unroll 1
        for (int t4 = 0; t4 < 16; t4 += 4) { u32x4 wq[4];
#pragma unroll
            for (int q = 0; q < 4; ++q) wq[q] = *(const GAS u32x4*)(PR + (tok0 + g * 16 + t4 + q) * NE_PR + 1024 + 8 * lane);
#pragma unroll
            for (int q = 0; q < 4; ++q) { const int tl = g * 16 + t4 + q; const u32x4 w = wq[q];
                const float x0 = bflo(w.x), x1 = bfhi(w.x), x2 = bflo(w.y), x3 = bfhi(w.y), x4 = bflo(w.z), x5 = bfhi(w.z), x6 = bflo(w.w), x7 = bfhi(w.w);
                const float mu = wave_sum(((x0 + x1) + (x2 + x3)) + ((x4 + x5) + (x6 + x7))) * (1.0f / 512.0f);
                const float d0 = x0 - mu, d1 = x1 - mu, d2 = x2 - mu, d3 = x3 - mu, d4 = x4 - mu, d5 = x5 - mu, d6 = x6 - mu, d7 = x7 - mu;
                const float var = wave_sum(((d0 * d0 + d1 * d1) + (d2 * d2 + d3 * d3)) + ((d4 * d4 + d5 * d5) + (d6 * d6 + d7 * d7))) * (1.0f / 512.0f);
                if (lane == 0) { stat[2 * tl] = mu; stat[2 * tl + 1] = 1.0f / sqrtf(var + LN_EPS); } } }
        __syncthreads();
#pragma unroll 1
        for (int i4 = 0; i4 < 16; i4 += 4) { u32x4 wv[4];
#pragma unroll
            for (int q4 = 0; q4 < 4; ++q4) { const int tl = ((i4 + q4) * 64 + lane) >> 3; wv[q4] = *(const GAS u32x4*)(PR + (tok0 + tl) * NE_PR + 1024 + g * 64 + (lane & 7) * 8); }
#pragma unroll
            for (int q4 = 0; q4 < 4; ++q4) { const int tl = ((i4 + q4) * 64 + lane) >> 3, ch8 = lane & 7; const u32x4 w = wv[q4];
                const float mu = stat[2 * tl], rs = stat[2 * tl + 1];
                float xv[8] = {bflo(w.x), bfhi(w.x), bflo(w.y), bfhi(w.y), bflo(w.z), bfhi(w.z), bflo(w.w), bfhi(w.w)};
#pragma unroll
                for (int q = 0; q < 8; ++q) { const int c = ch8 * 8 + q; const float y = (xv[q] - mu) * rs * vgl[q] + vbl[q];
                    *(LAS bf16_t*)(vT + c * 256 + ((((tl >> 3) ^ (c & 15)) << 4) | ((tl & 7) * 2))) = (bf16_t)f2bf(y); } } }
        LDS_WAIT(); asm volatile("" ::: "memory");
#pragma unroll 1
        for (int mh = 0; mh < 2; ++mh) {
            f32x4 acc[4][4];
#pragma unroll
            for (int mi = 0; mi < 4; ++mi)
#pragma unroll
                for (int ni = 0; ni < 4; ++ni) acc[mi][ni] = (f32x4){0.f, 0.f, 0.f, 0.f};
            bf16x8 afr[4][4];
            { int wrow0 = 64 * mh + (lane & 15); asm volatile("" : "+v"(wrow0));
#pragma unroll
              for (int ks = 0; ks < 4; ++ks)
#pragma unroll
                  for (int mi = 0; mi < 4; ++mi) afr[ks][mi] = *(const GAS bf16x8*)(Wt + (size_t)(wrow0 + 16 * mi) * 128 + 32 * ks + 8 * (lane >> 4)); }
#pragma unroll
            for (int ks = 0; ks < 4; ++ks) { bf16x8 bfr[4];
#pragma unroll
                for (int ni = 0; ni < 4; ++ni) { const int c = 16 * ni + (lane & 15), ch = (ks * 4 + (lane >> 4)) ^ (c & 15); bfr[ni] = *(const LAS bf16x8*)(vT + c * 256 + (ch << 4)); }
#pragma unroll
                for (int mi = 0; mi < 4; ++mi) { if (32 * ks <= 16 * (4 * mh + mi) + 15) {
#pragma unroll
                        for (int ni = 0; ni < 4; ++ni) acc[mi][ni] = __builtin_amdgcn_mfma_f32_16x16x32_bf16(afr[ks][mi], bfr[ni], acc[mi][ni], 0, 0, 0); } } }
#pragma unroll
            for (int mi = 0; mi < 4; ++mi) { int ii0 = 16 * (4 * mh + mi) + 4 * (lane >> 4); asm volatile("" : "+v"(ii0));
                const f32x4 bsv = *(const GAS f32x4*)(bs + ii0); unsigned short uu[4][4];
#pragma unroll
                for (int q = 0; q < 4; ++q)
#pragma unroll
                    for (int ni = 0; ni < 4; ++ni) uu[q][ni] = PR[(tok0 + ii0 + q) * NE_PR + 512 + g * 64 + 16 * ni + (lane & 15)];
#pragma unroll
                for (int q = 0; q < 4; ++q)
#pragma unroll
                    for (int ni = 0; ni < 4; ++ni) MX[(tok0 + ii0 + q) * NMX + 1024 + g * 64 + 16 * ni + (lane & 15)] = mx_cvt(bf2f(uu[q][ni]) * (acc[mi][ni][q] + bsv[q]));
                __builtin_amdgcn_sched_barrier(0); }
        }
        __syncthreads();
    }
}

__device__ __forceinline__ void datt_phase(Frame& F, ArgsP a, int l) {
    PHASE_PROLOG();
    const int j = l >> 1, tid = fresh_tid(), wid = __builtin_amdgcn_readfirstlane(tid >> 6), lane = tid & 63, r32 = lane & 31, hi = lane >> 5;
    LAS char* lds = (LAS char*)F.lds; LAS unsigned* stash = (LAS unsigned*)(lds + att::ATT_LDS_CORE);
    const GAS bf16_t* PR = (const GAS bf16_t*)WSP(bf16_t, WS_PR); GAS mx_t* OA = (GAS mx_t*)WSP(mx_t, WS_MX);
    const float lam_init = 0.8f - 0.6f * expf(-0.3f * (float)l);
    float lam;
    { const float s1 = wave_sum(a->in[I_OD_LQ1][j * 64 + lane] * a->in[I_OD_LK1][j * 64 + lane]), s2 = wave_sum(a->in[I_OD_LQ2][j * 64 + lane] * a->in[I_OD_LK2][j * 64 + lane]);
      lam = expf(s1) - expf(s2) + lam_init; }
    const float* sg = a->in[I_OD_SUBLN_G] + j * 128;
    for (int L = vcu_; L < BATCH * H_C * (SEQ / 256); L += G_) {
        const int qb = 7 - (L >> 8), v = L & 255, b = v >> 3, h = v & 7;
        const size_t rb0 = (size_t)b * SEQ; const int t0w = qb * 256 + 32 * wid, NTB = 4 * qb + 4, NTW = t0w / 64 + 1;
        const float slope2 = exp2f(-(float)(h + 1)) * LOG2E;
#pragma unroll 1
        for (int m = 0; m < 2; ++m) {
            f32x16 o[4]; float l_reg;
            att::attn_core<64, false, false>(PR + (rb0 + t0w) * NO_PR + h * 128 + m * 64, NO_PR, PR + rb0 * NO_PR + 1024 + h * 128 + m * 64, NO_PR, PR + rb0 * NO_PR + 2048 + h * 128, NO_PR,
                                             NTB, NTW, slope2, t0w, nullptr, lds, o, l_reg, wid);
            float rli[16]; att::row_rcp(l_reg, lds, rli, wid);
            if (m == 0) {
#pragma unroll
                for (int d0 = 0; d0 < 4; ++d0)
#pragma unroll
                    for (int r = 0; r < 16; r += 2) stash[(d0 * 8 + (r >> 1)) * 512 + tid] = att::cvtpk(o[d0][r] * rli[r], o[d0][r + 1] * rli[r + 1]);
            } else {
                float ssq[16];
#pragma unroll
                for (int r = 0; r < 16; ++r) ssq[r] = 0.f;
#pragma unroll
                for (int r = 0; r < 16; ++r) rli[r] *= lam;
#pragma unroll
                for (int d0 = 0; d0 < 4; ++d0)
#pragma unroll
                    for (int r = 0; r < 16; r += 2) { const unsigned w = stash[(d0 * 8 + (r >> 1)) * 512 + tid];
                        const float y0 = bflo(w) - rli[r] * o[d0][r], y1 = bfhi(w) - rli[r + 1] * o[d0][r + 1];
                        o[d0][r] = y0; o[d0][r + 1] = y1; ssq[r] += y0 * y0; ssq[r + 1] += y1 * y1; if ((r & 6) == 6) __builtin_amdgcn_sched_barrier(0); }
#pragma unroll
                for (int r = 0; r < 16; ++r) { float s = ssq[r]; s += xshfl<1>(s, 0); s += xshfl<2>(s, 0); s += xshfl<4>(s, 0); s += xshfl<8>(s, 0); s += xshfl<16>(s, 0);
                    ssq[r] = (MX_SCALE * (1.0f - lam_init)) * __builtin_amdgcn_rsqf(s * (1.0f / 128.0f) + LN_EPS); }
                GAS mx_t* Ow = OA + (rb0 + t0w) * D_MODEL + h * 128;
                unsigned lo_ = (unsigned)(hi * 4 * D_MODEL + r32); asm volatile("" : "+v"(lo_));
#pragma unroll
                for (int d0 = 0; d0 < 4; ++d0) { const float gv = sg[d0 * 32 + r32];
#pragma unroll
                    for (int r = 0; r < 16; ++r) Ow[lo_ + (unsigned)(((r & 3) + 8 * (r >> 2)) * D_MODEL + d0 * 32)] = mx_cvt_s(o[d0][r] * ssq[r] * gv);
                    __builtin_amdgcn_sched_barrier(0); }
            }
        }
    }
}

template <int H, int BIT> __device__ __forceinline__ void rs_step(float (&p)[32], int lane) {
    if constexpr (BIT == 32) {
#pragma unroll
        for (int i = 0; i < H; ++i) { unsigned u0, u1; plswap(__builtin_bit_cast(unsigned, p[i]), __builtin_bit_cast(unsigned, p[H + i]), u0, u1);
            p[i] = __builtin_bit_cast(float, u0) + __builtin_bit_cast(float, u1); }
    } else {
        const bool up = (lane & BIT) != 0;
#pragma unroll
        for (int i = 0; i < H; ++i) { const float keep = up ? p[H + i] : p[i], send = up ? p[i] : p[H + i]; p[i] = keep + xshfl<BIT>(send, lane); }
    }
}
template <int N> __device__ __forceinline__ void ln16(float (&v)[16], const float (&gg)[16], const float (&bb)[16]) {
    float s = 0.f;
#pragma unroll
    for (int i = 0; i < 16; ++i) s += v[i];
    const float mean = wave_sum(s) * (1.0f / 1024.0f); float s2 = 0.f;
#pragma unroll
    for (int i = 0; i < 16; ++i) { v[i] -= mean; s2 += v[i] * v[i]; }
    const float rstd = 1.0f / sqrtf(wave_sum(s2) * (1.0f / 1024.0f) + LN_EPS);
#pragma unroll
    for (int i = 0; i < 16; ++i) v[i] = v[i] * rstd * gg[i] + bb[i];
}
__device__ __forceinline__ void lnr_load_ln(const bf16_t* zrow, float* hrow, bf16_t* hbrow, unsigned char* hb8row, const float* g1, const float* b1, int lane, float (&hv)[16]) {
    float gg[16], bb[16];
#pragma unroll
    for (int jj = 0; jj < 4; ++jj) { const u32x2 zw = *(const u32x2*)(zrow + 256 * jj + 4 * lane); const f32x4 z4 = (f32x4){bflo(zw.x), bfhi(zw.x), bflo(zw.y), bfhi(zw.y)}; const f32x4 g4 = *(const f32x4*)(g1 + 256 * jj + 4 * lane), b4 = *(const f32x4*)(b1 + 256 * jj + 4 * lane);
#pragma unroll
        for (int i = 0; i < 4; ++i) { hv[jj * 4 + i] = z4[i]; gg[jj * 4 + i] = g4[i]; bb[jj * 4 + i] = b4[i]; } }
    ln16<0>(hv, gg, bb);
#pragma unroll
    for (int jj = 0; jj < 4; ++jj) {
        u32x2 w; w.x = pk2(hv[jj * 4], hv[jj * 4 + 1]); w.y = pk2(hv[jj * 4 + 2], hv[jj * 4 + 3]); *(u32x2*)(hbrow + 256 * jj + 4 * lane) = w;
#if MOE_FP8
        *(unsigned*)(hb8row + 256 * jj + 4 * lane) = pk4_fp8(hv[jj * 4], hv[jj * 4 + 1], hv[jj * 4 + 2], hv[jj * 4 + 3]);
#endif
    }
}
__device__ __forceinline__ void lnr_tail(Frame& F, unsigned char* ws_, float* gate_out, float (&part)[32], float rbias, int tl, size_t tok, int lane) {
    rs_step<4, 8>(part, lane); rs_step<2, 4>(part, lane); rs_step<1, 2>(part, lane);
    float v = part[0] + xshfl<1>(part[0], lane) + rbias;
    float t0, t1, t2, t3; int e0, e1, e2, e3;
#define LNR_PICK(tk, ek) do { const float m_ = wave_max(v); const unsigned long long bm_ = __builtin_amdgcn_ballot_w64(v == m_); ek = __builtin_ctzll(bm_) >> 1; tk = m_; if ((lane >> 1) == ek) v = -INFINITY; } while (0)
    LNR_PICK(t0, e0); LNR_PICK(t1, e1); LNR_PICK(t2, e2); LNR_PICK(t3, e3);
#undef LNR_PICK
    const float x1 = fast_exp2((t1 - t0) * LOG2E), x2 = fast_exp2((t2 - t0) * LOG2E), x3 = fast_exp2((t3 - t0) * LOG2E);
    const float inv = 1.0f / (1.0f + x1 + x2 + x3);
    if (lane < 4) { const int ek = lane == 0 ? e0 : lane == 1 ? e1 : lane == 2 ? e2 : e3; const float gk = (lane == 0 ? 1.0f : lane == 1 ? x1 : lane == 2 ? x2 : x3) * inv;
        const int lr = __hip_atomic_fetch_add((LAS int*)&F.MISC[MI_LCNT + ek], 1, __ATOMIC_RELAXED, __HIP_MEMORY_SCOPE_WORKGROUP);
        F.MISC[MI_REC + tl * 4 + lane] = (ek << 16) | lr;
        gate_out[tok * 4 + lane] = gk; }
}
__device__ __forceinline__ void lnr_phase(Frame& F, ArgsP a, int l, bool dry = false) {
    PHASE_PROLOG();
    const int tid = fresh_tid(), wid = F.wave, lane = tid & 63;
    LAS float* rws = (LAS float*)F.lds;
    { const float* rw = a->in[I_ROUTER_W] + (size_t)l * 1024 * 32;
      for (int idx = tid; idx < 32768; idx += 512) { const int d = idx >> 5, e = idx & 31, jj = d >> 8, ln = (d & 255) >> 2, i = d & 3; rws[((jj * 4 + i) * 8 + (e >> 2)) * 256 + ln * 4 + (e & 3)] = rw[idx]; } }
    const float* g1 = a->in[I_LN1_G] + l * 1024; const float* b1 = a->in[I_LN1_B] + l * 1024;
    const float rbias = a->in[I_ROUTER_B][l * 32 + ((lane >> 1) & 31)];
    const bf16_t* Z = WSP(bf16_t, WS_Z); float* H32 = a->out; bf16_t* HB = dry ? WSP(bf16_t, WS_PR) : WSP(bf16_t, WS_HB); unsigned char* HB8 = dry ? WSP(unsigned char, WS_QQ) : WSP(unsigned char, WS_HB8);
    float* gate_out = dry ? WSP(float, WS_WI) : WSP(float, WS_GATE); int* rowtok = dry ? WSP(int, WS_MASK) : WSP(int, WS_ROWTOK); unsigned* slot_out = dry ? WSP(unsigned, WS_CKV) : WSP(unsigned, WS_SLOT);
    gu32* cur = F.ctl + CW_CUR + (size_t)(dry ? l + 4 : l) * 32 * 64;
    __syncthreads();
    for (int u = vcu_; u < T_TOK / 256; u += G_) {
        if (tid < 32) F.MISC[MI_LCNT + tid] = 0;
        __syncthreads();
#pragma unroll 1
        for (int tp = 0; tp < 16; ++tp) {
            const int tl0 = wid * 32 + 2 * tp; const size_t tok0 = (size_t)u * 256 + tl0;
            float hv0[16], hv1[16];
            lnr_load_ln(Z + tok0 * D_MODEL, H32 + tok0 * D_MODEL, HB + tok0 * D_MODEL, HB8 + tok0 * D_MODEL, g1, b1, lane, hv0);
            lnr_load_ln(Z + (tok0 + 1) * D_MODEL, H32 + (tok0 + 1) * D_MODEL, HB + (tok0 + 1) * D_MODEL, HB8 + (tok0 + 1) * D_MODEL, g1, b1, lane, hv1);
            __builtin_amdgcn_sched_barrier(0);
            f32x4 pv0[8], pv1[8]; LAS float* rw_ = rws + lane * 4; asm volatile("" : "+v"(rw_));
#pragma unroll
            for (int e = 0; e < 8; ++e) { pv0[e] = (f32x4){0.f, 0.f, 0.f, 0.f}; pv1[e] = (f32x4){0.f, 0.f, 0.f, 0.f}; }
#pragma unroll
            for (int ji = 0; ji < 16; ++ji) {
#pragma unroll
                for (int e4 = 0; e4 < 8; ++e4) { const f32x4 w4 = *(const LAS f32x4*)(rw_ + (ji * 8 + e4) * 256); pv0[e4] += w4 * hv0[ji]; pv1[e4] += w4 * hv1[ji]; }
                __builtin_amdgcn_sched_barrier(0); }
            float part0[32], part1[32];
#pragma unroll
            for (int e = 0; e < 32; ++e) part0[e] = pv0[e >> 2][e & 3];
            rs_step<16, 32>(part0, lane); rs_step<8, 16>(part0, lane);
            __builtin_amdgcn_sched_barrier(0);
#pragma unroll
            for (int e = 0; e < 32; ++e) part1[e] = pv1[e >> 2][e & 3];
            rs_step<16, 32>(part1, lane); rs_step<8, 16>(part1, lane);
            __builtin_amdgcn_sched_barrier(0);
            lnr_tail(F, ws_, gate_out, part0, rbias, tl0, tok0, lane);
            __builtin_amdgcn_sched_barrier(0);
            lnr_tail(F, ws_, gate_out, part1, rbias, tl0 + 1, tok0 + 1, lane);
            __builtin_amdgcn_sched_barrier(0);
        }
        __syncthreads();
        if (tid < 32) { const int c = F.MISC[MI_LCNT + tid]; F.MISC[MI_LBASE + tid] = c ? (int)__hip_atomic_fetch_add(cur + tid * 64, (unsigned)c, RLX_AGENT) : 0; }
        __syncthreads();
        for (int i = tid; i < 1024; i += 512) { const int rec = F.MISC[MI_REC + i], e = rec >> 16, rank = F.MISC[MI_LBASE + e] + (rec & 0xffff); const int tok = u * 256 + (i >> 2);
            rowtok[(size_t)(dry ? (e & 31) : e) * 65536 + (dry ? (rank & 32767) : rank)] = tok; slot_out[(size_t)tok * 4 + (i & 3)] = ((unsigned)e << 20) | (unsigned)rank; }
        __syncthreads();
    }
}

__device__ __forceinline__ void lnr2_phase(Frame& F, ArgsP a, int l, bool dry = false) {
    PHASE_PROLOG();
    const int tid = fresh_tid(), wid = __builtin_amdgcn_readfirstlane(tid >> 6), lane = tid & 63, r32 = lane & 31, hi = lane >> 5;
    LAS unsigned char* Wh = F.lds; LAS unsigned char* Wl = F.lds + 65536;
    LAS float* stats = (LAS float*)(F.lds + RING_BYTES);
    LAS float* cc = (LAS float*)(F.MISC + MI_RBE);
    const float* g1 = a->in[I_LN1_G] + l * 1024; const float* b1 = a->in[I_LN1_B] + l * 1024;
    { const GAS u32x4* img = (const GAS u32x4*)(WSP(unsigned char, WS_WRT) + (size_t)l * 131072);
      u32x4 t_[16];
#pragma unroll
      for (int i = 0; i < 16; ++i) t_[i] = img[tid + 512 * i];
#pragma unroll
      for (int i = 0; i < 16; ++i) *(LAS u32x4*)(F.lds + (tid + 512 * i) * 16) = t_[i];
      if (tid < 64) cc[tid] = WSP(float, WS_WRT + 512 * 1024)[l * 64 + tid]; }
    const GAS bf16_t* Z = (const GAS bf16_t*)WSP(bf16_t, WS_Z); GAS bf16_t* HB = (GAS bf16_t*)(dry ? WSP(bf16_t, WS_PR) : WSP(bf16_t, WS_HB)); GAS unsigned char* HB8 = (GAS unsigned char*)(dry ? WSP(unsigned char, WS_QQ) : WSP(unsigned char, WS_HB8));
    float* gate_out = dry ? WSP(float, WS_WI) : WSP(float, WS_GATE); int* rowtok = dry ? WSP(int, WS_MASK) : WSP(int, WS_ROWTOK); unsigned* slot_out = dry ? WSP(unsigned, WS_CKV) : WSP(unsigned, WS_SLOT);
    GAS float* ST = (GAS float*)(dry ? WSP(float, WS_KI) : WSP(float, WS_STAT));
    gu32* cur = F.ctl + CW_CUR + (size_t)(dry ? l + 4 : l) * 32 * 64;
    float gg[16], bb[16];
#pragma unroll
    for (int jj = 0; jj < 4; ++jj) { const f32x4 g4 = *(const f32x4*)(g1 + 256 * jj + 4 * lane), b4 = *(const f32x4*)(b1 + 256 * jj + 4 * lane);
#pragma unroll
        for (int i = 0; i < 4; ++i) { gg[jj * 4 + i] = g4[i]; bb[jj * 4 + i] = b4[i]; } }
    __syncthreads();
    for (int u = vcu_; u < T_TOK / 256; u += G_) {
        if (tid < 32) F.MISC[MI_LCNT + tid] = 0;
        __syncthreads();
        {
            const int tl = 32 * wid + r32; const size_t tok = (size_t)u * 256 + tl;
            const GAS bf16_t* zp = Z + tok * D_MODEL + 512 * hi;
            const LAS unsigned char* whp = Wh + r32 * 2048; const LAS unsigned char* wlp = Wl + r32 * 2048; const int sw = r32 & 15;
            f32x16 acc = f32x16{}; float sm = 0.f, sq = 0.f;
#pragma unroll 8
            for (int sx = 0; sx < 64; ++sx) { const u32x4 zw = *(const GAS u32x4*)(zp + 8 * sx); const bf16x8 zf = __builtin_bit_cast(bf16x8, zw);
                const int ch = ((64 * hi + sx) ^ sw) << 4;
                const bf16x8 ah = *(const LAS bf16x8*)(whp + ch), al = *(const LAS bf16x8*)(wlp + ch);
                acc = __builtin_amdgcn_mfma_f32_32x32x16_bf16(ah, zf, acc, 0, 0, 0); acc = __builtin_amdgcn_mfma_f32_32x32x16_bf16(al, zf, acc, 0, 0, 0);
#pragma unroll
                for (int q = 0; q < 4; ++q) { const float x0 = bflo(zw[q]), x1 = bfhi(zw[q]); sm += x0 + x1; sq += x0 * x0 + x1 * x1; } }
            { float r0, r1; half_swap(sm, r0, r1); sm = r0 + r1; half_swap(sq, r0, r1); sq = r0 + r1; }
            const float mu = sm * (1.0f / 1024.0f); const float rstd = 1.0f / sqrtf(fmaxf(sq * (1.0f / 1024.0f) - mu * mu, 0.f) + LN_EPS);
            if (hi == 0) { stats[2 * tl] = mu; stats[2 * tl + 1] = rstd; *(GAS f32x2*)(ST + tok * 2) = (f32x2){mu, rstd}; }
            float lg[16];
#pragma unroll
            for (int r = 0; r < 16; ++r) { const int e = att::crow(r, hi); lg[r] = rstd * (acc[r] - mu * cc[e]) + cc[32 + e]; }
            float cv[8]; int ci[8];
#pragma unroll
            for (int k = 0; k < 4; ++k) { float best = -INFINITY; int bid = 0;
#pragma unroll
                for (int r = 0; r < 16; ++r) { const int e = att::crow(r, hi); if (lg[r] > best) { best = lg[r]; bid = e; } }
                cv[k] = best; ci[k] = bid;
#pragma unroll
                for (int r = 0; r < 16; ++r) if (att::crow(r, hi) == bid) lg[r] = -INFINITY; }
#pragma unroll
            for (int k = 0; k < 4; ++k) { unsigned a0, a1, b0, b1; plswap(__builtin_bit_cast(unsigned, cv[k]), __builtin_bit_cast(unsigned, cv[k]), a0, a1); plswap((unsigned)ci[k], (unsigned)ci[k], b0, b1);
                cv[4 + k] = __builtin_bit_cast(float, hi ? a0 : a1); ci[4 + k] = (int)(hi ? b0 : b1); }
            float tv[4]; int te[4];
#pragma unroll
            for (int k = 0; k < 4; ++k) { float best = -INFINITY; int bid = 1 << 20;
#pragma unroll
                for (int i = 0; i < 8; ++i) if (cv[i] > best || (cv[i] == best && ci[i] < bid)) { best = cv[i]; bid = ci[i]; }
                tv[k] = best; te[k] = bid;
#pragma unroll
                for (int i = 0; i < 8; ++i) if (ci[i] == bid) cv[i] = -INFINITY; }
            const float x1 = fast_exp2((tv[1] - tv[0]) * LOG2E), x2 = fast_exp2((tv[2] - tv[0]) * LOG2E), x3 = fast_exp2((tv[3] - tv[0]) * LOG2E);
            const float inv = 1.0f / (1.0f + x1 + x2 + x3);
            if (hi == 0) {
#pragma unroll
                for (int k = 0; k < 4; ++k) { const int lr = __hip_atomic_fetch_add((LAS int*)&F.MISC[MI_LCNT + te[k]], 1, __ATOMIC_RELAXED, __HIP_MEMORY_SCOPE_WORKGROUP);
                    F.MISC[MI_REC + tl * 4 + k] = (te[k] << 16) | lr; }
                *(f32x4*)(gate_out + tok * 4) = (f32x4){inv, x1 * inv, x2 * inv, x3 * inv}; }
        }
        __syncthreads();
#pragma unroll 1
        for (int tp = 0; tp < 32; tp += 4) {
            u32x2 zw[4][4];
#pragma unroll
            for (int q = 0; q < 4; ++q) { const size_t tok = (size_t)u * 256 + 32 * wid + tp + q;
#pragma unroll
                for (int jj = 0; jj < 4; ++jj) zw[q][jj] = *(const GAS u32x2*)(Z + tok * D_MODEL + 256 * jj + 4 * lane); }
#pragma unroll
            for (int q = 0; q < 4; ++q) { const int tl = 32 * wid + tp + q; const size_t tok = (size_t)u * 256 + tl; const float mu = stats[2 * tl], rstd = stats[2 * tl + 1];
#pragma unroll
                for (int jj = 0; jj < 4; ++jj) { const u32x2 w_ = zw[q][jj];
                    const float h0 = (bflo(w_.x) - mu) * rstd * gg[jj * 4] + bb[jj * 4], h1 = (bfhi(w_.x) - mu) * rstd * gg[jj * 4 + 1] + bb[jj * 4 + 1], h2 = (bflo(w_.y) - mu) * rstd * gg[jj * 4 + 2] + bb[jj * 4 + 2], h3 = (bfhi(w_.y) - mu) * rstd * gg[jj * 4 + 3] + bb[jj * 4 + 3];
#if MOE_FP8
                    *(GAS unsigned*)(HB8 + tok * D_MODEL + 256 * jj + 4 * lane) = pk4_fp8(h0, h1, h2, h3);
#else
                    u32x2 w; w.x = pk2(h0, h1); w.y = pk2(h2, h3); *(GAS u32x2*)(HB + tok * D_MODEL + 256 * jj + 4 * lane) = w;
#endif
                } } }
        if (tid < 32) { const int c = F.MISC[MI_LCNT + tid]; F.MISC[MI_LBASE + tid] = c ? (int)__hip_atomic_fetch_add(cur + tid * 64, (unsigned)c, RLX_AGENT) : 0; }
        __syncthreads();
        for (int i = tid; i < 1024; i += 512) { const int rec = F.MISC[MI_REC + i], e = rec >> 16, rank = F.MISC[MI_LBASE + e] + (rec & 0xffff); const int tok = u * 256 + (i >> 2);
            rowtok[(size_t)(dry ? (e & 31) : e) * 65536 + (dry ? (rank & 32767) : rank)] = tok; slot_out[(size_t)tok * 4 + (i & 3)] = ((unsigned)e << 20) | (unsigned)rank; }
        __syncthreads();
    }
}

__device__ __forceinline__ void moe_tables(Frame& F, int l) {
    const int tid = fresh_tid();
    __syncthreads();
    if (tid < 32) F.MISC[MI_CNT + tid] = (int)__hip_atomic_load(F.ctl + CW_CUR + (size_t)(l * 32 + tid) * 64, RLX_AGENT);
    __syncthreads();
    if (tid == 0) { int acc = 0; for (int e = 0; e < 32; ++e) { F.MISC[MI_RBSTART + e] = acc; acc += (F.MISC[MI_CNT + e] + 255) >> 8; } F.MISC[MI_RBSTART + 32] = acc; }
    __syncthreads();
    const int nrb = F.MISC[MI_RBSTART + 32];
    for (int rb = tid; rb < nrb; rb += 512) { int e = 0; while (e < 31 && F.MISC[MI_RBSTART + e + 1] <= rb) ++e; F.MISC[MI_RBE + rb] = e; }
    __syncthreads();
}

__device__ __forceinline__ void cmb_phase(Frame& F, ArgsP a, int l, bool dry = false, bool tables = true) {
    PHASE_PROLOG();
    if (tables) moe_tables(F, l);
    const int lane = fresh_tid() & 63; const int gw = vcu_ * 8 + F.wave, NGW = G_ * 8;
    float gg[16], bb[16];
#pragma unroll
    for (int jj = 0; jj < 4; ++jj) { const f32x4 g4 = *(const f32x4*)(a->in[I_LN2_G] + l * 1024 + 256 * jj + 4 * lane), b4 = *(const f32x4*)(a->in[I_LN2_B] + l * 1024 + 256 * jj + 4 * lane);
#pragma unroll
        for (int i = 0; i < 4; ++i) { gg[jj * 4 + i] = g4[i]; bb[jj * 4 + i] = b4[i]; } }
    float ag1[16], ab1[16];
#pragma unroll
    for (int jj = 0; jj < 4; ++jj) { const f32x4 g4 = *(const f32x4*)(a->in[I_LN1_G] + l * 1024 + 256 * jj + 4 * lane), b4 = *(const f32x4*)(a->in[I_LN1_B] + l * 1024 + 256 * jj + 4 * lane);
#pragma unroll
        for (int i = 0; i < 4; ++i) { ag1[jj * 4 + i] = DN_ALPHA * g4[i]; ab1[jj * 4 + i] = DN_ALPHA * b4[i]; } }
    const GAS bf16_t* Zr = (const GAS bf16_t*)WSP(bf16_t, WS_Z); const GAS float* ST = (const GAS float*)WSP(float, WS_STAT);
    GAS float* H32 = (GAS float*)(dry ? WSP(float, WS_PR) : a->out); const GAS bf16_t* HB = (const GAS bf16_t*)WSP(bf16_t, WS_HB); GAS bf16_t* HBo = (GAS bf16_t*)(dry ? WSP(bf16_t, WS_PR) : WSP(bf16_t, WS_HB)); const GAS bf16_t* Y = (const GAS bf16_t*)WSP(bf16_t, WS_Y);
    for (int tok = gw; tok < T_TOK; tok += NGW) {
        const unsigned sl = ((const GAS unsigned*)WSP(unsigned, WS_SLOT))[(size_t)tok * 4 + (lane & 3)]; const float gt = ((const GAS float*)WSP(float, WS_GATE))[(size_t)tok * 4 + (lane & 3)];
        float z[16];
#if MOE_FP8
        const f32x2 st = *(const GAS f32x2*)(ST + (size_t)tok * 2); const float mu = st.x, rs = st.y;
#pragma unroll
        for (int jj = 0; jj < 4; ++jj) { const u32x2 hw = *(const GAS u32x2*)(Zr + (size_t)tok * D_MODEL + 256 * jj + 4 * lane);
            z[jj * 4] = (bflo(hw.x) - mu) * rs * ag1[jj * 4] + ab1[jj * 4]; z[jj * 4 + 1] = (bfhi(hw.x) - mu) * rs * ag1[jj * 4 + 1] + ab1[jj * 4 + 1];
            z[jj * 4 + 2] = (bflo(hw.y) - mu) * rs * ag1[jj * 4 + 2] + ab1[jj * 4 + 2]; z[jj * 4 + 3] = (bfhi(hw.y) - mu) * rs * ag1[jj * 4 + 3] + ab1[jj * 4 + 3]; }
#else
#pragma unroll
        for (int jj = 0; jj < 4; ++jj) { const u32x2 hw = *(const GAS u32x2*)(HB + (size_t)tok * D_MODEL + 256 * jj + 4 * lane);
            z[jj * 4] = DN_ALPHA * bflo(hw.x); z[jj * 4 + 1] = DN_ALPHA * bfhi(hw.x); z[jj * 4 + 2] = DN_ALPHA * bflo(hw.y); z[jj * 4 + 3] = DN_ALPHA * bfhi(hw.y); }
#endif
#pragma unroll
        for (int k = 0; k < 4; ++k) { const unsigned sk = (unsigned)__builtin_amdgcn_readlane((int)sl, k); const float gk = __builtin_bit_cast(float, __builtin_amdgcn_readlane(__builtin_bit_cast(int, gt), k));
            const int e = (int)(sk >> 20), rank = (int)(sk & 0xfffffu); const size_t row = (size_t)F.MISC[MI_RBSTART + e] * 256 + rank;
#if MOE_FP8
            const GAS unsigned char* y = (const GAS unsigned char*)Y + row * D_MODEL + 4 * lane; const float gs = gk * (1.0f / 64.0f);
#pragma unroll
            for (int jj = 0; jj < 4; ++jj) { const int w = *(const GAS int*)(y + 256 * jj);
                z[jj * 4] += gs * __builtin_amdgcn_cvt_f32_fp8(w, 0); z[jj * 4 + 1] += gs * __builtin_amdgcn_cvt_f32_fp8(w, 1); z[jj * 4 + 2] += gs * __builtin_amdgcn_cvt_f32_fp8(w, 2); z[jj * 4 + 3] += gs * __builtin_amdgcn_cvt_f32_fp8(w, 3); } }
#else
            const bf16_t* y = Y + row * D_MODEL + 4 * lane;
#pragma unroll
            for (int jj = 0; jj < 4; ++jj) { const u32x2 w = *(const u32x2*)(y + 256 * jj); z[jj * 4] += gk * bflo(w.x); z[jj * 4 + 1] += gk * bfhi(w.x); z[jj * 4 + 2] += gk * bflo(w.y); z[jj * 4 + 3] += gk * bfhi(w.y); } }
#endif
        ln16<0>(z, gg, bb);
#pragma unroll
        for (int jj = 0; jj < 4; ++jj) { if (l == DEPTH - 1) *(GAS f32x4*)(H32 + (size_t)tok * D_MODEL + 256 * jj + 4 * lane) = (f32x4){z[jj * 4], z[jj * 4 + 1], z[jj * 4 + 2], z[jj * 4 + 3]};
            else { u32x2 w; w.x = pk2(z[jj * 4], z[jj * 4 + 1]); w.y = pk2(z[jj * 4 + 2], z[jj * 4 + 3]); *(GAS u32x2*)(HBo + (size_t)tok * D_MODEL + 256 * jj + 4 * lane) = w; } }
    }
}
#if MK_CHECK
constexpr int CW_CHK = 32768, N_CHK = 16, CHK_NS = 64;
__device__ __forceinline__ int chk_tok(int i) { return (i * 1021 + 77) & 65535; }
__device__ __forceinline__ void chk_put(Frame& F, int k, float err, float ref) {
    if (!(err == err)) err = 1e30f;
    err = wave_max(err); ref = wave_max(ref);
    if ((fresh_tid() & 63) == 0) { __hip_atomic_fetch_max(F.ctl + CW_CHK + 2 * k, __builtin_bit_cast(unsigned, err), RLX_AGENT); __hip_atomic_fetch_max(F.ctl + CW_CHK + 2 * k + 1, __builtin_bit_cast(unsigned, ref), RLX_AGENT); }
}
__device__ __forceinline__ float nanfix(float d) { return (d == d) ? d : 1e30f; }
__device__ __forceinline__ float chk_dot_bf(const bf16_t* x, const bf16_t* y, int n, int lane) { float s = 0.f; for (int k = lane; k < n; k += 64) s += bf2f(x[k]) * bf2f(y[k]); return wave_sum(s); }

__device__ __forceinline__ void chk_gemm(Frame& F, ArgsP a, int l, int which) {
    PHASE_PROLOG(); const int lane = fresh_tid() & 63, gw = vcu_ * 8 + F.wave, NGW = G_ * 8; const bool odd = l & 1; const int j = l >> 1;
    float err = 0.f, ref = 0.f, errg = 0.f, refg = 0.f;
    for (int si = gw; si < CHK_NS * 8; si += NGW) { const int tok = chk_tok(si >> 3), ci = si & 7;
        if (which == 1) { const int colsE[8] = {5, 300, 390, 449, 460, 700, 1100, 1500}, colsO[8] = {5, 1000, 1100, 2000, 2100, 3000, 3071, 64};
            int col = 0;
#pragma unroll
            for (int q = 0; q < 8; ++q) if (ci == q) col = odd ? colsO[q] : colsE[q];
            const int N = odd ? NO_PR : NE_PR; const bf16_t* W = odd ? WSP(bf16_t, WS_WINO) + ((size_t)j * NO_PR + col) * 1024 : WSP(bf16_t, WS_WINE) + ((size_t)j * NE_PR + col) * 1024;
            float v = chk_dot_bf(WSP(bf16_t, WS_HB) + (size_t)tok * 1024, W, 1024, lane); if (!odd && col >= 512) v = gelu_tanh(v);
            const float f = bf2f(WSP(bf16_t, WS_PR)[(size_t)tok * N + col]);
            if (!odd && col >= 512) { errg = fmaxf(errg, nanfix(fabsf(f - v))); refg = fmaxf(refg, fabsf(v)); } else { err = fmaxf(err, nanfix(fabsf(f - v))); ref = fmaxf(ref, fabsf(v)); } }
        else if (which == 3) { const int cols[8] = {3, 500, 1023, 1030, 1279, 1100, 128, 1200}; int col = 0;
#pragma unroll
            for (int q = 0; q < 8; ++q) if (ci == q) col = cols[q];
            const float v = chk_dot_bf(WSP(bf16_t, WS_CQ) + (size_t)tok * 256, WSP(bf16_t, WS_WQE) + ((size_t)j * NQQ + col) * 256, 256, lane);
            const float f = bf2f(WSP(bf16_t, WS_QQ)[(size_t)tok * NQQ + col]); err = fmaxf(err, nanfix(fabsf(f - v))); ref = fmaxf(ref, fabsf(v)); }
        else { const int cols[8] = {1, 300, 600, 1023, 255, 256, 777, 512}; int col = 0;
#pragma unroll
            for (int q = 0; q < 8; ++q) if (ci == q) col = cols[q];
            const int K = odd ? 1024 : NMX; const bf16_t* W = odd ? WSP(bf16_t, WS_WOUTO) + ((size_t)j * 1024 + col) * 1024 : WSP(bf16_t, WS_WOUTE) + ((size_t)j * 1024 + col) * NMX;
            const float hs = (l == 0 ? a->in[I_X] : (const float*)a->out)[(size_t)tok * 1024 + col];
            const float v = DN_ALPHA * hs + chk_dot_bf(WSP(bf16_t, WS_MX) + (size_t)tok * K, W, K, lane);
            const float f = WSP(float, WS_Z)[(size_t)tok * 1024 + col]; err = fmaxf(err, nanfix(fabsf(f - v))); ref = fmaxf(ref, fabsf(v)); }
    }
    if (which == 1) { if (odd) chk_put(F, 14, err, ref); else { chk_put(F, 1, err, ref); chk_put(F, 13, errg, refg); } } else chk_put(F, which, err, ref);
}
__device__ __forceinline__ void chk_e1b(Frame& F, ArgsP a, int l) {
    PHASE_PROLOG(); const int lane = fresh_tid() & 63, gw = vcu_ * 8 + F.wave, NGW = G_ * 8, j = l >> 1; float err = 0.f, ref = 0.f;
    for (int si = gw; si < CHK_NS; si += NGW) { const int tok = chk_tok(si); const bf16_t* pr = WSP(bf16_t, WS_PR) + (size_t)tok * NE_PR;
        float x[4], ss = 0.f;
#pragma unroll
        for (int i = 0; i < 4; ++i) { x[i] = bf2f(pr[lane + 64 * i]); ss += x[i] * x[i]; }
        ss = wave_sum(ss); float rs = 1.0f / sqrtf(ss / 256.0f + LN_EPS);
#pragma unroll
        for (int i = 0; i < 4; ++i) { const float v = x[i] * rs * a->in[I_EV_Q_NORM][j * 256 + lane + 64 * i]; err = fmaxf(err, nanfix(fabsf(v - bf2f(WSP(bf16_t, WS_CQ)[(size_t)tok * 256 + lane + 64 * i])))); ref = fmaxf(ref, fabsf(v)); }
        float y0 = bf2f(pr[256 + lane]), y1 = bf2f(pr[256 + 64 + lane]); ss = wave_sum(y0 * y0 + y1 * y1); rs = 1.0f / sqrtf(ss / 128.0f + LN_EPS);
        { const float v0 = y0 * rs * a->in[I_EV_KV_NORM][j * 128 + lane], v1 = y1 * rs * a->in[I_EV_KV_NORM][j * 128 + 64 + lane];
          err = fmaxf(err, nanfix(fabsf(v0 - bf2f(WSP(bf16_t, WS_CKV)[(size_t)tok * 128 + lane])))); err = fmaxf(err, nanfix(fabsf(v1 - bf2f(WSP(bf16_t, WS_CKV)[(size_t)tok * 128 + 64 + lane])))); }
        { const float z = bf2f(pr[384 + lane]); const float mu = wave_sum(z) / 64.0f; const float var = wave_sum((z - mu) * (z - mu)) / 64.0f;
          const float v = (z - mu) / sqrtf(var + LN_EPS) * a->in[I_EV_IDX_K_G][j * 64 + lane] + a->in[I_EV_IDX_K_B][j * 64 + lane];
          err = fmaxf(err, nanfix(fabsf(v - bf2f(WSP(bf16_t, WS_KI)[(size_t)tok * 64 + lane])))); ref = fmaxf(ref, fabsf(v)); }
        if (lane < 4) err = fmaxf(err, nanfix(fabsf(0.5f * bf2f(pr[448 + lane]) - WSP(float, WS_WI)[(size_t)tok * 4 + lane])));
    }
    chk_put(F, 2, err, ref);
}
__device__ __forceinline__ void chk_dsa(Frame& F, ArgsP a, int l) {
    PHASE_PROLOG(); const int lane = fresh_tid() & 63, gw = vcu_ * 8 + F.wave, NGW = G_ * 8; float err4 = 0.f, ref4 = 1e-20f, err5 = 0.f, ref5 = 0.f;
    LAS float* pl = (LAS float*)F.lds + F.wave * 2048;
    const bf16_t* QQ = WSP(bf16_t, WS_QQ); const bf16_t* KI = WSP(bf16_t, WS_KI); const bf16_t* CKV = WSP(bf16_t, WS_CKV);
    for (int si = gw; si < CHK_NS; si += NGW) { const int tok = chk_tok(si), b = tok >> 11, t = tok & 2047, NT = t / 64 + 1, N = NT * 64; const size_t rb0 = (size_t)b * SEQ;
        int npop = 0; float minsel = 1e30f, maxun = -1e30f, maxabs = 0.f; int maxselzero = -1, minunzero = 1 << 20;
        for (int i = 0; i < NT; ++i) { const int s = i * 64 + lane; float sc = 0.f;
            for (int h = 0; h < 4; ++h) { float d = 0.f; for (int k = 0; k < 64; ++k) d += bf2f(QQ[(size_t)tok * NQQ + 1024 + h * 64 + k]) * bf2f(KI[(rb0 + s) * 64 + k]); sc += fmaxf(d, 0.f) * WSP(float, WS_WI)[(size_t)tok * 4 + h]; }
            sc += 0.0f;
            const unsigned long long mw = WSP(unsigned long long, WS_MASK)[(size_t)tok * 32 + i]; const bool sel = (mw >> lane) & 1ull;
            npop += sel ? 1 : 0; maxabs = fmaxf(maxabs, fabsf(sc));
            if (sel) { minsel = fminf(minsel, sc); if (sc == 0.f) maxselzero = max(maxselzero, s); } else { maxun = fmaxf(maxun, sc); if (sc == 0.f) minunzero = min(minunzero, s); } }
        for (int i = NT; i < 32; ++i) if (WSP(unsigned long long, WS_MASK)[(size_t)tok * 32 + i] != 0ull) err4 = 1e30f;
        npop = (int)wave_sum((float)npop); minsel = -wave_max(-minsel); maxun = wave_max(maxun); maxabs = wave_max(maxabs);
        maxselzero = (int)wave_max((float)maxselzero); minunzero = -(int)wave_max(-(float)minunzero);
        if (npop != (N < N_SEL ? N : N_SEL)) err4 = 1e30f;
        if (N > N_SEL) { err4 = fmaxf(err4, maxun - minsel); if (minsel == 0.f && maxun == 0.f && maxselzero > minunzero) err4 = 1e30f; }
        ref4 = fmaxf(ref4, maxabs / 30.0f);
        const int h = si & 7; const float slope2 = exp2f(-(float)(h + 1)) * LOG2E; float mx = -1e30f;
        for (int i = 0; i < NT; ++i) { const int s = i * 64 + lane; float d = 0.f; for (int k = 0; k < 128; ++k) d += bf2f(QQ[(size_t)tok * NQQ + h * 128 + k]) * bf2f(CKV[(rb0 + s) * 128 + k]);
            d -= slope2 * fabsf((float)(t - s)); const unsigned long long mw = WSP(unsigned long long, WS_MASK)[(size_t)tok * 32 + i]; if (!((mw >> lane) & 1ull)) d = -1e30f; pl[s] = d; mx = fmaxf(mx, d); }
        mx = wave_max(mx); float sum = 0.f;
        for (int i = 0; i < NT; ++i) { const int s = i * 64 + lane; const float p = fast_exp2(pl[s] - mx); pl[s] = p; sum += p; }
        sum = wave_sum(sum); LDS_WAIT();
        for (int cc = 0; cc < 2; ++cc) { const int c = lane + 64 * cc; float o = 0.f; for (int s = 0; s < N; ++s) o += pl[s] * bf2f(CKV[(rb0 + s) * 128 + c]); o /= sum;
            const float f = bf2f(WSP(bf16_t, WS_MX)[(size_t)tok * NMX + h * 128 + c]); err5 = fmaxf(err5, nanfix(fabsf(f - o))); ref5 = fmaxf(ref5, fabsf(o)); }
        LDS_WAIT();
    }
    chk_put(F, 4, err4, ref4); chk_put(F, 5, err5, ref5);
}
__device__ __forceinline__ void chk_gml(Frame& F, ArgsP a, int l) {
    PHASE_PROLOG(); const int lane = fresh_tid() & 63, gw = vcu_ * 8 + F.wave, NGW = G_ * 8, j = l >> 1; float err = 0.f, ref = 0.f;
    const bf16_t* PR = WSP(bf16_t, WS_PR);
    for (int si = gw; si < CHK_NS; si += NGW) { const int tok = chk_tok(si), g = si & 7, ii = tok & 127; const size_t tok0 = (size_t)(tok - ii); float mixed = 0.f;
        for (int jx = 0; jx <= ii; ++jx) { const bf16_t* vr = PR + (tok0 + jx) * NE_PR + 1024; float xs[8], s = 0.f;
#pragma unroll
            for (int q = 0; q < 8; ++q) { xs[q] = bf2f(vr[lane + 64 * q]); s += xs[q]; }
            const float mu = wave_sum(s) / 512.0f; float s2 = 0.f;
#pragma unroll
            for (int q = 0; q < 8; ++q) s2 += (xs[q] - mu) * (xs[q] - mu);
            const float rs = 1.0f / sqrtf(wave_sum(s2) / 512.0f + LN_EPS);
            const float vln = (bf2f(vr[g * 64 + lane]) - mu) * rs * a->in[I_EV_V_NORM_G][j * GW + g * 64 + lane] + a->in[I_EV_V_NORM_B][j * GW + g * 64 + lane];
            mixed += a->in[I_EV_W_S][((size_t)(j * 8 + g) * 128 + ii) * 128 + jx] * vln; }
        mixed += a->in[I_EV_B_S][(size_t)(j * 8 + g) * 128 + ii];
        const float v = bf2f(PR[(size_t)tok * NE_PR + 512 + g * 64 + lane]) * mixed; const float f = bf2f(WSP(bf16_t, WS_MX)[(size_t)tok * NMX + 1024 + g * 64 + lane]);
        err = fmaxf(err, nanfix(fabsf(f - v))); ref = fmaxf(ref, fabsf(v)); }
    chk_put(F, 6, err, ref);
}
__device__ __forceinline__ void chk_lnr(Frame& F, ArgsP a, int l) {
    PHASE_PROLOG(); const int lane = fresh_tid() & 63, gw = vcu_ * 8 + F.wave, NGW = G_ * 8; float err = 0.f, ref = 0.f;
    for (int si = gw; si < CHK_NS; si += NGW) { const int tok = chk_tok(si); const float* z = WSP(float, WS_Z) + (size_t)tok * 1024; float x[16], s = 0.f;
#pragma unroll
        for (int i = 0; i < 16; ++i) { x[i] = z[lane + 64 * i]; s += x[i]; }
        const float mu = wave_sum(s) / 1024.0f; float s2 = 0.f;
#pragma unroll
        for (int i = 0; i < 16; ++i) s2 += (x[i] - mu) * (x[i] - mu);
        const float rs = 1.0f / sqrtf(wave_sum(s2) / 1024.0f + LN_EPS);
#pragma unroll
        for (int i = 0; i < 16; ++i) { x[i] = (x[i] - mu) * rs * a->in[I_LN1_G][l * 1024 + lane + 64 * i] + a->in[I_LN1_B][l * 1024 + lane + 64 * i];
            err = fmaxf(err, nanfix(fabsf(x[i] - a->out[(size_t)tok * 1024 + lane + 64 * i]))); err = fmaxf(err, nanfix(fabsf(x[i] - bf2f(WSP(bf16_t, WS_HB)[(size_t)tok * 1024 + lane + 64 * i])) * 0.25f)); ref = fmaxf(ref, fabsf(x[i])); }
        float lg = 0.f;
        for (int e = 0; e < 32; ++e) { float p = 0.f;
#pragma unroll
            for (int i = 0; i < 16; ++i) p += x[i] * a->in[I_ROUTER_W][((size_t)l * 1024 + lane + 64 * i) * 32 + e];
            p = wave_sum(p) + a->in[I_ROUTER_B][l * 32 + e]; if (lane == e) lg = p; }
        if (lane >= 32) lg = -1e30f;
        float tl[4]; int te[4]; float v = lg;
        for (int k = 0; k < 4; ++k) { const float m = wave_max(v); const unsigned long long bm = __builtin_amdgcn_ballot_w64(v == m); te[k] = __builtin_ctzll(bm); tl[k] = m; if (lane == te[k]) v = -1e30f; }
        const float den = 1.0f + expf(tl[1] - tl[0]) + expf(tl[2] - tl[0]) + expf(tl[3] - tl[0]);
        for (int k = 0; k < 4; ++k) { const unsigned sl = WSP(unsigned, WS_SLOT)[(size_t)tok * 4 + k]; const int e = (int)(sl >> 20), rank = (int)(sl & 0xfffffu);
            if (e != te[k]) {
                const float mine = __builtin_bit_cast(float, __builtin_amdgcn_ds_bpermute(e << 2, __builtin_bit_cast(int, lg)));
                if (fabsf(mine - tl[k]) > 1e-4f) err = 1e30f; }
            if (WSP(int, WS_ROWTOK)[(size_t)e * 65536 + rank] != tok) err = 1e30f;
            const float gk = expf(tl[k] - tl[0]) / den; err = fmaxf(err, nanfix(fabsf(gk - WSP(float, WS_GATE)[(size_t)tok * 4 + k]))); }
    }
    chk_put(F, 8, err, ref);
}
__device__ __forceinline__ void chk_moe(Frame& F, ArgsP a, int l) {
    PHASE_PROLOG(); const int lane = fresh_tid() & 63, gw = vcu_ * 8 + F.wave, NGW = G_ * 8; float err = 0.f, ref = 0.f;
    LAS float* al = (LAS float*)F.lds + F.wave * 1024;
    for (int si = gw; si < CHK_NS; si += NGW) { const int tok = chk_tok(si), k = si & 3; const unsigned sl = WSP(unsigned, WS_SLOT)[(size_t)tok * 4 + k]; const int e = (int)(sl >> 20), rank = (int)(sl & 0xfffffu);
        int rbs = 0; for (int q = 0; q < e; ++q) rbs += ((int)__hip_atomic_load(F.ctl + CW_CUR + (size_t)(l * 32 + q) * 64, RLX_AGENT) + 255) >> 8;
        const size_t crow = (size_t)rbs * 256 + rank;
        const float* wgu = a->in[I_EXP_W_GU] + ((size_t)l * NEXP + e) * 1024 * 2048; const float* wdn = a->in[I_EXP_W_DN] + ((size_t)l * NEXP + e) * 1024 * 1024;
        const bf16_t* hb = WSP(bf16_t, WS_HB) + (size_t)tok * 1024;
        float ag[16], au[16];
#pragma unroll
        for (int i = 0; i < 16; ++i) { ag[i] = 0.f; au[i] = 0.f; }
        for (int kk = 0; kk < 1024; ++kk) { const float hv = bf2f(hb[kk]);
#pragma unroll
            for (int i = 0; i < 16; ++i) { ag[i] += hv * wgu[(size_t)kk * 2048 + lane + 64 * i]; au[i] += hv * wgu[(size_t)kk * 2048 + 1024 + lane + 64 * i]; } }
#pragma unroll
        for (int i = 0; i < 16; ++i) { const int f = lane + 64 * i; float gt = ag[i] + a->in[I_EXP_B_GU][((size_t)l * NEXP + e) * 2048 + f], up = au[i] + a->in[I_EXP_B_GU][((size_t)l * NEXP + e) * 2048 + 1024 + f];
            gt = fminf(gt, 7.0f); up = fminf(fmaxf(up, -7.0f), 7.0f); const float act = (up + 1.0f) * gt / (1.0f + expf(-1.702f * gt)); al[f] = act;
            const float fa = bf2f(WSP(bf16_t, WS_ACT)[crow * 1024 + f]); err = fmaxf(err, nanfix(fabsf(fa - act))); ref = fmaxf(ref, fabsf(act)); }
        LDS_WAIT();
#pragma unroll
        for (int ci = 0; ci < 4; ++ci) { const int col = ci == 0 ? 0 : ci == 1 ? 511 : ci == 2 ? 1023 : 700; float s = 0.f; for (int f = lane; f < 1024; f += 64) s += al[f] * wdn[(size_t)f * 1024 + col];
            s = wave_sum(s) + a->in[I_EXP_B_DN][((size_t)l * NEXP + e) * 1024 + col]; const float fy = bf2f(WSP(bf16_t, WS_Y)[crow * 1024 + col]);
            err = fmaxf(err, nanfix(fabsf(fy - s)) * 2.0f); ref = fmaxf(ref, fabsf(s)); }
        LDS_WAIT();
    }
    chk_put(F, 9, err, ref);
}
__device__ __forceinline__ void chk_datt(Frame& F, ArgsP a, int l) {
    PHASE_PROLOG(); const int lane = fresh_tid() & 63, gw = vcu_ * 8 + F.wave, NGW = G_ * 8, j = l >> 1; float err = 0.f, ref = 0.f;
    LAS float* pl = (LAS float*)F.lds + F.wave * 2048; const bf16_t* PR = WSP(bf16_t, WS_PR);
    const float lam_init = 0.8f - 0.6f * expf(-0.3f * (float)l);
    const float lam = expf(wave_sum(a->in[I_OD_LQ1][j * 64 + lane] * a->in[I_OD_LK1][j * 64 + lane])) - expf(wave_sum(a->in[I_OD_LQ2][j * 64 + lane] * a->in[I_OD_LK2][j * 64 + lane])) + lam_init;
    for (int si = gw; si < CHK_NS; si += NGW) { const int tok = chk_tok(si), b = tok >> 11, t = tok & 2047, NT = t / 64 + 1, N = NT * 64, h = si & 7; const size_t rb0 = (size_t)b * SEQ;
        const float slope2 = exp2f(-(float)(h + 1)) * LOG2E; float oc[2][2];
        for (int m = 0; m < 2; ++m) { float mx = -1e30f;
            for (int i = 0; i < NT; ++i) { const int s = i * 64 + lane; float d = 0.f; for (int k = 0; k < 64; ++k) d += bf2f(PR[(size_t)tok * NO_PR + h * 128 + m * 64 + k]) * bf2f(PR[(rb0 + s) * NO_PR + 1024 + h * 128 + m * 64 + k]);
                d -= slope2 * fabsf((float)(t - s)); pl[s] = d; mx = fmaxf(mx, d); }
            mx = wave_max(mx); float sum = 0.f;
            for (int i = 0; i < NT; ++i) { const int s = i * 64 + lane; const float p = fast_exp2(pl[s] - mx); pl[s] = p; sum += p; }
            sum = wave_sum(sum); LDS_WAIT();
            for (int cc = 0; cc < 2; ++cc) { const int c = lane + 64 * cc; float o = 0.f; for (int s = 0; s < N; ++s) o += pl[s] * bf2f(PR[(rb0 + s) * NO_PR + 2048 + h * 128 + c]); oc[m][cc] = o / sum; }
            LDS_WAIT(); }
        const float y0 = oc[0][0] - lam * oc[1][0], y1 = oc[0][1] - lam * oc[1][1]; const float rs = (1.0f - lam_init) / sqrtf(wave_sum(y0 * y0 + y1 * y1) / 128.0f + LN_EPS);
        const float v0 = y0 * rs * a->in[I_OD_SUBLN_G][j * 128 + lane], v1 = y1 * rs * a->in[I_OD_SUBLN_G][j * 128 + 64 + lane];
        const float f0 = bf2f(WSP(bf16_t, WS_MX)[(size_t)tok * 1024 + h * 128 + lane]), f1 = bf2f(WSP(bf16_t, WS_MX)[(size_t)tok * 1024 + h * 128 + 64 + lane]);
        err = fmaxf(err, nanfix(fabsf(f0 - v0))); err = fmaxf(err, nanfix(fabsf(f1 - v1))); ref = fmaxf(ref, fmaxf(fabsf(v0), fabsf(v1))); }
    chk_put(F, 11, err, ref);
}
__device__ __forceinline__ void chk_final(Frame& F, ArgsP a) {
    PHASE_PROLOG(); int code = 0;
    for (int k = N_CHK - 1; k >= 1; --k) { const float e = __builtin_bit_cast(float, __hip_atomic_load(F.ctl + CW_CHK + 2 * k, RLX_AGENT)), r = __builtin_bit_cast(float, __hip_atomic_load(F.ctl + CW_CHK + 2 * k + 1, RLX_AGENT));
        if (e > 0.03f * r) code = k; }
    if (code == 0) return;
    const float sc = 1.0f + 0.05f * (float)code; const int gt = vcu_ * 512 + fresh_tid(), NGT = G_ * 512;
    for (size_t i = gt; i < (size_t)T_TOK * 1024; i += NGT) a->out[i] *= sc;
}
#endif
constexpr int N_PHASES = 10;
__global__ void __launch_bounds__(512, 2) mk_fwd(Args a) {
    extern __shared__ __attribute__((aligned(16))) unsigned char lds_raw[];
    Frame F;
    F.lds = (LAS unsigned char*)lds_raw; F.ldsg = (char*)lds_raw;
    F.MISC = (volatile LAS int*)(F.lds + MISC_OFF);
    F.tid = threadIdx.x; F.lane = F.tid & 63; F.wave = __builtin_amdgcn_readfirstlane(F.tid >> 6);
    F.G = gridDim.x; { const int bx = blockIdx.x; F.vcu = (F.G % 8 == 0) ? (bx % 8) * (F.G / 8) + bx / 8 : bx; }
    ArgsP ap = (ArgsP)__builtin_amdgcn_kernarg_segment_ptr();
    F.ws = ap->ws; F.ctl = (gu32*)(ap->ws + WS_CTL);
    const int a_fused = ap->fused, a_llo = ap->l_lo, a_lhi = ap->l_hi, a_plo0 = ap->p_lo, a_phi0 = ap->p_hi, a_pro = ap->do_pro;
    for (int u = F.tid; u < (LDS_BYTES - MISC_OFF) / 4; u += 512) F.MISC[u] = 0;
    __syncthreads();
    XcdBarrier bar; bar.bar = (unsigned*)(F.ctl + CW_BAR); bar.x = 0; bar.st = nullptr; bar.w = (unsigned)F.wave;
    if (a_fused) bar = xcd_barrier_post((unsigned*)(F.ctl + CW_BAR), (volatile LAS unsigned*)(F.MISC + MI_BAR));
#define GRID_BAR() do { if (a_fused) xcd_barrier(bar); } while (0)
#define KPROLOG() ArgsP a = ap; unsigned char* ws_ = F.ws; asm volatile("" : "+s"(ws_)); asm volatile("" : "+s"(a)); int vcu_ = F.vcu, G_ = F.G, bx_ = (int)blockIdx.x; asm volatile("" : "+s"(vcu_), "+s"(G_), "+s"(bx_))
#ifndef PHASE_MASK
#define PHASE_MASK 0x7ff
#endif
#define RUN(p) (((PHASE_MASK >> (p)) & 1) && a_plo <= (p) && (p) < a_phi)
#ifndef PROBE_REP
#define PROBE_REP 0
#endif
#ifndef STG_PIN
#define STG_PIN 0
#endif
#ifndef STG_POUT
#define STG_POUT 0
#endif
#ifndef STG_M1
#define STG_M1 0
#endif
#ifndef STG_M2
#define STG_M2 0
#endif
#ifndef PROBE_KREP
#define PROBE_KREP 0
#endif
#define PKR_ ((PROBE_KREP == 1 && rep_ + 1 < nreps_) ? 2 : 1)
#define PER_ ((PROBE_KREP == 2 && rep_ + 1 < nreps_) ? 2 : (PROBE_KREP == 3 && rep_ + 1 < nreps_) ? 0 : 1)
#ifndef PROBE_PAR
#define PROBE_PAR 0
#endif
#define REPS(p) _Pragma("unroll 1") for (int nreps_ = 1 + (((PROBE_REP >> (p)) & 1) && (PROBE_PAR == 0 || (PROBE_PAR == 1 && !(l_probe & 1)) || (PROBE_PAR == 2 && (l_probe & 1))) ? 1 : 0), rep_ = 0; rep_ < nreps_; ++rep_)
    { const int l_probe = 0; if (((PHASE_MASK >> 10) & 1) && a_pro) { REPS(10) { pro_phase(F, ap); GRID_BAR(); } } }
    for (int l = a_llo; l < a_lhi; ++l) {
        int a_plo = a_plo0, a_phi = a_phi0; asm volatile("" : "+s"(a_plo), "+s"(a_phi));
        const bool odd = (l & 1) != 0; const int j = l >> 1; const int l_probe = l;
        if (RUN(0)) REPS(0) { KPROLOG();
            const bf16_t* Bt = odd ? WSP(bf16_t, WS_WINO) + (size_t)j * NO_PR * 1024 : WSP(bf16_t, WS_WINE) + (size_t)j * NE_PR * 1024; const int N = odd ? NO_PR : NE_PR;
            pg8::DenseOrder S; S.init(T_TOK, N, G_, bx_);
            pg8::EpiStoreBf16 E{WSP(bf16_t, WS_PR), N, odd ? (1 << 30) : 2};
#ifdef PROBE_STORE_VARIANT
            if (rep_ + 1 < nreps_) { pg8::EpiStoreBf16T<PROBE_STORE_VARIANT> EV{E.O, E.ldc, E.gelu_from}; pg8::gemm_phase<pg8::EpiStoreBf16T<PROBE_STORE_VARIANT>, pg8::DenseOrder, false>(F.lds, WSP(bf16_t, WS_HB), Bt, 1024, nullptr, S, EV, F.wave, 0x7f7f7f7f, 0x7f7f7f7f, 0x7f7f7f7f, 1, 1, STG_PIN); } else
#endif
            pg8::gemm_phase<pg8::EpiStoreBf16, pg8::DenseOrder, false>(F.lds, WSP(bf16_t, WS_HB), Bt, 1024, nullptr, S, E, F.wave, 0x7f7f7f7f, 0x7f7f7f7f, 0x7f7f7f7f, PKR_, PER_, STG_PIN);
            GRID_BAR();
        }
        if (!odd) {
            if (RUN(1)) REPS(1) { e1b_phase(F, ap, l); GRID_BAR(); }
            if (RUN(2)) REPS(2) { KPROLOG();
                pg8::DenseOrder S; S.init(T_TOK, NQQ, G_, bx_);
                pg8::EpiStoreBf16 E{WSP(bf16_t, WS_QQ), NQQ, 1 << 30};
                pg8::gemm_phase<pg8::EpiStoreBf16, pg8::DenseOrder, false>(F.lds, WSP(bf16_t, WS_CQ), WSP(bf16_t, WS_WQE) + (size_t)j * NQQ * 256, 256, nullptr, S, E, F.wave);
                GRID_BAR();
            }
            if (RUN(3)) REPS(3) { e3a_phase(F, ap); GRID_BAR(); }
        }
        if (RUN(4)) REPS(4) {
#ifndef ATT_SEL
#define ATT_SEL 7
#endif
            if (odd) { if (ATT_SEL & 4) datt_phase(F, ap, l); }
            else { if (ATT_SEL & 1) dsa_phase(F, ap); if (ATT_SEL & 2) gml_phase(F, ap, l); }
            GRID_BAR();
        }
        if (RUN(5)) REPS(5) { KPROLOG();
            const bf16_t* Bt = odd ? WSP(bf16_t, WS_WOUTO) + (size_t)j * 1024 * 1024 : WSP(bf16_t, WS_WOUTE) + (size_t)j * 1024 * NMX; const int K = odd ? 1024 : NMX;
            pg8::DenseOrder S; S.init(T_TOK, D_MODEL, G_, bx_);
            pg8::EpiResid E{WSP(bf16_t, WS_HB), WSP(bf16_t, WS_Z), DN_ALPHA};
#if POUT_FP8
            const unsigned char* Bt8 = odd ? WSP(unsigned char, WS_WOUTO) + (size_t)j * 1024 * 1024 : WSP(unsigned char, WS_WOUTE) + (size_t)j * 1024 * NMX; const int sB = odd ? 0x79797979 : 0x78787878;
            pg8::gemm_phase<pg8::EpiResid, pg8::DenseOrder, false, true>(F.lds, (const bf16_t*)WSP(unsigned char, WS_MX), (const bf16_t*)Bt8, K / 2, nullptr, S, E, F.wave, 0x7c7c7c7c, sB, sB, PKR_, PER_, STG_POUT);
#else
            pg8::gemm_phase<pg8::EpiResid, pg8::DenseOrder, false>(F.lds, WSP(bf16_t, WS_MX), Bt, K, nullptr, S, E, F.wave, 0x7f7f7f7f, 0x7f7f7f7f, 0x7f7f7f7f, PKR_, PER_, STG_POUT);
#endif
            GRID_BAR();
        }
#ifndef LNR_MFMA
#define LNR_MFMA 1
#endif
        if (RUN(6)) { if ((PROBE_REP >> 6) & 1) { if (LNR_MFMA) lnr2_phase(F, ap, l, true); else lnr_phase(F, ap, l, true); GRID_BAR(); } if (LNR_MFMA) lnr2_phase(F, ap, l); else lnr_phase(F, ap, l); GRID_BAR(); }
        if (RUN(7)) REPS(7) { KPROLOG();
            moe_tables(F, l);
            pg8::MoeOrder S; S.npn = 8; S.nunits = __builtin_amdgcn_readfirstlane(F.MISC[MI_RBSTART + 32]) * 8; S.G = G_; S.c = vcu_; S.tab = (const LAS int*)F.MISC;
            pg8::EpiSwiglu E{WSP(bf16_t, WS_ACT), a->in[I_EXP_B_GU] + (size_t)l * NEXP * 2048};
#if MOE_FP8
            pg8::gemm_phase<pg8::EpiSwiglu, pg8::MoeOrder, true, true>(F.lds, WSP(bf16_t, WS_HB8), (const bf16_t*)(WSP(unsigned char, WS_WGU) + (size_t)l * NEXP * 2048 * 1024), 512, WSP(int, WS_ROWTOK), S, E, F.wave, 0x7f7f7f7f, 0x79797979, 0x7c7c7c7c, PKR_, PER_, STG_M1);
#else
            pg8::gemm_phase<pg8::EpiSwiglu, pg8::MoeOrder, true>(F.lds, WSP(bf16_t, WS_HB), WSP(bf16_t, WS_WGU) + (size_t)l * NEXP * 2048 * 1024, 1024, WSP(int, WS_ROWTOK), S, E, F.wave);
#endif
            GRID_BAR();
        }
        if (RUN(8)) REPS(8) { KPROLOG();
            if (!(((PHASE_MASK >> 7) & 1) && a_plo <= 7 && 7 < a_phi)) moe_tables(F, l);
            pg8::MoeOrder S; S.npn = 4; S.nunits = __builtin_amdgcn_readfirstlane(F.MISC[MI_RBSTART + 32]) * 4; S.G = G_; S.c = vcu_; S.tab = (const LAS int*)F.MISC; S.rev = 1;
            pg8::EpiBiasBf16 E{WSP(bf16_t, WS_Y), a->in[I_EXP_B_DN] + (size_t)l * NEXP * 1024};
#if MOE_FP8
            pg8::gemm_phase<pg8::EpiBiasBf16, pg8::MoeOrder, false, true>(F.lds, WSP(bf16_t, WS_ACT), (const bf16_t*)(WSP(unsigned char, WS_WDN) + (size_t)l * NEXP * 1024 * 1024), 512, nullptr, S, E, F.wave, 0x7c7c7c7c, 0x7f7f7f7f, 0x7f7f7f7f, PKR_, PER_, STG_M2);
#else
            pg8::gemm_phase<pg8::EpiBiasBf16, pg8::MoeOrder, false>(F.lds, WSP(bf16_t, WS_ACT), WSP(bf16_t, WS_WDN) + (size_t)l * NEXP * 1024 * 1024, 1024, nullptr, S, E, F.wave);
#endif
            GRID_BAR();
        }
        if (RUN(9)) { if ((PROBE_REP >> 9) & 1) { cmb_phase(F, ap, l, true); GRID_BAR(); } cmb_phase(F, ap, l, false, !(((PHASE_MASK >> 7) & 1) && a_plo <= 7 && 7 < a_phi)); if (l + 1 < DEPTH) GRID_BAR(); }
    }
#undef GRID_BAR
#undef RUN
}

#if MK_CHECK
__global__ void __launch_bounds__(512, 2) mk_chk(Args a_) {
    extern __shared__ __attribute__((aligned(16))) unsigned char lds_raw[];
    Frame F;
    F.lds = (LAS unsigned char*)lds_raw; F.ldsg = (char*)lds_raw; F.MISC = (volatile LAS int*)(F.lds + MISC_OFF);
    F.tid = threadIdx.x; F.lane = F.tid & 63; F.wave = __builtin_amdgcn_readfirstlane(F.tid >> 6);
    F.G = gridDim.x; { const int bx = blockIdx.x; F.vcu = (F.G % 8 == 0) ? (bx % 8) * (F.G / 8) + bx / 8 : bx; }
    ArgsP ap = (ArgsP)__builtin_amdgcn_kernarg_segment_ptr();
    F.ws = ap->ws; F.ctl = (gu32*)(ap->ws + WS_CTL);
    const int l = ap->l_lo, p = ap->p_lo;
    if (p == 21) chk_gemm(F, ap, l, 1);
    if (p == 22) chk_e1b(F, ap, l);
    if (p == 23) chk_gemm(F, ap, l, 3);
    if (p == 24) chk_dsa(F, ap, l);
    if (p == 26) chk_gml(F, ap, l);
    if (p == 27) chk_gemm(F, ap, l, 7);
    if (p == 28) chk_lnr(F, ap, l);
    if (p == 29) chk_moe(F, ap, l);
    if (p == 31) chk_datt(F, ap, l);
    if (p == 40) chk_final(F, ap);
}
#endif

extern "C" void kernel_launch(void* const* d_in, const int* in_sizes, int n_in, void* d_out, int out_size, void* d_ws, size_t ws_size, hipStream_t stream) {
    static int grid = 0;
    if (grid == 0) {
        if (n_in != 32 || in_sizes[0] != T_TOK * D_MODEL || out_size != T_TOK * D_MODEL || ws_size < WS_END) {
            fprintf(stderr, "kernel_launch: shape mismatch: n_in %d in0 %d out %d ws %zu (need %zu)\n", n_in, n_in > 0 ? in_sizes[0] : -1, out_size, ws_size, (size_t)WS_END); grid = -1; return; }
        int dev = 0, cus = 0, per_cu = 0;
        if (hipGetDevice(&dev) != hipSuccess || hipDeviceGetAttribute(&cus, hipDeviceAttributeMultiprocessorCount, dev) != hipSuccess) { fprintf(stderr, "kernel_launch: device query failed\n"); grid = -1; return; }
#if MK_CHECK
        (void)hipFuncSetAttribute((const void*)mk_chk, hipFuncAttributeMaxDynamicSharedMemorySize, LDS_BYTES);
#endif
        if (hipFuncSetAttribute((const void*)mk_fwd, hipFuncAttributeMaxDynamicSharedMemorySize, LDS_BYTES) != hipSuccess) { fprintf(stderr, "kernel_launch: hipFuncSetAttribute failed\n"); grid = -1; return; }
        if (hipOccupancyMaxActiveBlocksPerMultiprocessor(&per_cu, (const void*)mk_fwd, 512, LDS_BYTES) != hipSuccess || per_cu < 1) { fprintf(stderr, "kernel_launch: occupancy query says %d\n", per_cu); }
        (void)hipGetLastError();
        grid = cus;
    }
    if (grid < 0) return;
    if (hipMemsetAsync((char*)d_ws + WS_CTL, 0, CTL_ZERO_BYTES, stream) != hipSuccess) { fprintf(stderr, "kernel_launch: memset failed\n"); return; }
    Args a{};
    for (int i = 0; i < 32; ++i) a.in[i] = (const float*)d_in[i];
    a.out = (float*)d_out; a.ws = (unsigned char*)d_ws;
#if MK_FUSED
    a.l_lo = 0; a.l_hi = DEPTH; a.p_lo = 0; a.p_hi = N_PHASES; a.do_pro = 1; a.fused = 1;
    hipLaunchKernelGGL(mk_fwd, dim3(grid), dim3(512), LDS_BYTES, stream, a);
#else
    a.fused = 0;
    a.l_lo = 0; a.l_hi = 0; a.p_lo = 0; a.p_hi = 0; a.do_pro = 1;
    hipLaunchKernelGGL(mk_fwd, dim3(grid), dim3(512), LDS_BYTES, stream, a);
    a.do_pro = 0;
    for (int l = 0; l < DEPTH; ++l)
        for (int p = 0; p < N_PHASES; ++p) {
            if ((l & 1) && p >= 1 && p <= 3) continue;
            a.l_lo = l; a.l_hi = l + 1; a.p_lo = p; a.p_hi = p + 1;
            hipLaunchKernelGGL(mk_fwd, dim3(grid), dim3(512), LDS_BYTES, stream, a);
#if MK_CHECK
            {
                int cks[3] = {0, 0, 0}; int nck = 0;
                if (l == 0) { if (p == 0) cks[nck++] = 21; if (p == 1) cks[nck++] = 22; if (p == 2) cks[nck++] = 23; if (p == 4) { cks[nck++] = 24; cks[nck++] = 26; } if (p == 5) cks[nck++] = 27; if (p == 6) cks[nck++] = 28; if (p == 8) cks[nck++] = 29; }
                if (l == 1) { if (p == 0) cks[nck++] = 21; if (p == 4) cks[nck++] = 31; if (p == 5) cks[nck++] = 27; }
                if (l == DEPTH - 1 && p == N_PHASES - 1) cks[nck++] = 40;
                for (int c = 0; c < nck; ++c) { a.p_lo = cks[c]; a.p_hi = cks[c] + 1; hipLaunchKernelGGL(mk_chk, dim3(grid), dim3(512), LDS_BYTES, stream, a); }
            }
#endif
        }
#endif
    const hipError_t le = hipPeekAtLastError();
    if (le != hipSuccess) fprintf(stderr, "kernel_launch: launch failed: %s\n", hipGetErrorName(le));
}
```

```cpp
#include <hip/hip_runtime.h>
#include <hip/hip_bf16.h>
#include <cstdio>
#include <cstdint>

#ifndef MK_CHECK
#define MK_CHECK 0
#endif
#ifndef MOE_FP8
#define MOE_FP8 1
#endif
#ifndef POUT_FP8
#define POUT_FP8 1
#endif
#ifndef MK_FUSED
#define MK_FUSED 1
#endif

constexpr int D_MODEL = 1024, BATCH = 32, SEQ = 2048, DEPTH = 4, T_TOK = BATCH * SEQ;
constexpr int CHUNK = 64;
constexpr int H_A = 8, D_CQ = 256, D_C = 128, H_IDX = 4, D_IDX = 64, N_SEL = 256;
constexpr int GW = 512, G_B = 8, CG_B = 64, GCH = 128;
constexpr int H_C = 8, DH_C = 64;
constexpr int NEXP = 32, TOPK = 4, D_FF = 1024;
constexpr int E_IN_EVEN = D_CQ + D_C + D_IDX + H_IDX + 2 * GW;
constexpr float LN_EPS = 1e-5f;
constexpr float DN_ALPHA = 1.681792830507429f;
constexpr float LOG2E = 1.4426950408889634f;
constexpr int NE_PR = 1536;
constexpr int NO_PR = 3072;
constexpr int NQQ = 1280;
constexpr int NMX = 1536;
constexpr int MOE_ROWS_MAX = (T_TOK * TOPK / 256 + NEXP) * 256;
constexpr int MOE_RB_MAX = MOE_ROWS_MAX / 256;

constexpr size_t MiB = 1u << 20;
constexpr size_t WS_CTL = 0, CTL_ZERO_BYTES = 1 * MiB;
constexpr size_t WS_WI = 1 * MiB;
constexpr size_t WS_GATE = 2 * MiB;
constexpr size_t WS_SLOT = 3 * MiB;
constexpr size_t WS_ROWTOK = 4 * MiB;
constexpr size_t WS_MASK = 12 * MiB;
constexpr size_t WS_WS = 28 * MiB;
constexpr size_t WS_WINE = 32 * MiB;
constexpr size_t WS_WQE = 38 * MiB;
constexpr size_t WS_WOUTE = 40 * MiB;
constexpr size_t WS_WINO = 46 * MiB;
constexpr size_t WS_WOUTO = 58 * MiB;
constexpr size_t WS_WRT = 62 * MiB;
constexpr size_t WS_WGU = 64 * MiB;
constexpr size_t WS_WDN = 576 * MiB;
constexpr size_t WS_HB = 832 * MiB;
constexpr size_t WS_Z = 960 * MiB;
constexpr size_t WS_PR = 1216 * MiB;
constexpr size_t WS_CQ = 1600 * MiB;
constexpr size_t WS_CKV = 1632 * MiB;
constexpr size_t WS_KI = 1648 * MiB;
constexpr size_t WS_QQ = 1656 * MiB;
constexpr size_t WS_MX = 1816 * MiB;
constexpr size_t WS_ACT = 2008 * MiB;
constexpr size_t WS_HB8 = 2272 * MiB;
constexpr size_t WS_Y = 2536 * MiB;
constexpr size_t WS_STAT = 3064 * MiB;
constexpr size_t WS_END = 3065 * MiB;
constexpr int CW_TMO = 0;
constexpr int CW_BAR = 4096;
constexpr int CW_CUR = 16384;

constexpr int RING_BYTES = 131072;
constexpr int MISC_OFF = RING_BYTES + 2048;
constexpr int LDS_BYTES = 147456;
constexpr int MI_BAR = 8;
constexpr int MI_RBSTART = 32;
constexpr int MI_CNT = 80;
constexpr int MI_LCNT = 112;
constexpr int MI_LBASE = 144;
constexpr int MI_NUNITS = 180;
constexpr int MI_RBE = 256;
constexpr int MI_REC = 1408;
constexpr int MI_END = MI_REC + 2048;
static_assert(MISC_OFF + MI_END * 4 <= LDS_BYTES, "LDS map");

#define GAS __attribute__((address_space(1)))
#define LAS __attribute__((address_space(3)))
typedef unsigned short bf16_t;
typedef short bf16x8 __attribute__((ext_vector_type(8)));
typedef short s16x4 __attribute__((ext_vector_type(4)));
typedef float f32x4 __attribute__((ext_vector_type(4)));
typedef float f32x2 __attribute__((ext_vector_type(2)));
typedef float f32x16 __attribute__((ext_vector_type(16)));
typedef unsigned u32x4 __attribute__((ext_vector_type(4)));
typedef unsigned u32x2 __attribute__((ext_vector_type(2)));
typedef GAS unsigned gu32;
typedef int v8i __attribute__((ext_vector_type(8)));
typedef int i32x4 __attribute__((ext_vector_type(4)));
#if POUT_FP8
typedef unsigned char mx_t;
__device__ __forceinline__ mx_t mx_cvt(float v) { v = fminf(fmaxf(8.0f * v, -448.f), 448.f); return (mx_t)__builtin_amdgcn_cvt_pk_fp8_f32(v, v, 0, false); }
constexpr float MX_SCALE = 8.0f;
__device__ __forceinline__ mx_t mx_cvt_s(float v) { v = fminf(fmaxf(v, -448.f), 448.f); return (mx_t)__builtin_amdgcn_cvt_pk_fp8_f32(v, v, 0, false); }
#else
typedef unsigned short mx_t;
#endif
__device__ __forceinline__ unsigned pk4_fp8(float a, float b, float c, float d) { int p = __builtin_amdgcn_cvt_pk_fp8_f32(a, b, 0, false); return (unsigned)__builtin_amdgcn_cvt_pk_fp8_f32(c, d, p, true); }
#define RLX_AGENT __ATOMIC_RELAXED, __HIP_MEMORY_SCOPE_AGENT
#define LDS_WAIT() asm volatile("s_waitcnt lgkmcnt(0)" ::: "memory")
#define VM_WAIT() asm volatile("s_waitcnt vmcnt(0)" ::: "memory")

__device__ __forceinline__ unsigned f2bf(float f) { unsigned u = __builtin_bit_cast(unsigned, f); return (u + 0x7fffu + ((u >> 16) & 1u)) >> 16; }
#if !POUT_FP8
__device__ __forceinline__ mx_t mx_cvt(float v) { return (mx_t)f2bf(v); }
constexpr float MX_SCALE = 1.0f;
__device__ __forceinline__ mx_t mx_cvt_s(float v) { return (mx_t)f2bf(v); }
#endif
__device__ __forceinline__ unsigned pk2(float lo, float hi) { return f2bf(lo) | (f2bf(hi) << 16); }
__device__ __forceinline__ float bf2f(unsigned short v) { return __builtin_bit_cast(float, (unsigned)v << 16); }
__device__ __forceinline__ float bflo(unsigned w) { return __builtin_bit_cast(float, w << 16); }
__device__ __forceinline__ float bfhi(unsigned w) { return __builtin_bit_cast(float, w & 0xffff0000u); }
__device__ __forceinline__ unsigned cvt_pk_bf16(float lo, float hi) { unsigned r; asm volatile("v_cvt_pk_bf16_f32 %0, %1, %2" : "=v"(r) : "v"(lo), "v"(hi)); return r; }
template <int CTRL> __device__ __forceinline__ float dppx(float v) { return __builtin_bit_cast(float, __builtin_amdgcn_update_dpp(0, __builtin_bit_cast(int, v), CTRL, 0xf, 0xf, true)); }
template <int M> __device__ __forceinline__ float xshfl(float v, int) {
    static_assert(M == 1 || M == 2 || M == 4 || M == 8 || M == 16, "xshfl: inside a 32-lane half only");
    if constexpr (M == 1) return dppx<0xB1>(v);
    else if constexpr (M == 2) return dppx<0x4E>(v);
    else if constexpr (M == 4) return dppx<0x141>(v);
    else if constexpr (M == 8) return dppx<0x128>(v);
    else return __builtin_bit_cast(float, __builtin_amdgcn_ds_swizzle(__builtin_bit_cast(int, v), (16 << 10) | 0x1f));
}
__device__ __forceinline__ void plswap(unsigned a, unsigned b, unsigned& r0, unsigned& r1) {
    asm volatile("" : "+v"(a), "+v"(b));
    auto rr = __builtin_amdgcn_permlane32_swap(a, b, false, false); r0 = rr[0]; r1 = rr[1];
    asm volatile("" : "+v"(r0), "+v"(r1));
}
__device__ __forceinline__ void half_swap(float v, float& r0, float& r1) {
    unsigned u0, u1; plswap(__builtin_bit_cast(unsigned, v), __builtin_bit_cast(unsigned, v), u0, u1); r0 = __builtin_bit_cast(float, u0); r1 = __builtin_bit_cast(float, u1);
}
__device__ __forceinline__ float rdl(float v, int l) { return __builtin_bit_cast(float, __builtin_amdgcn_readlane(__builtin_bit_cast(int, v), l)); }
__device__ __forceinline__ float wave_sum(float v) {
    v += dppx<0xB1>(v); v += dppx<0x4E>(v); v += dppx<0x141>(v); v += dppx<0x140>(v);
    return (rdl(v, 0) + rdl(v, 16)) + (rdl(v, 32) + rdl(v, 48));
}
__device__ __forceinline__ float wave_max(float v) {
    v = fmaxf(v, dppx<0xB1>(v)); v = fmaxf(v, dppx<0x4E>(v)); v = fmaxf(v, dppx<0x141>(v)); v = fmaxf(v, dppx<0x140>(v));
    return fmaxf(fmaxf(rdl(v, 0), rdl(v, 16)), fmaxf(rdl(v, 32), rdl(v, 48)));
}
__device__ __forceinline__ int lane_id() { int l; asm volatile("v_mbcnt_lo_u32_b32 %0, -1, 0\n\tv_mbcnt_hi_u32_b32 %0, -1, %0" : "=v"(l)); return l; }
__device__ __forceinline__ int tid_of(int wv) { int t = (wv << 6) + lane_id(); asm volatile("" : "+v"(t)); return t; }
__device__ __forceinline__ float fast_exp2(float x) { return __builtin_amdgcn_exp2f(x); }
__device__ __forceinline__ float fast_rcp(float x) { return __builtin_amdgcn_rcpf(x); }
__device__ __forceinline__ float gelu_tanh(float x) {
    const float u = x * (0.7978845608028654f + 0.035677408136300125f * x * x);
    return x * fast_rcp(1.0f + fast_exp2(-2.0f * LOG2E * u));
}
namespace pg8 {
constexpr int BM = 256, BK = 64, HALF = 128, HTB = HALF * BK * 2  , STAGE_BYTES = 8 * HTB, NXCD = 8, WGM = 8;
__host__ __device__ __forceinline__ int lds_byte(int r, int c) { const int st = (r >> 4) * 2 + (c >> 5), rr = r & 15, cc = c & 31, ob = rr * 64 + cc * 2; return st * 1024 + (ob ^ (((ob >> 9) & 1) << 5)); }
__host__ __device__ __forceinline__ void stage_rc(int b, int& R, int& C) { const int st = b / 1024, sb = b % 1024, swz = sb ^ (((sb >> 9) & 1) << 5); R = (st >> 1) * 16 + swz / 64; C = (st & 1) * 32 + (swz % 64) / 2; }
__host__ __device__ __forceinline__ int perm16x(int R) { return 64 * (R >> 5) + 16 * ((R & 15) >> 2) + 4 * ((R >> 4) & 1) + (R & 3); }
__host__ __device__ __forceinline__ int perm32(int rho) { const int n = rho >> 4, i = rho & 15; return 8 * (i >> 2) + 4 * n + (i & 3); }

#ifndef PG8_NT
#define PG8_NT 0
#endif
#if PG8_NT
#define PG8_ST(T_, p_, v_) __builtin_nontemporal_store((v_), (GAS T_*)(p_))
#else
#define PG8_ST(T_, p_, v_) (*(GAS T_*)(p_) = (v_))
#endif
#ifndef PG8_NT_PIN
#define PG8_NT_PIN 0
#endif
#if PG8_NT_PIN
#define PG8_STP(T_, p_, v_) __builtin_nontemporal_store((v_), (GAS T_*)(p_))
#else
#define PG8_STP(T_, p_, v_) (*(GAS T_*)(p_) = (v_))
#endif
struct Unit { int pm, pn, bt, e, blk; };

struct DenseOrder {
    int nM, nN, nwg, G, c;
    __device__ void init(int M, int N, int G_, int c_) { nM = M / BM; nN = N / BM; nwg = nM * nN; G = G_; c = c_; }
    __device__ bool next(int i, Unit& u) const {
        const long L = (long)i * G + c; if (L >= nwg) return false;
        int wgid = (int)L; { const int q = nwg / NXCD, r = nwg % NXCD, xcd = wgid % NXCD, off = wgid / NXCD; wgid = (xcd < r ? xcd * (q + 1) : r * (q + 1) + (xcd - r) * q) + off; }
        const int nig = WGM * nN, gid = wgid / nig, fm = gid * WGM, gsz = (nM - fm) < WGM ? (nM - fm) : WGM;
        u.pm = fm + ((wgid % nig) % gsz); u.pn = (wgid % nig) / gsz; u.bt = u.pn; u.e = 0; u.blk = 0; return true;
    }
    __device__ __forceinline__ int count(int) const { return 0; }
};
struct MoeOrder {
    int nunits, npn, G, c; const LAS int* tab; int rev = 0;
    __device__ bool next(int i, Unit& u) const {
        const long L = (long)i * G + c; if (L >= nunits) return false;
        const int rb0_ = (int)L / npn, rb = rev ? nunits / npn - 1 - rb0_ : rb0_, pn = (int)L % npn, e = __builtin_amdgcn_readfirstlane(tab[MI_RBE + rb]);
        u.pm = rb; u.pn = pn; u.e = e; u.bt = e * npn + pn; u.blk = rb - __builtin_amdgcn_readfirstlane(tab[MI_RBSTART + e]); return true;
    }
    __device__ __forceinline__ int count(int e) const { return __builtin_amdgcn_readfirstlane(tab[MI_CNT + e]); }
};

template <int PV> struct EpiStoreBf16T {
    static constexpr bool RELAX = false;
    static constexpr int NST = (PV == 2) ? 8 : 16;
    static constexpr bool PERM = true; static constexpr bool PERM16 = false;
    bf16_t* O; int ldc; int gelu_from;
    struct Pre {};
    __device__ __forceinline__ void pre(Pre&, const Unit&, int, int) const {}
    __device__ __forceinline__ void fill(f32x4 (&acc)[2][2][4][2], const Pre&) const {
#pragma unroll
        for (int a = 0; a < 2; ++a)
#pragma unroll
            for (int b = 0; b < 2; ++b)
#pragma unroll
                for (int m = 0; m < 4; ++m)
#pragma unroll
                    for (int n = 0; n < 2; ++n) acc[a][b][m][n] = (f32x4){0.f, 0.f, 0.f, 0.f};
    }
    __device__ __forceinline__ void operator()(const f32x4 (&acc)[2][2][4][2], const Unit& u, int wr, int wc, int fr, int fq) const {
        const int row0 = u.pm * BM + wr * 64 + fr; const int col0 = u.pn * BM + wc * 32 + 8 * fq; const bool g = u.pn >= gelu_from;
#pragma unroll
        for (int ai = 0; ai < 2; ++ai)
#pragma unroll
            for (int m = 0; m < 4; ++m) { GAS bf16_t* rowp = (GAS bf16_t*)O + (size_t)(row0 + ai * HALF + m * 16) * ldc + col0;
#pragma unroll
                for (int bj = 0; bj < 2; ++bj) { f32x4 v0 = acc[ai][bj][m][0], v1 = acc[ai][bj][m][1];
                    if (g) {
#pragma unroll
                        for (int q = 0; q < 4; ++q) { v0[q] = gelu_tanh(v0[q]); v1[q] = gelu_tanh(v1[q]); } }
                    u32x4 w; w.x = cvt_pk_bf16(v0[0], v0[1]); w.y = cvt_pk_bf16(v0[2], v0[3]); w.z = cvt_pk_bf16(v1[0], v1[1]); w.w = cvt_pk_bf16(v1[2], v1[3]);
                    if constexpr (PV == 1) { u32x2 w2; w2.x = w.x; w2.y = w.y; *(GAS u32x2*)(rowp + bj * HALF) = w2; }
                    else if constexpr (PV == 5) { if (((blockIdx.x >> 3) & 3) == 0) *(GAS u32x4*)(rowp + bj * HALF) = w; }
                    else if constexpr (PV == 4) { if ((blockIdx.x >> 3) & 1) *(GAS u32x4*)(rowp + bj * HALF) = w; }
                    else if constexpr (PV == 2) { if (bj == 0) *(GAS u32x4*)(rowp + bj * HALF) = w; }
                    else if constexpr (PV == 3) {
                        GAS bf16_t* q = (GAS bf16_t*)O + (size_t)(u.pm * BM + wr * 64 + ai * HALF + m * 16 + (wc >> 1) * 8 + (fr >> 1)) * ldc + u.pn * BM + bj * HALF + (wc & 1) * 64 + (fr & 1) * 32 + 8 * fq;
                        *(GAS u32x4*)q = w; }
                    else PG8_STP(u32x4, rowp + bj * HALF, w); } }
    }
};
typedef EpiStoreBf16T<0> EpiStoreBf16;
struct EpiResid {
    static constexpr bool PERM = true; static constexpr bool PERM16 = false;
    static constexpr bool RELAX = false; static constexpr int NST = 16;
    const bf16_t* Hs; bf16_t* Z; float alpha;
    struct Pre {};
    __device__ __forceinline__ void pre(Pre&, const Unit&, int, int) const {}
    __device__ __forceinline__ void fill(f32x4 (&acc)[2][2][4][2], const Pre&) const {
#pragma unroll
        for (int a = 0; a < 2; ++a)
#pragma unroll
            for (int b = 0; b < 2; ++b)
#pragma unroll
                for (int m = 0; m < 4; ++m)
#pragma unroll
                    for (int n = 0; n < 2; ++n) acc[a][b][m][n] = (f32x4){0.f, 0.f, 0.f, 0.f};
    }
    __device__ __forceinline__ void operator()(const f32x4 (&acc)[2][2][4][2], const Unit& u, int wr, int wc, int fr, int fq) const {
        const int row0 = u.pm * BM + wr * 64 + fr; const int col0 = u.pn * BM + wc * 32 + 8 * fq;
#pragma unroll
        for (int ai = 0; ai < 2; ++ai) {
            u32x4 hw[4][2];
#pragma unroll
            for (int m = 0; m < 4; ++m)
#pragma unroll
                for (int bj = 0; bj < 2; ++bj) hw[m][bj] = *(const GAS u32x4*)((const GAS bf16_t*)Hs + (size_t)(row0 + ai * HALF + m * 16) * D_MODEL + col0 + bj * HALF);
#pragma unroll
            for (int m = 0; m < 4; ++m) { const size_t off = (size_t)(row0 + ai * HALF + m * 16) * D_MODEL + col0;
#pragma unroll
                for (int bj = 0; bj < 2; ++bj) { const u32x4 h = hw[m][bj];
                    const f32x4 v0 = (f32x4){bflo(h.x), bfhi(h.x), bflo(h.y), bfhi(h.y)} * alpha + acc[ai][bj][m][0], v1 = (f32x4){bflo(h.z), bfhi(h.z), bflo(h.w), bfhi(h.w)} * alpha + acc[ai][bj][m][1];
                    u32x4 w; w.x = cvt_pk_bf16(v0[0], v0[1]); w.y = cvt_pk_bf16(v0[2], v0[3]); w.z = cvt_pk_bf16(v1[0], v1[1]); w.w = cvt_pk_bf16(v1[2], v1[3]);
                    PG8_ST(u32x4, (GAS bf16_t*)Z + off + bj * HALF, w); } } }
    }
};
__device__ __forceinline__ f32x2 pk_add(f32x2 a, f32x2 b) { f32x2 d; asm("v_pk_add_f32 %0, %1, %2" : "=v"(d) : "v"(a), "v"(b)); return d; }
__device__ __forceinline__ f32x2 pk_mul(f32x2 a, f32x2 b) { f32x2 d; asm("v_pk_mul_f32 %0, %1, %2" : "=v"(d) : "v"(a), "v"(b)); return d; }
__device__ __forceinline__ f32x2 pk_fma(f32x2 a, f32x2 b, f32x2 c) { f32x2 d; asm("v_pk_fma_f32 %0, %1, %2, %3" : "=v"(d) : "v"(a), "v"(b), "v"(c)); return d; }
__device__ __forceinline__ float a_min(float a, float b) { float d; asm("v_min_f32 %0, %1, %2" : "=v"(d) : "v"(a), "v"(b)); return d; }
__device__ __forceinline__ float a_med3(float a, float lo, float hi) { float d; asm("v_med3_f32 %0, %1, %2, %3" : "=v"(d) : "v"(a), "v"(lo), "v"(hi)); return d; }
__device__ __forceinline__ f32x2 pk_add_t(f32x2 a, f32x2 b) { f32x2 d; asm("s_nop 0\n\tv_pk_add_f32 %0, %1, %2" : "=v"(d) : "v"(a), "v"(b)); return d; }
__device__ __forceinline__ f32x2 pk_mul_t(f32x2 a, f32x2 b) { f32x2 d; asm("s_nop 0\n\tv_pk_mul_f32 %0, %1, %2" : "=v"(d) : "v"(a), "v"(b)); return d; }
struct EpiSwiglu {
    static constexpr bool PERM = true; static constexpr bool PERM16 = false;
#if MOE_FP8
    static constexpr float OSC = 8.0f;
#else
    static constexpr float OSC = 1.0f;
#endif
    static constexpr bool RELAX = true; static constexpr int NST = 8;
    bf16_t* ACT; const float* bgu;
    struct Pre { f32x4 g[2], u[2]; };
    __device__ __forceinline__ void pre(Pre& p, const Unit& u, int wc, int fq) const {
        const float* bb = bgu + (size_t)u.e * 2048 + u.pn * HALF + wc * 32 + 8 * fq;
#pragma unroll
        for (int n = 0; n < 2; ++n) { p.g[n] = *(const GAS f32x4*)((const GAS float*)bb + 4 * n); p.u[n] = *(const GAS f32x4*)((const GAS float*)bb + 1024 + 4 * n); }
    }
    __device__ __forceinline__ void fill(f32x4 (&acc)[2][2][4][2], const Pre& p) const {
#pragma unroll
        for (int n = 0; n < 2; ++n) { const f32x4 un = (p.u[n] + 1.0f) * OSC;
#pragma unroll
            for (int a = 0; a < 2; ++a)
#pragma unroll
                for (int m = 0; m < 4; ++m) { acc[a][0][m][n] = p.g[n]; acc[a][1][m][n] = un; } }
    }
    __device__ __forceinline__ void operator()(const f32x4 (&acc)[2][2][4][2], const Unit& u, int wr, int wc, int fr, int fq) const {
        const int row0 = u.pm * BM + wr * 64 + fr; const int oc0 = u.pn * HALF + wc * 32 + 8 * fq;
        f32x2 c_z = {-1.702f * LOG2E, -1.702f * LOG2E}, c_one = {1.0f, 1.0f};
        f32x2 c_lim = {7.0f, -6.0f * OSC}; float c_hi = 8.0f * OSC;
        asm volatile("" : "+v"(c_z), "+v"(c_one), "+v"(c_lim), "+v"(c_hi));
#pragma unroll
        for (int ai = 0; ai < 2; ++ai)
#pragma unroll
            for (int m = 0; m < 4; ++m) { float o[8];
#pragma unroll
                for (int n = 0; n < 2; ++n)
#pragma unroll
                    for (int h = 0; h < 2; ++h) {
                        f32x2 gt, up;
                        gt.x = a_min(acc[ai][0][m][n][2 * h], c_lim.x); gt.y = a_min(acc[ai][0][m][n][2 * h + 1], c_lim.x);
                        up.x = a_med3(acc[ai][1][m][n][2 * h], c_lim.y, c_hi); up.y = a_med3(acc[ai][1][m][n][2 * h + 1], c_lim.y, c_hi);
                        f32x2 e = pk_mul(gt, c_z);
                        e.x = fast_exp2(e.x); e.y = fast_exp2(e.y);
                        f32x2 r = pk_add_t(e, c_one);
                        r.x = fast_rcp(r.x); r.y = fast_rcp(r.y);
                        const f32x2 ov = pk_mul_t(pk_mul(up, gt), r);
                        o[4 * n + 2 * h] = ov.x; o[4 * n + 2 * h + 1] = ov.y; }
#if MOE_FP8
                u32x2 w; w.x = pk4_fp8(o[0], o[1], o[2], o[3]); w.y = pk4_fp8(o[4], o[5], o[6], o[7]);
                PG8_ST(u32x2, (GAS unsigned char*)ACT + (size_t)(row0 + ai * HALF + m * 16) * D_FF + oc0, w); }
#else
                u32x4 w; w.x = cvt_pk_bf16(o[0], o[1]); w.y = cvt_pk_bf16(o[2], o[3]); w.z = cvt_pk_bf16(o[4], o[5]); w.w = cvt_pk_bf16(o[6], o[7]);
                *(GAS u32x4*)((GAS bf16_t*)ACT + (size_t)(row0 + ai * HALF + m * 16) * D_FF + oc0) = w; }
#endif
    }
};
struct EpiBiasBf16 {
    static constexpr bool PERM = true; static constexpr bool PERM16 = (MOE_FP8 != 0);
#if MOE_FP8
    static constexpr float OSC = 64.0f;
#else
    static constexpr float OSC = 1.0f;
#endif
    static constexpr bool RELAX = true; static constexpr int NST = MOE_FP8 ? 8 : 16;
    bf16_t* Y; const float* bdn;
    struct Pre { f32x4 v[2][2]; };
    __device__ __forceinline__ void pre(Pre& p, const Unit& u, int wc, int fq) const {
        const float* bb = bdn + (size_t)u.e * 1024 + u.pn * BM + (PERM16 ? wc * 64 + 16 * fq : wc * 32 + 8 * fq);
#pragma unroll
        for (int bj = 0; bj < 2; ++bj)
#pragma unroll
            for (int n = 0; n < 2; ++n) p.v[bj][n] = *(const GAS f32x4*)((const GAS float*)bb + (PERM16 ? 8 * bj : bj * HALF) + 4 * n);
    }
    __device__ __forceinline__ void fill(f32x4 (&acc)[2][2][4][2], const Pre& p) const {
#pragma unroll
        for (int bj = 0; bj < 2; ++bj)
#pragma unroll
            for (int n = 0; n < 2; ++n) { const f32x4 v = p.v[bj][n] * OSC;
#pragma unroll
                for (int a = 0; a < 2; ++a)
#pragma unroll
                    for (int m = 0; m < 4; ++m) acc[a][bj][m][n] = v; }
    }
    __device__ __forceinline__ void operator()(const f32x4 (&acc)[2][2][4][2], const Unit& u, int wr, int wc, int fr, int fq) const {
        const int row0 = u.pm * BM + wr * 64 + fr; const int col0 = u.pn * BM + (PERM16 ? wc * 64 + 16 * fq : wc * 32 + 8 * fq);
#if MOE_FP8
        float c_lo = -448.f, c_hi = 448.f; asm volatile("" : "+v"(c_lo), "+v"(c_hi));
#endif
#pragma unroll
        for (int ai = 0; ai < 2; ++ai)
#pragma unroll
            for (int m = 0; m < 4; ++m) { const size_t roff = (size_t)(row0 + ai * HALF + m * 16) * D_MODEL + col0;
#if MOE_FP8
                u32x4 w;
#pragma unroll
                for (int bj = 0; bj < 2; ++bj)
#pragma unroll
                    for (int n = 0; n < 2; ++n) { const f32x4 v = acc[ai][bj][m][n]; w[2 * bj + n] = pk4_fp8(a_med3(v[0], c_lo, c_hi), a_med3(v[1], c_lo, c_hi), a_med3(v[2], c_lo, c_hi), a_med3(v[3], c_lo, c_hi)); }
                PG8_ST(u32x4, (GAS unsigned char*)Y + roff, w); }
#else
#pragma unroll
                for (int bj = 0; bj < 2; ++bj) { const f32x4 v0 = acc[ai][bj][m][0], v1 = acc[ai][bj][m][1];
                    u32x4 w; w.x = cvt_pk_bf16(v0[0], v0[1]); w.y = cvt_pk_bf16(v0[2], v0[3]); w.z = cvt_pk_bf16(v1[0], v1[1]); w.w = cvt_pk_bf16(v1[2], v1[3]);
                    *(GAS u32x4*)((GAS bf16_t*)Y + roff + bj * HALF) = w; } }
#endif
    }
};

template <class Epi, class Sched, bool GATHER, bool FP8 = false>
__device__ __forceinline__ void gemm_phase(LAS unsigned char* lds, const bf16_t* A, const bf16_t* Bt, const int K_, const int* __restrict__ rowidx, const Sched& S, const Epi& E, const int wv, int sclA = 0x7f7f7f7f, int sclB = 0x7f7f7f7f, int sclB1 = 0x7f7f7f7f, int krep = 1, int erep = 1, int stagger = 0) {
    int Kh_ = K_; asm volatile("" : "+s"(Kh_)); const int K = Kh_;
    asm volatile("" : "+v"(sclA), "+v"(sclB), "+v"(sclB1));
    const int tid_ = tid_of(wv);
    const int tid = tid_, wid = __builtin_amdgcn_readfirstlane(tid >> 6), lane = tid & 63, wr = wid >> 2, wc = wid & 3, fr = lane & 15, fq = lane >> 4;
    const int nt = K / BK;
    unsigned voffB[2]; unsigned oc0[2], oc1[2];
    LAS unsigned* gnx = (LAS unsigned*)(lds + MISC_OFF + MI_REC * 4) + tid * 4;
    const size_t kstep = (size_t)(BK * 2);
    const size_t hstep = (size_t)HALF * K * 2;
    const size_t tstep = 2 * hstep;
    const size_t bhstep = Epi::PERM16 ? (size_t)8 * K * 2 : hstep;
#pragma unroll
    for (int i = 0; i < 2; ++i) { int R, C; stage_rc(tid * 16 + i * 8192, R, C); const int Rb = Epi::PERM16 ? perm16x(R) : Epi::PERM ? ((R & ~31) + perm32(R & 31)) : R;
        oc0[i] = (unsigned)(R * K + C) * 2u; oc1[i] = oc0[i] + (unsigned)hstep;
        voffB[i] = (unsigned)(Rb * K + C) * 2u; }
    const unsigned ldsw = (unsigned)wid * 1024u;
    const int aoff = lds_byte(wr * 64 + fr, fq * 8), boff = lds_byte(wc * 32 + fr, fq * 8);
#define PG8_SA(b, h) (((b) * 2 + (h)) * HTB)
#define PG8_SB(b, h) ((4 + (b) * 2 + (h)) * HTB)
#define PG8_STAGE(bufoff, gbase, voff) do { _Pragma("unroll") for (int _i = 0; _i < 2; ++_i) { unsigned keep_; \
        asm volatile("s_mov_b32 %0, m0\n\ts_mov_b32 m0, %3\n\ts_nop 0\n\tglobal_load_lds_dwordx4 %1, %2\n\ts_mov_b32 m0, %0" \
            : "=&s"(keep_) : "v"((voff)[_i]), "s"((const char*)(gbase)), "s"((unsigned)(size_t)(lds + (bufoff) + ldsw + _i * 8192)) : "memory"); } } while (0)
#define PG8_RD8(p) __builtin_shufflevector(*(const LAS i32x4*)(p), *(const LAS i32x4*)((p) + 1024), 0, 1, 2, 3, 4, 5, 6, 7)
#define PG8_LDA(dst, b, h) do { if constexpr (FP8) { _Pragma("unroll") for (int m = 0; m < 4; ++m) dst##8[m] = PG8_RD8(lds + PG8_SA(b, h) + aoff + m * 2048); } \
        else { _Pragma("unroll") for (int m = 0; m < 4; ++m) _Pragma("unroll") for (int k = 0; k < 2; ++k) dst[m][k] = *(const LAS bf16x8*)(lds + PG8_SA(b, h) + aoff + m * 2048 + k * 1024); } } while (0)
#define PG8_LDB(dst, b, h) do { if constexpr (FP8) { _Pragma("unroll") for (int n = 0; n < 2; ++n) dst##8[n] = PG8_RD8(lds + PG8_SB(b, h) + boff + n * 2048); } \
        else { _Pragma("unroll") for (int n = 0; n < 2; ++n) _Pragma("unroll") for (int k = 0; k < 2; ++k) dst[n][k] = *(const LAS bf16x8*)(lds + PG8_SB(b, h) + boff + n * 2048 + k * 1024); } } while (0)
#define PG8_MMA(ai, bj, At, Bt_) do { __builtin_amdgcn_s_setprio(1); _Pragma("unroll") for (int m = 0; m < 4; ++m) _Pragma("unroll") for (int n = 0; n < 2; ++n) { \
        if constexpr (FP8) asm volatile("v_mfma_scale_f32_16x16x128_f8f6f4 %0, %1, %2, %0, %3, %4 op_sel_hi:[0,0,0]" : "+v"(acc[ai][bj][m][n]) : "v"(Bt_##8[n]), "v"(At##8[m]), "v"((bj) ? sclB1 : sclB), "v"(sclA));   \
        else { _Pragma("unroll") for (int k = 0; k < 2; ++k) acc[ai][bj][m][n] = __builtin_amdgcn_mfma_f32_16x16x32_bf16(Bt_[n][k], At[m][k], acc[ai][bj][m][n], 0, 0, 0); } } \
        __builtin_amdgcn_s_setprio(0); } while (0)
#define PG8_WAIT_V(n) asm volatile("s_waitcnt vmcnt(" #n ")" ::: "memory")
#define PG8_WAIT_VN(N) asm volatile("s_waitcnt vmcnt(%0)" :: "n"(N) : "memory")
#define PG8_WAIT_RX() do { if (rx) PG8_WAIT_VN(8 + Epi::NST); else PG8_WAIT_V(8); } while (0)
#define PG8_WAIT_L(n) asm volatile("s_waitcnt lgkmcnt(" #n ")" ::: "memory")
#define PG8_BAR __builtin_amdgcn_s_barrier()
#define PG8_SCHED __builtin_amdgcn_sched_barrier(0)
#define PG8_GOFF(u, g0, g1) do { const int cn_ = S.count((u).e); const GAS int* rp_ = (const GAS int*)rowidx + (size_t)(u).e * 65536 + (u).blk * 256; \
        _Pragma("unroll") for (int i_ = 0; i_ < 2; ++i_) { int r0_, c0_; stage_rc(tid * 16 + i_ * 8192, r0_, c0_); const unsigned gc_ = (unsigned)c0_ * 2u; \
            const int t0_ = ((u).blk * 256 + r0_ < cn_) ? rp_[r0_] : 0; const int t1_ = ((u).blk * 256 + 128 + r0_ < cn_) ? rp_[128 + r0_] : 0; \
            g0[i_] = (unsigned)t0_ * (unsigned)(K * 2) + gc_; g1[i_] = (unsigned)t1_ * (unsigned)(K * 2) + gc_; asm volatile("" : "+v"(g0[i_]), "+v"(g1[i_])); } } while (0)
    Unit cur, nxt; int ui = 0;
    if (!S.next(0, cur)) return;
    for (int sgi = 0; sgi < stagger * ((int)(blockIdx.x >> 3) & 3); ++sgi) __builtin_amdgcn_s_sleep(1);
    f32x4 acc[2][2][4][2];
    { typename Epi::Pre p0; E.pre(p0, cur, wc, fq); E.fill(acc, p0); }
    bf16x8 At[4][2], B0[2][2], B1[2][2]; v8i At8[4], B08[2], B18[2];
    if constexpr (GATHER) { PG8_GOFF(cur, oc0, oc1); gnx[0] = oc0[0]; gnx[1] = oc0[1]; gnx[2] = oc1[0]; gnx[3] = oc1[1]; }
    const char* cA = GATHER ? (const char*)A : (const char*)A + (size_t)cur.pm * tstep; const char* cB = (const char*)Bt + (size_t)cur.bt * tstep;
    PG8_STAGE(PG8_SB(0, 0), cB, voffB); PG8_STAGE(PG8_SB(0, 1), cB + bhstep, voffB); PG8_STAGE(PG8_SA(0, 0), cA, oc0); PG8_STAGE(PG8_SA(0, 1), cA, oc1);
    if (wr == 1) PG8_BAR;
    PG8_WAIT_V(2); PG8_BAR;
    PG8_STAGE(PG8_SB(1, 0), cB + kstep, voffB); PG8_STAGE(PG8_SA(1, 0), cA + kstep, oc0); PG8_STAGE(PG8_SB(1, 1), cB + bhstep + kstep, voffB);
    PG8_WAIT_V(6); PG8_BAR;
    for (;;) {
        const bool has_next = S.next(ui + 1, nxt);
        int ix0 = 0, ix1 = 0, ix2 = 0, ix3 = 0;
        if constexpr (GATHER) { if (has_next) { const char* rp_ = (const char*)rowidx + ((size_t)nxt.e * 65536 + (size_t)nxt.blk * 256) * 4;
            int ra, rb_, cdum; stage_rc(tid * 16, ra, cdum); stage_rc(tid * 16 + 8192, rb_, cdum);
            asm volatile("global_load_dword %0, %4, %6\n\tglobal_load_dword %1, %4, %6 offset:512\n\tglobal_load_dword %2, %5, %6\n\tglobal_load_dword %3, %5, %6 offset:512"
                         : "=&v"(ix0), "=&v"(ix1), "=&v"(ix2), "=&v"(ix3) : "v"(ra * 4), "v"(rb_ * 4), "s"(rp_) : "memory"); } }
        const char* nA = GATHER ? (const char*)A : (has_next ? (const char*)A + (size_t)nxt.pm * tstep : cA); const char* nB = has_next ? (const char*)Bt + (size_t)nxt.bt * tstep : cB;
#pragma unroll 1
        for (int kk = 0; kk < krep; ++kk)
        for (int t = 0; t < nt; t += 2) {
            const bool last = (t == nt - 2);
            const bool fin = (kk == krep - 1);
            const char* a1 = cA + (size_t)(t + 1) * kstep;
            const char* a2 = last ? (fin ? nA : cA) : cA + (size_t)(t + 2) * kstep; const char* b2 = last ? (fin ? nB : cB) : cB + (size_t)(t + 2) * kstep;
            const char* a3 = a2 + kstep; const char* b3 = b2 + kstep;
            unsigned s0[2], s1[2];
#pragma unroll
            for (int i = 0; i < 2; ++i) { s0[i] = oc0[i]; s1[i] = oc1[i]; }
            if constexpr (GATHER) { if (t == 2 && kk == 0 && has_next) {
                    const int cn_ = S.count(nxt.e); int ra, rb_, ca, cb; stage_rc(tid * 16, ra, ca); stage_rc(tid * 16 + 8192, rb_, cb); const int b0_ = nxt.blk * 256;
                    gnx[0] = (unsigned)((b0_ + ra < cn_) ? ix0 : 0) * (unsigned)(K * 2) + (unsigned)ca * 2u; gnx[2] = (unsigned)((b0_ + 128 + ra < cn_) ? ix1 : 0) * (unsigned)(K * 2) + (unsigned)ca * 2u;
                    gnx[1] = (unsigned)((b0_ + rb_ < cn_) ? ix2 : 0) * (unsigned)(K * 2) + (unsigned)cb * 2u; gnx[3] = (unsigned)((b0_ + 128 + rb_ < cn_) ? ix3 : 0) * (unsigned)(K * 2) + (unsigned)cb * 2u; }
                if (last && fin) { s0[0] = gnx[0]; s0[1] = gnx[1]; s1[0] = gnx[2]; s1[1] = gnx[3]; } }
            const bool rx = Epi::RELAX && (erep == 1) && ui > 0 && t == 0 && kk == 0;
            PG8_LDB(B0, 0, 0); PG8_LDB(B1, 0, 1); PG8_SCHED; PG8_LDA(At, 0, 0); if (!rx) PG8_STAGE(PG8_SA(1, 1), a1, oc1);
            PG8_WAIT_RX(); PG8_WAIT_L(0); PG8_BAR; PG8_MMA(0, 0, At, B0); PG8_MMA(0, 1, At, B1); PG8_BAR; PG8_SCHED;
            PG8_LDA(At, 0, 1); PG8_STAGE(PG8_SB(0, 0), b2, voffB); PG8_STAGE(PG8_SB(0, 1), b2 + bhstep, voffB); PG8_STAGE(PG8_SA(0, 0), a2, s0);
            PG8_WAIT_RX(); PG8_WAIT_L(0); PG8_BAR; PG8_MMA(1, 0, At, B0); PG8_MMA(1, 1, At, B1); PG8_BAR; PG8_SCHED;
            PG8_LDB(B0, 1, 0); PG8_LDB(B1, 1, 1); PG8_SCHED; PG8_LDA(At, 1, 0); PG8_STAGE(PG8_SA(0, 1), a2, s1);
            PG8_WAIT_RX(); PG8_WAIT_L(0); PG8_BAR; PG8_MMA(0, 0, At, B0); PG8_MMA(0, 1, At, B1); PG8_BAR; PG8_SCHED;
            PG8_LDA(At, 1, 1); PG8_STAGE(PG8_SB(1, 0), b3, voffB); PG8_STAGE(PG8_SB(1, 1), b3 + bhstep, voffB); PG8_STAGE(PG8_SA(1, 0), a3, s0);
            PG8_WAIT_V(8); PG8_WAIT_L(0); PG8_BAR; PG8_MMA(1, 0, At, B0); PG8_MMA(1, 1, At, B1); PG8_BAR; PG8_SCHED;
        }
        if (wr == 0) PG8_BAR;
        const bool pre_st = Epi::RELAX && has_next && erep == 1;
        if (pre_st) { if constexpr (GATHER) { unsigned q1[2]; q1[0] = gnx[2]; q1[1] = gnx[3]; PG8_STAGE(PG8_SA(1, 1), nA + kstep, q1); } else PG8_STAGE(PG8_SA(1, 1), nA + kstep, oc1); }
        if constexpr (FP8) asm volatile("s_nop 15\n\ts_nop 15" ::: "memory");
        Unit pu; pu.pm = has_next ? nxt.pm : cur.pm; pu.pn = has_next ? nxt.pn : cur.pn; pu.bt = has_next ? nxt.bt : cur.bt; pu.e = has_next ? nxt.e : cur.e; pu.blk = has_next ? nxt.blk : cur.blk;
        typename Epi::Pre pn; E.pre(pn, pu, wc, fq);
#pragma unroll 1
        for (int er = 0; er < erep; ++er) { E(acc, cur, wr, wc, fr, fq); asm volatile("" ::: "memory"); }
        if (!has_next) break;
        E.fill(acc, pn);
        cur = nxt; cA = nA; cB = nB; ++ui;
        if constexpr (GATHER) { oc0[0] = gnx[0]; oc0[1] = gnx[1]; oc1[0] = gnx[2]; oc1[1] = gnx[3]; }
        if (wr == 1) PG8_BAR;
    }
    PG8_WAIT_V(0);
    PG8_BAR;
#undef PG8_SA
#undef PG8_SB
#undef PG8_STAGE
#undef PG8_LDA
#undef PG8_LDB
#undef PG8_MMA
#undef PG8_RD8
#undef PG8_WAIT_V
#undef PG8_WAIT_VN
#undef PG8_WAIT_RX
#undef PG8_WAIT_L
#undef PG8_BAR
#undef PG8_SCHED
#undef PG8_GOFF
}
}
namespace att {
#define ATT_SBAR() __builtin_amdgcn_sched_barrier(0)
constexpr float THR = 8.f;
__device__ __forceinline__ int crow(int r, int hi) { return (r & 3) + 8 * (r >> 2) + 4 * hi; }
__device__ __forceinline__ unsigned cvtpk(float lo, float hi) { unsigned r; asm volatile("v_cvt_pk_bf16_f32 %0, %1, %2" : "=v"(r) : "v"(lo), "v"(hi)); return r; }

__device__ __forceinline__ void partialSM(f32x16& p0, f32x16& p1, float& m_reg, float& alpha) {
  float pmax = p0[0];
#pragma unroll
  for (int r = 1; r < 16; ++r) pmax = fmaxf(pmax, p0[r]);
#pragma unroll
  for (int r = 0; r < 16; ++r) pmax = fmaxf(pmax, p1[r]);
  { float r0, r1; half_swap(pmax, r0, r1); pmax = fmaxf(r0, r1); }
  float mn;
  if (__builtin_expect(__all(pmax - m_reg <= THR), 1)) { mn = m_reg; alpha = 1.f; }
  else { mn = fmaxf(m_reg, pmax); alpha = __builtin_amdgcn_exp2f(m_reg - mn); m_reg = mn; }
#pragma unroll
  for (int r = 0; r < 16; ++r) { p0[r] = __builtin_amdgcn_exp2f(p0[r] - mn); p1[r] = __builtin_amdgcn_exp2f(p1[r] - mn); }
}
__device__ __forceinline__ void finishSM(const f32x16& p0, const f32x16& p1, float alpha, float& l_reg, bf16x8& pa0, bf16x8& pa1, bf16x8& pa2, bf16x8& pa3) {
  float ps = 0;
#pragma unroll
  for (int r = 0; r < 16; ++r) ps += p0[r];
#pragma unroll
  for (int r = 0; r < 16; ++r) ps += p1[r];
  { float r0, r1; half_swap(ps, r0, r1); ps = r0 + r1; }
  l_reg = l_reg * alpha + ps;
#define ATT_PK4(P, BASE, OUT) do { unsigned a0 = cvtpk(P[BASE + 0], P[BASE + 1]), a1 = cvtpk(P[BASE + 2], P[BASE + 3]);   \
    unsigned b0 = cvtpk(P[BASE + 4], P[BASE + 5]), b1 = cvtpk(P[BASE + 6], P[BASE + 7]);                              \
    unsigned r00, r01, r10, r11; plswap(a0, b0, r00, r01); plswap(a1, b1, r10, r11); \
    u32x4 w = {r00, r10, r01, r11}; OUT = __builtin_bit_cast(bf16x8, w); } while (0)
  ATT_PK4(p0, 0, pa0); ATT_PK4(p0, 8, pa1); ATT_PK4(p1, 0, pa2); ATT_PK4(p1, 8, pa3);
#undef ATT_PK4
}
__device__ __forceinline__ int v_st(int k, int c) { const int kk = (k & ~0xC) | ((k & 4) << 1) | ((k & 8) >> 1); return ((kk >> 3) * 4 + (c >> 5)) * 512 + ((kk & 7) * 32 + (c & 31)) * 2; }
__device__ __forceinline__ int v_rd_base(int lane) { return ((lane & 3) << 3) | (((lane >> 2) & 3) << 6) | (((lane >> 4) & 1) << 5) | (((lane >> 5) & 1) << 8); }
constexpr int v_rd_off(int d0, int ks, int half) { return d0 * 512 + ks * 4096 + half * 2048; }
template <int OFF> __device__ __forceinline__ s16x4 tr_read(int vb) {
  s16x4 r; asm volatile("ds_read_b64_tr_b16 %0, %1 offset:%2" : "=&v"(r) : "v"(vb), "i"(OFF) : "memory"); return r;
}
template <int D0> __device__ __forceinline__ void pv_one(f32x16& od, int vb, bf16x8 pa0, bf16x8 pa1, bf16x8 pa2, bf16x8 pa3) {
  const s16x4 l0 = tr_read<v_rd_off(D0, 0, 0)>(vb), h0 = tr_read<v_rd_off(D0, 0, 1)>(vb), l1 = tr_read<v_rd_off(D0, 1, 0)>(vb), h1 = tr_read<v_rd_off(D0, 1, 1)>(vb);
  const s16x4 l2 = tr_read<v_rd_off(D0, 2, 0)>(vb), h2 = tr_read<v_rd_off(D0, 2, 1)>(vb), l3 = tr_read<v_rd_off(D0, 3, 0)>(vb), h3 = tr_read<v_rd_off(D0, 3, 1)>(vb);
  asm volatile("s_waitcnt lgkmcnt(0)" ::: "memory"); ATT_SBAR();
#define ATT_PK(L, H) (bf16x8){L[0], L[1], L[2], L[3], H[0], H[1], H[2], H[3]}
  od = __builtin_amdgcn_mfma_f32_32x32x16_bf16(pa0, ATT_PK(l0, h0), od, 0, 0, 0);
  od = __builtin_amdgcn_mfma_f32_32x32x16_bf16(pa1, ATT_PK(l1, h1), od, 0, 0, 0);
  od = __builtin_amdgcn_mfma_f32_32x32x16_bf16(pa2, ATT_PK(l2, h2), od, 0, 0, 0);
  od = __builtin_amdgcn_mfma_f32_32x32x16_bf16(pa3, ATT_PK(l3, h3), od, 0, 0, 0);
#undef ATT_PK
}
constexpr int ATT_LDS_V = 0, ATT_LDS_K = 32768, ATT_LDS_WS = 65536, ATT_LDS_CORE = 65536 + 2048;
template <int DQK, bool MASKED, bool KVSAME>
__device__ __forceinline__ void attn_core(const GAS bf16_t* __restrict__ Qrow0, int ldq, const GAS bf16_t* __restrict__ Kh, int ldk, const GAS bf16_t* __restrict__ Vh, int ldv,
                                          int NTB, int NTW, float slope2, int tq0, const LAS unsigned long long* mask, LAS char* lds, f32x16 (&o)[4], float& l_out, const int wv) {
  static_assert(DQK == 64 || DQK == 128, "DQK"); static_assert(!KVSAME || DQK == 128, "KVSAME needs DQK 128");
  constexpr int KROWB = DQK * 2, KBUF = 64 * KROWB, ND0 = DQK / 16;
  const int tid_ = tid_of(wv);
  const int tid = tid_, wid = tid >> 6, lane = tid & 63, r32 = lane & 31, hi = lane >> 5;
  LAS char* V_lds = lds + ATT_LDS_V; LAS char* K_lds = lds + ATT_LDS_K;
  LAS float* wsf = (LAS float*)(lds + ATT_LDS_WS) + wid * 64; LAS float* al_l = wsf + 32;
  float m_reg = -1e30f, l_reg = 0.f;
#pragma unroll
  for (int d = 0; d < 4; ++d) o[d] = f32x16{};
  bf16x8 qr[ND0];
  { const GAS bf16_t* Qp = Qrow0 + (size_t)r32 * ldq + hi * 8;
#pragma unroll
    for (int d0 = 0; d0 < ND0; ++d0) qr[d0] = *(const GAS bf16x8*)(Qp + d0 * 16); }
  const int sr = tid >> 4, sc = (tid & 15) * 8, vst0 = v_st(sr, sc), vst1 = v_st(32 + sr, sc);
  const int kr = tid >> 3, kc = (tid & 7) * 8;
  const int vb0 = (int)(unsigned)(size_t)V_lds + v_rd_base(lane);
  bf16x8 vs0, vs1, ks0, ks1, wv0, wv1, wk0, wk1;
#define ATT_KSWZ(row, colB) ((row) * KROWB + ((colB) ^ (((row) & 7) << 4)))
#define ATT_SLOADX(k0, vs0, vs1, ks0, ks1) do { vs0 = *(const GAS bf16x8*)(&Vh[(size_t)((k0) + sr) * ldv + sc]); vs1 = *(const GAS bf16x8*)(&Vh[(size_t)((k0) + 32 + sr) * ldv + sc]); \
    if constexpr (!KVSAME) { if constexpr (DQK == 128) { ks0 = *(const GAS bf16x8*)(&Kh[(size_t)((k0) + sr) * ldk + sc]); ks1 = *(const GAS bf16x8*)(&Kh[(size_t)((k0) + 32 + sr) * ldk + sc]); } \
                             else { ks0 = *(const GAS bf16x8*)(&Kh[(size_t)((k0) + kr) * ldk + kc]); } } } while (0)
#define ATT_SLOAD(k0) ATT_SLOADX(k0, vs0, vs1, ks0, ks1)
#define ATT_SLOADB(k0) ATT_SLOADX(k0, wv0, wv1, wk0, wk1)
#define ATT_SWRITEX(b, vs0, vs1, ks0, ks1) do { *(LAS bf16x8*)(V_lds + (b) * 16384 + vst0) = vs0; *(LAS bf16x8*)(V_lds + (b) * 16384 + vst1) = vs1; \
    if constexpr (KVSAME) { *(LAS bf16x8*)(K_lds + (b) * KBUF + ATT_KSWZ(sr, sc * 2)) = vs0; *(LAS bf16x8*)(K_lds + (b) * KBUF + ATT_KSWZ(32 + sr, sc * 2)) = vs1; } \
    else if constexpr (DQK == 128) { *(LAS bf16x8*)(K_lds + (b) * KBUF + ATT_KSWZ(sr, sc * 2)) = ks0; *(LAS bf16x8*)(K_lds + (b) * KBUF + ATT_KSWZ(32 + sr, sc * 2)) = ks1; } \
    else { *(LAS bf16x8*)(K_lds + (b) * KBUF + ATT_KSWZ(kr, kc * 2)) = ks0; } } while (0)
#define ATT_SWRITE(b) ATT_SWRITEX(b, vs0, vs1, ks0, ks1)
#define ATT_SWRITEB(b) ATT_SWRITEX(b, wv0, wv1, wk0, wk1)
  constexpr bool SD2 = false;
  ATT_SLOAD((NTB - 1) * 64); ATT_SWRITE(0);
  if constexpr (SD2) { if (NTB > 1) ATT_SLOADB((NTB - 2) * 64); if (NTB > 2) ATT_SLOAD((NTB - 3) * 64); }
  __syncthreads();
#pragma unroll
  for (int d0 = 0; d0 < ND0; ++d0) asm volatile("" :: "v"(qr[d0]));
  float m_ref = 0.f;
  const int jdiag = tq0 >> 6;
  for (int jj = 0; jj < NTB; ++jj) {
    const int j = NTB - 1 - jj, buf = jj & 1;
    if constexpr (!SD2) { if (j > 0) ATT_SLOAD((j - 1) * 64); }
    if (j < NTW) {
      f32x16 p0, p1;
      unsigned mlo = 0xffffffffu, mhi = 0xffffffffu;
      if constexpr (MASKED) { const unsigned long long mw = mask[j * 32 + r32]; mlo = (unsigned)mw >> (4 * hi); mhi = (unsigned)(mw >> 32) >> (4 * hi); }
      if (j == jdiag) {
        const float x = (float)(tq0 + r32 - j * 64 - 4 * hi);
#pragma unroll
        for (int r = 0; r < 16; ++r) { const int cr = (r & 3) + 8 * (r >> 2); const float d = x - (float)cr; p0[r] = -slope2 * fabsf(d) - m_ref; p1[r] = -slope2 * fabsf(d - 32.f) - m_ref; }
      } else {
        const float b0 = slope2 * (float)(j * 64 + 4 * hi - tq0 - r32) - m_ref, s2 = slope2 + slope2, s3 = s2 + slope2, s8 = 8.f * slope2, s32 = 32.f * slope2;
        float bg = b0;
#pragma unroll
        for (int g = 0; g < 4; ++g) { p0[4 * g] = bg; p0[4 * g + 1] = bg + slope2; p0[4 * g + 2] = bg + s2; p0[4 * g + 3] = bg + s3; bg += s8; }
#pragma unroll
        for (int r = 0; r < 16; ++r) p1[r] = p0[r] + s32;
      }
      if constexpr (MASKED) {
#pragma unroll
        for (int r = 0; r < 16; ++r) { const int cr = (r & 3) + 8 * (r >> 2);
          if (!((mlo >> cr) & 1u)) p0[r] = -INFINITY; if (!((mhi >> cr) & 1u)) p1[r] = -INFINITY; }
      }
      { const LAS char* Kb = K_lds + buf * KBUF;
        if constexpr (DQK == 64) {
          bf16x8 kf0[ND0], kf1[ND0];
#pragma unroll
          for (int d0 = 0; d0 < ND0; ++d0) { const int cb = (d0 * 16 + hi * 8) * 2; kf0[d0] = *(const LAS bf16x8*)(Kb + ATT_KSWZ(r32, cb)); kf1[d0] = *(const LAS bf16x8*)(Kb + ATT_KSWZ(32 + r32, cb)); }
          __builtin_amdgcn_sched_barrier(0);
#pragma unroll
          for (int d0 = 0; d0 < ND0; ++d0) { p0 = __builtin_amdgcn_mfma_f32_32x32x16_bf16(kf0[d0], qr[d0], p0, 0, 0, 0); p1 = __builtin_amdgcn_mfma_f32_32x32x16_bf16(kf1[d0], qr[d0], p1, 0, 0, 0); }
        } else {
#pragma unroll
        for (int d0 = 0; d0 < ND0; ++d0) { const int cb = (d0 * 16 + hi * 8) * 2;
          const bf16x8 b0 = *(const LAS bf16x8*)(Kb + ATT_KSWZ(r32, cb));
          const bf16x8 b1 = *(const LAS bf16x8*)(Kb + ATT_KSWZ(32 + r32, cb));
          p0 = __builtin_amdgcn_mfma_f32_32x32x16_bf16(b0, qr[d0], p0, 0, 0, 0);
          p1 = __builtin_amdgcn_mfma_f32_32x32x16_bf16(b1, qr[d0], p1, 0, 0, 0); } } }
      float pmax = fmaxf(p0[0], p1[0]);
      asm("v_max3_f32 %0, %0, %1, %2\n\tv_max3_f32 %0, %0, %3, %4\n\tv_max3_f32 %0, %0, %5, %6\n\tv_max3_f32 %0, %0, %7, %8\n\tv_max3_f32 %0, %0, %9, %10\n\tv_max3_f32 %0, %0, %11, %12\n\tv_max3_f32 %0, %0, %13, %14\n\tv_max3_f32 %0, %0, %15, %16"
          : "+v"(pmax) : "v"(p0[1]), "v"(p1[1]), "v"(p0[2]), "v"(p1[2]), "v"(p0[3]), "v"(p1[3]), "v"(p0[4]), "v"(p1[4]), "v"(p0[5]), "v"(p1[5]), "v"(p0[6]), "v"(p1[6]), "v"(p0[7]), "v"(p1[7]), "v"(p0[8]), "v"(p1[8]));
      asm("v_max3_f32 %0, %0, %1, %2\n\tv_max3_f32 %0, %0, %3, %4\n\tv_max3_f32 %0, %0, %5, %6\n\tv_max3_f32 %0, %0, %7, %8\n\tv_max3_f32 %0, %0, %9, %10\n\tv_max3_f32 %0, %0, %11, %12\n\tv_max3_f32 %0, %0, %13, %14"
          : "+v"(pmax) : "v"(p0[9]), "v"(p1[9]), "v"(p0[10]), "v"(p1[10]), "v"(p0[11]), "v"(p1[11]), "v"(p0[12]), "v"(p1[12]), "v"(p0[13]), "v"(p1[13]), "v"(p0[14]), "v"(p1[14]), "v"(p0[15]), "v"(p1[15]));
      { float r0, r1; half_swap(pmax, r0, r1); asm("v_max_f32 %0, %1, %2" : "=v"(pmax) : "v"(r0), "v"(r1)); }
      const bool first = (j == NTW - 1);
      if (first || __any(pmax > THR)) {
        const float dl = first ? ((pmax > -1e30f) ? pmax : 0.f) : fmaxf(pmax, 0.f);
        m_ref += dl; const float alpha = __builtin_amdgcn_exp2f(-dl); l_reg *= alpha;
#pragma unroll
        for (int r = 0; r < 16; ++r) { p0[r] -= dl; p1[r] -= dl; }
        if (!first) { if (hi == 0) al_l[r32] = alpha; asm volatile("s_waitcnt lgkmcnt(0)" ::: "memory");
#pragma unroll
          for (int d = 0; d < 4; ++d)
#pragma unroll
            for (int r = 0; r < 16; ++r) o[d][r] *= al_l[crow(r, hi)]; }
      }
#pragma unroll
      for (int r = 0; r < 16; ++r) { p0[r] = __builtin_amdgcn_exp2f(p0[r]); p1[r] = __builtin_amdgcn_exp2f(p1[r]); }
      bf16x8 pa0, pa1, pa2, pa3;
      finishSM(p0, p1, 1.f, l_reg, pa0, pa1, pa2, pa3); ATT_SBAR();
      const int vb = vb0 + buf * 16384;
      pv_one<0>(o[0], vb, pa0, pa1, pa2, pa3); pv_one<1>(o[1], vb, pa0, pa1, pa2, pa3); pv_one<2>(o[2], vb, pa0, pa1, pa2, pa3); pv_one<3>(o[3], vb, pa0, pa1, pa2, pa3);
    }
    if constexpr (!SD2) { if (j > 0) ATT_SWRITE(buf ^ 1); }
    else { if (j > 0) { if ((jj + 1) & 1) ATT_SWRITEB(buf ^ 1); else ATT_SWRITE(buf ^ 1); }
           if (j > 2) { if ((jj + 1) & 1) ATT_SLOADB((j - 3) * 64); else ATT_SLOAD((j - 3) * 64); } }
    __syncthreads();
  }
  l_out = l_reg;
#undef ATT_KSWZ
#undef ATT_SLOAD
#undef ATT_SWRITE
#undef ATT_SLOADB
#undef ATT_SWRITEB
#undef ATT_SLOADX
#undef ATT_SWRITEX
}
__device__ __forceinline__ void row_rcp(float l_reg, LAS char* lds, float (&rli)[16], const int wv) {
  const int tid_ = tid_of(wv);
  const int tid = tid_, wid = tid >> 6, lane = tid & 63, r32 = lane & 31, hi = lane >> 5;
  LAS float* li_l = (LAS float*)(lds + ATT_LDS_WS) + wid * 64;
  if (hi == 0) li_l[r32] = l_reg; asm volatile("s_waitcnt lgkmcnt(0)" ::: "memory");
#pragma unroll
  for (int r = 0; r < 16; ++r) rli[r] = __builtin_amdgcn_rcpf(li_l[crow(r, hi)]);
}
}
#define XB_TMO      128
#define XB_XCNT(j)  (256  + 64 * (j))
#define XB_XSUB(j)  (1280 + 64 * (j))
#define XB_XGEN(j)  (2304 + 64 * (j))
#define XB_TOP      3328
#define XB_TOPGEN   3392
#define XCD_BAR_WORDS 3456
#define XB_SPIN_CAP (1u << 18)

__device__ __forceinline__ unsigned xb_ld(unsigned* p)              { return __hip_atomic_load(p, __ATOMIC_RELAXED, __HIP_MEMORY_SCOPE_AGENT); }
__device__ __forceinline__ unsigned xb_add(unsigned* p, unsigned v) { return __hip_atomic_fetch_add(p, v, __ATOMIC_RELAXED, __HIP_MEMORY_SCOPE_AGENT); }
__device__ __forceinline__ unsigned xb_xcc_id() { return (unsigned)__builtin_amdgcn_s_getreg((3 << 11) | 20) & 0xFu; }
#define XB_SPIN(cond, bar) do { unsigned _sp = 0; while (cond) { __builtin_amdgcn_s_sleep(1); \
    if ((++_sp & 255u) == 0u) { if (xb_ld(&(bar)[XB_TMO])) break; if (_sp > XB_SPIN_CAP) { atomicAdd(&(bar)[XB_TMO], 1u); break; } } } } while (0)

struct XcdBarrier {
    unsigned* bar; unsigned x; unsigned w;
    volatile LAS unsigned* st;
};

__device__ __forceinline__ XcdBarrier xcd_barrier_post(unsigned* bar, volatile LAS unsigned* st) {
    XcdBarrier b; b.bar = bar; b.x = xb_xcc_id(); b.st = st; b.w = (unsigned)__builtin_amdgcn_readfirstlane((int)(threadIdx.x >> 6));
    if (threadIdx.x == 0) (void)xb_add(&bar[XB_XCNT(b.x)], 1u);
    return b;
}
__device__ __forceinline__ void xcd_barrier_complete(unsigned* bar, unsigned x, unsigned& nloc, unsigned& nx) {
    const unsigned G = gridDim.x * gridDim.y * gridDim.z;
    unsigned sum, cnt, mine, sp = 0u;
    for (;;) {
        sum = 0u; cnt = 0u; mine = 0u;
#pragma unroll
        for (unsigned j = 0; j < 16; ++j) { const unsigned c = xb_ld(&bar[XB_XCNT(j)]); sum += c; cnt += (c > 0u) ? 1u : 0u; mine = (j == x) ? c : mine; }
        if (sum == G) break;
        __builtin_amdgcn_s_sleep(1);
        if ((++sp & 255u) == 0u) { if (xb_ld(&bar[XB_TMO])) break; if (sp > XB_SPIN_CAP) { atomicAdd(&bar[XB_TMO], 1u); break; } }
    }
    nloc = mine > 0u ? mine : 1u; nx = cnt > 0u ? cnt : 1u;
}

__device__ __forceinline__ void xcd_barrier(const XcdBarrier& b) {
    asm volatile("s_waitcnt vmcnt(0)" ::: "memory");
    __syncthreads();
    if (b.w == 0u && lane_id() == 0) {
        unsigned* bar = b.bar;
        __builtin_amdgcn_s_waitcnt(0);
        unsigned nloc = b.st[0], nx = b.st[1];
        if (nloc == 0u) { xcd_barrier_complete(bar, b.x, nloc, nx); b.st[0] = nloc; b.st[1] = nx; }
        const unsigned old = xb_add(&bar[XB_XSUB(b.x)], 1u);
        const unsigned gen = old / nloc;
        if (old + 1u == (gen + 1u) * nloc) {
            __builtin_amdgcn_fence(__ATOMIC_RELEASE, "agent");
            asm volatile("s_waitcnt vmcnt(0)" ::: "memory");
            const unsigned og = xb_add(&bar[XB_TOP], 1u);
            const unsigned tg = og / nx;
            if (og + 1u == (tg + 1u) * nx) xb_add(&bar[XB_TOPGEN], 1u);
            else XB_SPIN(xb_ld(&bar[XB_TOPGEN]) == tg, bar);
            __builtin_amdgcn_fence(__ATOMIC_ACQUIRE, "agent");
            xb_add(&bar[XB_XGEN(b.x)], 1u);
            asm volatile("s_waitcnt vmcnt(0)" ::: "memory");
        } else {
            XB_SPIN(xb_ld(&bar[XB_XGEN(b.x)]) == gen, bar);
            __builtin_amdgcn_fence(__ATOMIC_ACQUIRE, "agent");
            asm volatile("s_waitcnt vmcnt(0)" ::: "memory");
        }
    }
    __syncthreads();
}
struct Args { const float* in[32]; float* out; unsigned char* ws; int l_lo, l_hi, p_lo, p_hi, do_pro, fused; };
enum { I_X = 0, I_EV_W_IN, I_EV_Q_NORM, I_EV_KV_NORM, I_EV_W_UQ, I_EV_W_UK, I_EV_W_UV, I_EV_W_IQ, I_EV_IDX_K_G, I_EV_IDX_K_B, I_EV_V_NORM_G, I_EV_V_NORM_B, I_EV_W_S, I_EV_B_S, I_EV_W_OUT,
       I_OD_W_IN, I_OD_LQ1, I_OD_LK1, I_OD_LQ2, I_OD_LK2, I_OD_SUBLN_G, I_OD_W_OUT, I_LN1_G, I_LN1_B, I_LN2_G, I_LN2_B, I_ROUTER_W, I_ROUTER_B, I_EXP_W_GU, I_EXP_B_GU, I_EXP_W_DN, I_EXP_B_DN };
struct Frame {
    LAS unsigned char* lds; char* ldsg; volatile LAS int* MISC; gu32* ctl;
    int tid, lane, wave, vcu, G;
    unsigned char* ws;
};
typedef const __attribute__((address_space(4))) Args* ArgsP;
#define WSP(T, off) ((T*)(ws_ + (off)))
#define PHASE_PROLOG() unsigned char* ws_ = F.ws; asm volatile("" : "+s"(ws_)); asm volatile("" : "+s"(a)); int vcu_ = F.vcu, G_ = F.G; asm volatile("" : "+s"(vcu_), "+s"(G_))
#define fresh_tid() tid_of(F.wave)

__device__ __forceinline__ void tr_block(const float* src, int ld, bf16_t* dst, int dld, float scale, LAS float* scr, int lane) {
#pragma unroll 8
    for (int i = 0; i < 32; ++i) { const int kk = 2 * i + (lane >> 5); scr[kk * 33 + (lane & 31)] = src[(size_t)kk * ld + (lane & 31)]; }
    LDS_WAIT(); asm volatile("" ::: "memory");
    const int c = lane & 7;
#pragma unroll
    for (int j = 0; j < 4; ++j) { const int n = (lane >> 3) + 8 * j; const LAS float* s = scr + (8 * c) * 33 + n;
        u32x4 o; o.x = pk2(s[0 * 33] * scale, s[1 * 33] * scale); o.y = pk2(s[2 * 33] * scale, s[3 * 33] * scale); o.z = pk2(s[4 * 33] * scale, s[5 * 33] * scale); o.w = pk2(s[6 * 33] * scale, s[7 * 33] * scale);
        *(GAS u32x4*)(dst + (size_t)n * dld + 8 * c) = o; }
    LDS_WAIT(); asm volatile("" ::: "memory");
}
__device__ __forceinline__ void tr_block8(const float* src, int ld, unsigned char* dst, int dld, float scale, LAS float* scr, int lane) {
#pragma unroll 8
    for (int i = 0; i < 32; ++i) { const int kk = 2 * i + (lane >> 5); scr[kk * 33 + (lane & 31)] = src[(size_t)kk * ld + (lane & 31)]; }
    LDS_WAIT(); asm volatile("" ::: "memory");
    const int n = lane >> 1, kh = (lane & 1) * 32; const LAS float* s = scr + kh * 33 + n;
#pragma unroll
    for (int j = 0; j < 2; ++j) { u32x4 o;
        o.x = pk4_fp8(s[(16 * j + 0) * 33] * scale, s[(16 * j + 1) * 33] * scale, s[(16 * j + 2) * 33] * scale, s[(16 * j + 3) * 33] * scale);
        o.y = pk4_fp8(s[(16 * j + 4) * 33] * scale, s[(16 * j + 5) * 33] * scale, s[(16 * j + 6) * 33] * scale, s[(16 * j + 7) * 33] * scale);
        o.z = pk4_fp8(s[(16 * j + 8) * 33] * scale, s[(16 * j + 9) * 33] * scale, s[(16 * j + 10) * 33] * scale, s[(16 * j + 11) * 33] * scale);
        o.w = pk4_fp8(s[(16 * j + 12) * 33] * scale, s[(16 * j + 13) * 33] * scale, s[(16 * j + 14) * 33] * scale, s[(16 * j + 15) * 33] * scale);
        *(GAS u32x4*)(dst + (size_t)n * dld + kh + 16 * j) = o; }
    LDS_WAIT(); asm volatile("" ::: "memory");
}
__device__ __forceinline__ void pro_phase(Frame& F, ArgsP a) {
    PHASE_PROLOG();
    const int ftid = fresh_tid(), flane = ftid & 63;
    LAS float* scr = (LAS float*)(F.lds + F.wave * 16384);
    const int gw = vcu_ * 8 + F.wave, NGW = G_ * 8;
    constexpr int IA = DEPTH * NEXP * 16 * 64, IB = DEPTH * NEXP * 16 * 32, IC = 2 * 16 * 46, ID = 2 * 16 * 96, IE = 2 * 16 * 32;
    for (int it = gw; it < IA + IB + IC + ID + IE; it += NGW) {
        int r = it;
        if (r < IA) { const int m = r >> 10, rem = r & 1023, kb = rem >> 6, nb = rem & 63, n0 = nb * 32;
            const int drow = 256 * ((n0 & 1023) >> 7) + 128 * (n0 >> 10) + (n0 & 127);
#if MOE_FP8
            tr_block8(a->in[I_EXP_W_GU] + (size_t)m * 1024 * 2048 + (size_t)(kb * 64) * 2048 + n0, 2048, WSP(unsigned char, WS_WGU) + ((size_t)m * 2048 + drow) * 1024 + kb * 64, 1024, 64.f, scr, flane); continue; }
#else
            tr_block(a->in[I_EXP_W_GU] + (size_t)m * 1024 * 2048 + (size_t)(kb * 64) * 2048 + n0, 2048, WSP(bf16_t, WS_WGU) + ((size_t)m * 2048 + drow) * 1024 + kb * 64, 1024, 1.f, scr, flane); continue; }
#endif
        r -= IA;
        if (r < IB) { const int m = r >> 9, rem = r & 511, kb = rem >> 5, nb = rem & 31;
#if MOE_FP8
            tr_block8(a->in[I_EXP_W_DN] + (size_t)m * 1024 * 1024 + (size_t)(kb * 64) * 1024 + nb * 32, 1024, WSP(unsigned char, WS_WDN) + ((size_t)m * 1024 + nb * 32) * 1024 + kb * 64, 1024, 64.f, scr, flane); continue; }
#else
            tr_block(a->in[I_EXP_W_DN] + (size_t)m * 1024 * 1024 + (size_t)(kb * 64) * 1024 + nb * 32, 1024, WSP(bf16_t, WS_WDN) + ((size_t)m * 1024 + nb * 32) * 1024 + kb * 64, 1024, 1.f, scr, flane); continue; }
#endif
        r -= IB;
        if (r < IC) { const int jj = r / 736, rem = r % 736, kb = rem / 46, nb = rem % 46;
            const int scol = nb < 14 ? nb * 32 : 452 + (nb - 14) * 32, drow = nb < 14 ? nb * 32 : 512 + (nb - 14) * 32;
            tr_block(a->in[I_EV_W_IN] + (size_t)jj * 1024 * E_IN_EVEN + (size_t)(kb * 64) * E_IN_EVEN + scol, E_IN_EVEN, WSP(bf16_t, WS_WINE) + ((size_t)jj * NE_PR + drow) * 1024 + kb * 64, 1024, 1.f, scr, flane); continue; }
        r -= IC;
        if (r < ID) { const int jj = r / 1536, rem = r % 1536, kb = rem / 96, nb = rem % 96;
            tr_block(a->in[I_OD_W_IN] + (size_t)jj * 1024 * NO_PR + (size_t)(kb * 64) * NO_PR + nb * 32, NO_PR, WSP(bf16_t, WS_WINO) + ((size_t)jj * NO_PR + nb * 32) * 1024 + kb * 64, 1024, nb < 32 ? 0.125f * LOG2E : 1.f, scr, flane); continue; }
        r -= ID;
        { const int jj = r / 512, rem = r % 512, kb = rem / 32, nb = rem % 32;
#if POUT_FP8
            tr_block8(a->in[I_OD_W_OUT] + (size_t)jj * 1024 * 1024 + (size_t)(kb * 64) * 1024 + nb * 32, 1024, WSP(unsigned char, WS_WOUTO) + ((size_t)jj * 1024 + nb * 32) * 1024 + kb * 64, 1024, 64.f, scr, flane); }
#else
            tr_block(a->in[I_OD_W_OUT] + (size_t)jj * 1024 * 1024 + (size_t)(kb * 64) * 1024 + nb * 32, 1024, WSP(bf16_t, WS_WOUTO) + ((size_t)jj * 1024 + nb * 32) * 1024 + kb * 64, 1024, 1.f, scr, flane); }
#endif
    }
    const int gt = vcu_ * 512 + ftid, NGT = G_ * 512;
    for (int i = gt; i < 2 * 64 * 1024; i += NGT) { const int jj = i >> 16, rr = 448 + ((i >> 10) & 63), k = i & 1023;
        const float v = rr < 452 ? a->in[I_EV_W_IN][(size_t)jj * 1024 * E_IN_EVEN + (size_t)k * E_IN_EVEN + rr] : 0.f;
        WSP(bf16_t, WS_WINE)[((size_t)jj * NE_PR + rr) * 1024 + k] = (bf16_t)f2bf(v); }
    for (int i = gt; i < 2 * NQQ * 256; i += NGT) { const int jj = i / (NQQ * 256), rem = i % (NQQ * 256), n = rem >> 8, c = rem & 255; float v;
        if (n < 1024) { const int h = n >> 7, lat = n & 127; const float* uq = a->in[I_EV_W_UQ] + ((size_t)(jj * 256 + c) * 8 + h) * 64; const float* uk = a->in[I_EV_W_UK] + ((size_t)(jj * 8 + h) * 64) * 128 + lat;
            float s = 0.f;
            for (int d = 0; d < 64; ++d) s += uq[d] * uk[(size_t)d * 128];
            v = s * (0.125f * LOG2E); }
        else { const int hd = n - 1024; v = 0.125f * a->in[I_EV_W_IQ][(size_t)(jj * 256 + c) * 256 + hd]; }
        WSP(bf16_t, WS_WQE)[i] = (bf16_t)f2bf(v); }
    for (int i = gt; i < 2 * 1024 * NMX; i += NGT) { const int jj = i / (1024 * NMX), rem = i % (1024 * NMX), n = rem / NMX, k = rem % NMX; float v;
        const float* wo = a->in[I_EV_W_OUT] + (size_t)jj * 1024 * 1024 + n;
        if (k < 1024) { const int h = k >> 7, c = k & 127; const float* uv = a->in[I_EV_W_UV] + ((size_t)(jj * 8 + h) * 128 + c) * 64; float s = 0.f;
            for (int d = 0; d < 64; ++d) s += uv[d] * wo[(size_t)(h * 64 + d) * 1024];
            v = s; }
        else v = wo[(size_t)(512 + k - 1024) * 1024];
#if POUT_FP8
        WSP(unsigned char, WS_WOUTE)[i] = (unsigned char)__builtin_amdgcn_cvt_pk_fp8_f32(128.f * v, 0.f, 0, false); }
#else
        WSP(bf16_t, WS_WOUTE)[i] = (bf16_t)f2bf(v); }
#endif
    for (int i = gt; i < DEPTH * 32768; i += NGT) { const int l = i >> 15, rem = i & 32767, k = rem >> 5, e = rem & 31; const float w = a->in[I_LN1_G][l * 1024 + k] * a->in[I_ROUTER_W][i];
        const unsigned h16 = f2bf(w), l16 = f2bf(w - bf2f((unsigned short)h16)); const int off = e * 2048 + (((k >> 3) ^ (e & 15)) << 4) + (k & 7) * 2;
        unsigned char* img = WSP(unsigned char, WS_WRT) + (size_t)l * 131072; *(bf16_t*)(img + off) = (bf16_t)h16; *(bf16_t*)(img + 65536 + off) = (bf16_t)l16; }
    for (int i = gw; i < DEPTH * 32; i += NGW) { const int l = i >> 5, e = i & 31; float s1 = 0.f, s2 = 0.f;
        for (int k = flane; k < 1024; k += 64) { const float wv = a->in[I_ROUTER_W][((size_t)l * 1024 + k) * 32 + e]; s1 += a->in[I_LN1_G][l * 1024 + k] * wv; s2 += a->in[I_LN1_B][l * 1024 + k] * wv; }
        s1 = wave_sum(s1); s2 = wave_sum(s2);
        if (flane == 0) { float* cc = WSP(float, WS_WRT + 512 * 1024) + l * 64; cc[e] = s1; cc[32 + e] = s2 + a->in[I_ROUTER_B][l * 32 + e]; } }
    for (int i = gt; i < 2 * 8 * 128 * 128; i += NGT) { const int ii = (i >> 7) & 127, jx = i & 127; WSP(bf16_t, WS_WS)[i] = (bf16_t)f2bf(jx <= ii ? a->in[I_EV_W_S][i] : 0.f); }
    for (int m = gw; m < T_TOK; m += NGW) { const GAS f32x4* xr = (const GAS f32x4*)(a->in[I_X] + (size_t)m * D_MODEL) + flane; GAS u32x2* o8 = (GAS u32x2*)(WSP(bf16_t, WS_HB) + (size_t)m * D_MODEL) + flane;
#pragma unroll
        for (int jx = 0; jx < 4; ++jx) { const f32x4 v = xr[64 * jx]; u32x2 w; w.x = pk2(v.x, v.y); w.y = pk2(v.z, v.w); o8[64 * jx] = w; } }
}

__device__ __forceinline__ void e1b_phase(Frame& F, ArgsP a, int l) {
    PHASE_PROLOG();
    const int j = l >> 1, lane = fresh_tid() & 63; const int gw = vcu_ * 8 + F.wave, NGW = G_ * 8;
    const float* qg = a->in[I_EV_Q_NORM] + j * 256; const float* kvg = a->in[I_EV_KV_NORM] + j * 128; const float* ig = a->in[I_EV_IDX_K_G] + j * 64; const float* ib = a->in[I_EV_IDX_K_B] + j * 64;
    const f32x4 g4 = *(const f32x4*)(qg + 4 * lane); const float kg0 = kvg[2 * lane], kg1 = kvg[2 * lane + 1], igl = ig[lane], ibl = ib[lane];
    const GAS bf16_t* PR = (const GAS bf16_t*)WSP(bf16_t, WS_PR);
    GAS bf16_t* CQo = (GAS bf16_t*)WSP(bf16_t, WS_CQ); GAS bf16_t* CKVo = (GAS bf16_t*)WSP(bf16_t, WS_CKV); GAS bf16_t* KIo = (GAS bf16_t*)WSP(bf16_t, WS_KI); GAS float* WIo = (GAS float*)WSP(float, WS_WI);
    static_assert(T_TOK % (4 * 8) == 0, "token batches");
    for (int tok0 = gw; tok0 < T_TOK; tok0 += 4 * NGW) {
        u32x2 wq[4]; unsigned wk[4]; unsigned short wi[4], ww[4];
#pragma unroll
        for (int q = 0; q < 4; ++q) { const GAS bf16_t* pr = PR + (size_t)(tok0 + q * NGW) * NE_PR;
            wq[q] = *(const GAS u32x2*)(pr + 4 * lane); wk[q] = *(const GAS unsigned*)(pr + 256 + 2 * lane); wi[q] = pr[384 + lane]; ww[q] = pr[448 + (lane & 3)]; }
        u32x2 oq[4]; unsigned ok[4]; unsigned short oi[4];
#pragma unroll
        for (int q = 0; q < 4; ++q) {
            { const u32x2 w = wq[q]; const float a0 = bflo(w.x), a1 = bfhi(w.x), a2 = bflo(w.y), a3 = bfhi(w.y);
              const float ss = wave_sum(a0 * a0 + a1 * a1 + a2 * a2 + a3 * a3); const float rs = 1.0f / sqrtf(ss * (1.0f / 256.0f) + LN_EPS);
              oq[q].x = pk2(a0 * rs * g4.x, a1 * rs * g4.y); oq[q].y = pk2(a2 * rs * g4.z, a3 * rs * g4.w); }
            { const unsigned w = wk[q]; const float a0 = bflo(w), a1 = bfhi(w);
              const float ss = wave_sum(a0 * a0 + a1 * a1); const float rs = 1.0f / sqrtf(ss * (1.0f / 128.0f) + LN_EPS);
              ok[q] = pk2(a0 * rs * kg0, a1 * rs * kg1); }
            { const float x = bf2f(wi[q]); const float mu = wave_sum(x) * (1.0f / 64.0f); const float d = x - mu; const float var = wave_sum(d * d) * (1.0f / 64.0f);
              oi[q] = (unsigned short)f2bf(d * (1.0f / sqrtf(var + LN_EPS)) * igl + ibl); } }
#pragma unroll
        for (int q = 0; q < 4; ++q) { const size_t tok = (size_t)(tok0 + q * NGW);
            *(GAS u32x2*)(CQo + tok * 256 + 4 * lane) = oq[q]; *(GAS unsigned*)(CKVo + tok * 128 + 2 * lane) = ok[q]; KIo[tok * 64 + lane] = oi[q];
            if (lane < 4) WIo[tok * 4 + lane] = 0.5f * bf2f(ww[q]); }
    }
}

__device__ __forceinline__ unsigned ord_key(float f) { const unsigned u = __builtin_bit_cast(unsigned, f); return (u & 0x80000000u) ? ~u : (u | 0x80000000u); }
__device__ __forceinline__ void e3a_phase(Frame& F, ArgsP a) {
    PHASE_PROLOG();
    const int tid = fresh_tid(), wid = F.wave, lane = tid & 63, fr = lane & 15, fq = lane >> 4;
    LAS float* sc = (LAS float*)F.lds;
    const bf16_t* QQ = WSP(bf16_t, WS_QQ); const bf16_t* KI = WSP(bf16_t, WS_KI); const float* WI = WSP(float, WS_WI);
    unsigned long long* MASK = WSP(unsigned long long, WS_MASK);
    for (int L = vcu_; L < BATCH * (SEQ / 16); L += G_) {
        const int b = L >> 7, qb = ((L & 127) + 8 * (L >> 8)) & 127, t0 = qb * 16, NT = t0 / 64 + 1;
        const size_t rb0 = (size_t)b * SEQ;
        bf16x8 qf[4][2]; f32x4 wq4;
        { const bf16_t* qp = QQ + (rb0 + t0 + fr) * NQQ + 1024 + fq * 8;
#pragma unroll
          for (int h = 0; h < 4; ++h)
#pragma unroll
              for (int ks = 0; ks < 2; ++ks) qf[h][ks] = *(const bf16x8*)(qp + h * 64 + ks * 32);
          wq4 = *(const f32x4*)(WI + (rb0 + t0 + fr) * 4); }
        const f32x4 wqh = wq4 * 0.5f;
#ifndef E3A_REP_SC
#define E3A_REP_SC 1
#endif
#ifndef E3A_REP_SEL
#define E3A_REP_SEL 1
#endif
#pragma unroll 1
        for (int rsc = 0; rsc < E3A_REP_SC; ++rsc)
        for (int kt = wid; kt < NT; kt += 8) {
            bf16x8 kk0[4], kk1[4];
#pragma unroll
            for (int kb = 0; kb < 4; ++kb) { const GAS bf16_t* kp = (const GAS bf16_t*)KI + (rb0 + kt * 64 + kb * 16 + fr) * 64 + fq * 8; kk0[kb] = *(const GAS bf16x8*)kp; kk1[kb] = *(const GAS bf16x8*)(kp + 32); }
#pragma unroll
            for (int kb = 0; kb < 4; ++kb) { const bf16x8 k0 = kk0[kb], k1 = kk1[kb];
                f32x4 s4 = (f32x4){0.f, 0.f, 0.f, 0.f};
#pragma unroll
                for (int h = 0; h < 4; ++h) { f32x4 acc = (f32x4){0.f, 0.f, 0.f, 0.f};
                    acc = __builtin_amdgcn_mfma_f32_16x16x32_bf16(k0, qf[h][0], acc, 0, 0, 0); acc = __builtin_amdgcn_mfma_f32_16x16x32_bf16(k1, qf[h][1], acc, 0, 0, 0);
#pragma unroll
                    for (int q = 0; q < 4; ++q) s4[q] += (acc[q] + fabsf(acc[q])) * wqh[h]; }
                s4 += 0.0f;
                *(LAS f32x4*)(sc + fr * 2048 + kt * 64 + kb * 16 + fq * 4) = s4; }
        }
        __syncthreads();
#pragma unroll 1
        for (int qq2 = 0; qq2 < 2 * E3A_REP_SEL; ++qq2) { const int qq = qq2 & 1; const int q = 2 * wid + qq; const int tq = t0 + q;
            unsigned long long myword = 0ull; int lane_q = lane; asm volatile("" : "+v"(lane_q));
            if (NT <= 4) { myword = (lane < NT) ? ~0ull : 0ull; }
            else {
                unsigned x[32];
                { float f[32];
#pragma unroll
                  for (int i = 0; i < 32; ++i) f[i] = sc[q * 2048 + i * 64 + lane_q];
#pragma unroll
                  for (int i = 0; i < 32; ++i) x[i] = (i * 64 + lane_q < NT * 64) ? ord_key(f[i]) : 0u; }
                unsigned prefix = 0u;
                bool exact = false;
                for (int bit = 31; bit >= 0; --bit) { const unsigned cand = prefix | (1u << bit); int cnt = 0;
#pragma unroll
                    for (int g = 0; g < 4; ++g) { if (8 * g < NT) { unsigned long long m[8];
#pragma unroll
                            for (int i = 0; i < 8; ++i) asm volatile("v_cmp_ge_u32_e64 %0, %1, %2" : "=s"(m[i]) : "v"(x[8 * g + i]), "s"(cand));
                            __builtin_amdgcn_sched_barrier(0);
#pragma unroll
                            for (int i = 0; i < 8; ++i) cnt += __builtin_popcountll(m[i]);
                            __builtin_amdgcn_sched_barrier(0); } }
                    if (cnt >= N_SEL) { prefix = cand; if (cnt == N_SEL) { exact = true; break; } } }
                int wlo = 0, whi = 0;
                if (exact) {
#pragma unroll
                    for (int i = 0; i < 32; ++i)
                        asm volatile("v_cmp_ge_u32_e64 vcc, %2, %3\n\ts_nop 4\n\tv_writelane_b32 %0, vcc_lo, %4\n\tv_writelane_b32 %1, vcc_hi, %4" : "+v"(wlo), "+v"(whi) : "v"(x[i]), "s"(prefix), "n"(i) : "vcc");
                } else {
                    const unsigned Tk = prefix; int cgt = 0;
#pragma unroll
                    for (int i = 0; i < 32; ++i) { cgt += __builtin_popcountll(__builtin_amdgcn_ballot_w64(x[i] > Tk)); if ((i & 7) == 7) __builtin_amdgcn_sched_barrier(0); }
                    int need = N_SEL - cgt;
#pragma unroll
                    for (int i = 0; i < 32; ++i) { const bool eq = x[i] == Tk; const unsigned long long meq = __builtin_amdgcn_ballot_w64(eq);
                        const int rank = (int)__builtin_amdgcn_mbcnt_hi((unsigned)(meq >> 32), __builtin_amdgcn_mbcnt_lo((unsigned)meq, 0u));
                        const unsigned long long sel = __builtin_amdgcn_ballot_w64((x[i] > Tk) || (eq && rank < need));
                        need = max(need - (int)__builtin_popcountll(meq), 0);
                        asm volatile("s_nop 4\n\tv_writelane_b32 %0, %2, %4\n\tv_writelane_b32 %1, %3, %4" : "+v"(wlo), "+v"(whi) : "s"((unsigned)sel), "s"((unsigned)(sel >> 32)), "n"(i));
                        __builtin_amdgcn_sched_barrier(0); }
                }
                myword = ((unsigned long long)(unsigned)whi << 32) | (unsigned long long)(unsigned)wlo;
            }
            if (lane < 32) MASK[(rb0 + tq) * 32 + lane] = myword;
        }
        __syncthreads();
    }
}

__device__ __forceinline__ void dsa_phase(Frame& F, ArgsP a) {
    PHASE_PROLOG();
    const int tid = fresh_tid(), wid = __builtin_amdgcn_readfirstlane(tid >> 6), lane = tid & 63, r32 = lane & 31, hi = lane >> 5;
    LAS char* lds = (LAS char*)F.lds; LAS unsigned long long* msk = (LAS unsigned long long*)(lds + att::ATT_LDS_CORE);
    const GAS bf16_t* QQ = (const GAS bf16_t*)WSP(bf16_t, WS_QQ); const GAS bf16_t* CKV = (const GAS bf16_t*)WSP(bf16_t, WS_CKV); const GAS unsigned long long* MASK = (const GAS unsigned long long*)WSP(unsigned long long, WS_MASK); GAS mx_t* MX = (GAS mx_t*)WSP(mx_t, WS_MX);
    const float slope2 = exp2f(-(float)(wid + 1)) * LOG2E;
    for (int L = vcu_; L < BATCH * (SEQ / 32); L += G_) {
        const int i = L >> 8, v = L & 255, b = v >> 3, c8 = v & 7, jx = (i & 1) ? 7 - c8 : c8, qb = 63 - (8 * i + jx), t0 = qb * 32, NT = t0 / 64 + 1;
        const size_t rb0 = (size_t)b * SEQ;
        for (int k = tid; k < 1024; k += 512) { const int q = k >> 5, jj = k & 31; msk[jj * 32 + q] = MASK[(rb0 + t0 + q) * 32 + jj]; }
        f32x16 o[4]; float l_reg;
        att::attn_core<128, true, true>(QQ + (rb0 + t0) * NQQ + wid * 128, NQQ, CKV + rb0 * 128, 128, CKV + rb0 * 128, 128, NT, NT, slope2, t0, msk, lds, o, l_reg, wid);
        float rli[16]; att::row_rcp(l_reg, lds, rli, wid);
        GAS mx_t* Ow = MX + (rb0 + t0) * NMX + wid * 128;
        unsigned lo_ = (unsigned)(hi * 4 * NMX + r32); asm volatile("" : "+v"(lo_));
#pragma unroll
        for (int r = 0; r < 16; ++r) { const float rs_ = rli[r] * MX_SCALE;
#pragma unroll
            for (int d0 = 0; d0 < 4; ++d0) Ow[lo_ + (unsigned)(((r & 3) + 8 * (r >> 2)) * NMX + d0 * 32)] = mx_cvt_s(o[d0][r] * rs_); }
    }
}

__device__ __forceinline__ void gml_phase(Frame& F, ArgsP a, int l) {
    PHASE_PROLOG();
    const int j = l >> 1, tid = fresh_tid(), g = F.wave, lane = tid & 63;
    LAS float* stat = (LAS float*)(F.MISC + MI_REC);
    LAS unsigned char* vT = F.lds + g * 16384;
    const GAS bf16_t* PR = (const GAS bf16_t*)WSP(bf16_t, WS_PR); GAS mx_t* MX = (GAS mx_t*)WSP(mx_t, WS_MX); const GAS bf16_t* Wt = (const GAS bf16_t*)WSP(bf16_t, WS_WS) + (size_t)(j * 8 + g) * 128 * 128;
    const GAS float* vg = (const GAS float*)(a->in[I_EV_V_NORM_G] + j * GW); const GAS float* vb = (const GAS float*)(a->in[I_EV_V_NORM_B] + j * GW); const GAS float* bs = (const GAS float*)(a->in[I_EV_B_S] + (size_t)(j * 8 + g) * 128);
    float vgl[8], vbl[8];
    { const f32x4 g0 = *(const GAS f32x4*)(vg + g * 64 + (lane & 7) * 8), g1 = *(const GAS f32x4*)(vg + g * 64 + (lane & 7) * 8 + 4), b0 = *(const GAS f32x4*)(vb + g * 64 + (lane & 7) * 8), b1 = *(const GAS f32x4*)(vb + g * 64 + (lane & 7) * 8 + 4);
#pragma unroll
      for (int q = 0; q < 4; ++q) { vgl[q] = g0[q]; vgl[4 + q] = g1[q]; vbl[q] = b0[q]; vbl[4 + q] = b1[q]; } }
    for (int L = vcu_; L < BATCH * (SEQ / GCH); L += G_) {
        const size_t tok0 = (size_t)(L >> 4) * SEQ + (size_t)(L & 15) * GCH;
#pragma unroll 1
        for (int t4 = 0; t4 < 16; t4 += 4) { u32x4 wq[4];
#pragma unroll
            for (int q = 0; q < 4; ++q) wq[q] = *(const GAS u32x4*)(PR + (tok0 + g * 16 + t4 + q) * NE_PR + 1024 + 8 * lane);
#pragma unroll
            for (int q = 0; q < 4; ++q) { const int tl = g * 16 + t4 + q; const u32x4 w = wq[q];
                const float x0 = bflo(w.x), x1 = bfhi(w.x), x2 = bflo(w.y), x3 = bfhi(w.y), x4 = bflo(w.z), x5 = bfhi(w.z), x6 = bflo(w.w), x7 = bfhi(w.w);
                const float mu = wave_sum(((x0 + x1) + (x2 + x3)) + ((x4 + x5) + (x6 + x7))) * (1.0f / 512.0f);
                const float d0 = x0 - mu, d1 = x1 - mu, d2 = x2 - mu, d3 = x3 - mu, d4 = x4 - mu, d5 = x5 - mu, d6 = x6 - mu, d7 = x7 - mu;
                const float var = wave_sum(((d0 * d0 + d1 * d1) + (d2 * d2 + d3 * d3)) + ((d4 * d4 + d5 * d5) + (d6 * d6 + d7 * d7))) * (1.0f / 512.0f);
                if (lane == 0) { stat[2 * tl] = mu; stat[2 * tl + 1] = 1.0f / sqrtf(var + LN_EPS); } } }
        __syncthreads();
#pragma unroll 1
        for (int i4 = 0; i4 < 16; i4 += 4) { u32x4 wv[4];
#pragma unroll
            for (int q4 = 0; q4 < 4; ++q4) { const int tl = ((i4 + q4) * 64 + lane) >> 3; wv[q4] = *(const GAS u32x4*)(PR + (tok0 + tl) * NE_PR + 1024 + g * 64 + (lane & 7) * 8); }
#pragma unroll
            for (int q4 = 0; q4 < 4; ++q4) { const int tl = ((i4 + q4) * 64 + lane) >> 3, ch8 = lane & 7; const u32x4 w = wv[q4];
                const float mu = stat[2 * tl], rs = stat[2 * tl + 1];
                float xv[8] = {bflo(w.x), bfhi(w.x), bflo(w.y), bfhi(w.y), bflo(w.z), bfhi(w.z), bflo(w.w), bfhi(w.w)};
#pragma unroll
                for (int q = 0; q < 8; ++q) { const int c = ch8 * 8 + q; const float y = (xv[q] - mu) * rs * vgl[q] + vbl[q];
                    *(LAS bf16_t*)(vT + c * 256 + ((((tl >> 3) ^ (c & 15)) << 4) | ((tl & 7) * 2))) = (bf16_t)f2bf(y); } } }
        LDS_WAIT(); asm volatile("" ::: "memory");
#pragma unroll 1
        for (int mh = 0; mh < 2; ++mh) {
            f32x4 acc[4][4];
#pragma unroll
            for (int mi = 0; mi < 4; ++mi)
#pragma unroll
                for (int ni = 0; ni < 4; ++ni) acc[mi][ni] = (f32x4){0.f, 0.f, 0.f, 0.f};
            bf16x8 afr[4][4];
            { int wrow0 = 64 * mh + (lane & 15); asm volatile("" : "+v"(wrow0));
#pragma unroll
              for (int ks = 0; ks < 4; ++ks)
#pragma unroll
                  for (int mi = 0; mi < 4; ++mi) afr[ks][mi] = *(const GAS bf16x8*)(Wt + (size_t)(wrow0 + 16 * mi) * 128 + 32 * ks + 8 * (lane >> 4)); }
#pragma unroll
            for (int ks = 0; ks < 4; ++ks) { bf16x8 bfr[4];
#pragma unroll
                for (int ni = 0; ni < 4; ++ni) { const int c = 16 * ni + (lane & 15), ch = (ks * 4 + (lane >> 4)) ^ (c & 15); bfr[ni] = *(const LAS bf16x8*)(vT + c * 256 + (ch << 4)); }
#pragma unroll
                for (int mi = 0; mi < 4; ++mi) { if (32 * ks <= 16 * (4 * mh + mi) + 15) {
#pragma unroll
                        for (int ni = 0; ni < 4; ++ni) acc[mi][ni] = __builtin_amdgcn_mfma_f32_16x16x32_bf16(afr[ks][mi], bfr[ni], acc[mi][ni], 0, 0, 0); } } }
#pragma unroll
            for (int mi = 0; mi < 4; ++mi) { int ii0 = 16 * (4 * mh + mi) + 4 * (lane >> 4); asm volatile("" : "+v"(ii0));
                const f32x4 bsv = *(const GAS f32x4*)(bs + ii0); unsigned short uu[4][4];
#pragma unroll
                for (int q = 0; q < 4; ++q)
#pragma unroll
                    for (int ni = 0; ni < 4; ++ni) uu[q][ni] = PR[(tok0 + ii0 + q) * NE_PR + 512 + g * 64 + 16 * ni + (lane & 15)];
#pragma unroll
                for (int q = 0; q < 4; ++q)
#pragma unroll
                    for (int ni = 0; ni < 4; ++ni) MX[(tok0 + ii0 + q) * NMX + 1024 + g * 64 + 16 * ni + (lane & 15)] = mx_cvt(bf2f(uu[q][ni]) * (acc[mi][ni][q] + bsv[q]));
                __builtin_amdgcn_sched_barrier(0); }
        }
        __syncthreads();
    }
}

__device__ __forceinline__ void datt_phase(Frame& F, ArgsP a, int l) {
    PHASE_PROLOG();
    const int j = l >> 1, tid = fresh_tid(), wid = __builtin_amdgcn_readfirstlane(tid >> 6), lane = tid & 63, r32 = lane & 31, hi = lane >> 5;
    LAS char* lds = (LAS char*)F.lds; LAS unsigned* stash = (LAS unsigned*)(lds + att::ATT_LDS_CORE);
    const GAS bf16_t* PR = (const GAS bf16_t*)WSP(bf16_t, WS_PR); GAS mx_t* OA = (GAS mx_t*)WSP(mx_t, WS_MX);
    const float lam_init = 0.8f - 0.6f * expf(-0.3f * (float)l);
    float lam;
    { const float s1 = wave_sum(a->in[I_OD_LQ1][j * 64 + lane] * a->in[I_OD_LK1][j * 64 + lane]), s2 = wave_sum(a->in[I_OD_LQ2][j * 64 + lane] * a->in[I_OD_LK2][j * 64 + lane]);
      lam = expf(s1) - expf(s2) + lam_init; }
    const float* sg = a->in[I_OD_SUBLN_G] + j * 128;
    for (int L = vcu_; L < BATCH * H_C * (SEQ / 256); L += G_) {
        const int qb = 7 - (L >> 8), v = L & 255, b = v >> 3, h = v & 7;
        const size_t rb0 = (size_t)b * SEQ; const int t0w = qb * 256 + 32 * wid, NTB = 4 * qb + 4, NTW = t0w / 64 + 1;
        const float slope2 = exp2f(-(float)(h + 1)) * LOG2E;
#pragma unroll 1
        for (int m = 0; m < 2; ++m) {
            f32x16 o[4]; float l_reg;
            att::attn_core<64, false, false>(PR + (rb0 + t0w) * NO_PR + h * 128 + m * 64, NO_PR, PR + rb0 * NO_PR + 1024 + h * 128 + m * 64, NO_PR, PR + rb0 * NO_PR + 2048 + h * 128, NO_PR,
                                             NTB, NTW, slope2, t0w, nullptr, lds, o, l_reg, wid);
            float rli[16]; att::row_rcp(l_reg, lds, rli, wid);
            if (m == 0) {
#pragma unroll
                for (int d0 = 0; d0 < 4; ++d0)
#pragma unroll
                    for (int r = 0; r < 16; r += 2) stash[(d0 * 8 + (r >> 1)) * 512 + tid] = att::cvtpk(o[d0][r] * rli[r], o[d0][r + 1] * rli[r + 1]);
            } else {
                float ssq[16];
#pragma unroll
                for (int r = 0; r < 16; ++r) ssq[r] = 0.f;
#pragma unroll
                for (int r = 0; r < 16; ++r) rli[r] *= lam;
#pragma unroll
                for (int d0 = 0; d0 < 4; ++d0)
#pragma unroll
                    for (int r = 0; r < 16; r += 2) { const unsigned w = stash[(d0 * 8 + (r >> 1)) * 512 + tid];
                        const float y0 = bflo(w) - rli[r] * o[d0][r], y1 = bfhi(w) - rli[r + 1] * o[d0][r + 1];
                        o[d0][r] = y0; o[d0][r + 1] = y1; ssq[r] += y0 * y0; ssq[r + 1] += y1 * y1; if ((r & 6) == 6) __builtin_amdgcn_sched_barrier(0); }
#pragma unroll
                for (int r = 0; r < 16; ++r) { float s = ssq[r]; s += xshfl<1>(s, 0); s += xshfl<2>(s, 0); s += xshfl<4>(s, 0); s += xshfl<8>(s, 0); s += xshfl<16>(s, 0);
                    ssq[r] = (MX_SCALE * (1.0f - lam_init)) * __builtin_amdgcn_rsqf(s * (1.0f / 128.0f) + LN_EPS); }
                GAS mx_t* Ow = OA + (rb0 + t0w) * D_MODEL + h * 128;
                unsigned lo_ = (unsigned)(hi * 4 * D_MODEL + r32); asm volatile("" : "+v"(lo_));
#pragma unroll
                for (int d0 = 0; d0 < 4; ++d0) { const float gv = sg[d0 * 32 + r32];
#pragma unroll
                    for (int r = 0; r < 16; ++r) Ow[lo_ + (unsigned)(((r & 3) + 8 * (r >> 2)) * D_MODEL + d0 * 32)] = mx_cvt_s(o[d0][r] * ssq[r] * gv);
                    __builtin_amdgcn_sched_barrier(0); }
            }
        }
    }
}

template <int H, int BIT> __device__ __forceinline__ void rs_step(float (&p)[32], int lane) {
    if constexpr (BIT == 32) {
#pragma unroll
        for (int i = 0; i < H; ++i) { unsigned u0, u1; plswap(__builtin_bit_cast(unsigned, p[i]), __builtin_bit_cast(unsigned, p[H + i]), u0, u1);
            p[i] = __builtin_bit_cast(float, u0) + __builtin_bit_cast(float, u1); }
    } else {
        const bool up = (lane & BIT) != 0;
#pragma unroll
        for (int i = 0; i < H; ++i) { const float keep = up ? p[H + i] : p[i], send = up ? p[i] : p[H + i]; p[i] = keep + xshfl<BIT>(send, lane); }
    }
}
template <int N> __device__ __forceinline__ void ln16(float (&v)[16], const float (&gg)[16], const float (&bb)[16]) {
    float s = 0.f;
#pragma unroll
    for (int i = 0; i < 16; ++i) s += v[i];
    const float mean = wave_sum(s) * (1.0f / 1024.0f); float s2 = 0.f;
#pragma unroll
    for (int i = 0; i < 16; ++i) { v[i] -= mean; s2 += v[i] * v[i]; }
    const float rstd = 1.0f / sqrtf(wave_sum(s2) * (1.0f / 1024.0f) + LN_EPS);
#pragma unroll
    for (int i = 0; i < 16; ++i) v[i] = v[i] * rstd * gg[i] + bb[i];
}
__device__ __forceinline__ void lnr_load_ln(const bf16_t* zrow, float* hrow, bf16_t* hbrow, unsigned char* hb8row, const float* g1, const float* b1, int lane, float (&hv)[16]) {
    float gg[16], bb[16];
#pragma unroll
    for (int jj = 0; jj < 4; ++jj) { const u32x2 zw = *(const u32x2*)(zrow + 256 * jj + 4 * lane); const f32x4 z4 = (f32x4){bflo(zw.x), bfhi(zw.x), bflo(zw.y), bfhi(zw.y)}; const f32x4 g4 = *(const f32x4*)(g1 + 256 * jj + 4 * lane), b4 = *(const f32x4*)(b1 + 256 * jj + 4 * lane);
#pragma unroll
        for (int i = 0; i < 4; ++i) { hv[jj * 4 + i] = z4[i]; gg[jj * 4 + i] = g4[i]; bb[jj * 4 + i] = b4[i]; } }
    ln16<0>(hv, gg, bb);
#pragma unroll
    for (int jj = 0; jj < 4; ++jj) {
        u32x2 w; w.x = pk2(hv[jj * 4], hv[jj * 4 + 1]); w.y = pk2(hv[jj * 4 + 2], hv[jj * 4 + 3]); *(u32x2*)(hbrow + 256 * jj + 4 * lane) = w;
#if MOE_FP8
        *(unsigned*)(hb8row + 256 * jj + 4 * lane) = pk4_fp8(hv[jj * 4], hv[jj * 4 + 1], hv[jj * 4 + 2], hv[jj * 4 + 3]);
#endif
    }
}
__device__ __forceinline__ void lnr_tail(Frame& F, unsigned char* ws_, float* gate_out, float (&part)[32], float rbias, int tl, size_t tok, int lane) {
    rs_step<4, 8>(part, lane); rs_step<2, 4>(part, lane); rs_step<1, 2>(part, lane);
    float v = part[0] + xshfl<1>(part[0], lane) + rbias;
    float t0, t1, t2, t3; int e0, e1, e2, e3;
#define LNR_PICK(tk, ek) do { const float m_ = wave_max(v); const unsigned long long bm_ = __builtin_amdgcn_ballot_w64(v == m_); ek = __builtin_ctzll(bm_) >> 1; tk = m_; if ((lane >> 1) == ek) v = -INFINITY; } while (0)
    LNR_PICK(t0, e0); LNR_PICK(t1, e1); LNR_PICK(t2, e2); LNR_PICK(t3, e3);
#undef LNR_PICK
    const float x1 = fast_exp2((t1 - t0) * LOG2E), x2 = fast_exp2((t2 - t0) * LOG2E), x3 = fast_exp2((t3 - t0) * LOG2E);
    const float inv = 1.0f / (1.0f + x1 + x2 + x3);
    if (lane < 4) { const int ek = lane == 0 ? e0 : lane == 1 ? e1 : lane == 2 ? e2 : e3; const float gk = (lane == 0 ? 1.0f : lane == 1 ? x1 : lane == 2 ? x2 : x3) * inv;
        const int lr = __hip_atomic_fetch_add((LAS int*)&F.MISC[MI_LCNT + ek], 1, __ATOMIC_RELAXED, __HIP_MEMORY_SCOPE_WORKGROUP);
        F.MISC[MI_REC + tl * 4 + lane] = (ek << 16) | lr;
        gate_out[tok * 4 + lane] = gk; }
}
__device__ __forceinline__ void lnr_phase(Frame& F, ArgsP a, int l, bool dry = false) {
    PHASE_PROLOG();
    const int tid = fresh_tid(), wid = F.wave, lane = tid & 63;
    LAS float* rws = (LAS float*)F.lds;
    { const float* rw = a->in[I_ROUTER_W] + (size_t)l * 1024 * 32;
      for (int idx = tid; idx < 32768; idx += 512) { const int d = idx >> 5, e = idx & 31, jj = d >> 8, ln = (d & 255) >> 2, i = d & 3; rws[((jj * 4 + i) * 8 + (e >> 2)) * 256 + ln * 4 + (e & 3)] = rw[idx]; } }
    const float* g1 = a->in[I_LN1_G] + l * 1024; const float* b1 = a->in[I_LN1_B] + l * 1024;
    const float rbias = a->in[I_ROUTER_B][l * 32 + ((lane >> 1) & 31)];
    const bf16_t* Z = WSP(bf16_t, WS_Z); float* H32 = a->out; bf16_t* HB = dry ? WSP(bf16_t, WS_PR) : WSP(bf16_t, WS_HB); unsigned char* HB8 = dry ? WSP(unsigned char, WS_QQ) : WSP(unsigned char, WS_HB8);
    float* gate_out = dry ? WSP(float, WS_WI) : WSP(float, WS_GATE); int* rowtok = dry ? WSP(int, WS_MASK) : WSP(int, WS_ROWTOK); unsigned* slot_out = dry ? WSP(unsigned, WS_CKV) : WSP(unsigned, WS_SLOT);
    gu32* cur = F.ctl + CW_CUR + (size_t)(dry ? l + 4 : l) * 32 * 64;
    __syncthreads();
    for (int u = vcu_; u < T_TOK / 256; u += G_) {
        if (tid < 32) F.MISC[MI_LCNT + tid] = 0;
        __syncthreads();
#pragma unroll 1
        for (int tp = 0; tp < 16; ++tp) {
            const int tl0 = wid * 32 + 2 * tp; const size_t tok0 = (size_t)u * 256 + tl0;
            float hv0[16], hv1[16];
            lnr_load_ln(Z + tok0 * D_MODEL, H32 + tok0 * D_MODEL, HB + tok0 * D_MODEL, HB8 + tok0 * D_MODEL, g1, b1, lane, hv0);
            lnr_load_ln(Z + (tok0 + 1) * D_MODEL, H32 + (tok0 + 1) * D_MODEL, HB + (tok0 + 1) * D_MODEL, HB8 + (tok0 + 1) * D_MODEL, g1, b1, lane, hv1);
            __builtin_amdgcn_sched_barrier(0);
            f32x4 pv0[8], pv1[8]; LAS float* rw_ = rws + lane * 4; asm volatile("" : "+v"(rw_));
#pragma unroll
            for (int e = 0; e < 8; ++e) { pv0[e] = (f32x4){0.f, 0.f, 0.f, 0.f}; pv1[e] = (f32x4){0.f, 0.f, 0.f, 0.f}; }
#pragma unroll
            for (int ji = 0; ji < 16; ++ji) {
#pragma unroll
                for (int e4 = 0; e4 < 8; ++e4) { const f32x4 w4 = *(const LAS f32x4*)(rw_ + (ji * 8 + e4) * 256); pv0[e4] += w4 * hv0[ji]; pv1[e4] += w4 * hv1[ji]; }
                __builtin_amdgcn_sched_barrier(0); }
            float part0[32], part1[32];
#pragma unroll
            for (int e = 0; e < 32; ++e) part0[e] = pv0[e >> 2][e & 3];
            rs_step<16, 32>(part0, lane); rs_step<8, 16>(part0, lane);
            __builtin_amdgcn_sched_barrier(0);
#pragma unroll
            for (int e = 0; e < 32; ++e) part1[e] = pv1[e >> 2][e & 3];
            rs_step<16, 32>(part1, lane); rs_step<8, 16>(part1, lane);
            __builtin_amdgcn_sched_barrier(0);
            lnr_tail(F, ws_, gate_out, part0, rbias, tl0, tok0, lane);
            __builtin_amdgcn_sched_barrier(0);
            lnr_tail(F, ws_, gate_out, part1, rbias, tl0 + 1, tok0 + 1, lane);
            __builtin_amdgcn_sched_barrier(0);
        }
        __syncthreads();
        if (tid < 32) { const int c = F.MISC[MI_LCNT + tid]; F.MISC[MI_LBASE + tid] = c ? (int)__hip_atomic_fetch_add(cur + tid * 64, (unsigned)c, RLX_AGENT) : 0; }
        __syncthreads();
        for (int i = tid; i < 1024; i += 512) { const int rec = F.MISC[MI_REC + i], e = rec >> 16, rank = F.MISC[MI_LBASE + e] + (rec & 0xffff); const int tok = u * 256 + (i >> 2);
            rowtok[(size_t)(dry ? (e & 31) : e) * 65536 + (dry ? (rank & 32767) : rank)] = tok; slot_out[(size_t)tok * 4 + (i & 3)] = ((unsigned)e << 20) | (unsigned)rank; }
        __syncthreads();
    }
}

__device__ __forceinline__ void lnr2_phase(Frame& F, ArgsP a, int l, bool dry = false) {
    PHASE_PROLOG();
    const int tid = fresh_tid(), wid = __builtin_amdgcn_readfirstlane(tid >> 6), lane = tid & 63, r32 = lane & 31, hi = lane >> 5;
    LAS unsigned char* Wh = F.lds; LAS unsigned char* Wl = F.lds + 65536;
    LAS float* stats = (LAS float*)(F.lds + RING_BYTES);
    LAS float* cc = (LAS float*)(F.MISC + MI_RBE);
    const float* g1 = a->in[I_LN1_G] + l * 1024; const float* b1 = a->in[I_LN1_B] + l * 1024;
    { const GAS u32x4* img = (const GAS u32x4*)(WSP(unsigned char, WS_WRT) + (size_t)l * 131072);
      u32x4 t_[16];
#pragma unroll
      for (int i = 0; i < 16; ++i) t_[i] = img[tid + 512 * i];
#pragma unroll
      for (int i = 0; i < 16; ++i) *(LAS u32x4*)(F.lds + (tid + 512 * i) * 16) = t_[i];
      if (tid < 64) cc[tid] = WSP(float, WS_WRT + 512 * 1024)[l * 64 + tid]; }
    const GAS bf16_t* Z = (const GAS bf16_t*)WSP(bf16_t, WS_Z); GAS bf16_t* HB = (GAS bf16_t*)(dry ? WSP(bf16_t, WS_PR) : WSP(bf16_t, WS_HB)); GAS unsigned char* HB8 = (GAS unsigned char*)(dry ? WSP(unsigned char, WS_QQ) : WSP(unsigned char, WS_HB8));
    float* gate_out = dry ? WSP(float, WS_WI) : WSP(float, WS_GATE); int* rowtok = dry ? WSP(int, WS_MASK) : WSP(int, WS_ROWTOK); unsigned* slot_out = dry ? WSP(unsigned, WS_CKV) : WSP(unsigned, WS_SLOT);
    GAS float* ST = (GAS float*)(dry ? WSP(float, WS_KI) : WSP(float, WS_STAT));
    gu32* cur = F.ctl + CW_CUR + (size_t)(dry ? l + 4 : l) * 32 * 64;
    float gg[16], bb[16];
#pragma unroll
    for (int jj = 0; jj < 4; ++jj) { const f32x4 g4 = *(const f32x4*)(g1 + 256 * jj + 4 * lane), b4 = *(const f32x4*)(b1 + 256 * jj + 4 * lane);
#pragma unroll
        for (int i = 0; i < 4; ++i) { gg[jj * 4 + i] = g4[i]; bb[jj * 4 + i] = b4[i]; } }
    __syncthreads();
    for (int u = vcu_; u < T_TOK / 256; u += G_) {
        if (tid < 32) F.MISC[MI_LCNT + tid] = 0;
        __syncthreads();
        {
            const int tl = 32 * wid + r32; const size_t tok = (size_t)u * 256 + tl;
            const GAS bf16_t* zp = Z + tok * D_MODEL + 512 * hi;
            const LAS unsigned char* whp = Wh + r32 * 2048; const LAS unsigned char* wlp = Wl + r32 * 2048; const int sw = r32 & 15;
            f32x16 acc = f32x16{}; float sm = 0.f, sq = 0.f;
#pragma unroll 8
            for (int sx = 0; sx < 64; ++sx) { const u32x4 zw = *(const GAS u32x4*)(zp + 8 * sx); const bf16x8 zf = __builtin_bit_cast(bf16x8, zw);
                const int ch = ((64 * hi + sx) ^ sw) << 4;
                const bf16x8 ah = *(const LAS bf16x8*)(whp + ch), al = *(const LAS bf16x8*)(wlp + ch);
                acc = __builtin_amdgcn_mfma_f32_32x32x16_bf16(ah, zf, acc, 0, 0, 0); acc = __builtin_amdgcn_mfma_f32_32x32x16_bf16(al, zf, acc, 0, 0, 0);
#pragma unroll
                for (int q = 0; q < 4; ++q) { const float x0 = bflo(zw[q]), x1 = bfhi(zw[q]); sm += x0 + x1; sq += x0 * x0 + x1 * x1; } }
            { float r0, r1; half_swap(sm, r0, r1); sm = r0 + r1; half_swap(sq, r0, r1); sq = r0 + r1; }
            const float mu = sm * (1.0f / 1024.0f); const float rstd = 1.0f / sqrtf(fmaxf(sq * (1.0f / 1024.0f) - mu * mu, 0.f) + LN_EPS);
            if (hi == 0) { stats[2 * tl] = mu; stats[2 * tl + 1] = rstd; *(GAS f32x2*)(ST + tok * 2) = (f32x2){mu, rstd}; }
            float lg[16];
#pragma unroll
            for (int r = 0; r < 16; ++r) { const int e = att::crow(r, hi); lg[r] = rstd * (acc[r] - mu * cc[e]) + cc[32 + e]; }
            float cv[8]; int ci[8];
#pragma unroll
            for (int k = 0; k < 4; ++k) { float best = -INFINITY; int bid = 0;
#pragma unroll
                for (int r = 0; r < 16; ++r) { const int e = att::crow(r, hi); if (lg[r] > best) { best = lg[r]; bid = e; } }
                cv[k] = best; ci[k] = bid;
#pragma unroll
                for (int r = 0; r < 16; ++r) if (att::crow(r, hi) == bid) lg[r] = -INFINITY; }
#pragma unroll
            for (int k = 0; k < 4; ++k) { unsigned a0, a1, b0, b1; plswap(__builtin_bit_cast(unsigned, cv[k]), __builtin_bit_cast(unsigned, cv[k]), a0, a1); plswap((unsigned)ci[k], (unsigned)ci[k], b0, b1);
                cv[4 + k] = __builtin_bit_cast(float, hi ? a0 : a1); ci[4 + k] = (int)(hi ? b0 : b1); }
            float tv[4]; int te[4];
#pragma unroll
            for (int k = 0; k < 4; ++k) { float best = -INFINITY; int bid = 1 << 20;
#pragma unroll
                for (int i = 0; i < 8; ++i) if (cv[i] > best || (cv[i] == best && ci[i] < bid)) { best = cv[i]; bid = ci[i]; }
                tv[k] = best; te[k] = bid;
#pragma unroll
                for (int i = 0; i < 8; ++i) if (ci[i] == bid) cv[i] = -INFINITY; }
            const float x1 = fast_exp2((tv[1] - tv[0]) * LOG2E), x2 = fast_exp2((tv[2] - tv[0]) * LOG2E), x3 = fast_exp2((tv[3] - tv[0]) * LOG2E);
            const float inv = 1.0f / (1.0f + x1 + x2 + x3);
            if (hi == 0) {
#pragma unroll
                for (int k = 0; k < 4; ++k) { const int lr = __hip_atomic_fetch_add((LAS int*)&F.MISC[MI_LCNT + te[k]], 1, __ATOMIC_RELAXED, __HIP_MEMORY_SCOPE_WORKGROUP);
                    F.MISC[MI_REC + tl * 4 + k] = (te[k] << 16) | lr; }
                *(f32x4*)(gate_out + tok * 4) = (f32x4){inv, x1 * inv, x2 * inv, x3 * inv}; }
        }
        __syncthreads();
#pragma unroll 1
        for (int tp = 0; tp < 32; tp += 4) {
            u32x2 zw[4][4];
#pragma unroll
            for (int q = 0; q < 4; ++q) { const size_t tok = (size_t)u * 256 + 32 * wid + tp + q;
#pragma unroll
                for (int jj = 0; jj < 4; ++jj) zw[q][jj] = *(const GAS u32x2*)(Z + tok * D_MODEL + 256 * jj + 4 * lane); }
#pragma unroll
            for (int q = 0; q < 4; ++q) { const int tl = 32 * wid + tp + q; const size_t tok = (size_t)u * 256 + tl; const float mu = stats[2 * tl], rstd = stats[2 * tl + 1];
#pragma unroll
                for (int jj = 0; jj < 4; ++jj) { const u32x2 w_ = zw[q][jj];
                    const float h0 = (bflo(w_.x) - mu) * rstd * gg[jj * 4] + bb[jj * 4], h1 = (bfhi(w_.x) - mu) * rstd * gg[jj * 4 + 1] + bb[jj * 4 + 1], h2 = (bflo(w_.y) - mu) * rstd * gg[jj * 4 + 2] + bb[jj * 4 + 2], h3 = (bfhi(w_.y) - mu) * rstd * gg[jj * 4 + 3] + bb[jj * 4 + 3];
#if MOE_FP8
                    *(GAS unsigned*)(HB8 + tok * D_MODEL + 256 * jj + 4 * lane) = pk4_fp8(h0, h1, h2, h3);
#else
                    u32x2 w; w.x = pk2(h0, h1); w.y = pk2(h2, h3); *(GAS u32x2*)(HB + tok * D_MODEL + 256 * jj + 4 * lane) = w;
#endif
                } } }
        if (tid < 32) { const int c = F.MISC[MI_LCNT + tid]; F.MISC[MI_LBASE + tid] = c ? (int)__hip_atomic_fetch_add(cur + tid * 64, (unsigned)c, RLX_AGENT) : 0; }
        __syncthreads();
        for (int i = tid; i < 1024; i += 512) { const int rec = F.MISC[MI_REC + i], e = rec >> 16, rank = F.MISC[MI_LBASE + e] + (rec & 0xffff); const int tok = u * 256 + (i >> 2);
            rowtok[(size_t)(dry ? (e & 31) : e) * 65536 + (dry ? (rank & 32767) : rank)] = tok; slot_out[(size_t)tok * 4 + (i & 3)] = ((unsigned)e << 20) | (unsigned)rank; }
        __syncthreads();
    }
}

__device__ __forceinline__ void moe_tables(Frame& F, int l) {
    const int tid = fresh_tid();
    __syncthreads();
    if (tid < 32) F.MISC[MI_CNT + tid] = (int)__hip_atomic_load(F.ctl + CW_CUR + (size_t)(l * 32 + tid) * 64, RLX_AGENT);
    __syncthreads();
    if (tid == 0) { int acc = 0; for (int e = 0; e < 32; ++e) { F.MISC[MI_RBSTART + e] = acc; acc += (F.MISC[MI_CNT + e] + 255) >> 8; } F.MISC[MI_RBSTART + 32] = acc; }
    __syncthreads();
    const int nrb = F.MISC[MI_RBSTART + 32];
    for (int rb = tid; rb < nrb; rb += 512) { int e = 0; while (e < 31 && F.MISC[MI_RBSTART + e + 1] <= rb) ++e; F.MISC[MI_RBE + rb] = e; }
    __syncthreads();
}

__device__ __forceinline__ void cmb_phase(Frame& F, ArgsP a, int l, bool dry = false, bool tables = true) {
    PHASE_PROLOG();
    if (tables) moe_tables(F, l);
    const int lane = fresh_tid() & 63; const int gw = vcu_ * 8 + F.wave, NGW = G_ * 8;
    float gg[16], bb[16];
#pragma unroll
    for (int jj = 0; jj < 4; ++jj) { const f32x4 g4 = *(const f32x4*)(a->in[I_LN2_G] + l * 1024 + 256 * jj + 4 * lane), b4 = *(const f32x4*)(a->in[I_LN2_B] + l * 1024 + 256 * jj + 4 * lane);
#pragma unroll
        for (int i = 0; i < 4; ++i) { gg[jj * 4 + i] = g4[i]; bb[jj * 4 + i] = b4[i]; } }
    float ag1[16], ab1[16];
#pragma unroll
    for (int jj = 0; jj < 4; ++jj) { const f32x4 g4 = *(const f32x4*)(a->in[I_LN1_G] + l * 1024 + 256 * jj + 4 * lane), b4 = *(const f32x4*)(a->in[I_LN1_B] + l * 1024 + 256 * jj + 4 * lane);
#pragma unroll
        for (int i = 0; i < 4; ++i) { ag1[jj * 4 + i] = DN_ALPHA * g4[i]; ab1[jj * 4 + i] = DN_ALPHA * b4[i]; } }
    const GAS bf16_t* Zr = (const GAS bf16_t*)WSP(bf16_t, WS_Z); const GAS float* ST = (const GAS float*)WSP(float, WS_STAT);
    GAS float* H32 = (GAS float*)(dry ? WSP(float, WS_PR) : a->out); const GAS bf16_t* HB = (const GAS bf16_t*)WSP(bf16_t, WS_HB); GAS bf16_t* HBo = (GAS bf16_t*)(dry ? WSP(bf16_t, WS_PR) : WSP(bf16_t, WS_HB)); const GAS bf16_t* Y = (const GAS bf16_t*)WSP(bf16_t, WS_Y);
    for (int tok = gw; tok < T_TOK; tok += NGW) {
        const unsigned sl = ((const GAS unsigned*)WSP(unsigned, WS_SLOT))[(size_t)tok * 4 + (lane & 3)]; const float gt = ((const GAS float*)WSP(float, WS_GATE))[(size_t)tok * 4 + (lane & 3)];
        float z[16];
#if MOE_FP8
        const f32x2 st = *(const GAS f32x2*)(ST + (size_t)tok * 2); const float mu = st.x, rs = st.y;
#pragma unroll
        for (int jj = 0; jj < 4; ++jj) { const u32x2 hw = *(const GAS u32x2*)(Zr + (size_t)tok * D_MODEL + 256 * jj + 4 * lane);
            z[jj * 4] = (bflo(hw.x) - mu) * rs * ag1[jj * 4] + ab1[jj * 4]; z[jj * 4 + 1] = (bfhi(hw.x) - mu) * rs * ag1[jj * 4 + 1] + ab1[jj * 4 + 1];
            z[jj * 4 + 2] = (bflo(hw.y) - mu) * rs * ag1[jj * 4 + 2] + ab1[jj * 4 + 2]; z[jj * 4 + 3] = (bfhi(hw.y) - mu) * rs * ag1[jj * 4 + 3] + ab1[jj * 4 + 3]; }
#else
#pragma unroll
        for (int jj = 0; jj < 4; ++jj) { const u32x2 hw = *(const GAS u32x2*)(HB + (size_t)tok * D_MODEL + 256 * jj + 4 * lane);
            z[jj * 4] = DN_ALPHA * bflo(hw.x); z[jj * 4 + 1] = DN_ALPHA * bfhi(hw.x); z[jj * 4 + 2] = DN_ALPHA * bflo(hw.y); z[jj * 4 + 3] = DN_ALPHA * bfhi(hw.y); }
#endif
#pragma unroll
        for (int k = 0; k < 4; ++k) { const unsigned sk = (unsigned)__builtin_amdgcn_readlane((int)sl, k); const float gk = __builtin_bit_cast(float, __builtin_amdgcn_readlane(__builtin_bit_cast(int, gt), k));
            const int e = (int)(sk >> 20), rank = (int)(sk & 0xfffffu); const size_t row = (size_t)F.MISC[MI_RBSTART + e] * 256 + rank;
#if MOE_FP8
            const GAS unsigned char* y = (const GAS unsigned char*)Y + row * D_MODEL + 4 * lane; const float gs = gk * (1.0f / 64.0f);
#pragma unroll
            for (int jj = 0; jj < 4; ++jj) { const int w = *(const GAS int*)(y + 256 * jj);
                z[jj * 4] += gs * __builtin_amdgcn_cvt_f32_fp8(w, 0); z[jj * 4 + 1] += gs * __builtin_amdgcn_cvt_f32_fp8(w, 1); z[jj * 4 + 2] += gs * __builtin_amdgcn_cvt_f32_fp8(w, 2); z[jj * 4 + 3] += gs * __builtin_amdgcn_cvt_f32_fp8(w, 3); } }
#else
            const bf16_t* y = Y + row * D_MODEL + 4 * lane;
#pragma unroll
            for (int jj = 0; jj < 4; ++jj) { const u32x2 w = *(const u32x2*)(y + 256 * jj); z[jj * 4] += gk * bflo(w.x); z[jj * 4 + 1] += gk * bfhi(w.x); z[jj * 4 + 2] += gk * bflo(w.y); z[jj * 4 + 3] += gk * bfhi(w.y); } }
#endif
        ln16<0>(z, gg, bb);
#pragma unroll
        for (int jj = 0; jj < 4; ++jj) { if (l == DEPTH - 1) *(GAS f32x4*)(H32 + (size_t)tok * D_MODEL + 256 * jj + 4 * lane) = (f32x4){z[jj * 4], z[jj * 4 + 1], z[jj * 4 + 2], z[jj * 4 + 3]};
            else { u32x2 w; w.x = pk2(z[jj * 4], z[jj * 4 + 1]); w.y = pk2(z[jj * 4 + 2], z[jj * 4 + 3]); *(GAS u32x2*)(HBo + (size_t)tok * D_MODEL + 256 * jj + 4 * lane) = w; } }
    }
}
#if MK_CHECK
constexpr int CW_CHK = 32768, N_CHK = 16, CHK_NS = 64;
__device__ __forceinline__ int chk_tok(int i) { return (i * 1021 + 77) & 65535; }
__device__ __forceinline__ void chk_put(Frame& F, int k, float err, float ref) {
    if (!(err == err)) err = 1e30f;
    err = wave_max(err); ref = wave_max(ref);
    if ((fresh_tid() & 63) == 0) { __hip_atomic_fetch_max(F.ctl + CW_CHK + 2 * k, __builtin_bit_cast(unsigned, err), RLX_AGENT); __hip_atomic_fetch_max(F.ctl + CW_CHK + 2 * k + 1, __builtin_bit_cast(unsigned, ref), RLX_AGENT); }
}
__device__ __forceinline__ float nanfix(float d) { return (d == d) ? d : 1e30f; }
__device__ __forceinline__ float chk_dot_bf(const bf16_t* x, const bf16_t* y, int n, int lane) { float s = 0.f; for (int k = lane; k < n; k += 64) s += bf2f(x[k]) * bf2f(y[k]); return wave_sum(s); }

__device__ __forceinline__ void chk_gemm(Frame& F, ArgsP a, int l, int which) {
    PHASE_PROLOG(); const int lane = fresh_tid() & 63, gw = vcu_ * 8 + F.wave, NGW = G_ * 8; const bool odd = l & 1; const int j = l >> 1;
    float err = 0.f, ref = 0.f, errg = 0.f, refg = 0.f;
    for (int si = gw; si < CHK_NS * 8; si += NGW) { const int tok = chk_tok(si >> 3), ci = si & 7;
        if (which == 1) { const int colsE[8] = {5, 300, 390, 449, 460, 700, 1100, 1500}, colsO[8] = {5, 1000, 1100, 2000, 2100, 3000, 3071, 64};
            int col = 0;
#pragma unroll
            for (int q = 0; q < 8; ++q) if (ci == q) col = odd ? colsO[q] : colsE[q];
            const int N = odd ? NO_PR : NE_PR; const bf16_t* W = odd ? WSP(bf16_t, WS_WINO) + ((size_t)j * NO_PR + col) * 1024 : WSP(bf16_t, WS_WINE) + ((size_t)j * NE_PR + col) * 1024;
            float v = chk_dot_bf(WSP(bf16_t, WS_HB) + (size_t)tok * 1024, W, 1024, lane); if (!odd && col >= 512) v = gelu_tanh(v);
            const float f = bf2f(WSP(bf16_t, WS_PR)[(size_t)tok * N + col]);
            if (!odd && col >= 512) { errg = fmaxf(errg, nanfix(fabsf(f - v))); refg = fmaxf(refg, fabsf(v)); } else { err = fmaxf(err, nanfix(fabsf(f - v))); ref = fmaxf(ref, fabsf(v)); } }
        else if (which == 3) { const int cols[8] = {3, 500, 1023, 1030, 1279, 1100, 128, 1200}; int col = 0;
#pragma unroll
            for (int q = 0; q < 8; ++q) if (ci == q) col = cols[q];
            const float v = chk_dot_bf(WSP(bf16_t, WS_CQ) + (size_t)tok * 256, WSP(bf16_t, WS_WQE) + ((size_t)j * NQQ + col) * 256, 256, lane);
            const float f = bf2f(WSP(bf16_t, WS_QQ)[(size_t)tok * NQQ + col]); err = fmaxf(err, nanfix(fabsf(f - v))); ref = fmaxf(ref, fabsf(v)); }
        else { const int cols[8] = {1, 300, 600, 1023, 255, 256, 777, 512}; int col = 0;
#pragma unroll
            for (int q = 0; q < 8; ++q) if (ci == q) col = cols[q];
            const int K = odd ? 1024 : NMX; const bf16_t* W = odd ? WSP(bf16_t, WS_WOUTO) + ((size_t)j * 1024 + col) * 1024 : WSP(bf16_t, WS_WOUTE) + ((size_t)j * 1024 + col) * NMX;
            const float hs = (l == 0 ? a->in[I_X] : (const float*)a->out)[(size_t)tok * 1024 + col];
            const float v = DN_ALPHA * hs + chk_dot_bf(WSP(bf16_t, WS_MX) + (size_t)tok * K, W, K, lane);
            const float f = WSP(float, WS_Z)[(size_t)tok * 1024 + col]; err = fmaxf(err, nanfix(fabsf(f - v))); ref = fmaxf(ref, fabsf(v)); }
    }
    if (which == 1) { if (odd) chk_put(F, 14, err, ref); else { chk_put(F, 1, err, ref); chk_put(F, 13, errg, refg); } } else chk_put(F, which, err, ref);
}
__device__ __forceinline__ void chk_e1b(Frame& F, ArgsP a, int l) {
    PHASE_PROLOG(); const int lane = fresh_tid() & 63, gw = vcu_ * 8 + F.wave, NGW = G_ * 8, j = l >> 1; float err = 0.f, ref = 0.f;
    for (int si = gw; si < CHK_NS; si += NGW) { const int tok = chk_tok(si); const bf16_t* pr = WSP(bf16_t, WS_PR) + (size_t)tok * NE_PR;
        float x[4], ss = 0.f;
#pragma unroll
        for (int i = 0; i < 4; ++i) { x[i] = bf2f(pr[lane + 64 * i]); ss += x[i] * x[i]; }
        ss = wave_sum(ss); float rs = 1.0f / sqrtf(ss / 256.0f + LN_EPS);
#pragma unroll
        for (int i = 0; i < 4; ++i) { const float v = x[i] * rs * a->in[I_EV_Q_NORM][j * 256 + lane + 64 * i]; err = fmaxf(err, nanfix(fabsf(v - bf2f(WSP(bf16_t, WS_CQ)[(size_t)tok * 256 + lane + 64 * i])))); ref = fmaxf(ref, fabsf(v)); }
        float y0 = bf2f(pr[256 + lane]), y1 = bf2f(pr[256 + 64 + lane]); ss = wave_sum(y0 * y0 + y1 * y1); rs = 1.0f / sqrtf(ss / 128.0f + LN_EPS);
        { const float v0 = y0 * rs * a->in[I_EV_KV_NORM][j * 128 + lane], v1 = y1 * rs * a->in[I_EV_KV_NORM][j * 128 + 64 + lane];
          err = fmaxf(err, nanfix(fabsf(v0 - bf2f(WSP(bf16_t, WS_CKV)[(size_t)tok * 128 + lane])))); err = fmaxf(err, nanfix(fabsf(v1 - bf2f(WSP(bf16_t, WS_CKV)[(size_t)tok * 128 + 64 + lane])))); }
        { const float z = bf2f(pr[384 + lane]); const float mu = wave_sum(z) / 64.0f; const float var = wave_sum((z - mu) * (z - mu)) / 64.0f;
          const float v = (z - mu) / sqrtf(var + LN_EPS) * a->in[I_EV_IDX_K_G][j * 64 + lane] + a->in[I_EV_IDX_K_B][j * 64 + lane];
          err = fmaxf(err, nanfix(fabsf(v - bf2f(WSP(bf16_t, WS_KI)[(size_t)tok * 64 + lane])))); ref = fmaxf(ref, fabsf(v)); }
        if (lane < 4) err = fmaxf(err, nanfix(fabsf(0.5f * bf2f(pr[448 + lane]) - WSP(float, WS_WI)[(size_t)tok * 4 + lane])));
    }
    chk_put(F, 2, err, ref);
}
__device__ __forceinline__ void chk_dsa(Frame& F, ArgsP a, int l) {
    PHASE_PROLOG(); const int lane = fresh_tid() & 63, gw = vcu_ * 8 + F.wave, NGW = G_ * 8; float err4 = 0.f, ref4 = 1e-20f, err5 = 0.f, ref5 = 0.f;
    LAS float* pl = (LAS float*)F.lds + F.wave * 2048;
    const bf16_t* QQ = WSP(bf16_t, WS_QQ); const bf16_t* KI = WSP(bf16_t, WS_KI); const bf16_t* CKV = WSP(bf16_t, WS_CKV);
    for (int si = gw; si < CHK_NS; si += NGW) { const int tok = chk_tok(si), b = tok >> 11, t = tok & 2047, NT = t / 64 + 1, N = NT * 64; const size_t rb0 = (size_t)b * SEQ;
        int npop = 0; float minsel = 1e30f, maxun = -1e30f, maxabs = 0.f; int maxselzero = -1, minunzero = 1 << 20;
        for (int i = 0; i < NT; ++i) { const int s = i * 64 + lane; float sc = 0.f;
            for (int h = 0; h < 4; ++h) { float d = 0.f; for (int k = 0; k < 64; ++k) d += bf2f(QQ[(size_t)tok * NQQ + 1024 + h * 64 + k]) * bf2f(KI[(rb0 + s) * 64 + k]); sc += fmaxf(d, 0.f) * WSP(float, WS_WI)[(size_t)tok * 4 + h]; }
            sc += 0.0f;
            const unsigned long long mw = WSP(unsigned long long, WS_MASK)[(size_t)tok * 32 + i]; const bool sel = (mw >> lane) & 1ull;
            npop += sel ? 1 : 0; maxabs = fmaxf(maxabs, fabsf(sc));
            if (sel) { minsel = fminf(minsel, sc); if (sc == 0.f) maxselzero = max(maxselzero, s); } else { maxun = fmaxf(maxun, sc); if (sc == 0.f) minunzero = min(minunzero, s); } }
        for (int i = NT; i < 32; ++i) if (WSP(unsigned long long, WS_MASK)[(size_t)tok * 32 + i] != 0ull) err4 = 1e30f;
        npop = (int)wave_sum((float)npop); minsel = -wave_max(-minsel); maxun = wave_max(maxun); maxabs = wave_max(maxabs);
        maxselzero = (int)wave_max((float)maxselzero); minunzero = -(int)wave_max(-(float)minunzero);
        if (npop != (N < N_SEL ? N : N_SEL)) err4 = 1e30f;
        if (N > N_SEL) { err4 = fmaxf(err4, maxun - minsel); if (minsel == 0.f && maxun == 0.f && maxselzero > minunzero) err4 = 1e30f; }
        ref4 = fmaxf(ref4, maxabs / 30.0f);
        const int h = si & 7; const float slope2 = exp2f(-(float)(h + 1)) * LOG2E; float mx = -1e30f;
        for (int i = 0; i < NT; ++i) { const int s = i * 64 + lane; float d = 0.f; for (int k = 0; k < 128; ++k) d += bf2f(QQ[(size_t)tok * NQQ + h * 128 + k]) * bf2f(CKV[(rb0 + s) * 128 + k]);
            d -= slope2 * fabsf((float)(t - s)); const unsigned long long mw = WSP(unsigned long long, WS_MASK)[(size_t)tok * 32 + i]; if (!((mw >> lane) & 1ull)) d = -1e30f; pl[s] = d; mx = fmaxf(mx, d); }
        mx = wave_max(mx); float sum = 0.f;
        for (int i = 0; i < NT; ++i) { const int s = i * 64 + lane; const float p = fast_exp2(pl[s] - mx); pl[s] = p; sum += p; }
        sum = wave_sum(sum); LDS_WAIT();
        for (int cc = 0; cc < 2; ++cc) { const int c = lane + 64 * cc; float o = 0.f; for (int s = 0; s < N; ++s) o += pl[s] * bf2f(CKV[(rb0 + s) * 128 + c]); o /= sum;
            const float f = bf2f(WSP(bf16_t, WS_MX)[(size_t)tok * NMX + h * 128 + c]); err5 = fmaxf(err5, nanfix(fabsf(f - o))); ref5 = fmaxf(ref5, fabsf(o)); }
        LDS_WAIT();
    }
    chk_put(F, 4, err4, ref4); chk_put(F, 5, err5, ref5);
}
__device__ __forceinline__ void chk_gml(Frame& F, ArgsP a, int l) {
    PHASE_PROLOG(); const int lane = fresh_tid() & 63, gw = vcu_ * 8 + F.wave, NGW = G_ * 8, j = l >> 1; float err = 0.f, ref = 0.f;
    const bf16_t* PR = WSP(bf16_t, WS_PR);
    for (int si = gw; si < CHK_NS; si += NGW) { const int tok = chk_tok(si), g = si & 7, ii = tok & 127; const size_t tok0 = (size_t)(tok - ii); float mixed = 0.f;
        for (int jx = 0; jx <= ii; ++jx) { const bf16_t* vr = PR + (tok0 + jx) * NE_PR + 1024; float xs[8], s = 0.f;
#pragma unroll
            for (int q = 0; q < 8; ++q) { xs[q] = bf2f(vr[lane + 64 * q]); s += xs[q]; }
            const float mu = wave_sum(s) / 512.0f; float s2 = 0.f;
#pragma unroll
            for (int q = 0; q < 8; ++q) s2 += (xs[q] - mu) * (xs[q] - mu);
            const float rs = 1.0f / sqrtf(wave_sum(s2) / 512.0f + LN_EPS);
            const float vln = (bf2f(vr[g * 64 + lane]) - mu) * rs * a->in[I_EV_V_NORM_G][j * GW + g * 64 + lane] + a->in[I_EV_V_NORM_B][j * GW + g * 64 + lane];
            mixed += a->in[I_EV_W_S][((size_t)(j * 8 + g) * 128 + ii) * 128 + jx] * vln; }
        mixed += a->in[I_EV_B_S][(size_t)(j * 8 + g) * 128 + ii];
        const float v = bf2f(PR[(size_t)tok * NE_PR + 512 + g * 64 + lane]) * mixed; const float f = bf2f(WSP(bf16_t, WS_MX)[(size_t)tok * NMX + 1024 + g * 64 + lane]);
        err = fmaxf(err, nanfix(fabsf(f - v))); ref = fmaxf(ref, fabsf(v)); }
    chk_put(F, 6, err, ref);
}
__device__ __forceinline__ void chk_lnr(Frame& F, ArgsP a, int l) {
    PHASE_PROLOG(); const int lane = fresh_tid() & 63, gw = vcu_ * 8 + F.wave, NGW = G_ * 8; float err = 0.f, ref = 0.f;
    for (int si = gw; si < CHK_NS; si += NGW) { const int tok = chk_tok(si); const float* z = WSP(float, WS_Z) + (size_t)tok * 1024; float x[16], s = 0.f;
#pragma unroll
        for (int i = 0; i < 16; ++i) { x[i] = z[lane + 64 * i]; s += x[i]; }
        const float mu = wave_sum(s) / 1024.0f; float s2 = 0.f;
#pragma unroll
        for (int i = 0; i < 16; ++i) s2 += (x[i] - mu) * (x[i] - mu);
        const float rs = 1.0f / sqrtf(wave_sum(s2) / 1024.0f + LN_EPS);
#pragma unroll
        for (int i = 0; i < 16; ++i) { x[i] = (x[i] - mu) * rs * a->in[I_LN1_G][l * 1024 + lane + 64 * i] + a->in[I_LN1_B][l * 1024 + lane + 64 * i];
            err = fmaxf(err, nanfix(fabsf(x[i] - a->out[(size_t)tok * 1024 + lane + 64 * i]))); err = fmaxf(err, nanfix(fabsf(x[i] - bf2f(WSP(bf16_t, WS_HB)[(size_t)tok * 1024 + lane + 64 * i])) * 0.25f)); ref = fmaxf(ref, fabsf(x[i])); }
        float lg = 0.f;
        for (int e = 0; e < 32; ++e) { float p = 0.f;
#pragma unroll
            for (int i = 0; i < 16; ++i) p += x[i] * a->in[I_ROUTER_W][((size_t)l * 1024 + lane + 64 * i) * 32 + e];
            p = wave_sum(p) + a->in[I_ROUTER_B][l * 32 + e]; if (lane == e) lg = p; }
        if (lane >= 32) lg = -1e30f;
        float tl[4]; int te[4]; float v = lg;
        for (int k = 0; k < 4; ++k) { const float m = wave_max(v); const unsigned long long bm = __builtin_amdgcn_ballot_w64(v == m); te[k] = __builtin_ctzll(bm); tl[k] = m; if (lane == te[k]) v = -1e30f; }
        const float den = 1.0f + expf(tl[1] - tl[0]) + expf(tl[2] - tl[0]) + expf(tl[3] - tl[0]);
        for (int k = 0; k < 4; ++k) { const unsigned sl = WSP(unsigned, WS_SLOT)[(size_t)tok * 4 + k]; const int e = (int)(sl >> 20), rank = (int)(sl & 0xfffffu);
            if (e != te[k]) {
                const float mine = __builtin_bit_cast(float, __builtin_amdgcn_ds_bpermute(e << 2, __builtin_bit_cast(int, lg)));
                if (fabsf(mine - tl[k]) > 1e-4f) err = 1e30f; }
            if (WSP(int, WS_ROWTOK)[(size_t)e * 65536 + rank] != tok) err = 1e30f;
            const float gk = expf(tl[k] - tl[0]) / den; err = fmaxf(err, nanfix(fabsf(gk - WSP(float, WS_GATE)[(size_t)tok * 4 + k]))); }
    }
    chk_put(F, 8, err, ref);
}
__device__ __forceinline__ void chk_moe(Frame& F, ArgsP a, int l) {
    PHASE_PROLOG(); const int lane = fresh_tid() & 63, gw = vcu_ * 8 + F.wave, NGW = G_ * 8; float err = 0.f, ref = 0.f;
    LAS float* al = (LAS float*)F.lds + F.wave * 1024;
    for (int si = gw; si < CHK_NS; si += NGW) { const int tok = chk_tok(si), k = si & 3; const unsigned sl = WSP(unsigned, WS_SLOT)[(size_t)tok * 4 + k]; const int e = (int)(sl >> 20), rank = (int)(sl & 0xfffffu);
        int rbs = 0; for (int q = 0; q < e; ++q) rbs += ((int)__hip_atomic_load(F.ctl + CW_CUR + (size_t)(l * 32 + q) * 64, RLX_AGENT) + 255) >> 8;
        const size_t crow = (size_t)rbs * 256 + rank;
        const float* wgu = a->in[I_EXP_W_GU] + ((size_t)l * NEXP + e) * 1024 * 2048; const float* wdn = a->in[I_EXP_W_DN] + ((size_t)l * NEXP + e) * 1024 * 1024;
        const bf16_t* hb = WSP(bf16_t, WS_HB) + (size_t)tok * 1024;
        float ag[16], au[16];
#pragma unroll
        for (int i = 0; i < 16; ++i) { ag[i] = 0.f; au[i] = 0.f; }
        for (int kk = 0; kk < 1024; ++kk) { const float hv = bf2f(hb[kk]);
#pragma unroll
            for (int i = 0; i < 16; ++i) { ag[i] += hv * wgu[(size_t)kk * 2048 + lane + 64 * i]; au[i] += hv * wgu[(size_t)kk * 2048 + 1024 + lane + 64 * i]; } }
#pragma unroll
        for (int i = 0; i < 16; ++i) { const int f = lane + 64 * i; float gt = ag[i] + a->in[I_EXP_B_GU][((size_t)l * NEXP + e) * 2048 + f], up = au[i] + a->in[I_EXP_B_GU][((size_t)l * NEXP + e) * 2048 + 1024 + f];
            gt = fminf(gt, 7.0f); up = fminf(fmaxf(up, -7.0f), 7.0f); const float act = (up + 1.0f) * gt / (1.0f + expf(-1.702f * gt)); al[f] = act;
            const float fa = bf2f(WSP(bf16_t, WS_ACT)[crow * 1024 + f]); err = fmaxf(err, nanfix(fabsf(fa - act))); ref = fmaxf(ref, fabsf(act)); }
        LDS_WAIT();
#pragma unroll
        for (int ci = 0; ci < 4; ++ci) { const int col = ci == 0 ? 0 : ci == 1 ? 511 : ci == 2 ? 1023 : 700; float s = 0.f; for (int f = lane; f < 1024; f += 64) s += al[f] * wdn[(size_t)f * 1024 + col];
            s = wave_sum(s) + a->in[I_EXP_B_DN][((size_t)l * NEXP + e) * 1024 + col]; const float fy = bf2f(WSP(bf16_t, WS_Y)[crow * 1024 + col]);
            err = fmaxf(err, nanfix(fabsf(fy - s)) * 2.0f); ref = fmaxf(ref, fabsf(s)); }
        LDS_WAIT();
    }
    chk_put(F, 9, err, ref);
}
__device__ __forceinline__ void chk_datt(Frame& F, ArgsP a, int l) {
    PHASE_PROLOG(); const int lane = fresh_tid() & 63, gw = vcu_ * 8 + F.wave, NGW = G_ * 8, j = l >> 1; float err = 0.f, ref = 0.f;
    LAS float* pl = (LAS float*)F.lds + F.wave * 2048; const bf16_t* PR = WSP(bf16_t, WS_PR);
    const float lam_init = 0.8f - 0.6f * expf(-0.3f * (float)l);
    const float lam = expf(wave_sum(a->in[I_OD_LQ1][j * 64 + lane] * a->in[I_OD_LK1][j * 64 + lane])) - expf(wave_sum(a->in[I_OD_LQ2][j * 64 + lane] * a->in[I_OD_LK2][j * 64 + lane])) + lam_init;
    for (int si = gw; si < CHK_NS; si += NGW) { const int tok = chk_tok(si), b = tok >> 11, t = tok & 2047, NT = t / 64 + 1, N = NT * 64, h = si & 7; const size_t rb0 = (size_t)b * SEQ;
        const float slope2 = exp2f(-(float)(h + 1)) * LOG2E; float oc[2][2];
        for (int m = 0; m < 2; ++m) { float mx = -1e30f;
            for (int i = 0; i < NT; ++i) { const int s = i * 64 + lane; float d = 0.f; for (int k = 0; k < 64; ++k) d += bf2f(PR[(size_t)tok * NO_PR + h * 128 + m * 64 + k]) * bf2f(PR[(rb0 + s) * NO_PR + 1024 + h * 128 + m * 64 + k]);
                d -= slope2 * fabsf((float)(t - s)); pl[s] = d; mx = fmaxf(mx, d); }
            mx = wave_max(mx); float sum = 0.f;
            for (int i = 0; i < NT; ++i) { const int s = i * 64 + lane; const float p = fast_exp2(pl[s] - mx); pl[s] = p; sum += p; }
            sum = wave_sum(sum); LDS_WAIT();
            for (int cc = 0; cc < 2; ++cc) { const int c = lane + 64 * cc; float o = 0.f; for (int s = 0; s < N; ++s) o += pl[s] * bf2f(PR[(rb0 + s) * NO_PR + 2048 + h * 128 + c]); oc[m][cc] = o / sum; }
            LDS_WAIT(); }
        const float y0 = oc[0][0] - lam * oc[1][0], y1 = oc[0][1] - lam * oc[1][1]; const float rs = (1.0f - lam_init) / sqrtf(wave_sum(y0 * y0 + y1 * y1) / 128.0f + LN_EPS);
        const float v0 = y0 * rs * a->in[I_OD_SUBLN_G][j * 128 + lane], v1 = y1 * rs * a->in[I_OD_SUBLN_G][j * 128 + 64 + lane];
        const float f0 = bf2f(WSP(bf16_t, WS_MX)[(size_t)tok * 1024 + h * 128 + lane]), f1 = bf2f(WSP(bf16_t, WS_MX)[(size_t)tok * 1024 + h * 128 + 64 + lane]);
        err = fmaxf(err, nanfix(fabsf(f0 - v0))); err = fmaxf(err, nanfix(fabsf(f1 - v1))); ref = fmaxf(ref, fmaxf(fabsf(v0), fabsf(v1))); }
    chk_put(F, 11, err, ref);
}
__device__ __forceinline__ void chk_final(Frame& F, ArgsP a) {
    PHASE_PROLOG(); int code = 0;
    for (int k = N_CHK - 1; k >= 1; --k) { const float e = __builtin_bit_cast(float, __hip_atomic_load(F.ctl + CW_CHK + 2 * k, RLX_AGENT)), r = __builtin_bit_cast(float, __hip_atomic_load(F.ctl + CW_CHK + 2 * k + 1, RLX_AGENT));
        if (e > 0.03f * r) code = k; }
    if (code == 0) return;
    const float sc = 1.0f + 0.05f * (float)code; const int gt = vcu_ * 512 + fresh_tid(), NGT = G_ * 512;
    for (size_t i = gt; i < (size_t)T_TOK * 1024; i += NGT) a->out[i] *= sc;
}
#endif
constexpr int N_PHASES = 10;
__global__ void __launch_bounds__(512, 2) mk_fwd(Args a) {
    extern __shared__ __attribute__((aligned(16))) unsigned char lds_raw[];
    Frame F;
    F.lds = (LAS unsigned char*)lds_raw; F.ldsg = (char*)lds_raw;
    F.MISC = (volatile LAS int*)(F.lds + MISC_OFF);
    F.tid = threadIdx.x; F.lane = F.tid & 63; F.wave = __builtin_amdgcn_readfirstlane(F.tid >> 6);
    F.G = gridDim.x; { const int bx = blockIdx.x; F.vcu = (F.G % 8 == 0) ? (bx % 8) * (F.G / 8) + bx / 8 : bx; }
    ArgsP ap = (ArgsP)__builtin_amdgcn_kernarg_segment_ptr();
    F.ws = ap->ws; F.ctl = (gu32*)(ap->ws + WS_CTL);
    const int a_fused = ap->fused, a_llo = ap->l_lo, a_lhi = ap->l_hi, a_plo0 = ap->p_lo, a_phi0 = ap->p_hi, a_pro = ap->do_pro;
    for (int u = F.tid; u < (LDS_BYTES - MISC_OFF) / 4; u += 512) F.MISC[u] = 0;
    __syncthreads();
    XcdBarrier bar; bar.bar = (unsigned*)(F.ctl + CW_BAR); bar.x = 0; bar.st = nullptr; bar.w = (unsigned)F.wave;
    if (a_fused) bar = xcd_barrier_post((unsigned*)(F.ctl + CW_BAR), (volatile LAS unsigned*)(F.MISC + MI_BAR));
#define GRID_BAR() do { if (a_fused) xcd_barrier(bar); } while (0)
#define KPROLOG() ArgsP a = ap; unsigned char* ws_ = F.ws; asm volatile("" : "+s"(ws_)); asm volatile("" : "+s"(a)); int vcu_ = F.vcu, G_ = F.G, bx_ = (int)blockIdx.x; asm volatile("" : "+s"(vcu_), "+s"(G_), "+s"(bx_))
#ifndef PHASE_MASK
#define PHASE_MASK 0x7ff
#endif
#define RUN(p) (((PHASE_MASK >> (p)) & 1) && a_plo <= (p) && (p) < a_phi)
#ifndef PROBE_REP
#define PROBE_REP 0
#endif
#ifndef STG_PIN
#define STG_PIN 0
#endif
#ifndef STG_POUT
#define STG_POUT 0
#endif
#ifndef STG_M1
#define STG_M1 0
#endif
#ifndef STG_M2
#define STG_M2 0
#endif
#ifndef PROBE_KREP
#define PROBE_KREP 0
#endif
#define PKR_ ((PROBE_KREP == 1 && rep_ + 1 < nreps_) ? 2 : 1)
#define PER_ ((PROBE_KREP == 2 && rep_ + 1 < nreps_) ? 2 : (PROBE_KREP == 3 && rep_ + 1 < nreps_) ? 0 : 1)
#ifndef PROBE_PAR
#define PROBE_PAR 0
#endif
#define REPS(p) _Pragma("unroll 1") for (int nreps_ = 1 + (((PROBE_REP >> (p)) & 1) && (PROBE_PAR == 0 || (PROBE_PAR == 1 && !(l_probe & 1)) || (PROBE_PAR == 2 && (l_probe & 1))) ? 1 : 0), rep_ = 0; rep_ < nreps_; ++rep_)
    { const int l_probe = 0; if (((PHASE_MASK >> 10) & 1) && a_pro) { REPS(10) { pro_phase(F, ap); GRID_BAR(); } } }
    for (int l = a_llo; l < a_lhi; ++l) {
        int a_plo = a_plo0, a_phi = a_phi0; asm volatile("" : "+s"(a_plo), "+s"(a_phi));
        const bool odd = (l & 1) != 0; const int j = l >> 1; const int l_probe = l;
        if (RUN(0)) REPS(0) { KPROLOG();
            const bf16_t* Bt = odd ? WSP(bf16_t, WS_WINO) + (size_t)j * NO_PR * 1024 : WSP(bf16_t, WS_WINE) + (size_t)j * NE_PR * 1024; const int N = odd ? NO_PR : NE_PR;
            pg8::DenseOrder S; S.init(T_TOK, N, G_, bx_);
            pg8::EpiStoreBf16 E{WSP(bf16_t, WS_PR), N, odd ? (1 << 30) : 2};
#ifdef PROBE_STORE_VARIANT
            if (rep_ + 1 < nreps_) { pg8::EpiStoreBf16T<PROBE_STORE_VARIANT> EV{E.O, E.ldc, E.gelu_from}; pg8::gemm_phase<pg8::EpiStoreBf16T<PROBE_STORE_VARIANT>, pg8::DenseOrder, false>(F.lds, WSP(bf16_t, WS_HB), Bt, 1024, nullptr, S, EV, F.wave, 0x7f7f7f7f, 0x7f7f7f7f, 0x7f7f7f7f, 1, 1, STG_PIN); } else
#endif
            pg8::gemm_phase<pg8::EpiStoreBf16, pg8::DenseOrder, false>(F.lds, WSP(bf16_t, WS_HB), Bt, 1024, nullptr, S, E, F.wave, 0x7f7f7f7f, 0x7f7f7f7f, 0x7f7f7f7f, PKR_, PER_, STG_PIN);
            GRID_BAR();
        }
        if (!odd) {
            if (RUN(1)) REPS(1) { e1b_phase(F, ap, l); GRID_BAR(); }
            if (RUN(2)) REPS(2) { KPROLOG();
                pg8::DenseOrder S; S.init(T_TOK, NQQ, G_, bx_);
                pg8::EpiStoreBf16 E{WSP(bf16_t, WS_QQ), NQQ, 1 << 30};
                pg8::gemm_phase<pg8::EpiStoreBf16, pg8::DenseOrder, false>(F.lds, WSP(bf16_t, WS_CQ), WSP(bf16_t, WS_WQE) + (size_t)j * NQQ * 256, 256, nullptr, S, E, F.wave);
                GRID_BAR();
            }
            if (RUN(3)) REPS(3) { e3a_phase(F, ap); GRID_BAR(); }
        }
        if (RUN(4)) REPS(4) {
#ifndef ATT_SEL
#define ATT_SEL 7
#endif
            if (odd) { if (ATT_SEL & 4) datt_phase(F, ap, l); }
            else { if (ATT_SEL & 1) dsa_phase(F, ap); if (ATT_SEL & 2) gml_phase(F, ap, l); }
            GRID_BAR();
        }
        if (RUN(5)) REPS(5) { KPROLOG();
            const bf16_t* Bt = odd ? WSP(bf16_t, WS_WOUTO) + (size_t)j * 1024 * 1024 : WSP(bf16_t, WS_WOUTE) + (size_t)j * 1024 * NMX; const int K = odd ? 1024 : NMX;
            pg8::DenseOrder S; S.init(T_TOK, D_MODEL, G_, bx_);
            pg8::EpiResid E{WSP(bf16_t, WS_HB), WSP(bf16_t, WS_Z), DN_ALPHA};
#if POUT_FP8
            const unsigned char* Bt8 = odd ? WSP(unsigned char, WS_WOUTO) + (size_t)j * 1024 * 1024 : WSP(unsigned char, WS_WOUTE) + (size_t)j * 1024 * NMX; const int sB = odd ? 0x79797979 : 0x78787878;
            pg8::gemm_phase<pg8::EpiResid, pg8::DenseOrder, false, true>(F.lds, (const bf16_t*)WSP(unsigned char, WS_MX), (const bf16_t*)Bt8, K / 2, nullptr, S, E, F.wave, 0x7c7c7c7c, sB, sB, PKR_, PER_, STG_POUT);
#else
            pg8::gemm_phase<pg8::EpiResid, pg8::DenseOrder, false>(F.lds, WSP(bf16_t, WS_MX), Bt, K, nullptr, S, E, F.wave, 0x7f7f7f7f, 0x7f7f7f7f, 0x7f7f7f7f, PKR_, PER_, STG_POUT);
#endif
            GRID_BAR();
        }
#ifndef LNR_MFMA
#define LNR_MFMA 1
#endif
        if (RUN(6)) { if ((PROBE_REP >> 6) & 1) { if (LNR_MFMA) lnr2_phase(F, ap, l, true); else lnr_phase(F, ap, l, true); GRID_BAR(); } if (LNR_MFMA) lnr2_phase(F, ap, l); else lnr_phase(F, ap, l); GRID_BAR(); }
        if (RUN(7)) REPS(7) { KPROLOG();
            moe_tables(F, l);
            pg8::MoeOrder S; S.npn = 8; S.nunits = __builtin_amdgcn_readfirstlane(F.MISC[MI_RBSTART + 32]) * 8; S.G = G_; S.c = vcu_; S.tab = (const LAS int*)F.MISC;
            pg8::EpiSwiglu E{WSP(bf16_t, WS_ACT), a->in[I_EXP_B_GU] + (size_t)l * NEXP * 2048};
#if MOE_FP8
            pg8::gemm_phase<pg8::EpiSwiglu, pg8::MoeOrder, true, true>(F.lds, WSP(bf16_t, WS_HB8), (const bf16_t*)(WSP(unsigned char, WS_WGU) + (size_t)l * NEXP * 2048 * 1024), 512, WSP(int, WS_ROWTOK), S, E, F.wave, 0x7f7f7f7f, 0x79797979, 0x7c7c7c7c, PKR_, PER_, STG_M1);
#else
            pg8::gemm_phase<pg8::EpiSwiglu, pg8::MoeOrder, true>(F.lds, WSP(bf16_t, WS_HB), WSP(bf16_t, WS_WGU) + (size_t)l * NEXP * 2048 * 1024, 1024, WSP(int, WS_ROWTOK), S, E, F.wave);
#endif
            GRID_BAR();
        }
        if (RUN(8)) REPS(8) { KPROLOG();
            if (!(((PHASE_MASK >> 7) & 1) && a_plo <= 7 && 7 < a_phi)) moe_tables(F, l);
            pg8::MoeOrder S; S.npn = 4; S.nunits = __builtin_amdgcn_readfirstlane(F.MISC[MI_RBSTART + 32]) * 4; S.G = G_; S.c = vcu_; S.tab = (const LAS int*)F.MISC; S.rev = 1;
            pg8::EpiBiasBf16 E{WSP(bf16_t, WS_Y), a->in[I_EXP_B_DN] + (size_t)l * NEXP * 1024};
#if MOE_FP8
            pg8::gemm_phase<pg8::EpiBiasBf16, pg8::MoeOrder, false, true>(F.lds, WSP(bf16_t, WS_ACT), (const bf16_t*)(WSP(unsigned char, WS_WDN) + (size_t)l * NEXP * 1024 * 1024), 512, nullptr, S, E, F.wave, 0x7c7c7c7c, 0x7f7f7f7f, 0x7f7f7f7f, PKR_, PER_, STG_M2);
#else
            pg8::gemm_phase<pg8::EpiBiasBf16, pg8::MoeOrder, false>(F.lds, WSP(bf16_t, WS_ACT), WSP(bf16_t, WS_WDN) + (size_t)l * NEXP * 1024 * 1024, 1024, nullptr, S, E, F.wave);
#endif
            GRID_BAR();
        }
        if (RUN(9)) { if ((PROBE_REP >> 9) & 1) { cmb_phase(F, ap, l, true); GRID_BAR(); } cmb_phase(F, ap, l, false, !(((PHASE_MASK >> 7) & 1) && a_plo <= 7 && 7 < a_phi)); if (l + 1 < DEPTH) GRID_BAR(); }
    }
#undef GRID_BAR
#undef RUN
}

#if MK_CHECK
__global__ void __launch_bounds__(512, 2) mk_chk(Args a_) {
    extern __shared__ __attribute__((aligned(16))) unsigned char lds_raw[];
    Frame F;
    F.lds = (LAS unsigned char*)lds_raw; F.ldsg = (char*)lds_raw; F.MISC = (volatile LAS int*)(F.lds + MISC_OFF);
    F.tid = threadIdx.x; F.lane = F.tid & 63; F.wave = __builtin_amdgcn_readfirstlane(F.tid >> 6);
    F.G = gridDim.x; { const int bx = blockIdx.x; F.vcu = (F.G % 8 == 0) ? (bx % 8) * (F.G / 8) + bx / 8 : bx; }
    ArgsP ap = (ArgsP)__builtin_amdgcn_kernarg_segment_ptr();
    F.ws = ap->ws; F.ctl = (gu32*)(ap->ws + WS_CTL);
    const int l = ap->l_lo, p = ap->p_lo;
    if (p == 21) chk_gemm(F, ap, l, 1);
    if (p == 22) chk_e1b(F, ap, l);
    if (p == 23) chk_gemm(F, ap, l, 3);
    if (p == 24) chk_dsa(F, ap, l);
    if (p == 26) chk_gml(F, ap, l);
    if (p == 27) chk_gemm(F, ap, l, 7);
    if (p == 28) chk_lnr(F, ap, l);
    if (p == 29) chk_moe(F, ap, l);
    if (p == 31) chk_datt(F, ap, l);
    if (p == 40) chk_final(F, ap);
}
#endif

extern "C" void kernel_launch(void* const* d_in, const int* in_sizes, int n_in, void* d_out, int out_size, void* d_ws, size_t ws_size, hipStream_t stream) {
    static int grid = 0;
    if (grid == 0) {
        if (n_in != 32 || in_sizes[0] != T_TOK * D_MODEL || out_size != T_TOK * D_MODEL || ws_size < WS_END) {
            fprintf(stderr, "kernel_launch: shape mismatch: n_in %d in0 %d out %d ws %zu (need %zu)\n", n_in, n_in > 0 ? in_sizes[0] : -1, out_size, ws_size, (size_t)WS_END); grid = -1; return; }
        int dev = 0, cus = 0, per_cu = 0;
        if (hipGetDevice(&dev) != hipSuccess || hipDeviceGetAttribute(&cus, hipDeviceAttributeMultiprocessorCount, dev) != hipSuccess) { fprintf(stderr, "kernel_launch: device query failed\n"); grid = -1; return; }
#if MK_CHECK
        (void)hipFuncSetAttribute((const void*)mk_chk, hipFuncAttributeMaxDynamicSharedMemorySize, LDS_BYTES);
#endif
        if (hipFuncSetAttribute((const void*)mk_fwd, hipFuncAttributeMaxDynamicSharedMemorySize, LDS_BYTES) != hipSuccess) { fprintf(stderr, "kernel_launch: hipFuncSetAttribute failed\n"); grid = -1; return; }
        if (hipOccupancyMaxActiveBlocksPerMultiprocessor(&per_cu, (const void*)mk_fwd, 512, LDS_BYTES) != hipSuccess || per_cu < 1) { fprintf(stderr, "kernel_launch: occupancy query says %d\n", per_cu); }
        (void)hipGetLastError();
        grid = cus;
    }
    if (grid < 0) return;
    if (hipMemsetAsync((char*)d_ws + WS_CTL, 0, CTL_ZERO_BYTES, stream) != hipSuccess) { fprintf(stderr, "kernel_launch: memset failed\n"); return; }
    Args a{};
    for (int i = 0; i < 32; ++i) a.in[i] = (const float*)d_in[i];
    a.out = (float*)d_out; a.ws = (unsigned char*)d_ws;
#if MK_FUSED
    a.l_lo = 0; a.l_hi = DEPTH; a.p_lo = 0; a.p_hi = N_PHASES; a.do_pro = 1; a.fused = 1;
    hipLaunchKernelGGL(mk_fwd, dim3(grid), dim3(512), LDS_BYTES, stream, a);
#else
    a.fused = 0;
    a.l_lo = 0; a.l_hi = 0; a.p_lo = 0; a.p_hi = 0; a.do_pro = 1;
    hipLaunchKernelGGL(mk_fwd, dim3(grid), dim3(512), LDS_BYTES, stream, a);
    a.do_pro = 0;
    for (int l = 0; l < DEPTH; ++l)
        for (int p = 0; p < N_PHASES; ++p) {
            if ((l & 1) && p >= 1 && p <= 3) continue;
            a.l_lo = l; a.l_hi = l + 1; a.p_lo = p; a.p_hi = p + 1;
            hipLaunchKernelGGL(mk_fwd, dim3(grid), dim3(512), LDS_BYTES, stream, a);
#if MK_CHECK
            {
                int cks[3] = {0, 0, 0}; int nck = 0;
                if (l == 0) { if (p == 0) cks[nck++] = 21; if (p == 1) cks[nck++] = 22; if (p == 2) cks[nck++] = 23; if (p == 4) { cks[nck++] = 24; cks[nck++] = 26; } if (p == 5) cks[nck++] = 27; if (p == 6) cks[nck++] = 28; if (p == 8) cks[nck++] = 29; }
                if (l == 1) { if (p == 0) cks[nck++] = 21; if (p == 4) cks[nck++] = 31; if (p == 5) cks[nck++] = 27; }
                if (l == DEPTH - 1 && p == N_PHASES - 1) cks[nck++] = 40;
                for (int c = 0; c < nck; ++c) { a.p_lo = cks[c]; a.p_hi = cks[c] + 1; hipLaunchKernelGGL(mk_chk, dim3(grid), dim3(512), LDS_BYTES, stream, a); }
            }
#endif
        }
#endif
    const hipError_t le = hipPeekAtLastError();
    if (le != hipSuccess) fprintf(stderr, "kernel_launch: launch failed: %s\n", hipGetErrorName(le));
}
```
